# Optimizing an MI355X kernel written in HIP

```python
import jax, jax.numpy as jnp
from jax import lax
import numpy as np

D_MODEL = 2048
BATCH = 1
SEQ = 8192
DEPTH = 2

GRID_W = 64
CTX_LEN = 256
N_HEADS = 16
QK_NOPE_DIM = 128
QK_ROPE_DIM = 64
V_HEAD_DIM = 128
Q_LORA_RANK = 512
KV_LORA_RANK = 512
ROPE_THETA = 10000.0
Q_BLOCK = 128
ATTN_SCALE = (QK_NOPE_DIM + QK_ROPE_DIM) ** -0.5
CONV_WIDTH = 2048
CONV_K = 3
D_FF = 5632
N_EXPERTS = 8
TOP_K = 2
D_FF_EXPERT = 2816
MOE_BLOCK = 128
N_DENSE = (DEPTH + 1) // 2
N_MOE = DEPTH // 2
NORM_EPS = 1e-6
IN_SIZES = (Q_LORA_RANK, KV_LORA_RANK, QK_ROPE_DIM, CONV_WIDTH, CONV_WIDTH, CONV_WIDTH, D_MODEL, D_MODEL)
KV_LO = Q_LORA_RANK
KV_HI = Q_LORA_RANK + KV_LORA_RANK + QK_ROPE_DIM
D_IN = Q_LORA_RANK + KV_LORA_RANK + QK_ROPE_DIM + 3 * CONV_WIDTH + 2 * D_MODEL

kernel_name = 'hybrid_mla_shortconv_moe_dit_prefix'


def rmsnorm(x, g):
    xf = x.astype(jnp.float32)
    y = xf * lax.rsqrt(jnp.mean(xf * xf, axis=-1, keepdims=True) + NORM_EPS)
    return (y * g.astype(jnp.float32)).astype(x.dtype)


def modulate(h, shift, scale):
    return h * (1 + scale) + shift


def axial_rope_tables(n_tokens, dtype):
    rows = n_tokens // GRID_W
    row = jnp.repeat(jnp.arange(rows), GRID_W).astype(jnp.float32)
    col = jnp.tile(jnp.arange(GRID_W), rows).astype(jnp.float32)
    half = QK_ROPE_DIM // 2
    inv_freq = jnp.power(ROPE_THETA, -jnp.arange(0, half, 2, dtype=jnp.float32) / half)
    ang_r = row[:, None] * inv_freq
    ang_c = col[:, None] * inv_freq
    return (jnp.cos(ang_r).astype(dtype), jnp.sin(ang_r).astype(dtype),
            jnp.cos(ang_c).astype(dtype), jnp.sin(ang_c).astype(dtype))


def rotate(x, cos, sin):
    x1, x2 = jnp.split(x, 2, axis=-1)
    cos = cos[None, :, None, :]
    sin = sin[None, :, None, :]
    return jnp.concatenate([x1 * cos - x2 * sin, x2 * cos + x1 * sin], axis=-1)


def rope_2d(x, rot):
    if rot is None:
        return x
    cos_r, sin_r, cos_c, sin_c = rot
    x_row, x_col = jnp.split(x, 2, axis=-1)
    return jnp.concatenate([rotate(x_row, cos_r, sin_r), rotate(x_col, cos_c, sin_c)], axis=-1)


def split_in(p):
    parts, o = [], 0
    for s in IN_SIZES:
        parts.append(p[..., o:o + s])
        o += s
    return parts


def mla_query(q_a, g_qa, w_qb, rot):
    B, L, _ = q_a.shape
    q = (rmsnorm(q_a, g_qa) @ w_qb).reshape(B, L, N_HEADS, QK_NOPE_DIM + QK_ROPE_DIM)
    q_nope, q_rope = q[..., :QK_NOPE_DIM], q[..., QK_NOPE_DIM:]
    return jnp.concatenate([q_nope, rope_2d(q_rope, rot)], axis=-1)


def mla_keys_values(c_kv, k_rope, g_kva, w_kvb, rot):
    B, L, _ = c_kv.shape
    kv = (rmsnorm(c_kv, g_kva) @ w_kvb).reshape(B, L, N_HEADS, QK_NOPE_DIM + V_HEAD_DIM)
    k_nope, v = kv[..., :QK_NOPE_DIM], kv[..., QK_NOPE_DIM:]
    k_r = rope_2d(k_rope[:, :, None, :], rot)
    k_r = jnp.broadcast_to(k_r, (B, L, N_HEADS, QK_ROPE_DIM))
    return jnp.concatenate([k_nope, k_r], axis=-1), v


def block_attention(q, k, v):
    B, L, H, dq = q.shape
    nb = L // Q_BLOCK
    qb = q.reshape(B, nb, Q_BLOCK, H, dq).swapaxes(0, 1)

    def one_block(q_blk):
        s = jnp.einsum('bqhd,bkhd->bhqk', q_blk, k, preferred_element_type=jnp.float32) * ATTN_SCALE
        p = jax.nn.softmax(s, axis=-1).astype(v.dtype)
        return jnp.einsum('bhqk,bkhd->bqhd', p, v)

    o = lax.map(one_block, qb)
    return o.swapaxes(0, 1).reshape(B, L, H, v.shape[-1])


def dwconv_centred(u, w):
    pad = CONV_K // 2
    L = u.shape[1]
    up = jnp.pad(u, ((0, 0), (pad, pad), (0, 0)))
    out = w[0] * up[:, 0:L]
    for j in range(1, CONV_K):
        out = out + w[j] * up[:, j:j + L]
    return out


def mixer(p, rot, ctx_kv, lp):
    B, L, _ = p.shape
    q_a, c_kv, k_rope, cx, cb, cc, ga, gb = split_in(p)
    q = mla_query(q_a, lp['g_qa'], lp['w_qb'], rot)
    k, v = mla_keys_values(c_kv, k_rope, lp['g_kva'], lp['w_kvb'], rot)
    if ctx_kv is None:
        k_all, v_all = k, v
    else:
        k_all = jnp.concatenate([ctx_kv[0], k], axis=1)
        v_all = jnp.concatenate([ctx_kv[1], v], axis=1)
    attn = block_attention(q, k_all, v_all)
    o_a = attn.reshape(B, L, N_HEADS * V_HEAD_DIM) @ lp['w_oa']
    o_b = (cb * dwconv_centred(cc * cx, lp['w_conv'])) @ lp['w_ob']
    merged = jax.nn.sigmoid(ga) * o_a + jax.nn.sigmoid(gb) * o_b
    return merged @ lp['w_o'], (k, v)


def swiglu(h, w_gate, w_up, w_down):
    return (jax.nn.silu(h @ w_gate) * (h @ w_up)) @ w_down


def moe_swiglu(h, w_router, w_gate, w_up, w_down):
    N, D = h.shape
    logits = (h @ w_router).astype(jnp.float32)
    top_val, top_idx = lax.top_k(logits, TOP_K)
    gates = jax.nn.softmax(top_val, axis=-1)
    A = N * TOP_K
    e_flat = top_idx.reshape(A)
    tok_flat = jnp.repeat(jnp.arange(N), TOP_K)
    g_flat = gates.reshape(A)
    order = jnp.argsort(e_flat)
    e_s, tok_s, g_s = e_flat[order], tok_flat[order], g_flat[order]
    counts = jnp.bincount(e_flat, length=N_EXPERTS)
    start = jnp.cumsum(counts) - counts
    padded = (counts + MOE_BLOCK - 1) // MOE_BLOCK * MOE_BLOCK
    p_end = jnp.cumsum(padded)
    p_start = p_end - padded
    dest = p_start[e_s] + jnp.arange(A) - start[e_s]
    n_blocks = -(-A // MOE_BLOCK) + N_EXPERTS
    buf = jnp.zeros((n_blocks * MOE_BLOCK, D), h.dtype).at[dest].set(h[tok_s])
    block_expert = jnp.clip(jnp.searchsorted(p_end, jnp.arange(n_blocks) * MOE_BLOCK, side='right'),
                            0, N_EXPERTS - 1)

    def one_block(args):
        xb, e = args
        return swiglu(xb, w_gate[e], w_up[e], w_down[e])

    ybuf = lax.map(one_block, (buf.reshape(n_blocks, MOE_BLOCK, D), block_expert))
    y_s = ybuf.reshape(-1, D)[dest] * g_s[:, None].astype(h.dtype)
    return jnp.zeros((N, D), h.dtype).at[tok_s].add(y_s)


def setup_inputs(seed: int = 0) -> dict:
    key = jax.random.key(seed)
    ks = iter(jax.random.split(key, 32))
    f32 = jnp.float32

    def nrm(shape, scale):
        return jax.random.normal(next(ks), shape, f32) * scale

    def gain(shape):
        return 1.0 + nrm(shape, 0.02)

    D = D_MODEL
    return {
        'x': nrm((BATCH, SEQ, D), 1.0),
        'c': nrm((BATCH, D), 1.0),
        'ctx': nrm((BATCH, CTX_LEN, D), 1.0),
        'c_ctx': nrm((D,), 1.0),
        'w_ada': nrm((DEPTH, D, 6 * D), 0.5 * D ** -0.5),
        'b_ada': nrm((DEPTH, 6 * D), 0.01),
        'g_attn': gain((DEPTH, D)),
        'w_in': nrm((DEPTH, D, D_IN), D ** -0.5),
        'g_qa': gain((DEPTH, Q_LORA_RANK)),
        'w_qb': nrm((DEPTH, Q_LORA_RANK, N_HEADS * (QK_NOPE_DIM + QK_ROPE_DIM)), Q_LORA_RANK ** -0.5),
        'g_kva': gain((DEPTH, KV_LORA_RANK)),
        'w_kvb': nrm((DEPTH, KV_LORA_RANK, N_HEADS * (QK_NOPE_DIM + V_HEAD_DIM)), KV_LORA_RANK ** -0.5),
        'w_conv': nrm((DEPTH, CONV_K, CONV_WIDTH), CONV_K ** -0.5),
        'w_oa': nrm((DEPTH, N_HEADS * V_HEAD_DIM, D), (N_HEADS * V_HEAD_DIM) ** -0.5),
        'w_ob': nrm((DEPTH, CONV_WIDTH, D), CONV_WIDTH ** -0.5),
        'w_o': nrm((DEPTH, D, D), D ** -0.5),
        'g_ffn': gain((DEPTH, D)),
        'w_gate_dense': nrm((N_DENSE, D, D_FF), D ** -0.5),
        'w_up_dense': nrm((N_DENSE, D, D_FF), D ** -0.5),
        'w_down_dense': nrm((N_DENSE, D_FF, D), D_FF ** -0.5),
        'w_router': nrm((N_MOE, D, N_EXPERTS), D ** -0.5),
        'w_gate_exp': nrm((N_MOE, N_EXPERTS, D, D_FF_EXPERT), D ** -0.5),
        'w_up_exp': nrm((N_MOE, N_EXPERTS, D, D_FF_EXPERT), D ** -0.5),
        'w_down_exp': nrm((N_MOE, N_EXPERTS, D_FF_EXPERT, D), D_FF_EXPERT ** -0.5),
        'g_final': gain((D,)),
    }


def reference(x, c, ctx, c_ctx, w_ada, b_ada, g_attn, w_in, g_qa, w_qb, g_kva, w_kvb, w_conv,
              w_oa, w_ob, w_o, g_ffn, w_gate_dense, w_up_dense, w_down_dense, w_router,
              w_gate_exp, w_up_exp, w_down_exp, g_final):
    B, S, D = x.shape
    rot = axial_rope_tables(S, x.dtype)
    xc = ctx
    Lc = ctx.shape[1]
    for i in range(DEPTH):
        last = i == DEPTH - 1
        mod = jnp.split(jax.nn.silu(c) @ w_ada[i] + b_ada[i], 6, axis=-1)
        sh1, sc1, gt1, sh2, sc2, gt2 = [m[:, None, :] for m in mod]
        sh1c, sc1c, gt1c, sh2c, sc2c, gt2c = jnp.split(jax.nn.silu(c_ctx) @ w_ada[i] + b_ada[i], 6, axis=-1)
        lp = {'g_qa': g_qa[i], 'w_qb': w_qb[i], 'g_kva': g_kva[i], 'w_kvb': w_kvb[i],
              'w_conv': w_conv[i], 'w_oa': w_oa[i], 'w_ob': w_ob[i], 'w_o': w_o[i]}

        h = modulate(rmsnorm(x, g_attn[i]), sh1, sc1)
        hc = modulate(rmsnorm(xc, g_attn[i]), sh1c, sc1c)
        if last:
            kv_c = hc @ w_in[i][:, KV_LO:KV_HI]
            k_c, v_c = mla_keys_values(kv_c[..., :KV_LORA_RANK], kv_c[..., KV_LORA_RANK:],
                                       g_kva[i], w_kvb[i], None)
        else:
            out_c, (k_c, v_c) = mixer(hc @ w_in[i], None, None, lp)
            xc = xc + gt1c * out_c
        out, _ = mixer(h @ w_in[i], rot, (k_c, v_c), lp)
        x = x + gt1 * out

        h2 = modulate(rmsnorm(x, g_ffn[i]), sh2, sc2)
        if not last:
            h2c = modulate(rmsnorm(xc, g_ffn[i]), sh2c, sc2c)
            h2 = jnp.concatenate([h2c, h2], axis=1)
        if i % 2 == 0:
            j = i // 2
            y = swiglu(h2, w_gate_dense[j], w_up_dense[j], w_down_dense[j])
        else:
            j = i // 2
            y = moe_swiglu(h2.reshape(-1, D), w_router[j], w_gate_exp[j], w_up_exp[j],
                           w_down_exp[j]).reshape(h2.shape)
        if not last:
            xc = xc + gt2c * y[:, :Lc]
            y = y[:, Lc:]
        x = x + gt2 * y
    return rmsnorm(x, g_final)
```

```cpp
#include <hip/hip_runtime.h>
#include <cstdio>
#include <cstdint>

constexpr int D = 2048, LC = 256, SEQ = 8192, MT = LC + SEQ, DEPTH = 2;
constexpr int NH = 16, DN = 128, DR = 64, DV = 128, DQK = DN + DR, QL = 512, KVL = 512;
constexpr int CW = 2048, DIN = QL + KVL + DR + 3 * CW + 2 * D;
constexpr int OFF_QA = 0, OFF_CKV = 512, OFF_KR = 1024, OFF_CX = 1088, OFF_CB = OFF_CX + CW, OFF_CC = OFF_CB + CW, OFF_GA = OFF_CC + CW, OFF_GB = OFF_GA + D;
constexpr int DFF = 5632, NE = 8, DFE = 2816;
constexpr float EPS = 1e-6f;
constexpr float ATT_SCALE = 0.07216878364870322f;

namespace slow {
typedef float f32x16 __attribute__((ext_vector_type(16)));

struct GArgs { const float* A; long lda, abs_; const float* B; long sbk, sbn, bbs; const int* rowidx; const int* rioff; const int* Mptr; int M, N, K, pad; };
static_assert(sizeof(GArgs) == 96, "GArgs has no implicit padding");

template <bool BT, class Epi>
__global__ __launch_bounds__(256) void k_gemm(GArgs g, Epi epi) {
    __shared__ float As[32][65];
    __shared__ float Bs[32][65];
    const int b = blockIdx.z, m0 = blockIdx.y * 64, n0 = blockIdx.x * 64;
    const int M = g.Mptr ? g.Mptr[b] : g.M;
    if (m0 >= M) return;
    const int t = threadIdx.x, lane = t & 63, w = t >> 6, wm = w >> 1, wn = w & 1;
    const float* A = g.A + (long)b * g.abs_; const float* B = g.B + (long)b * g.bbs;
    const int ar = t >> 2, ak = (t & 3) * 8, am = m0 + ar;
    long arow = -1;
    if (am < M) { const int base = g.rioff ? g.rioff[b] : 0; arow = g.rowidx ? (long)g.rowidx[base + am] : (long)(base + am); }
    f32x16 acc;
#pragma unroll
    for (int r = 0; r < 16; ++r) acc[r] = 0.f;
    for (int k0 = 0; k0 < g.K; k0 += 32) {
        float4 a0 = make_float4(0.f, 0.f, 0.f, 0.f), a1 = a0, b0, b1;
        if (arow >= 0) { const float4* p = (const float4*)(A + arow * g.lda + k0 + ak); a0 = p[0]; a1 = p[1]; }
        if (BT) { const int bn = t >> 2, bk = (t & 3) * 8; const float4* p = (const float4*)(B + (long)(n0 + bn) * g.sbn + k0 + bk); b0 = p[0]; b1 = p[1]; }
        else    { const int bk = t >> 3, bn = (t & 7) * 8; const float4* p = (const float4*)(B + (long)(k0 + bk) * g.sbk + n0 + bn); b0 = p[0]; b1 = p[1]; }
        __syncthreads();
        As[ak + 0][ar] = a0.x; As[ak + 1][ar] = a0.y; As[ak + 2][ar] = a0.z; As[ak + 3][ar] = a0.w;
        As[ak + 4][ar] = a1.x; As[ak + 5][ar] = a1.y; As[ak + 6][ar] = a1.z; As[ak + 7][ar] = a1.w;
        if (BT) { const int bn = t >> 2, bk = (t & 3) * 8;
            Bs[bk + 0][bn] = b0.x; Bs[bk + 1][bn] = b0.y; Bs[bk + 2][bn] = b0.z; Bs[bk + 3][bn] = b0.w;
            Bs[bk + 4][bn] = b1.x; Bs[bk + 5][bn] = b1.y; Bs[bk + 6][bn] = b1.z; Bs[bk + 7][bn] = b1.w; }
        else { const int bk = t >> 3, bn = (t & 7) * 8;
            Bs[bk][bn + 0] = b0.x; Bs[bk][bn + 1] = b0.y; Bs[bk][bn + 2] = b0.z; Bs[bk][bn + 3] = b0.w;
            Bs[bk][bn + 4] = b1.x; Bs[bk][bn + 5] = b1.y; Bs[bk][bn + 6] = b1.z; Bs[bk][bn + 7] = b1.w; }
        __syncthreads();
#pragma unroll
        for (int kk = 0; kk < 32; kk += 2) {
            const float a = As[kk + (lane >> 5)][wm * 32 + (lane & 31)];
            const float bb = Bs[kk + (lane >> 5)][wn * 32 + (lane & 31)];
            acc = __builtin_amdgcn_mfma_f32_32x32x2f32(a, bb, acc, 0, 0, 0);
        }
    }
    const int base = g.rioff ? g.rioff[b] : 0;
#pragma unroll
    for (int r = 0; r < 16; ++r) {
        const int row = m0 + wm * 32 + (r & 3) + 8 * (r >> 2) + 4 * (lane >> 5), col = n0 + wn * 32 + (lane & 31);
        if (row < M) epi(b, base + row, col, acc[r]);
    }
}
struct EpiStore { float* C; long ldc, cbs; float alpha; int accum;
    __device__ void operator()(int b, int row, int col, float v) const { float* p = C + (long)b * cbs + (long)row * ldc + col; *p = accum ? *p + alpha * v : alpha * v; } };
struct EpiResid { float* X; const float* gl; const float* gc;
    __device__ void operator()(int, int row, int col, float v) const { float* p = X + (long)row * D + col; *p += (row < LC ? gc[col] : gl[col]) * v; } };

template <bool BT, class Epi> static void gemm(hipStream_t st, const GArgs& g, const Epi& e, int nbatch, int maxM) {
    dim3 grid(g.N / 64, (maxM + 63) / 64, nbatch);
    hipLaunchKernelGGL((k_gemm<BT, Epi>), grid, dim3(256), 0, st, g, e);
}

__device__ __forceinline__ float block_sum(float v, float* red) {
#pragma unroll
    for (int o = 32; o > 0; o >>= 1) v += __shfl_xor(v, o);
    __syncthreads();
    if ((threadIdx.x & 63) == 0) red[threadIdx.x >> 6] = v;
    __syncthreads();
    return red[0] + red[1] + red[2] + red[3];
}
__device__ __forceinline__ float block_max(float v, float* red) {
#pragma unroll
    for (int o = 32; o > 0; o >>= 1) v = fmaxf(v, __shfl_xor(v, o));
    __syncthreads();
    if ((threadIdx.x & 63) == 0) red[threadIdx.x >> 6] = v;
    __syncthreads();
    return fmaxf(fmaxf(red[0], red[1]), fmaxf(red[2], red[3]));
}
__device__ __forceinline__ float silu(float x) { return x / (1.f + expf(-x)); }
__device__ __forceinline__ float sigm(float x) { return 1.f / (1.f + expf(-x)); }

__global__ void k_copy_x(const float* ctx, const float* x, float* XL) {
    const long n = (long)MT * D / 4; const float4* c4 = (const float4*)ctx; const float4* x4 = (const float4*)x; float4* o = (float4*)XL; const long nc = (long)LC * D / 4;
    for (long i = blockIdx.x * 256L + threadIdx.x; i < n; i += gridDim.x * 256L) o[i] = i < nc ? c4[i] : x4[i - nc];
}
__global__ void k_ada(const float* c, const float* cctx, const float* w_ada, const float* b_ada, float* MOD) {
    const int n = blockIdx.x * 256 + threadIdx.x, lv = blockIdx.y, l = lv >> 1, v = lv & 1;
    const float* cv = v ? cctx : c; const float* W = w_ada + (long)l * D * (6 * D);
    float acc = 0.f;
    for (int k = 0; k < D; ++k) acc += silu(cv[k]) * W[(long)k * (6 * D) + n];
    MOD[(long)lv * (6 * D) + n] = acc + b_ada[l * 6 * D + n];
}
__global__ __launch_bounds__(256) void k_modnorm(const float* X, const float* g, const float* modl, const float* modc, int sh_off, int sc_off, float* H) {
    __shared__ float red[4];
    const int r = blockIdx.x; const float* x = X + (long)r * D; const float* mod = r < LC ? modc : modl;
    float v[8]; float ss = 0.f;
#pragma unroll
    for (int j = 0; j < 8; ++j) { v[j] = x[threadIdx.x + 256 * j]; ss += v[j] * v[j]; }
    ss = block_sum(ss, red);
    const float rs = rsqrtf(ss * (1.f / D) + EPS);
#pragma unroll
    for (int j = 0; j < 8; ++j) { const int c = threadIdx.x + 256 * j; H[(long)r * D + c] = (v[j] * rs * g[c]) * (1.f + mod[sc_off + c]) + mod[sh_off + c]; }
}
__global__ __launch_bounds__(256) void k_rms512(const float* P, int off, const float* g, float* out) {
    __shared__ float red[4];
    const int r = blockIdx.x; const float* x = P + (long)r * DIN + off;
    const float a = x[threadIdx.x], b = x[threadIdx.x + 256];
    const float ss = block_sum(a * a + b * b, red);
    const float rs = rsqrtf(ss * (1.f / 512.f) + EPS);
    out[(long)r * 512 + threadIdx.x] = a * rs * g[threadIdx.x]; out[(long)r * 512 + threadIdx.x + 256] = b * rs * g[threadIdx.x + 256];
}
__device__ __forceinline__ float inv_freq(int i) { return powf(10000.f, -(float)(2 * i) / 32.f); }
__global__ void k_rope_q(float* Q) {
    const long idx = blockIdx.x * 256L + threadIdx.x;
    if (idx >= (long)SEQ * NH * 32) return;
    const int i = idx & 15, part = (idx >> 4) & 1, h = (idx >> 5) & 15; const int t = (int)(idx >> 9);
    const float pos = part ? (float)(t % 64) : (float)(t / 64);
    const float ang = pos * inv_freq(i), cs = cosf(ang), sn = sinf(ang);
    float* p = Q + (long)(LC + t) * (NH * DQK) + h * DQK + DN + part * 32;
    const float x1 = p[i], x2 = p[i + 16];
    p[i] = x1 * cs - x2 * sn; p[i + 16] = x2 * cs + x1 * sn;
}
__global__ void k_rope_k(const float* P, float* KR) {
    const long idx = blockIdx.x * 256L + threadIdx.x;
    if (idx >= (long)MT * 32) return;
    const int i = idx & 15, part = (idx >> 4) & 1; const int r = (int)(idx >> 5);
    const float* p = P + (long)r * DIN + OFF_KR + part * 32; float* o = KR + (long)r * DR + part * 32;
    const float x1 = p[i], x2 = p[i + 16];
    if (r < LC) { o[i] = x1; o[i + 16] = x2; return; }
    const int t = r - LC; const float pos = part ? (float)(t % 64) : (float)(t / 64);
    const float ang = pos * inv_freq(i), cs = cosf(ang), sn = sinf(ang);
    o[i] = x1 * cs - x2 * sn; o[i + 16] = x2 * cs + x1 * sn;
}
__global__ __launch_bounds__(256) void k_softmax(float* SC, int n) {
    __shared__ float red[4];
    float* s = SC + (long)blockIdx.x * n;
    float mx = -3.0e38f;
    for (int j = threadIdx.x; j < n; j += 256) mx = fmaxf(mx, s[j]);
    mx = block_max(mx, red);
    float sum = 0.f;
    for (int j = threadIdx.x; j < n; j += 256) { const float e = expf(s[j] - mx); s[j] = e; sum += e; }
    sum = block_sum(sum, red);
    const float inv = 1.f / sum;
    for (int j = threadIdx.x; j < n; j += 256) s[j] *= inv;
}
__global__ void k_conv(const float* P, const float* wconv, float* V2) {
    const long idx = blockIdx.x * 256L + threadIdx.x; if (idx >= (long)MT * CW) return;
    const int c = idx % CW; const int r = (int)(idx / CW);
    const int lo = r < LC ? 0 : LC, hi = r < LC ? LC : MT;
    const float* p = P + (long)r * DIN;
    float acc = wconv[CW + c] * (p[OFF_CC + c] * p[OFF_CX + c]);
    if (r - 1 >= lo) acc += wconv[c] * (p[OFF_CC + c - DIN] * p[OFF_CX + c - DIN]);
    if (r + 1 < hi) acc += wconv[2 * CW + c] * (p[OFF_CC + c + DIN] * p[OFF_CX + c + DIN]);
    V2[idx] = p[OFF_CB + c] * acc;
}
__global__ void k_merge(const float* P, const float* OA, const float* OB, float* MG) {
    const long idx = blockIdx.x * 256L + threadIdx.x; if (idx >= (long)MT * D) return;
    const int c = idx % D; const long r = idx / D;
    MG[idx] = sigm(P[r * DIN + OFF_GA + c]) * OA[idx] + sigm(P[r * DIN + OFF_GB + c]) * OB[idx];
}
__global__ void k_swiglu(float* G, const float* U, long n) {
    for (long i = blockIdx.x * 256L + threadIdx.x; i < n; i += gridDim.x * 256L) G[i] = silu(G[i]) * U[i];
}
__global__ __launch_bounds__(256) void k_router(const float* H2, const float* wr, int* sel, float* gw) {
    const int t = blockIdx.x * 4 + (threadIdx.x >> 6), lane = threadIdx.x & 63;
    const float* h = H2 + (long)(LC + t) * D;
    float lg[NE];
#pragma unroll
    for (int e = 0; e < NE; ++e) lg[e] = 0.f;
    for (int k = lane; k < D; k += 64) { const float hv = h[k];
#pragma unroll
        for (int e = 0; e < NE; ++e) lg[e] += hv * wr[k * NE + e]; }
#pragma unroll
    for (int e = 0; e < NE; ++e) {
#pragma unroll
        for (int o = 32; o > 0; o >>= 1) lg[e] += __shfl_xor(lg[e], o); }
    if (lane == 0) {
        int e0 = 0; for (int e = 1; e < NE; ++e) if (lg[e] > lg[e0]) e0 = e;
        int e1 = e0 == 0 ? 1 : 0; for (int e = 0; e < NE; ++e) if (e != e0 && lg[e] > lg[e1]) e1 = e;
        const float m = lg[e0], a = 1.f, b = expf(lg[e1] - m), inv = 1.f / (a + b);
        sel[2 * t] = e0; sel[2 * t + 1] = e1; gw[2 * t] = a * inv; gw[2 * t + 1] = b * inv;
    }
}
__global__ __launch_bounds__(512) void k_sort(const int* sel, int* cnt, int* off, int* toklist, int* slot_of) {
    __shared__ int scnt[NE];
    const int e = threadIdx.x >> 6, lane = threadIdx.x & 63; const int NA = 2 * SEQ;
    int c = 0;
    for (int a0 = 0; a0 < NA; a0 += 64) c += __popcll(__ballot(sel[a0 + lane] == e));
    if (lane == 0) scnt[e] = c;
    __syncthreads();
    int base = 0; for (int j = 0; j < e; ++j) base += scnt[j];
    if (lane == 0) { cnt[e] = c; off[e] = base; }
    int pos = base;
    for (int a0 = 0; a0 < NA; a0 += 64) {
        const bool f = sel[a0 + lane] == e; const unsigned long long m = __ballot(f);
        if (f) { const int p = pos + __popcll(m & ((1ull << lane) - 1ull)); toklist[p] = LC + (a0 + lane) / 2; slot_of[a0 + lane] = p; }
        pos += __popcll(m);
    }
}
__global__ void k_moe_combine(float* XL, const float* Ys, const int* slot_of, const float* gw, const float* gt2) {
    const long idx = blockIdx.x * 256L + threadIdx.x; if (idx >= (long)SEQ * D) return;
    const int c = idx % D; const int t = (int)(idx / D);
    const float y = gw[2 * t] * Ys[(long)slot_of[2 * t] * D + c] + gw[2 * t + 1] * Ys[(long)slot_of[2 * t + 1] * D + c];
    XL[(long)(LC + t) * D + c] += gt2[c] * y;
}
__global__ __launch_bounds__(256) void k_final(const float* XL, const float* g, float* out) {
    __shared__ float red[4];
    const int r = blockIdx.x; const float* x = XL + (long)(LC + r) * D;
    float v[8]; float ss = 0.f;
#pragma unroll
    for (int j = 0; j < 8; ++j) { v[j] = x[threadIdx.x + 256 * j]; ss += v[j] * v[j]; }
    ss = block_sum(ss, red);
    const float rs = rsqrtf(ss * (1.f / D) + EPS);
#pragma unroll
    for (int j = 0; j < 8; ++j) { const int c = threadIdx.x + 256 * j; out[(long)r * D + c] = v[j] * rs * g[c]; }
}

static inline int nblk(long n) { return (int)((n + 255) / 256); }

static void forward(void* const* d_in, float* out, float* ws, size_t ws_floats, hipStream_t st) {
    const float* x = (const float*)d_in[0]; const float* c = (const float*)d_in[1]; const float* ctx = (const float*)d_in[2]; const float* cctx = (const float*)d_in[3];
    const float* w_ada = (const float*)d_in[4]; const float* b_ada = (const float*)d_in[5]; const float* g_attn = (const float*)d_in[6]; const float* w_in = (const float*)d_in[7];
    const float* g_qa = (const float*)d_in[8]; const float* w_qb = (const float*)d_in[9]; const float* g_kva = (const float*)d_in[10]; const float* w_kvb = (const float*)d_in[11];
    const float* w_conv = (const float*)d_in[12]; const float* w_oa = (const float*)d_in[13]; const float* w_ob = (const float*)d_in[14]; const float* w_o = (const float*)d_in[15];
    const float* g_ffn = (const float*)d_in[16]; const float* w_gd = (const float*)d_in[17]; const float* w_ud = (const float*)d_in[18]; const float* w_dd = (const float*)d_in[19];
    const float* w_router = (const float*)d_in[20]; const float* w_ge = (const float*)d_in[21]; const float* w_ue = (const float*)d_in[22]; const float* w_de = (const float*)d_in[23];
    const float* g_final = (const float*)d_in[24];
    size_t o = 0; auto take = [&](size_t n) { float* p = ws + o; o += (n + 63) / 64 * 64; return p; };
    float* XL = take((size_t)MT * D); float* MOD = take(4 * 6 * D); float* H = take((size_t)MT * D); float* P = take((size_t)MT * DIN);
    float* QN = take((size_t)MT * 512); float* CN = take((size_t)MT * 512); float* Q = take((size_t)MT * NH * DQK); float* KV = take((size_t)MT * NH * 256);
    float* KR = take((size_t)MT * DR); float* SC = take((size_t)NH * 256 * MT); float* ATT = take((size_t)MT * D);
    int* IB = (int*)take(4 * SEQ + 64 + 2 * SEQ + 2 * SEQ);
    if (o > ws_floats) { fprintf(stderr, "slow::forward: workspace too small (%zu > %zu floats)\n", o, ws_floats); return; }
    int* sel = IB; int* slot_of = IB + 2 * SEQ; int* toklist = IB + 4 * SEQ; int* cnt = IB + 6 * SEQ; int* off = cnt + 8; float* gw = (float*)(IB + 6 * SEQ + 64);
    float* OA = SC; float* OB = SC + (size_t)MT * D; float* V2 = SC + 2 * (size_t)MT * D; float* MG = SC + 3 * (size_t)MT * D;
    static_assert((size_t)NH * 256 * MT >= 2 * (size_t)MT * D, "SC region");
    V2 = Q; MG = KV;
    float* OUT = H; float* H2 = H; float* G = P; float* U = P + (size_t)MT * DFF; float* Y = Q; float* Ys = KV;
    static_assert((size_t)MT * DIN >= 2 * (size_t)MT * DFF, "P region holds G and U");

    hipLaunchKernelGGL(k_copy_x, dim3(2048), dim3(256), 0, st, ctx, x, XL);
    hipLaunchKernelGGL(k_ada, dim3(6 * D / 256, 4), dim3(256), 0, st, c, cctx, w_ada, b_ada, MOD);
    for (int i = 0; i < DEPTH; ++i) {
        const bool last = (i == DEPTH - 1);
        const float* modl = MOD + (size_t)(2 * i) * 6 * D; const float* modc = MOD + (size_t)(2 * i + 1) * 6 * D;
        hipLaunchKernelGGL(k_modnorm, dim3(MT), dim3(256), 0, st, XL, g_attn + i * D, modl, modc, 0, D, H);
        { GArgs g{H, D, 0, w_in + (size_t)i * D * DIN, DIN, 1, 0, nullptr, nullptr, nullptr, MT, DIN, D}; gemm<false>(st, g, EpiStore{P, DIN, 0, 1.f, 0}, 1, MT); }
        hipLaunchKernelGGL(k_rms512, dim3(MT), dim3(256), 0, st, P, OFF_QA, g_qa + i * QL, QN);
        hipLaunchKernelGGL(k_rms512, dim3(MT), dim3(256), 0, st, P, OFF_CKV, g_kva + i * KVL, CN);
        { GArgs g{QN, 512, 0, w_qb + (size_t)i * QL * NH * DQK, NH * DQK, 1, 0, nullptr, nullptr, nullptr, MT, NH * DQK, QL}; gemm<false>(st, g, EpiStore{Q, NH * DQK, 0, 1.f, 0}, 1, MT); }
        { GArgs g{CN, 512, 0, w_kvb + (size_t)i * KVL * NH * 256, NH * 256, 1, 0, nullptr, nullptr, nullptr, MT, NH * 256, KVL}; gemm<false>(st, g, EpiStore{KV, NH * 256, 0, 1.f, 0}, 1, MT); }
        hipLaunchKernelGGL(k_rope_q, dim3(nblk((long)SEQ * NH * 32)), dim3(256), 0, st, Q);
        hipLaunchKernelGGL(k_rope_k, dim3(nblk((long)MT * 32)), dim3(256), 0, st, P, KR);
        for (int ch = last ? 0 : -1; ch < SEQ / 256; ++ch) {
            const int q0 = ch < 0 ? 0 : LC + 256 * ch, nk = ch < 0 ? LC : MT;
            { GArgs g{Q + (size_t)q0 * NH * DQK, NH * DQK, DQK, KV, 1, NH * 256, 256, nullptr, nullptr, nullptr, 256, nk, DN}; gemm<true>(st, g, EpiStore{SC, nk, (long)256 * nk, ATT_SCALE, 0}, NH, 256); }
            { GArgs g{Q + (size_t)q0 * NH * DQK + DN, NH * DQK, DQK, KR, 1, DR, 0, nullptr, nullptr, nullptr, 256, nk, DR}; gemm<true>(st, g, EpiStore{SC, nk, (long)256 * nk, ATT_SCALE, 1}, NH, 256); }
            hipLaunchKernelGGL(k_softmax, dim3(NH * 256), dim3(256), 0, st, SC, nk);
            { GArgs g{SC, nk, (long)256 * nk, KV + DN, NH * 256, 1, 256, nullptr, nullptr, nullptr, 256, DV, nk}; gemm<false>(st, g, EpiStore{ATT + (size_t)q0 * D, D, DV, 1.f, 0}, NH, 256); }
        }
        { GArgs g{ATT, D, 0, w_oa + (size_t)i * D * D, D, 1, 0, nullptr, nullptr, nullptr, MT, D, D}; gemm<false>(st, g, EpiStore{OA, D, 0, 1.f, 0}, 1, MT); }
        hipLaunchKernelGGL(k_conv, dim3(nblk((long)MT * CW)), dim3(256), 0, st, P, w_conv + (size_t)i * 3 * CW, V2);
        { GArgs g{V2, CW, 0, w_ob + (size_t)i * CW * D, D, 1, 0, nullptr, nullptr, nullptr, MT, D, CW}; gemm<false>(st, g, EpiStore{OB, D, 0, 1.f, 0}, 1, MT); }
        hipLaunchKernelGGL(k_merge, dim3(nblk((long)MT * D)), dim3(256), 0, st, P, OA, OB, MG);
        { GArgs g{MG, D, 0, w_o + (size_t)i * D * D, D, 1, 0, nullptr, nullptr, nullptr, MT, D, D}; gemm<false>(st, g, EpiResid{XL, modl + 2 * D, modc + 2 * D}, 1, MT); }
        hipLaunchKernelGGL(k_modnorm, dim3(MT), dim3(256), 0, st, XL, g_ffn + i * D, modl, modc, 3 * D, 4 * D, H2);
        if (i % 2 == 0) {
            const int j = i / 2;
            { GArgs g{H2, D, 0, w_gd + (size_t)j * D * DFF, DFF, 1, 0, nullptr, nullptr, nullptr, MT, DFF, D}; gemm<false>(st, g, EpiStore{G, DFF, 0, 1.f, 0}, 1, MT); }
            { GArgs g{H2, D, 0, w_ud + (size_t)j * D * DFF, DFF, 1, 0, nullptr, nullptr, nullptr, MT, DFF, D}; gemm<false>(st, g, EpiStore{U, DFF, 0, 1.f, 0}, 1, MT); }
            hipLaunchKernelGGL(k_swiglu, dim3(4096), dim3(256), 0, st, G, U, (long)MT * DFF);
            { GArgs g{G, DFF, 0, w_dd + (size_t)j * DFF * D, D, 1, 0, nullptr, nullptr, nullptr, MT, D, DFF}; gemm<false>(st, g, EpiResid{XL, modl + 5 * D, modc + 5 * D}, 1, MT); }
        } else {
            const int j = i / 2;
            float* Ge = P; float* Ue = P + (size_t)2 * SEQ * DFE;
            hipLaunchKernelGGL(k_router, dim3(SEQ / 4), dim3(256), 0, st, H2, w_router + (size_t)j * D * NE, sel, gw);
            hipLaunchKernelGGL(k_sort, dim3(1), dim3(512), 0, st, sel, cnt, off, toklist, slot_of);
            { GArgs g{H2, D, 0, w_ge + (size_t)j * NE * D * DFE, DFE, 1, (long)D * DFE, toklist, off, cnt, 0, DFE, D}; gemm<false>(st, g, EpiStore{Ge, DFE, 0, 1.f, 0}, NE, SEQ); }
            { GArgs g{H2, D, 0, w_ue + (size_t)j * NE * D * DFE, DFE, 1, (long)D * DFE, toklist, off, cnt, 0, DFE, D}; gemm<false>(st, g, EpiStore{Ue, DFE, 0, 1.f, 0}, NE, SEQ); }
            hipLaunchKernelGGL(k_swiglu, dim3(4096), dim3(256), 0, st, Ge, Ue, (long)2 * SEQ * DFE);
            { GArgs g{Ge, DFE, 0, w_de + (size_t)j * NE * DFE * D, D, 1, (long)DFE * D, nullptr, off, cnt, 0, D, DFE}; gemm<false>(st, g, EpiStore{Ys, D, 0, 1.f, 0}, NE, SEQ); }
            hipLaunchKernelGGL(k_moe_combine, dim3(nblk((long)SEQ * D)), dim3(256), 0, st, XL, Ys, slot_of, gw, modl + 5 * D);
        }
        (void)OUT; (void)Y;
    }
    hipLaunchKernelGGL(k_final, dim3(SEQ), dim3(256), 0, st, XL, g_final, out);
}
}


namespace mk {
#define LAS __attribute__((address_space(3)))
#define GAS __attribute__((address_space(1)))
typedef unsigned short bf16;
typedef short bf16x8 __attribute__((ext_vector_type(8)));
typedef short s16x4 __attribute__((ext_vector_type(4)));
typedef float f32x2 __attribute__((ext_vector_type(2)));
typedef float f32x4 __attribute__((ext_vector_type(4)));
typedef float f32x16 __attribute__((ext_vector_type(16)));
typedef unsigned u32x2 __attribute__((ext_vector_type(2)));
typedef unsigned u32x4 __attribute__((ext_vector_type(4)));
typedef __bf16 bf16x2_t __attribute__((ext_vector_type(2)));
typedef int i32x4 __attribute__((ext_vector_type(4)));
typedef GAS unsigned gu32;

constexpr int NWAVES = 8, NTHREADS = 512;
constexpr int NT_IN = 45;
constexpr int NIN = NT_IN * 256;
constexpr int KS_ADA = 16;
constexpr int MAXT = 72;
constexpr int XS_ROWS = MAXT * 256;

constexpr size_t al256(size_t x) { return (x + 255) / 256 * 256; }
constexpr size_t WS_CTL = 0, CTL_BYTES = 1u << 20;
constexpr size_t WS_MOD = WS_CTL + CTL_BYTES;
constexpr size_t WS_PART = WS_MOD + al256((size_t)4 * 6 * D * 4);
constexpr size_t WS_ROPE = WS_PART + al256((size_t)2 * KS_ADA * 2 * 6 * D * 4);
constexpr size_t WS_SEL = WS_ROPE + al256(2 * 128 * 16 * 4);
constexpr size_t WS_GW = WS_SEL + al256((size_t)2 * SEQ * 4);
constexpr size_t WS_SLOT = WS_GW + al256((size_t)2 * SEQ * 4);
constexpr int SC_IN = 0, SC_GU = 2 * NIN, SC_GUE = SC_GU + 2 * DFF, SC_TOTAL = SC_GUE + NE * 2 * DFE;
constexpr size_t WS_HSC = WS_SLOT + al256((size_t)2 * SEQ * 4);
constexpr size_t WS_XSC = WS_HSC + al256((size_t)MT * 4);
constexpr size_t WS_WSC = WS_XSC + al256((size_t)XS_ROWS * 4);
constexpr size_t CTL_COLMAX = 65536;
static_assert(CTL_COLMAX + (size_t)SC_TOTAL * 4 <= CTL_BYTES, "column maxima inside the zeroed control region");
constexpr size_t WS_XL = WS_WSC + al256((size_t)SC_TOTAL * 4);
constexpr size_t WS_HN = WS_XL + al256((size_t)MT * D * 4);
constexpr size_t WS_MIX = WS_HN + al256((size_t)MT * D * 2);
constexpr size_t MX_QC = 0;
constexpr size_t MX_KRB = MX_QC + al256((size_t)MT * 1024 * 2);
constexpr size_t MX_SSQ = MX_KRB + al256((size_t)MT * 64 * 2);
constexpr size_t MX_U = MX_SSQ + al256((size_t)MT * 16 * 4);
constexpr size_t MX_CB = MX_U + al256((size_t)MT * D * 2);
constexpr size_t MX_SGA = MX_CB + al256((size_t)MT * D * 2);
constexpr size_t MX_SGB = MX_SGA + al256((size_t)MT * D * 2);
constexpr size_t MX_Q = MX_SGB + al256((size_t)MT * D * 2);
constexpr size_t MX_KV = MX_Q + al256((size_t)MT * 3072 * 2);
constexpr size_t MX_O = MX_KV + al256((size_t)MT * 4096 * 2);
constexpr size_t MX_V2 = MX_O + al256((size_t)MT * D * 2);
constexpr size_t MX_M1 = MX_V2 + al256((size_t)MT * D * 2);
constexpr size_t MX_MG = MX_M1 + al256((size_t)MT * D * 2);
constexpr size_t MX_END = MX_MG + al256((size_t)MT * D * 2);
constexpr size_t FX_ACT = 0;
constexpr size_t FX_XS = 0;
constexpr size_t FX_ACTE = FX_XS + al256((size_t)XS_ROWS * D * 2);
constexpr size_t FX_YS = FX_ACTE + al256((size_t)XS_ROWS * DFE * 2);
constexpr size_t FX_END = FX_YS + al256((size_t)XS_ROWS * D * 2);
static_assert(MX_SGA - MX_CB == (size_t)MT * D * 2 && MX_SGB - MX_SGA == (size_t)MT * D * 2, "CB | SGA | SGB contiguous");
static_assert(FX_END <= MX_END && (size_t)MT * DFF * 2 <= MX_END, "FFN scratch overlays the mixer scratch");
constexpr size_t WS_W = WS_MIX + MX_END;
constexpr size_t W_IN = 0, W_IN_L = (size_t)NIN * D * 2;
constexpr size_t W_QB = W_IN + 2 * W_IN_L, W_QB_L = (size_t)3072 * 512 * 2;
constexpr size_t W_KVB = W_QB + 2 * W_QB_L, W_KVB_L = (size_t)4096 * 512 * 2;
constexpr size_t W_OA = W_KVB + 2 * W_KVB_L, W_SQ_L = (size_t)D * D * 2;
constexpr size_t W_OB = W_OA + 2 * W_SQ_L, W_O = W_OB + 2 * W_SQ_L;
constexpr size_t W_GU = W_O + 2 * W_SQ_L;
constexpr size_t W_DD = W_GU + (size_t)2 * DFF * D * 2;
constexpr size_t W_GUE = W_DD + (size_t)D * DFF * 2, W_GUE_E = (size_t)2 * DFE * D * 2;
constexpr size_t W_DE = W_GUE + NE * W_GUE_E, W_DE_E = (size_t)D * DFE * 2;
constexpr size_t W_END = W_DE + NE * W_DE_E;
constexpr size_t WS_END = WS_W + W_END;

constexpr int RING_BYTES = 131072;
constexpr int LCTL_OFF = RING_BYTES;
constexpr int LDS_BYTES = 147456;

__device__ __forceinline__ unsigned cvtpk(float lo, float hi) { f32x2 v = {lo, hi}; bf16x2_t b = __builtin_convertvector(v, bf16x2_t); return __builtin_bit_cast(unsigned, b); }
__device__ __forceinline__ u32x4 pack8(f32x4 a, f32x4 b) { u32x4 w; w.x = cvtpk(a[0], a[1]); w.y = cvtpk(a[2], a[3]); w.z = cvtpk(b[0], b[1]); w.w = cvtpk(b[2], b[3]); return w; }
__device__ __forceinline__ void unpack8(u32x4 w, f32x4& a, f32x4& b) {
    a[0] = __uint_as_float(w.x << 16); a[1] = __uint_as_float(w.x & 0xffff0000u); a[2] = __uint_as_float(w.y << 16); a[3] = __uint_as_float(w.y & 0xffff0000u);
    b[0] = __uint_as_float(w.z << 16); b[1] = __uint_as_float(w.z & 0xffff0000u); b[2] = __uint_as_float(w.w << 16); b[3] = __uint_as_float(w.w & 0xffff0000u); }
__device__ __forceinline__ f32x4 unpack4(u32x2 w) { f32x4 a; a[0] = __uint_as_float(w.x << 16); a[1] = __uint_as_float(w.x & 0xffff0000u); a[2] = __uint_as_float(w.y << 16); a[3] = __uint_as_float(w.y & 0xffff0000u); return a; }
__device__ __forceinline__ float fsig(float x) { return __builtin_amdgcn_rcpf(1.f + __builtin_amdgcn_exp2f(-1.4426950408889634f * x)); }
__device__ __forceinline__ f32x4 fsig4(f32x4 x) { f32x4 r; r[0] = fsig(x[0]); r[1] = fsig(x[1]); r[2] = fsig(x[2]); r[3] = fsig(x[3]); return r; }
__device__ __forceinline__ float wave_sum(float v) {
#pragma unroll
    for (int o = 1; o < 64; o <<= 1) v += __shfl_xor(v, o);
    return v;
}
#define LDS_WAIT() asm volatile("s_waitcnt lgkmcnt(0)" ::: "memory")
#define VM_WAIT() asm volatile("s_waitcnt vmcnt(0)" ::: "memory")

namespace pg8 {
constexpr int BM = 256, BK = 64, HALF = 128, HTB = HALF * BK * 2, STAGE_BYTES = 8 * HTB, NXCD = 8, WGM = 8;
__device__ __forceinline__ int lds_byte(int r, int c) { const int st = (r >> 4) * 2 + (c >> 5), rr = r & 15, cc = c & 31, ob = rr * 64 + cc * 2; return st * 1024 + (ob ^ (((ob >> 9) & 1) << 5)); }
__device__ __forceinline__ void stage_rc(int b, int& R, int& C) { const int st = b / 1024, sb = b % 1024, swz = sb ^ (((sb >> 9) & 1) << 5); R = (st >> 1) * 16 + swz / 64; C = (st & 1) * 32 + (swz % 64) / 2; }
__device__ __forceinline__ int perm32(int rho) { const int n = rho >> 4, i = rho & 15; return 8 * (i >> 2) + 4 * n + (i & 3); }
struct Unit { int pm, pn, kind; };
struct Geo { int lda, ldb, K; };
__device__ __forceinline__ void tile_of(int L, int nM, int nN, int& pm, int& pn) {
    const int nwg = nM * nN; int wgid = L; { const int q = nwg / NXCD, r = nwg % NXCD, xcd = wgid % NXCD, off = wgid / NXCD; wgid = (xcd < r ? xcd * (q + 1) : r * (q + 1) + (xcd - r) * q) + off; }
    const int nig = WGM * nN, gid = wgid / nig, fm = gid * WGM, gsz = (nM - fm) < WGM ? (nM - fm) : WGM;
    pm = fm + ((wgid % nig) % gsz); pn = (wgid % nig) / gsz;
}
template <class Epi, class Sched, bool ALIGN_EPI, bool I8 = false>
__device__ __forceinline__ void gemm_phase(LAS unsigned char* lds, const Geo g, const Sched& S, const Epi& E) {
    int tid = threadIdx.x; asm volatile("" : "+v"(tid));
    const int wid = __builtin_amdgcn_readfirstlane(tid >> 6), lane = tid & 63, wr = wid >> 2, wc = wid & 3, fr = lane & 15, fq = lane >> 4;
    const int nt = g.K / BK;
    unsigned voffA[2], voffB[2];
#pragma unroll
    for (int i = 0; i < 2; ++i) { int R, C; stage_rc(tid * 16 + i * 8192, R, C); const int Rb = Epi::PERM ? ((R & ~31) + perm32(R & 31)) : R;
        voffA[i] = (unsigned)(R * g.lda + C) * 2u; voffB[i] = (unsigned)(Rb * g.ldb + C) * 2u; }
    const size_t kstep = (size_t)(BK * 2);
    const size_t hstepA = (size_t)HALF * g.lda * 2, hstepB = (size_t)HALF * g.ldb * 2;
    const unsigned ldsw = (unsigned)wid * 1024u;
    const int aoff = lds_byte(wr * 64 + fr, fq * 8), boff = lds_byte(wc * 32 + fr, fq * 8);
#define PG8_SA(b, h) (((b) * 2 + (h)) * HTB)
#define PG8_SB(b, h) ((4 + (b) * 2 + (h)) * HTB)
#define PG8_STAGE(bufoff, gbase, voff) do { _Pragma("unroll") for (int _i = 0; _i < 2; ++_i) \
        __builtin_amdgcn_global_load_lds((const unsigned*)((const char*)(gbase) + (voff)[_i]), (LAS unsigned*)(lds + (bufoff) + ldsw + _i * 8192), 16, 0, 0); } while (0)
#define PG8_LDA(dst, b, h) do { _Pragma("unroll") for (int m = 0; m < 4; ++m) _Pragma("unroll") for (int k = 0; k < 2; ++k) dst[m][k] = *(const LAS bf16x8*)(lds + PG8_SA(b, h) + aoff + m * 2048 + k * 1024); } while (0)
#define PG8_LDB(dst, b, h) do { _Pragma("unroll") for (int n = 0; n < 2; ++n) _Pragma("unroll") for (int k = 0; k < 2; ++k) dst[n][k] = *(const LAS bf16x8*)(lds + PG8_SB(b, h) + boff + n * 2048 + k * 1024); } while (0)
#define PG8_MMA(ai, bj, At, Bt) do { __builtin_amdgcn_s_setprio(1); _Pragma("unroll") for (int m = 0; m < 4; ++m) _Pragma("unroll") for (int n = 0; n < 2; ++n) _Pragma("unroll") for (int k = 0; k < 2; ++k) { \
        if constexpr (I8) acc[ai][bj][m][n] = __builtin_bit_cast(f32x4, __builtin_amdgcn_mfma_i32_16x16x64_i8(__builtin_bit_cast(i32x4, Bt[n][k]), __builtin_bit_cast(i32x4, At[m][k]), __builtin_bit_cast(i32x4, acc[ai][bj][m][n]), 0, 0, 0)); \
        else acc[ai][bj][m][n] = __builtin_amdgcn_mfma_f32_16x16x32_bf16(Bt[n][k], At[m][k], acc[ai][bj][m][n], 0, 0, 0); } __builtin_amdgcn_s_setprio(0); } while (0)
#define PG8_WAIT_V(n) asm volatile("s_waitcnt vmcnt(" #n ")" ::: "memory")
#define PG8_WAIT_L(n) asm volatile("s_waitcnt lgkmcnt(" #n ")" ::: "memory")
#define PG8_BAR __builtin_amdgcn_s_barrier()
#define PG8_SCHED __builtin_amdgcn_sched_barrier(0)
    Unit cur, nxt; int ui = 0;
    if (!S.next(0, cur)) return;
    float zf = 0.f; asm volatile("" : "+v"(zf));
    f32x4 acc[2][2][4][2];
#pragma unroll
    for (int a = 0; a < 2; ++a)
#pragma unroll
        for (int b = 0; b < 2; ++b)
#pragma unroll
            for (int m = 0; m < 4; ++m)
#pragma unroll
                for (int n = 0; n < 2; ++n) acc[a][b][m][n] = (f32x4){zf, zf, zf, zf};
    bf16x8 At[4][2], B0[2][2], B1[2][2];
    const char* cA = S.abase(cur); const char* cB = S.bbase(cur);
    PG8_STAGE(PG8_SB(0, 0), cB, voffB); PG8_STAGE(PG8_SB(0, 1), cB + hstepB, voffB); PG8_STAGE(PG8_SA(0, 0), cA, voffA); PG8_STAGE(PG8_SA(0, 1), cA + hstepA, voffA);
    if (wr == 1) PG8_BAR;
    PG8_WAIT_V(2); PG8_BAR;
    PG8_STAGE(PG8_SB(1, 0), cB + kstep, voffB); PG8_STAGE(PG8_SA(1, 0), cA + kstep, voffA); PG8_STAGE(PG8_SB(1, 1), cB + hstepB + kstep, voffB);
    PG8_WAIT_V(6); PG8_BAR;
    for (;;) {
        const bool has_next = S.next(ui + 1, nxt);
        const char* nA = has_next ? S.abase(nxt) : cA; const char* nB = has_next ? S.bbase(nxt) : cB;
        for (int t = 0; t < nt; t += 2) {
            const bool last = (t == nt - 2);
            const char* a1 = cA + (size_t)(t + 1) * kstep;
            const char* a2 = last ? nA : cA + (size_t)(t + 2) * kstep; const char* b2 = last ? nB : cB + (size_t)(t + 2) * kstep;
            const char* a3 = a2 + kstep; const char* b3 = b2 + kstep;
            PG8_LDB(B0, 0, 0); PG8_LDB(B1, 0, 1); PG8_SCHED; PG8_LDA(At, 0, 0); PG8_STAGE(PG8_SA(1, 1), a1 + hstepA, voffA);
            PG8_WAIT_V(8); PG8_WAIT_L(0); PG8_BAR; PG8_MMA(0, 0, At, B0); PG8_MMA(0, 1, At, B1); PG8_BAR; PG8_SCHED;
            PG8_LDA(At, 0, 1); PG8_STAGE(PG8_SB(0, 0), b2, voffB); PG8_STAGE(PG8_SB(0, 1), b2 + hstepB, voffB); PG8_STAGE(PG8_SA(0, 0), a2, voffA);
            PG8_WAIT_V(8); PG8_WAIT_L(0); PG8_BAR; PG8_MMA(1, 0, At, B0); PG8_MMA(1, 1, At, B1); PG8_BAR; PG8_SCHED;
            PG8_LDB(B0, 1, 0); PG8_LDB(B1, 1, 1); PG8_SCHED; PG8_LDA(At, 1, 0); PG8_STAGE(PG8_SA(0, 1), a2 + hstepA, voffA);
            PG8_WAIT_V(8); PG8_WAIT_L(0); PG8_BAR; PG8_MMA(0, 0, At, B0); PG8_MMA(0, 1, At, B1); PG8_BAR; PG8_SCHED;
            PG8_LDA(At, 1, 1); PG8_STAGE(PG8_SB(1, 0), b3, voffB); PG8_STAGE(PG8_SB(1, 1), b3 + hstepB, voffB); PG8_STAGE(PG8_SA(1, 0), a3, voffA);
            PG8_WAIT_V(8); PG8_WAIT_L(0); PG8_BAR; PG8_MMA(1, 0, At, B0); PG8_MMA(1, 1, At, B1); PG8_BAR; PG8_SCHED;
        }
        if constexpr (ALIGN_EPI) { if (wr == 0) PG8_BAR; }
        if constexpr (I8) {
            static_assert(Epi::PERM, "the int8 path dequantises in the PERM column layout");
            const float* sa = S.sa(cur) + wr * 64 + fr; const float* sb = S.sb(cur) + wc * 32 + 8 * fq;
            f32x4 sbv[2][2];
#pragma unroll
            for (int b = 0; b < 2; ++b)
#pragma unroll
                for (int n = 0; n < 2; ++n) sbv[b][n] = *(const f32x4*)(sb + b * HALF + 4 * n);
#pragma unroll
            for (int a = 0; a < 2; ++a)
#pragma unroll
                for (int m = 0; m < 4; ++m) { const float sr = sa[a * HALF + m * 16];
#pragma unroll
                    for (int b = 0; b < 2; ++b)
#pragma unroll
                        for (int n = 0; n < 2; ++n) { const i32x4 iv = __builtin_bit_cast(i32x4, acc[a][b][m][n]);
                            acc[a][b][m][n] = (f32x4){(float)iv[0], (float)iv[1], (float)iv[2], (float)iv[3]} * (sbv[b][n] * sr); } }
        }
        E(acc, cur, wr, wc, fr, fq);
        if (!has_next) break;
#pragma unroll
        for (int a = 0; a < 2; ++a)
#pragma unroll
            for (int b = 0; b < 2; ++b)
#pragma unroll
                for (int m = 0; m < 4; ++m)
#pragma unroll
                    for (int n = 0; n < 2; ++n) acc[a][b][m][n] = (f32x4){zf, zf, zf, zf};
        cur = nxt; cA = nA; cB = nB; ++ui;
        if constexpr (ALIGN_EPI) { if (wr == 1) PG8_BAR; }
    }
    PG8_WAIT_V(0);
    if constexpr (!ALIGN_EPI) { if (wr == 0) PG8_BAR; }
    PG8_BAR;
#undef PG8_SA
#undef PG8_SB
#undef PG8_STAGE
#undef PG8_LDA
#undef PG8_LDB
#undef PG8_MMA
#undef PG8_WAIT_V
#undef PG8_WAIT_L
#undef PG8_BAR
#undef PG8_SCHED
}

struct TileOrder {
    int nM, nN, pm0, G, c, nx, xpm, xpn0;
    const char* A; const char* B; size_t tstepA, tstepB; const float* SA; const float* SB;
    __device__ __forceinline__ const float* sa(const Unit& u) const { return SA + (size_t)u.pm * 256; }
    __device__ __forceinline__ const float* sb(const Unit& u) const { return SB + (size_t)u.pn * 256; }
    __device__ __forceinline__ bool next(int i, Unit& u) const {
        const int L = i * G + c, n1 = nM * nN;
        if (L < n1) { tile_of(L, nM, nN, u.pm, u.pn); u.pm += pm0; u.kind = 0; return true; }
        if (L < n1 + nx) { u.pm = xpm; u.pn = xpn0 + (L - n1); u.kind = 0; return true; }
        return false; }
    __device__ __forceinline__ const char* abase(const Unit& u) const { return A + (size_t)u.pm * tstepA; }
    __device__ __forceinline__ const char* bbase(const Unit& u) const { return B + (size_t)u.pn * tstepB; }
};
struct QkvOrder {
    int nMkv, nMq, pm0q, G, c; const char* QC; const char* WQB; long dkv;
    __device__ __forceinline__ bool next(int i, Unit& u) const {
        const int L = i * G + c, n1 = nMkv * 16;
        if (L < n1) { tile_of(L, nMkv, 16, u.pm, u.pn); u.kind = 0; return true; }
        if (L < n1 + nMq * 12) { tile_of(L - n1, nMq, 12, u.pm, u.pn); u.pm += pm0q; u.kind = 1; return true; }
        return false; }
    __device__ __forceinline__ const char* abase(const Unit& u) const { return QC + (size_t)u.pm * (256 * 1024 * 2) + (u.kind == 0 ? 1024 : 0); }
    __device__ __forceinline__ const char* bbase(const Unit& u) const { return WQB + (u.kind == 0 ? dkv : 0l) + (size_t)u.pn * (256 * 512 * 2); }
};
struct MoeOrder {
    int T, nN, G, c; const char* A; const char* B; size_t tstepA, tstepB, estride; const LAS int* te; const float* SA; const float* SB; int sbstride;
    __device__ __forceinline__ const float* sa(const Unit& u) const { return SA + (size_t)u.pm * 256; }
    __device__ __forceinline__ const float* sb(const Unit& u) const { const int e = __builtin_amdgcn_readfirstlane(te[u.pm]); return SB + (size_t)e * sbstride + (size_t)u.pn * 256; }
    __device__ __forceinline__ bool next(int i, Unit& u) const {
        const int L = i * G + c; if (L >= T * nN) return false;
        tile_of(L, T, nN, u.pm, u.pn); u.kind = 0; return true; }
    __device__ __forceinline__ const char* abase(const Unit& u) const { return A + (size_t)u.pm * tstepA; }
    __device__ __forceinline__ const char* bbase(const Unit& u) const { const int e = __builtin_amdgcn_readfirstlane(te[u.pm]); return B + (size_t)e * estride + (size_t)u.pn * tstepB; }
};

typedef const f32x4 (&AccRef)[2][2][4][2];
struct EpiInproj {
    static constexpr bool PERM = true;
    bf16* QC; bf16* KRB; bf16* U; bf16* CB; float* SSQ; const float* ROPE;
    __device__ __forceinline__ void operator()(AccRef acc, const Unit& u, int wr, int wc, int fr_, int fq_) const {
        int fr = fr_, fq = fq_; asm volatile("" : "+v"(fr), "+v"(fq));
        const int pn = u.pn, row0 = u.pm * BM + wr * 64 + fr;
        if (pn < 4) {
#pragma unroll
            for (int ai = 0; ai < 2; ++ai)
#pragma unroll
                for (int m = 0; m < 4; ++m) { const int row = row0 + ai * HALF + m * 16; float s = 0.f;
#pragma unroll
                    for (int bj = 0; bj < 2; ++bj) { const f32x4 v0 = acc[ai][bj][m][0], v1 = acc[ai][bj][m][1];
                        s += (v0[0] * v0[0] + v0[1] * v0[1]) + (v0[2] * v0[2] + v0[3] * v0[3]) + (v1[0] * v1[0] + v1[1] * v1[1]) + (v1[2] * v1[2] + v1[3] * v1[3]);
                        *(u32x4*)(QC + (size_t)row * 1024 + pn * 256 + bj * HALF + wc * 32 + 8 * fq) = pack8(v0, v1); }
                    s += __shfl_xor(s, 16); s += __shfl_xor(s, 32);
                    if (fq == 0) SSQ[(size_t)row * 16 + pn * 4 + wc] = s; }
        } else if (pn == 4) {
            if (wc < 2) {
#pragma unroll
                for (int ai = 0; ai < 2; ++ai)
#pragma unroll
                    for (int m = 0; m < 4; ++m) { const int row = row0 + ai * HALF + m * 16; f32x4 v0 = acc[ai][0][m][0], v1 = acc[ai][0][m][1];
                        if (row >= LC) { const int t = row - LC, pos = wc ? (t & 63) : (t >> 6);
                            const f32x4 cs = *(const f32x4*)(ROPE + pos * 16 + 4 * fq), sn = *(const f32x4*)(ROPE + 2048 + pos * 16 + 4 * fq);
                            const f32x4 a0 = v0, a1 = v1;
                            v0[0] = a0[0] * cs[0] - a0[1] * sn[0]; v0[1] = a0[1] * cs[0] + a0[0] * sn[0]; v0[2] = a0[2] * cs[1] - a0[3] * sn[1]; v0[3] = a0[3] * cs[1] + a0[2] * sn[1];
                            v1[0] = a1[0] * cs[2] - a1[1] * sn[2]; v1[1] = a1[1] * cs[2] + a1[0] * sn[2]; v1[2] = a1[2] * cs[3] - a1[3] * sn[3]; v1[3] = a1[3] * cs[3] + a1[2] * sn[3]; }
                        *(u32x4*)(KRB + (size_t)row * 64 + wc * 32 + 8 * fq) = pack8(v0, v1); }
            }
        } else if (pn < 21) {
            const int j = pn - 5;
#pragma unroll
            for (int ai = 0; ai < 2; ++ai)
#pragma unroll
                for (int m = 0; m < 4; ++m) { const int row = row0 + ai * HALF + m * 16;
                    *(u32x4*)(U + (size_t)row * D + j * 128 + wc * 32 + 8 * fq) = pack8(acc[ai][0][m][0] * acc[ai][1][m][0], acc[ai][0][m][1] * acc[ai][1][m][1]); }
        } else {
            bf16* dst = CB + (size_t)((pn - 21) >> 3) * ((size_t)MT * D); const int col = ((pn - 21) & 7) * 256; const bool sg = pn >= 29;
#pragma unroll
            for (int ai = 0; ai < 2; ++ai)
#pragma unroll
                for (int m = 0; m < 4; ++m) { const int row = row0 + ai * HALF + m * 16;
#pragma unroll
                    for (int bj = 0; bj < 2; ++bj) { f32x4 v0 = acc[ai][bj][m][0], v1 = acc[ai][bj][m][1];
                        if (sg) { v0 = fsig4(v0); v1 = fsig4(v1); }
                        *(u32x4*)(dst + (size_t)row * D + col + bj * HALF + wc * 32 + 8 * fq) = pack8(v0, v1); } }
        }
    }
};
struct EpiQkv {
    static constexpr bool PERM = true;
    bf16* Q; bf16* KV; const float* SSQ; const float* ROPE;
    __device__ __forceinline__ void operator()(AccRef acc, const Unit& u, int wr, int wc, int fr_, int fq_) const {
        int fr = fr_, fq = fq_; asm volatile("" : "+v"(fr), "+v"(fq));
        const int row0 = u.pm * BM + wr * 64 + fr, grp = u.kind == 0 ? 8 : 0;
#pragma unroll
        for (int ai = 0; ai < 2; ++ai)
#pragma unroll
            for (int m = 0; m < 4; ++m) { const int row = row0 + ai * HALF + m * 16;
                const f32x4 s0 = *(const f32x4*)(SSQ + (size_t)row * 16 + grp), s1 = *(const f32x4*)(SSQ + (size_t)row * 16 + grp + 4);
                const float rs = rsqrtf(((s0[0] + s0[1]) + (s0[2] + s0[3]) + (s1[0] + s1[1]) + (s1[2] + s1[3])) * (1.f / 512.f) + EPS);
                const float rq = (u.kind == 0) ? rs : rs * (ATT_SCALE * 1.4426950408889634f);
#pragma unroll
                for (int bj = 0; bj < 2; ++bj) { f32x4 v0 = acc[ai][bj][m][0] * rq, v1 = acc[ai][bj][m][1] * rq;
                    if (u.kind == 0) { *(u32x4*)(KV + (size_t)row * 4096 + u.pn * 256 + bj * HALF + wc * 32 + 8 * fq) = pack8(v0, v1); }
                    else { const int hb = (u.pn * 8 + bj * 4 + wc) % 6;
                        if (hb >= 4 && row >= LC) { const int t = row - LC, pos = (hb == 5) ? (t & 63) : (t >> 6);
                            const f32x4 cs = *(const f32x4*)(ROPE + pos * 16 + 4 * fq), sn = *(const f32x4*)(ROPE + 2048 + pos * 16 + 4 * fq);
                            const f32x4 a0 = v0, a1 = v1;
                            v0[0] = a0[0] * cs[0] - a0[1] * sn[0]; v0[1] = a0[1] * cs[0] + a0[0] * sn[0]; v0[2] = a0[2] * cs[1] - a0[3] * sn[1]; v0[3] = a0[3] * cs[1] + a0[2] * sn[1];
                            v1[0] = a1[0] * cs[2] - a1[1] * sn[2]; v1[1] = a1[1] * cs[2] + a1[0] * sn[2]; v1[2] = a1[2] * cs[3] - a1[3] * sn[3]; v1[3] = a1[3] * cs[3] + a1[2] * sn[3]; }
                        *(u32x4*)(Q + (size_t)row * 3072 + u.pn * 256 + bj * HALF + wc * 32 + 8 * fq) = pack8(v0, v1); } } }
    }
};
template <int MODE> struct EpiMerge {
    static constexpr bool PERM = true;
    const bf16* SG; const bf16* M1; bf16* OUT;
    __device__ __forceinline__ void operator()(AccRef acc, const Unit& u, int wr, int wc, int fr_, int fq_) const {
        int fr = fr_, fq = fq_; asm volatile("" : "+v"(fr), "+v"(fq));
        const int row0 = u.pm * BM + wr * 64 + fr;
#pragma unroll
        for (int ai = 0; ai < 2; ++ai)
#pragma unroll
            for (int m = 0; m < 4; ++m) { const int row = row0 + ai * HALF + m * 16;
#pragma unroll
                for (int bj = 0; bj < 2; ++bj) { const size_t off = (size_t)row * D + u.pn * 256 + bj * HALF + wc * 32 + 8 * fq;
                    f32x4 g0, g1; unpack8(*(const u32x4*)(SG + off), g0, g1);
                    f32x4 v0 = acc[ai][bj][m][0] * g0, v1 = acc[ai][bj][m][1] * g1;
                    if (MODE == 1) { f32x4 m0, m1; unpack8(*(const u32x4*)(M1 + off), m0, m1); v0 += m0; v1 += m1; }
                    *(u32x4*)(OUT + off) = pack8(v0, v1); } }
    }
};
struct EpiSwiglu {
    static constexpr bool PERM = true;
    bf16* ACT; int ld;
    __device__ __forceinline__ void operator()(AccRef acc, const Unit& u, int wr, int wc, int fr_, int fq_) const {
        int fr = fr_, fq = fq_; asm volatile("" : "+v"(fr), "+v"(fq));
        const int row0 = u.pm * BM + wr * 64 + fr;
#pragma unroll
        for (int ai = 0; ai < 2; ++ai)
#pragma unroll
            for (int m = 0; m < 4; ++m) { const int row = row0 + ai * HALF + m * 16;
                const f32x4 g0 = acc[ai][0][m][0], g1 = acc[ai][0][m][1];
                const f32x4 v0 = g0 * fsig4(g0) * acc[ai][1][m][0], v1 = g1 * fsig4(g1) * acc[ai][1][m][1];
                *(u32x4*)(ACT + (size_t)row * ld + u.pn * 128 + wc * 32 + 8 * fq) = pack8(v0, v1); }
    }
};
struct EpiResid {
    static constexpr bool PERM = false;
    float* XL; const float* SRC; const float* gl;
    __device__ __forceinline__ void operator()(AccRef acc, const Unit& u, int wr, int wc, int fr_, int fq_) const {
        int fr = fr_, fq = fq_; asm volatile("" : "+v"(fr), "+v"(fq));
        const int row0 = u.pm * BM + wr * 64 + fr; const float* gate = gl + ((u.pm == 0) ? 6 * D : 0);
#pragma unroll
        for (int bj = 0; bj < 2; ++bj)
#pragma unroll
            for (int n = 0; n < 2; ++n) { const int col = u.pn * 256 + bj * HALF + wc * 32 + 16 * n + 4 * fq; const f32x4 gv = *(const f32x4*)(gate + col);
#pragma unroll
                for (int ai = 0; ai < 2; ++ai)
#pragma unroll
                    for (int m = 0; m < 4; ++m) { const size_t o = (size_t)(row0 + ai * HALF + m * 16) * D + col; *(f32x4*)(XL + o) = *(const f32x4*)(SRC + o) + gv * acc[ai][bj][m][n]; } }
    }
};
struct EpiStoreBf16 {
    static constexpr bool PERM = true;
    bf16* C; int ld;
    __device__ __forceinline__ void operator()(AccRef acc, const Unit& u, int wr, int wc, int fr_, int fq_) const {
        int fr = fr_, fq = fq_; asm volatile("" : "+v"(fr), "+v"(fq));
        const int row0 = u.pm * BM + wr * 64 + fr;
#pragma unroll
        for (int ai = 0; ai < 2; ++ai)
#pragma unroll
            for (int m = 0; m < 4; ++m)
#pragma unroll
                for (int bj = 0; bj < 2; ++bj)
                    *(u32x4*)(C + (size_t)(row0 + ai * HALF + m * 16) * ld + u.pn * 256 + bj * HALF + wc * 32 + 8 * fq) = pack8(acc[ai][bj][m][0], acc[ai][bj][m][1]);
    }
};
}

namespace att {
constexpr int QBLK = 32, KVBLK = 64;
constexpr int LDQ = NH * DQK, LDK = NH * 256, LDR = DR, LDO = D;
constexpr int SHM_V = KVBLK * DV * 2, SHM_K = KVBLK * DQK * 2;
constexpr int OFF_K = 2 * SHM_V, OFF_WS = 2 * SHM_V + 2 * SHM_K, OFF_QR = OFF_WS + NWAVES * 64 * 4, OFF_DO = OFF_QR + NWAVES * 4096, SHM_ATTN = OFF_DO + NTHREADS * 20;
static_assert(SHM_ATTN <= RING_BYTES, "attention scratch inside the ring");
constexpr float THR = 8.f;
#define KSWZ(row, colB) ((row) * 384 + ((colB) ^ (((row) & 7) << 4)))
#define SBAR() __builtin_amdgcn_sched_barrier(0)
__device__ __forceinline__ int crow(int r, int hi) { return (r & 3) + 8 * (r >> 2) + 4 * hi; }
constexpr float THR2 = THR * 1.4426950408889634f;
template <bool FIRST> __device__ __forceinline__ void partialSM(f32x16& p0, f32x16& p1, float& m_reg, f32x16& negm, float& alpha) {
    float pmax = p0[0];
#pragma unroll
    for (int r = 1; r < 16; ++r) pmax = fmaxf(pmax, p0[r]);
#pragma unroll
    for (int r = 0; r < 16; ++r) pmax = fmaxf(pmax, p1[r]);
    { auto rr = __builtin_amdgcn_permlane32_swap(__float_as_uint(pmax), __float_as_uint(pmax), false, false);
      pmax = fmaxf(__uint_as_float(rr[0]), __uint_as_float(rr[1])); }
    alpha = 1.f;
    if (FIRST || !__builtin_expect(__all(pmax <= THR2), 1)) {
        const float d = FIRST ? pmax : fmaxf(pmax, 0.f);
        m_reg += d; if (!FIRST) alpha = __builtin_amdgcn_exp2f(-d);
#pragma unroll
        for (int r = 0; r < 16; ++r) { p0[r] -= d; p1[r] -= d; }
#pragma unroll
        for (int r = 0; r < 16; ++r) negm[r] = -m_reg;
    }
#pragma unroll
    for (int r = 0; r < 16; ++r) p0[r] = __builtin_amdgcn_exp2f(p0[r]);
}
__device__ __forceinline__ void finishSM(f32x16& p0, f32x16& p1, float alpha, float& l_reg, bf16x8& pa0, bf16x8& pa1, bf16x8& pa2, bf16x8& pa3) {
#pragma unroll
    for (int r = 0; r < 16; ++r) p1[r] = __builtin_amdgcn_exp2f(p1[r]);
    f32x2 ps2 = {p0[0], p0[1]};
#pragma unroll
    for (int r = 2; r < 16; r += 2) ps2 += (f32x2){p0[r], p0[r + 1]};
#pragma unroll
    for (int r = 0; r < 16; r += 2) ps2 += (f32x2){p1[r], p1[r + 1]};
    float ps = ps2[0] + ps2[1];
    { auto rr = __builtin_amdgcn_permlane32_swap(__float_as_uint(ps), __float_as_uint(ps), false, false);
      ps = __uint_as_float(rr[0]) + __uint_as_float(rr[1]); }
    l_reg = l_reg * alpha + ps;
#define PK4(P, BASE, OUT) do { u32x4 w = {cvtpk(P[BASE + 0], P[BASE + 1]), cvtpk(P[BASE + 2], P[BASE + 3]), cvtpk(P[BASE + 4], P[BASE + 5]), cvtpk(P[BASE + 6], P[BASE + 7])}; \
    OUT = __builtin_bit_cast(bf16x8, w); } while (0)
    PK4(p0, 0, pa0); PK4(p0, 8, pa1); PK4(p1, 0, pa2); PK4(p1, 8, pa3);
#undef PK4
}
__device__ __forceinline__ void qkt(f32x16& p0, f32x16& p1, const LAS char* Ks, const int (&kb)[4], int krd, const bf16x8* qr, const LAS char* qrl, const f32x16& negm) {
#pragma unroll
    for (int d0 = 0; d0 < 12; ++d0) {
        const LAS char* a = d0 < 8 ? Ks + kb[d0 & 3] + (d0 >> 2) * 128 : Ks + kb[d0 - 8] + krd;
        const bf16x8 b0 = *(const LAS bf16x8*)a;
        const bf16x8 b1 = *(const LAS bf16x8*)(a + (d0 < 8 ? 32 * 256 : 32 * 128));
        if (d0 == 0) { p0 = __builtin_amdgcn_mfma_f32_32x32x16_bf16(b0, qr[0], negm, 0, 0, 0); p1 = __builtin_amdgcn_mfma_f32_32x32x16_bf16(b1, qr[0], negm, 0, 0, 0); }
        else { const bf16x8 qf = d0 < 8 ? qr[d0 & 7] : *(const LAS bf16x8*)(qrl + (d0 - 8) * 1024);
            p0 = __builtin_amdgcn_mfma_f32_32x32x16_bf16(b0, qf, p0, 0, 0, 0); p1 = __builtin_amdgcn_mfma_f32_32x32x16_bf16(b1, qf, p1, 0, 0, 0); } }
}
__device__ __forceinline__ int v_st(int k, int c) { const int kk = (k & ~0xC) | ((k & 4) << 1) | ((k & 8) >> 1); return ((kk >> 3) * 4 + (c >> 5)) * 512 + ((kk & 7) * 32 + (c & 31)) * 2; }
__device__ __forceinline__ int v_rd_base(int lane) { return ((lane & 3) << 3) | (((lane >> 2) & 3) << 6) | (((lane >> 4) & 1) << 5) | (((lane >> 5) & 1) << 8); }
constexpr int v_rd_off(int d0, int ks, int half) { return d0 * 512 + ks * 4096 + half * 2048; }
template <int OFF> __device__ __forceinline__ s16x4 tr_read(int vb) {
    s16x4 r; asm volatile("ds_read_b64_tr_b16 %0, %1 offset:%2" : "=&v"(r) : "v"(vb), "i"(OFF) : "memory"); return r;
}
template <int D0> __device__ __forceinline__ void pv_one(f32x16& od, int vb, bf16x8 pa0, bf16x8 pa1, bf16x8 pa2, bf16x8 pa3) {
    const s16x4 l0 = tr_read<v_rd_off(D0, 0, 0)>(vb), h0 = tr_read<v_rd_off(D0, 0, 1)>(vb), l1 = tr_read<v_rd_off(D0, 1, 0)>(vb), h1 = tr_read<v_rd_off(D0, 1, 1)>(vb);
    const s16x4 l2 = tr_read<v_rd_off(D0, 2, 0)>(vb), h2 = tr_read<v_rd_off(D0, 2, 1)>(vb), l3 = tr_read<v_rd_off(D0, 3, 0)>(vb), h3 = tr_read<v_rd_off(D0, 3, 1)>(vb);
    asm volatile("s_waitcnt lgkmcnt(0)" ::: "memory"); SBAR();
#define PK(L, H) (bf16x8){L[0], L[1], L[2], L[3], H[0], H[1], H[2], H[3]}
    od = __builtin_amdgcn_mfma_f32_32x32x16_bf16(PK(l0, h0), pa0, od, 0, 0, 0);
    od = __builtin_amdgcn_mfma_f32_32x32x16_bf16(PK(l1, h1), pa1, od, 0, 0, 0);
    od = __builtin_amdgcn_mfma_f32_32x32x16_bf16(PK(l2, h2), pa2, od, 0, 0, 0);
    od = __builtin_amdgcn_mfma_f32_32x32x16_bf16(PK(l3, h3), pa3, od, 0, 0, 0);
#undef PK
}
__device__ __forceinline__ void pv_d0(f32x16* o, int vb, bf16x8 pa0, bf16x8 pa1, bf16x8 pa2, bf16x8 pa3) {
    pv_one<0>(o[0], vb, pa0, pa1, pa2, pa3); pv_one<1>(o[1], vb, pa0, pa1, pa2, pa3); pv_one<2>(o[2], vb, pa0, pa1, pa2, pa3); pv_one<3>(o[3], vb, pa0, pa1, pa2, pa3);
}
constexpr int KROPE_OFF = 16384;
__device__ __forceinline__ void attn_unit(const bf16* Qb, const bf16* KVb, int hoff, const bf16* KRb, bf16* Ob, int seq, LAS char* lds) {
    int tid = threadIdx.x; asm volatile("" : "+v"(tid));
    const int wid = __builtin_amdgcn_readfirstlane(tid >> 6), lane = tid & 63, r32 = lane & 31, hi = lane >> 5;
    LAS char* V_lds = lds; LAS char* K_lds = lds + OFF_K;
        float m_reg = 0.f, l_reg = 0; f32x16 o[4]; bf16x8 qr[8]; f32x16 negm;
#pragma unroll
    for (int r = 0; r < 16; ++r) negm[r] = 0.f;
#pragma unroll
    for (int d = 0; d < 4; ++d)
#pragma unroll
        for (int r = 0; r < 16; ++r) o[d][r] = 0.f;
    const bf16* Qw = Qb + (long)(wid * QBLK + r32) * LDQ + hi * 8;
#pragma unroll
    for (int d0 = 0; d0 < 8; ++d0) qr[d0] = *(const bf16x8*)(Qw + d0 * 16);
    LAS char* qrl = lds + OFF_QR + wid * 4096 + lane * 16;
#pragma unroll
    for (int d0 = 8; d0 < 12; ++d0) *(LAS bf16x8*)(qrl + (d0 - 8) * 1024) = *(const bf16x8*)(Qw + d0 * 16);
    int kb[4];
#pragma unroll
    for (int i = 0; i < 4; ++i) kb[i] = r32 * 256 + (((2 * i + hi) ^ (r32 & 7)) << 4);
    const int krd = KROPE_OFF - r32 * 128;
    const int vb0 = (int)(uintptr_t)V_lds + v_rd_base(lane);
    unsigned gk[2], gv[2], gr;
#pragma unroll
    for (int i = 0; i < 2; ++i) { const int s = (wid + 8 * i) * 64 + lane;
        { const int row = s >> 4, lc = (s & 15) ^ (row & 7); gk[i] = (unsigned)(row * (LDK * 2) + lc * 16); }
        { const int st = s >> 5, k = (st >> 2) * 8 + ((s & 31) >> 2), cc = (st & 3) * 32 + (s & 3) * 8; gv[i] = (unsigned)(k * (LDK * 2) + cc * 2); } }
    { const int s = wid * 64 + lane, row = s >> 3, lc = (s & 7) ^ (row & 7); gr = (unsigned)(row * (LDR * 2) + lc * 16); }
    LAS u32x4* dofs = (LAS u32x4*)(lds + OFF_DO + tid * 16); LAS unsigned* dofr = (LAS unsigned*)(lds + OFF_DO + NTHREADS * 16 + tid * 4);
    *dofs = (u32x4){gk[0], gk[1], gv[0], gv[1]}; *dofr = gr;
    const unsigned ldsw = (unsigned)wid * 1024u;
    const __amdgpu_buffer_rsrc_t rkv = __builtin_amdgcn_make_buffer_rsrc((void*)KVb, 0, (int)((size_t)MT * LDK * 2), 0x00020000);
    const __amdgpu_buffer_rsrc_t rkr = __builtin_amdgcn_make_buffer_rsrc((void*)KRb, 0, (int)((size_t)MT * LDR * 2), 0x00020000);
#define DMA_K(t, slot) do { const int ko_ = (t) * (KVBLK * LDK * 2) + hoff, ro_ = (t) * (KVBLK * LDR * 2); const u32x4 of_ = *dofs; const unsigned gr_ = *dofr; \
    __builtin_amdgcn_raw_ptr_buffer_load_lds(rkv, (LAS void*)(K_lds + (slot) * SHM_K + ldsw), 16, (int)of_.x, ko_, 0, 0); \
    __builtin_amdgcn_raw_ptr_buffer_load_lds(rkv, (LAS void*)(K_lds + (slot) * SHM_K + 8192 + ldsw), 16, (int)of_.y, ko_, 0, 0); \
    __builtin_amdgcn_raw_ptr_buffer_load_lds(rkr, (LAS void*)(K_lds + (slot) * SHM_K + KROPE_OFF + ldsw), 16, (int)gr_, ro_, 0, 0); } while (0)
#define DMA_V(t, slot) do { const int vo_ = (t) * (KVBLK * LDK * 2) + hoff + DN * 2; const u32x4 of_ = *dofs; \
    __builtin_amdgcn_raw_ptr_buffer_load_lds(rkv, (LAS void*)(V_lds + (slot) * SHM_V + ldsw), 16, (int)of_.z, vo_, 0, 0); \
    __builtin_amdgcn_raw_ptr_buffer_load_lds(rkv, (LAS void*)(V_lds + (slot) * SHM_V + 8192 + ldsw), 16, (int)of_.w, vo_, 0, 0); } while (0)
#define WAITBAR() asm volatile("s_waitcnt vmcnt(0) lgkmcnt(0)\n\ts_barrier" ::: "memory")
#define RESC(a) do { if (__any((a) < 1.f)) { \
    _Pragma("unroll") for (int d = 0; d < 4; ++d) _Pragma("unroll") for (int r = 0; r < 16; ++r) o[d][r] *= (a); } } while (0)
    f32x16 pA0, pA1, pB0, pB1; float alA, alB; bf16x8 pa0, pa1, pa2, pa3; const int NT = seq / KVBLK;
    if (wid >= 4) __builtin_amdgcn_s_setprio(1);
    DMA_K(0, 0); DMA_V(0, 0); WAITBAR();
    DMA_K(1, 1);
    qkt(pA0, pA1, K_lds, kb, krd, qr, qrl, negm); partialSM<true>(pA0, pA1, m_reg, negm, alA);
    WAITBAR();
    for (int j = 1; j + 1 < NT; j += 2) {
        DMA_K(j + 1, 0); DMA_V(j, 1);
        SBAR(); qkt(pB0, pB1, K_lds + SHM_K, kb, krd, qr, qrl, negm);
        finishSM(pA0, pA1, alA, l_reg, pa0, pa1, pa2, pa3); SBAR();
        pv_d0(o, vb0, pa0, pa1, pa2, pa3); partialSM<false>(pB0, pB1, m_reg, negm, alB);
        RESC(alB); WAITBAR();
        DMA_K(j + 2, 1); DMA_V(j + 1, 0);
        SBAR(); qkt(pA0, pA1, K_lds, kb, krd, qr, qrl, negm);
        finishSM(pB0, pB1, alB, l_reg, pa0, pa1, pa2, pa3); SBAR();
        pv_d0(o, vb0 + SHM_V, pa0, pa1, pa2, pa3); partialSM<false>(pA0, pA1, m_reg, negm, alA);
        RESC(alA); WAITBAR();
    }
    DMA_V(NT - 1, 1);
    SBAR(); qkt(pB0, pB1, K_lds + SHM_K, kb, krd, qr, qrl, negm);
    finishSM(pA0, pA1, alA, l_reg, pa0, pa1, pa2, pa3); SBAR();
    pv_d0(o, vb0, pa0, pa1, pa2, pa3); partialSM<false>(pB0, pB1, m_reg, negm, alB);
    RESC(alB); WAITBAR();
    finishSM(pB0, pB1, alB, l_reg, pa0, pa1, pa2, pa3); SBAR();
    pv_d0(o, vb0 + SHM_V, pa0, pa1, pa2, pa3);
    const float rli = __builtin_amdgcn_rcpf(l_reg);
    WAITBAR();
    LAS char* stg = lds + wid * 8704 + r32 * 272 + hi * 8;
#pragma unroll
    for (int d0 = 0; d0 < 4; ++d0)
#pragma unroll
        for (int g = 0; g < 4; ++g) { u32x2 w; w.x = cvtpk(o[d0][4 * g] * rli, o[d0][4 * g + 1] * rli); w.y = cvtpk(o[d0][4 * g + 2] * rli, o[d0][4 * g + 3] * rli);
            *(LAS u32x2*)(stg + (32 * d0 + 8 * g) * 2) = w; }
    asm volatile("s_waitcnt lgkmcnt(0)" ::: "memory");
    bf16* Ow = Ob + (long)(wid * QBLK) * LDO;
#pragma unroll
    for (int i = 0; i < 8; ++i) { const int row = i * 4 + (lane >> 4), ch = lane & 15; const u32x4 v = *(const LAS u32x4*)(lds + wid * 8704 + row * 272 + ch * 16); *(u32x4*)(Ow + (long)row * LDO + ch * 8) = v; }
    WAITBAR();
    __builtin_amdgcn_s_setprio(0);
#undef DMA_K
#undef DMA_V
#undef WAITBAR
#undef RESC
}
#undef KSWZ
#undef SBAR
}

#define XB_TMO      128
#define XB_XCNT(j)  (256  + 64 * (j))
#define XB_XSUB(j)  (1280 + 64 * (j))
#define XB_XGEN(j)  (2304 + 64 * (j))
#define XB_TOP      3328
#define XB_TOPGEN   3392
#define XCD_BAR_WORDS 3456
#define XB_SPIN_CAP (1u << 18)
__device__ __forceinline__ unsigned xb_ld(unsigned* p)              { return __hip_atomic_load(p, __ATOMIC_RELAXED, __HIP_MEMORY_SCOPE_AGENT); }
__device__ __forceinline__ unsigned xb_add(unsigned* p, unsigned v) { return __hip_atomic_fetch_add(p, v, __ATOMIC_RELAXED, __HIP_MEMORY_SCOPE_AGENT); }
__device__ __forceinline__ unsigned xb_xcc_id() { return (unsigned)__builtin_amdgcn_s_getreg((3 << 11) | 20) & 0xFu; }
#define XB_SPIN(cond, bar) do { unsigned _sp = 0; while (cond) { __builtin_amdgcn_s_sleep(1); \
    if ((++_sp & 255u) == 0u) { if (xb_ld(&(bar)[XB_TMO])) break; if (_sp > XB_SPIN_CAP) { atomicAdd(&(bar)[XB_TMO], 1u); break; } } } } while (0)
struct XcdBarrier { unsigned* bar; unsigned x; volatile LAS unsigned* st; };
__device__ __forceinline__ XcdBarrier xcd_barrier_post(unsigned* bar, volatile LAS unsigned* st) {
    XcdBarrier b; b.bar = bar; b.x = xb_xcc_id(); b.st = st;
    if (threadIdx.x == 0) (void)xb_add(&bar[XB_XCNT(b.x)], 1u);
    return b;
}
__device__ __forceinline__ void xcd_barrier_complete(unsigned* bar, unsigned x, unsigned& nloc, unsigned& nx) {
    const unsigned G = gridDim.x * gridDim.y * gridDim.z;
    unsigned sum, cnt, mine, sp = 0u;
    for (;;) {
        sum = 0u; cnt = 0u; mine = 0u;
#pragma unroll
        for (unsigned j = 0; j < 16; ++j) { const unsigned c = xb_ld(&bar[XB_XCNT(j)]); sum += c; cnt += (c > 0u) ? 1u : 0u; mine = (j == x) ? c : mine; }
        if (sum == G) break;
        __builtin_amdgcn_s_sleep(1);
        if ((++sp & 255u) == 0u) { if (xb_ld(&bar[XB_TMO])) break; if (sp > XB_SPIN_CAP) { atomicAdd(&bar[XB_TMO], 1u); break; } }
    }
    nloc = mine > 0u ? mine : 1u; nx = cnt > 0u ? cnt : 1u;
}
__device__ __forceinline__ void xcd_barrier(const XcdBarrier& b) {
    asm volatile("s_waitcnt vmcnt(0)" ::: "memory");
    __syncthreads();
    if (threadIdx.x == 0) {
        unsigned* bar = b.bar;
        __builtin_amdgcn_s_waitcnt(0);
        unsigned nloc = b.st[0], nx = b.st[1];
        if (nloc == 0u) { xcd_barrier_complete(bar, b.x, nloc, nx); b.st[0] = nloc; b.st[1] = nx; }
        const unsigned old = xb_add(&bar[XB_XSUB(b.x)], 1u);
        const unsigned gen = old / nloc;
        if (old + 1u == (gen + 1u) * nloc) {
            __builtin_amdgcn_fence(__ATOMIC_RELEASE, "agent");
            asm volatile("s_waitcnt vmcnt(0)" ::: "memory");
            const unsigned og = xb_add(&bar[XB_TOP], 1u);
            const unsigned tg = og / nx;
            if (og + 1u == (tg + 1u) * nx) xb_add(&bar[XB_TOPGEN], 1u);
            else XB_SPIN(xb_ld(&bar[XB_TOPGEN]) == tg, bar);
            __builtin_amdgcn_fence(__ATOMIC_ACQUIRE, "agent");
            xb_add(&bar[XB_XGEN(b.x)], 1u);
            asm volatile("s_waitcnt vmcnt(0)" ::: "memory");
        } else {
            XB_SPIN(xb_ld(&bar[XB_XGEN(b.x)]) == gen, bar);
            __builtin_amdgcn_fence(__ATOMIC_ACQUIRE, "agent");
            asm volatile("s_waitcnt vmcnt(0)" ::: "memory");
        }
    }
    __syncthreads();
}

struct Params { const float* in[25]; float* out; unsigned char* ws; int ph_lo, ph_hi; };
static_assert(sizeof(Params) == 25 * 8 + 8 + 8 + 8, "Params has no padding");
struct Ctx { LAS unsigned char* lds; int tid, lane, wave, vcu, G, bid; };
__device__ __forceinline__ Ctx fresh(const Ctx& c) {
    Ctx f; f.lds = c.lds; int tid = c.tid; asm volatile("" : "+v"(tid)); f.tid = tid; f.lane = tid & 63; f.wave = __builtin_amdgcn_readfirstlane(tid >> 6);
    int vcu = c.vcu, G = c.G, bid = c.bid; asm volatile("" : "+v"(vcu), "+v"(G), "+v"(bid));
    f.vcu = __builtin_amdgcn_readfirstlane(vcu); f.G = __builtin_amdgcn_readfirstlane(G); f.bid = __builtin_amdgcn_readfirstlane(bid); return f; }
__device__ __forceinline__ unsigned char* fresh_ptr(unsigned char* p) { unsigned lo = (unsigned)(unsigned long long)p, hi = (unsigned)((unsigned long long)p >> 32); asm volatile("" : "+v"(lo), "+v"(hi));
    const unsigned long long v = ((unsigned long long)(unsigned)__builtin_amdgcn_readfirstlane((int)hi) << 32) | (unsigned)__builtin_amdgcn_readfirstlane((int)lo); return (unsigned char*)(GAS unsigned char*)v; }

__device__ __forceinline__ int win_dst(int s) {
    if (s < 1024) return s;
    if (s < 1088) { const int j = s - 1024, part = j >> 5, w = j & 31; return 1024 + part * 32 + 2 * (w & 15) + (w >> 4); }
    if (s < 3136) { const int c = s - 1088; return 1280 + 256 * (c >> 7) + (c & 127); }
    if (s < 5184) { return 5376 + (s - 3136); }
    if (s < 7232) { const int c = s - 5184; return 1280 + 256 * (c >> 7) + 128 + (c & 127); }
    if (s < 9280) { return 7424 + (s - 7232); }
    return 9472 + (s - 9280);
}
__device__ __forceinline__ int qb_dst(int n) { const int h = n / DQK, d = n - h * DQK; if (d < DN) return n; const int j = d - DN, part = j >> 5, w = j & 31; return h * DQK + DN + part * 32 + 2 * (w & 15) + (w >> 4); }
__device__ __forceinline__ int map_dst(int mode, int n) {
    switch (mode) { case 1: return win_dst(n); case 2: return qb_dst(n); case 3: return 256 * (n >> 7) + (n & 127); case 4: return 256 * (n >> 7) + 128 + (n & 127); default: return n; }
}
__device__ __forceinline__ void transpose_item(const float* W, int K, int N, bf16* WT, int mode, const float* gk, int item, int lane) {
    const int kblk = K / 64, nb = item / kblk, kb = item - nb * kblk, k0 = 64 * kb + 16 * (lane >> 4), n0 = 64 * nb + 4 * (lane & 15);
    const float* src = W + (size_t)k0 * N + n0;
    f32x4 v[16];
#pragma unroll
    for (int i = 0; i < 16; ++i) v[i] = *(const f32x4*)(src + (size_t)i * N);
    if (gk) {
#pragma unroll
        for (int i = 0; i < 16; ++i) v[i] *= gk[k0 + i]; }
#pragma unroll
    for (int x = 0; x < 4; ++x) { bf16* d = WT + (size_t)map_dst(mode, n0 + x) * K + k0;
        u32x4 lo, hi;
        lo.x = cvtpk(v[0][x], v[1][x]); lo.y = cvtpk(v[2][x], v[3][x]); lo.z = cvtpk(v[4][x], v[5][x]); lo.w = cvtpk(v[6][x], v[7][x]);
        hi.x = cvtpk(v[8][x], v[9][x]); hi.y = cvtpk(v[10][x], v[11][x]); hi.z = cvtpk(v[12][x], v[13][x]); hi.w = cvtpk(v[14][x], v[15][x]);
        *(u32x4*)d = lo; *(u32x4*)(d + 8) = hi; }
}
struct Strip { const float* W; int N, mode, nb; signed char* w8; float* wsc; };
constexpr int ST_IN = DIN / 64, ST_GD = DFF / 64, ST_GE = DFE / 64, N_STRIPS = 2 * ST_IN + 2 * ST_GD + NE * 2 * ST_GE;
__device__ __forceinline__ Strip strip_of(const Params& p, int sid) {
    unsigned char* wb = p.ws + WS_W; float* wsc = (float*)(p.ws + WS_WSC);
    Strip q;
    if (sid < 2 * ST_IN) { const int l = sid / ST_IN; q.nb = sid - l * ST_IN; q.W = p.in[7] + (size_t)l * D * DIN; q.N = DIN; q.mode = 1; q.w8 = (signed char*)(wb + W_IN + l * W_IN_L); q.wsc = wsc + SC_IN + l * NIN; return q; }
    sid -= 2 * ST_IN;
    if (sid < 2 * ST_GD) { const int which = sid / ST_GD; q.nb = sid - which * ST_GD; q.W = p.in[17 + which]; q.N = DFF; q.mode = 3 + which; q.w8 = (signed char*)(wb + W_GU); q.wsc = wsc + SC_GU; return q; }
    sid -= 2 * ST_GD;
    { const int e = sid / (2 * ST_GE); sid -= e * (2 * ST_GE); const int which = sid / ST_GE; q.nb = sid - which * ST_GE; q.W = p.in[21 + which] + (size_t)e * D * DFE; q.N = DFE; q.mode = 3 + which;
      q.w8 = (signed char*)(wb + W_GUE + e * W_GUE_E); q.wsc = wsc + SC_GUE + e * 2 * DFE; return q; }
}
__device__ __forceinline__ unsigned pack4i8(float a, float b, float c, float d) {
    const int ia = (int)__builtin_rintf(a), ib = (int)__builtin_rintf(b), ic = (int)__builtin_rintf(c), id = (int)__builtin_rintf(d);
    return ((unsigned)ia & 0xffu) | (((unsigned)ib & 0xffu) << 8) | (((unsigned)ic & 0xffu) << 16) | ((unsigned)id << 24); }
__device__ __forceinline__ void quant_strip(const Strip& q, const Ctx& c, LAS float* cmax  ) {
    const int qd = c.lane >> 4, c4 = 4 * (c.lane & 15), n0 = 64 * q.nb + c4;
    const float* src = q.W + (size_t)(256 * c.wave + 16 * qd) * q.N + n0;
    f32x4 m = {0.f, 0.f, 0.f, 0.f};
#pragma unroll 1
    for (int sb = 0; sb < 4; ++sb) { f32x4 v[16];
#pragma unroll
        for (int i = 0; i < 16; ++i) v[i] = *(const f32x4*)(src + (size_t)(64 * sb + i) * q.N);
#pragma unroll
        for (int i = 0; i < 16; ++i) m = __builtin_elementwise_max(m, __builtin_elementwise_abs(v[i])); }
#pragma unroll
    for (int x = 0; x < 4; ++x) { float t = m[x]; t = fmaxf(t, __shfl_xor(t, 16)); t = fmaxf(t, __shfl_xor(t, 32)); m[x] = t; }
    if (c.lane < 16) *(LAS f32x4*)(cmax + c.wave * 64 + c4) = m;
    __syncthreads();
    f32x4 am = *(const LAS f32x4*)(cmax + c4);
#pragma unroll
    for (int w = 1; w < 8; ++w) am = __builtin_elementwise_max(am, *(const LAS f32x4*)(cmax + w * 64 + c4));
    f32x4 inv; int dst[4];
#pragma unroll
    for (int x = 0; x < 4; ++x) { inv[x] = am[x] > 0.f ? 127.f / am[x] : 0.f; dst[x] = map_dst(q.mode, n0 + x); }
    if (c.wave == 0 && c.lane < 16) {
#pragma unroll
        for (int x = 0; x < 4; ++x) q.wsc[dst[x]] = am[x] * (1.f / 127.f); }
#pragma unroll 1
    for (int sb = 0; sb < 4; ++sb) { f32x4 v[16];
#pragma unroll
        for (int i = 0; i < 16; ++i) v[i] = *(const f32x4*)(src + (size_t)(64 * sb + i) * q.N);
        const int k0 = 256 * c.wave + 64 * sb + 16 * qd;
#pragma unroll
        for (int x = 0; x < 4; ++x) { const float iv = inv[x];
            u32x4 o; o.x = pack4i8(v[0][x] * iv, v[1][x] * iv, v[2][x] * iv, v[3][x] * iv); o.y = pack4i8(v[4][x] * iv, v[5][x] * iv, v[6][x] * iv, v[7][x] * iv);
            o.z = pack4i8(v[8][x] * iv, v[9][x] * iv, v[10][x] * iv, v[11][x] * iv); o.w = pack4i8(v[12][x] * iv, v[13][x] * iv, v[14][x] * iv, v[15][x] * iv);
            *(u32x4*)(q.w8 + (size_t)dst[x] * D + k0) = o; } }
    __syncthreads();
}
constexpr int I_QB = (QL / 64) * (NH * DQK / 64), I_KVB = (KVL / 64) * (NH * 256 / 64), I_SQ = (D / 64) * (D / 64), I_L = I_QB + I_KVB + 3 * I_SQ;
constexpr int I_DD = (DFF / 64) * (D / 64), I_DE = (DFE / 64) * (D / 64);
constexpr int N_ADA = 2 * KS_ADA * 48, N_SMALL = N_ADA + 2 * I_L + I_DD + NE * I_DE, SMALL_BATCH = 32, N_BATCH = (N_SMALL + SMALL_BATCH - 1) / SMALL_BATCH, N_QUEUE = N_STRIPS + N_BATCH;
__device__ __forceinline__ void small_item(const Params& p, const Ctx& c, int it, const LAS float* sil) {
    unsigned char* ws = p.ws; unsigned char* wb = ws + WS_W;
    if (it < N_ADA) {
        float* part = (float*)(ws + WS_PART); const int cg = it % 48, lk = it / 48, kc = lk % KS_ADA, l = lk / KS_ADA;
        const float* W = p.in[4] + (size_t)l * D * (6 * D) + (size_t)(kc * 128) * (6 * D) + cg * 256 + c.lane * 4;
        float zf = 0.f; asm volatile("" : "+v"(zf)); f32x4 al = {zf, zf, zf, zf}, ac = al;
#pragma unroll 8
        for (int k = 0; k < 128; ++k) { const f32x4 w = *(const f32x4*)(W + (size_t)k * (6 * D)); al += w * sil[kc * 128 + k]; ac += w * sil[D + kc * 128 + k]; }
        *(f32x4*)(part + ((size_t)(l * KS_ADA + kc) * 2 + 0) * (6 * D) + cg * 256 + c.lane * 4) = al;
        *(f32x4*)(part + ((size_t)(l * KS_ADA + kc) * 2 + 1) * (6 * D) + cg * 256 + c.lane * 4) = ac; return; }
    int r = it - N_ADA;
    if (r < 2 * I_L) { const int l = r / I_L; r -= l * I_L;
        if (r < I_QB) { transpose_item(p.in[9] + (size_t)l * QL * NH * DQK, QL, NH * DQK, (bf16*)(wb + W_QB + l * W_QB_L), 2, p.in[8] + l * QL, r, c.lane); return; } r -= I_QB;
        if (r < I_KVB) { transpose_item(p.in[11] + (size_t)l * KVL * NH * 256, KVL, NH * 256, (bf16*)(wb + W_KVB + l * W_KVB_L), 0, p.in[10] + l * KVL, r, c.lane); return; } r -= I_KVB;
        const int which = r / I_SQ; r -= which * I_SQ;
        transpose_item(p.in[13 + which] + (size_t)l * D * D, D, D, (bf16*)(wb + (which == 0 ? W_OA : which == 1 ? W_OB : W_O) + l * W_SQ_L), 0, nullptr, r, c.lane); return; }
    r -= 2 * I_L;
    if (r < I_DD) { transpose_item(p.in[19], DFF, D, (bf16*)(wb + W_DD), 0, nullptr, r, c.lane); return; }
    r -= I_DD;
    { const int e = r / I_DE; r -= e * I_DE; transpose_item(p.in[23] + (size_t)e * DFE * D, DFE, D, (bf16*)(wb + W_DE + e * W_DE_E), 0, nullptr, r, c.lane); }
}
constexpr int CW_QHEAD = 2048;
__device__ __forceinline__ void p0_prologue(const Params& p, const Ctx& c) {
    unsigned char* ws = p.ws; unsigned char* wb = ws + WS_W;
    const int gt = c.vcu * NTHREADS + c.tid, NGT = c.G * NTHREADS;
    LAS float* sil = (LAS float*)(c.lds + 98304);
    LAS float* cmax = (LAS float*)(c.lds + 114688);
    LAS int* qslot = (LAS int*)(c.lds + 116736);
    for (int k = c.tid; k < 2 * D; k += NTHREADS) { const float x = k < D ? p.in[1][k] : p.in[3][k - D]; sil[k] = x / (1.f + expf(-x)); }
    { float* rope = (float*)(ws + WS_ROPE);
      for (int i = gt; i < 2048; i += NGT) { const int pos = i >> 4, k = i & 15; const float ang = (float)pos * powf(10000.f, -(float)(2 * k) / 32.f); rope[i] = cosf(ang); rope[2048 + i] = sinf(ang); } }
    { const int n16 = 192 * D / 16; unsigned zu = 0u; asm volatile("" : "+v"(zu));
      for (int i = gt; i < 2 * n16; i += NGT) { const int l = i / n16, r = i - l * n16; *(u32x4*)(wb + W_IN + l * W_IN_L + (size_t)1088 * D + (size_t)r * 16) = (u32x4){zu, zu, zu, zu}; }
      for (int i = gt; i < 2 * 192; i += NGT) { const int l = i / 192, r = i - l * 192; ((float*)(ws + WS_WSC))[SC_IN + l * NIN + 1088 + r] = __uint_as_float(zu); } }
    __syncthreads();
    unsigned* head = (unsigned*)(ws + WS_CTL) + CW_QHEAD;
    for (;;) {
        if (c.tid == 0) *qslot = (int)__hip_atomic_fetch_add(head, 1u, __ATOMIC_RELAXED, __HIP_MEMORY_SCOPE_AGENT);
        __syncthreads();
        const int id = __builtin_amdgcn_readfirstlane(*qslot);
        __syncthreads();
        if (id >= N_QUEUE) break;
        if (id < N_STRIPS) { quant_strip(strip_of(p, id), c, cmax); continue; }
        const int base = (id - N_STRIPS) * SMALL_BATCH;
#pragma unroll 1
        for (int j = 0; j < SMALL_BATCH / NWAVES; ++j) { const int it = base + j * NWAVES + c.wave; if (it < N_SMALL) small_item(p, c, it, sil); }
    }
}
__device__ __forceinline__ void p1_mod(const Params& p, const Ctx& c) {
    const float* part = (const float*)(p.ws + WS_PART); float* mod = (float*)(p.ws + WS_MOD);
    for (int i = c.vcu * NTHREADS + c.tid; i < 4 * 6 * D; i += c.G * NTHREADS) { const int n = i % (6 * D), lv = i / (6 * D), l = lv >> 1, v = lv & 1;
        float s = p.in[5][l * 6 * D + n];
#pragma unroll
        for (int kc = 0; kc < KS_ADA; ++kc) s += part[((size_t)(l * KS_ADA + kc) * 2 + v) * (6 * D) + n];
        mod[i] = s; }
}
__device__ __forceinline__ void norm_pass(const Params& p, const Ctx& c, int layer, int which, int row_lo, bool moe, bool local_mod) {
    const float* XL = (const float*)(p.ws + WS_XL); unsigned char* HN = p.ws + WS_HN; float* HSC = (float*)(p.ws + WS_HSC); const float* mod = (const float*)(p.ws + WS_MOD);
    const bool from_in = (layer == 0 && which == 0);
    const float* g = (which ? p.in[16] : p.in[6]) + layer * D;
    const int gw = c.vcu * NWAVES + c.wave, NGW = c.G * NWAVES;
    LAS float* lmod = (LAS float*)(c.lds + 65536);
    if (local_mod) { const float* part = (const float*)(p.ws + WS_PART);
        for (int i = c.tid; i < 4 * D; i += NTHREADS) { const int vec = i / D, v = vec >> 1, n = ((vec & 1) ? D : 0) + (i - vec * D);
            float sacc = p.in[5][layer * 6 * D + n];
#pragma unroll
            for (int kc = 0; kc < KS_ADA; ++kc) sacc += part[((size_t)(layer * KS_ADA + kc) * 2 + v) * (6 * D) + n];
            lmod[i] = sacc; }
        __syncthreads(); }
    LAS float* wrt = (LAS float*)c.lds;
    if (moe) { const float* wr = p.in[20];
        for (int i = c.tid; i < D * NE / 4; i += NTHREADS) { const f32x4 w = *(const f32x4*)(wr + 4 * i); const int k = i >> 1, e0 = (i & 1) * 4;
            wrt[(e0 + 0) * D + k] = w[0]; wrt[(e0 + 1) * D + k] = w[1]; wrt[(e0 + 2) * D + k] = w[2]; wrt[(e0 + 3) * D + k] = w[3]; }
        __syncthreads(); }
    for (int r = row_lo + gw; r < MT; r += NGW) {
        const f32x4* xr = (const f32x4*)(from_in ? (r < LC ? p.in[2] + (size_t)r * D : p.in[0] + (size_t)(r - LC) * D) : XL + (size_t)r * D) + c.lane;
        const float* mv = mod + (size_t)(layer * 2 + (r < LC ? 1 : 0)) * (6 * D) + (which ? 3 * D : 0);
        f32x4 v[8]; float ss = 0.f;
#pragma unroll
        for (int j = 0; j < 8; ++j) { v[j] = xr[64 * j]; ss += (v[j][0] * v[j][0] + v[j][1] * v[j][1]) + (v[j][2] * v[j][2] + v[j][3] * v[j][3]); }
        const float rs = rsqrtf(wave_sum(ss) * (1.f / D) + EPS);
        float amax = 0.f;
#pragma unroll
        for (int j = 0; j < 8; ++j) { const int col = 4 * c.lane + 256 * j;
            const f32x4 gv = *(const f32x4*)(g + col);
            const f32x4 sh = local_mod ? *(const LAS f32x4*)(lmod + (r < LC ? 2 * D : 0) + col) : *(const f32x4*)(mv + col), sc = local_mod ? *(const LAS f32x4*)(lmod + (r < LC ? 3 * D : D) + col) : *(const f32x4*)(mv + D + col);
            v[j] = (v[j] * rs * gv) * (sc + 1.f) + sh;
            amax = fmaxf(fmaxf(amax, fmaxf(fabsf(v[j][0]), fabsf(v[j][1]))), fmaxf(fabsf(v[j][2]), fabsf(v[j][3]))); }
#pragma unroll
        for (int o = 1; o < 64; o <<= 1) amax = fmaxf(amax, __shfl_xor(amax, o));
        const float inv = amax > 0.f ? 127.f / amax : 0.f;
        unsigned* o4 = (unsigned*)(HN + (size_t)r * D) + c.lane;
#pragma unroll
        for (int j = 0; j < 8; ++j) o4[64 * j] = pack4i8(v[j][0] * inv, v[j][1] * inv, v[j][2] * inv, v[j][3] * inv);
        if (c.lane == 0) HSC[r] = amax * (1.f / 127.f);
        if (moe) {
            float lg[NE];
#pragma unroll
            for (int e = 0; e < NE; ++e) { float a = 0.f;
#pragma unroll
                for (int j = 0; j < 8; ++j) { const f32x4 w = *(const LAS f32x4*)(wrt + e * D + 4 * c.lane + 256 * j); a += (v[j][0] * w[0] + v[j][1] * w[1]) + (v[j][2] * w[2] + v[j][3] * w[3]); }
                lg[e] = a; }
#pragma unroll
            for (int e = 0; e < NE; ++e) lg[e] = wave_sum(lg[e]);
            int e0 = 0; float m0 = lg[0];
#pragma unroll
            for (int e = 1; e < NE; ++e) if (lg[e] > m0) { m0 = lg[e]; e0 = e; }
            int e1 = -1; float m1 = -3.0e38f;
#pragma unroll
            for (int e = 0; e < NE; ++e) if (e != e0 && lg[e] > m1) { m1 = lg[e]; e1 = e; }
            if (c.lane == 0) { const int t = r - LC; const float b = expf(m1 - m0), inv = 1.f / (1.f + b);
                int* sel = (int*)(p.ws + WS_SEL); float* gwt = (float*)(p.ws + WS_GW);
                sel[2 * t] = e0; sel[2 * t + 1] = e1; gwt[2 * t] = inv; gwt[2 * t + 1] = b * inv; }
        }
    }
}
__device__ __forceinline__ void conv_pass(const Params& p, const Ctx& c, int layer, int row_lo) {
    const bf16* U = (const bf16*)(p.ws + WS_MIX + MX_U); const bf16* CBp = (const bf16*)(p.ws + WS_MIX + MX_CB); bf16* V2 = (bf16*)(p.ws + WS_MIX + MX_V2);
    const float* wc = p.in[12] + (size_t)layer * 3 * CW;
    const int gw = c.vcu * NWAVES + c.wave, NGW = c.G * NWAVES, nitems = ((MT - row_lo) / 16) * 4;
    for (int it = gw; it < nitems; it += NGW) {
        const int q = it & 3, r0 = row_lo + (it >> 2) * 16, ch = q * 512 + c.lane * 8;
        const int lo = r0 < LC ? 0 : LC, hi = r0 < LC ? LC : MT;
        const f32x4 w0a = *(const f32x4*)(wc + ch), w0b = *(const f32x4*)(wc + ch + 4), w1a = *(const f32x4*)(wc + CW + ch), w1b = *(const f32x4*)(wc + CW + ch + 4), w2a = *(const f32x4*)(wc + 2 * CW + ch), w2b = *(const f32x4*)(wc + 2 * CW + ch + 4);
        float zf = 0.f; asm volatile("" : "+v"(zf)); const f32x4 z4 = {zf, zf, zf, zf}; f32x4 pa = z4, pb = pa, ca, cb, na, nb;
        if (r0 - 1 >= lo) unpack8(*(const u32x4*)(U + (size_t)(r0 - 1) * CW + ch), pa, pb);
        unpack8(*(const u32x4*)(U + (size_t)r0 * CW + ch), ca, cb);
#pragma unroll 4
        for (int r = r0; r < r0 + 16; ++r) {
            na = z4; nb = na;
            if (r + 1 < hi) unpack8(*(const u32x4*)(U + (size_t)(r + 1) * CW + ch), na, nb);
            f32x4 ga, gb; unpack8(*(const u32x4*)(CBp + (size_t)r * CW + ch), ga, gb);
            const f32x4 ya = ga * (w0a * pa + w1a * ca + w2a * na), yb = gb * (w0b * pb + w1b * cb + w2b * nb);
            *(u32x4*)(V2 + (size_t)r * CW + ch) = pack8(ya, yb);
            pa = ca; pb = cb; ca = na; cb = nb; }
    }
}
__device__ __forceinline__ void moe_counts(const Params& p, const Ctx& c) {
    const int* sel = (const int*)(p.ws + WS_SEL);
    LAS int* H = (LAS int*)c.lds;
    LAS int* tot = (LAS int*)(c.lds + 16384);
    LAS int* lctl = (LAS int*)(c.lds + LCTL_OFF);
    { int h[NE];
#pragma unroll
      for (int e = 0; e < NE; ++e) h[e] = 0;
#pragma unroll
      for (int i = 0; i < 8; ++i) { const int4 v = *(const int4*)(sel + c.tid * 32 + i * 4);
#pragma unroll
          for (int e = 0; e < NE; ++e) h[e] += (v.x == e) + (v.y == e) + (v.z == e) + (v.w == e); }
#pragma unroll
      for (int e = 0; e < NE; ++e) H[c.tid * 8 + e] = h[e]; }
    __syncthreads();
    { int s = 0;
#pragma unroll
      for (int i = 0; i < 8; ++i) s += H[(c.lane * 8 + i) * 8 + c.wave];
#pragma unroll
      for (int o = 1; o < 64; o <<= 1) s += __shfl_xor(s, o);
      if (c.lane == 0) tot[c.wave] = s; }
    __syncthreads();
    if (c.tid == 0) { int off = 0;
#pragma unroll
        for (int e = 0; e < NE; ++e) { lctl[128 + e] = off; off += (tot[e] + 255) >> 8; }
        lctl[128 + NE] = off; lctl[16] = off; }
    __syncthreads();
    if (c.tid < MAXT) { int e = 0;
#pragma unroll
        for (int x = 1; x < NE; ++x) e += (c.tid >= lctl[128 + x]) ? 1 : 0;
        lctl[32 + c.tid] = e; }
    __syncthreads();
}
__device__ __forceinline__ void moe_route(const Params& p, const Ctx& c) {
    const int* sel = (const int*)(p.ws + WS_SEL); int* slot = (int*)(p.ws + WS_SLOT);
    const unsigned char* HN = p.ws + WS_HN; unsigned char* XS = p.ws + WS_MIX + FX_XS; const float* HSC = (const float*)(p.ws + WS_HSC); float* XSC = (float*)(p.ws + WS_XSC);
    LAS int* H = (LAS int*)c.lds; LAS int* tot = (LAS int*)(c.lds + 16384); LAS int* lctl = (LAS int*)(c.lds + LCTL_OFF);
    for (int b = c.bid; b < 2 * SEQ / 64; b += c.G) {
        { int s = 0;
#pragma unroll
          for (int i = 0; i < 8; ++i) { const int t = c.lane * 8 + i; s += (t < 2 * b) ? H[t * 8 + c.wave] : 0; }
#pragma unroll
          for (int o = 1; o < 64; o <<= 1) s += __shfl_xor(s, o);
          if (c.lane == 0) tot[8 + c.wave] = s; }
        __syncthreads();
        if (c.wave == 0) { const int a = 64 * b + c.lane, e = sel[a]; int rank = 0;
#pragma unroll
            for (int x = 0; x < NE; ++x) { const unsigned long long m = __ballot(e == x); if (e == x) rank = tot[8 + x] + __popcll(m & ((1ull << c.lane) - 1ull)); }
            const int s = 256 * lctl[128 + e] + rank; slot[a] = s; tot[16 + c.lane] = s; }
        __syncthreads();
#pragma unroll
        for (int i = 0; i < 8; ++i) { const int j = c.wave * 8 + i, a = 64 * b + j, tok = a >> 1, s = tot[16 + j];
            const u32x4* src = (const u32x4*)(HN + (size_t)(LC + tok) * D) + c.lane; u32x4* dst = (u32x4*)(XS + (size_t)s * D) + c.lane;
            const u32x4 v0 = src[0], v1 = src[64]; dst[0] = v0; dst[64] = v1;
            if (c.lane == 0) XSC[s] = HSC[LC + tok]; }
        __syncthreads();
    }
}
__device__ __forceinline__ void final_pass(const Params& p, const Ctx& c) {
    const float* XL = (const float*)(p.ws + WS_XL); const bf16* YS = (const bf16*)(p.ws + WS_MIX + FX_YS);
    const int* slot = (const int*)(p.ws + WS_SLOT); const float* gwt = (const float*)(p.ws + WS_GW);
    const float* gt2 = (const float*)(p.ws + WS_MOD) + (size_t)2 * (6 * D) + 5 * D; const float* gf = p.in[24];
    const int gw = c.vcu * NWAVES + c.wave, NGW = c.G * NWAVES;
    for (int t = gw; t < SEQ; t += NGW) {
        const int s0 = slot[2 * t], s1 = slot[2 * t + 1]; const float g0 = gwt[2 * t], g1 = gwt[2 * t + 1];
        const f32x4* xr = (const f32x4*)(XL + (size_t)(LC + t) * D) + c.lane;
        const u32x2* y0 = (const u32x2*)(YS + (size_t)s0 * D) + c.lane; const u32x2* y1 = (const u32x2*)(YS + (size_t)s1 * D) + c.lane;
        f32x4 v[8]; float ss = 0.f;
#pragma unroll
        for (int j = 0; j < 8; ++j) { const f32x4 gv = *(const f32x4*)(gt2 + 4 * c.lane + 256 * j);
            v[j] = xr[64 * j] + gv * (unpack4(y0[64 * j]) * g0 + unpack4(y1[64 * j]) * g1);
            ss += (v[j][0] * v[j][0] + v[j][1] * v[j][1]) + (v[j][2] * v[j][2] + v[j][3] * v[j][3]); }
        const float rs = rsqrtf(wave_sum(ss) * (1.f / D) + EPS);
        f32x4* o = (f32x4*)(p.out + (size_t)t * D) + c.lane;
#pragma unroll
        for (int j = 0; j < 8; ++j) o[64 * j] = v[j] * rs * *(const f32x4*)(gf + 4 * c.lane + 256 * j);
    }
}


template <class Epi>
__device__ __forceinline__ void ctx_gemm(const Ctx& c, const bf16* A, int lda, const bf16* Bt, int ldb, int K, const Epi& E) {
    const int fr = c.lane & 15, fq = c.lane >> 4, wr = c.wave >> 2, wc = c.wave & 3;
    for (int j = c.vcu; j < 256; j += c.G) {
        const int m0 = (j >> 5) * 32 + wr * 16, n0 = (j & 31) * 64 + wc * 16;
        const bf16* ap = A + (size_t)(m0 + fr) * lda + 8 * fq; const bf16* bp = Bt + (size_t)(n0 + fr) * ldb + 8 * fq;
        float zf = 0.f; asm volatile("" : "+v"(zf));
        f32x4 acc0 = {zf, zf, zf, zf}, acc1 = acc0;
#pragma unroll 4
        for (int k0 = 0; k0 < K; k0 += 64) {
            const bf16x8 a0 = *(const bf16x8*)(ap + k0), b0 = *(const bf16x8*)(bp + k0), a1 = *(const bf16x8*)(ap + k0 + 32), b1 = *(const bf16x8*)(bp + k0 + 32);
            acc0 = __builtin_amdgcn_mfma_f32_16x16x32_bf16(b0, a0, acc0, 0, 0, 0);
            acc1 = __builtin_amdgcn_mfma_f32_16x16x32_bf16(b1, a1, acc1, 0, 0, 0);
        }
        E(m0 + fr, n0 + 4 * fq, acc0 + acc1);
    }
}
template <int MODE> struct CtxMerge { const bf16* SG; const bf16* M1; bf16* OUT;
    __device__ __forceinline__ void operator()(int row, int col, f32x4 acc) const { const size_t off = (size_t)row * D + col;
        f32x4 v = acc * unpack4(*(const u32x2*)(SG + off)); if (MODE == 1) v += unpack4(*(const u32x2*)(M1 + off));
        u32x2 w; w.x = cvtpk(v[0], v[1]); w.y = cvtpk(v[2], v[3]); *(u32x2*)(OUT + off) = w; } };
struct CtxResid { float* XL; const float* SRC; const float* gate;
    __device__ __forceinline__ void operator()(int row, int col, f32x4 acc) const { const size_t o = (size_t)row * D + col; *(f32x4*)(XL + o) = *(const f32x4*)(SRC + o) + *(const f32x4*)(gate + col) * acc; } };

constexpr int N_PHASES = 22;
__global__ void __launch_bounds__(NTHREADS, 2) mega(Params p) {
    extern __shared__ __attribute__((aligned(16))) unsigned char lds_raw[];
    Ctx c0; c0.lds = (LAS unsigned char*)lds_raw; c0.tid = threadIdx.x; c0.lane = c0.tid & 63; c0.wave = __builtin_amdgcn_readfirstlane(c0.tid >> 6);
    c0.G = gridDim.x; c0.bid = blockIdx.x; c0.vcu = (c0.G % 8 == 0) ? (c0.bid % 8) * (c0.G / 8) + c0.bid / 8 : c0.bid;
    { const Ctx& c = c0; unsigned char* ws = p.ws;
    for (int u = c.tid; u < (LDS_BYTES - LCTL_OFF) / 4; u += NTHREADS) ((LAS unsigned*)(c.lds + LCTL_OFF))[u] = 0u;
    __syncthreads();
    }
    XcdBarrier bar = xcd_barrier_post((unsigned*)(p.ws + WS_CTL) + 4096, (volatile LAS unsigned*)(c0.lds + LCTL_OFF));
    const int lo = p.ph_lo, hi = p.ph_hi;
#ifndef MK_EN
#define MK_EN 0xFFFFFF
#endif
#define EN(j) (((MK_EN) >> (j)) & 1)
#ifndef MK_DUP
#define MK_DUP 0
#endif
#define NREP(j) ((((MK_DUP) >> (j)) & 1) ? 2 : 1)
#define IN(k) (lo <= (k) && (k) < hi)
#define SEAM(k) do { if (IN(k) && IN((k) + 1)) xcd_barrier(bar); } while (0)
#define PH_BEGIN const Ctx c = fresh(c0); unsigned char* ws = fresh_ptr(p.ws); unsigned char* wb = ws + WS_W; unsigned char* mx = ws + WS_MIX; const float* mod = (const float*)(ws + WS_MOD); (void)wb; (void)mx; (void)mod;
    for (int rep_ = 0; rep_ < NREP(20); ++rep_) if (EN(20) && IN(0)) { if (rep_) { xcd_barrier(bar); if (c0.bid == 0 && c0.tid == 0) __hip_atomic_store((unsigned*)(p.ws + WS_CTL) + CW_QHEAD, 0u, __ATOMIC_RELAXED, __HIP_MEMORY_SCOPE_AGENT); xcd_barrier(bar); } PH_BEGIN p0_prologue(p, c); } SEAM(0);
#if defined(MK_XBAR)
    for (int xb_ = 0; xb_ < 16; ++xb_) xcd_barrier(bar);
#endif
#pragma unroll
    for (int layer = 0; layer < DEPTH; ++layer) {
        const int P = 2 + 9 * layer; const bool last = (layer == DEPTH - 1);
        const int pm0 = last ? 1 : 0, nM = last ? 32 : 33;
        for (int rep_ = 0; rep_ < NREP(0); ++rep_) if (EN(0) && IN(P + 0)) { if (rep_) xcd_barrier(bar); PH_BEGIN if (layer == 0) p1_mod(p, c); norm_pass(p, c, layer, 0, 0, false, layer == 0); } SEAM(P + 0);
        for (int rep_ = 0; rep_ < NREP(1); ++rep_) if (EN(1) && IN(P + 1)) { if (rep_) xcd_barrier(bar); PH_BEGIN
            pg8::Geo g{D / 2, D / 2, D / 2};
            pg8::TileOrder S{nM, NT_IN, pm0, c.G, c.bid, last ? 3 : 0, 0, 2, (const char*)(ws + WS_HN), (const char*)(wb + W_IN + layer * W_IN_L), (size_t)256 * D, (size_t)256 * D, (const float*)(ws + WS_HSC), (const float*)(ws + WS_WSC) + SC_IN + layer * NIN};
            pg8::EpiInproj E{(bf16*)(mx + MX_QC), (bf16*)(mx + MX_KRB), (bf16*)(mx + MX_U), (bf16*)(mx + MX_CB), (float*)(mx + MX_SSQ), (const float*)(ws + WS_ROPE)};
            pg8::gemm_phase<pg8::EpiInproj, pg8::TileOrder, true, true>(c.lds, g, S, E);
        } SEAM(P + 1);
        for (int rep_ = 0; rep_ < NREP(2); ++rep_) if (EN(2) && IN(P + 2)) { if (rep_) xcd_barrier(bar); PH_BEGIN
            pg8::Geo g{1024, 512, 512};
            pg8::QkvOrder S{33, nM, pm0, c.G, c.bid, (const char*)(mx + MX_QC), (const char*)(wb + W_QB + layer * W_QB_L), (long)(W_KVB + layer * W_KVB_L) - (long)(W_QB + layer * W_QB_L)};
            pg8::EpiQkv E{(bf16*)(mx + MX_Q), (bf16*)(mx + MX_KV), (const float*)(mx + MX_SSQ), (const float*)(ws + WS_ROPE)};
            pg8::gemm_phase<pg8::EpiQkv, pg8::QkvOrder, true>(c.lds, g, S, E);
            conv_pass(p, c, layer, pm0 * 256);
        } SEAM(P + 2);
        for (int rep_ = 0; rep_ < NREP(3); ++rep_) if (EN(3) && IN(P + 3)) { if (rep_) xcd_barrier(bar); PH_BEGIN
            const bf16* Q = (const bf16*)(mx + MX_Q); const bf16* KV = (const bf16*)(mx + MX_KV); const bf16* KR = (const bf16*)(mx + MX_KRB); bf16* O = (bf16*)(mx + MX_O);
            for (int i = 0;; ++i) { const int u = i * c.G + c.vcu; if (u >= NH * 32) break;
                const int h = u >> 5, q0 = LC + 256 * (u & 31);
                att::attn_unit(Q + (size_t)q0 * att::LDQ + h * DQK, KV, h * 512, KR, O + (size_t)q0 * D + h * DV, MT, (LAS char*)c.lds); }
            if (!last) for (int i = 0;; ++i) { const int h = i * c.G + c.vcu; if (h >= NH) break;
                att::attn_unit(Q + h * DQK, KV, h * 512, KR, O + h * DV, LC, (LAS char*)c.lds); }
            pg8::Geo g{D, D, D};
            pg8::TileOrder S{32, 8, 1, c.G, c.bid, 0, 0, 0, (const char*)(mx + MX_V2), (const char*)(wb + W_OB + layer * W_SQ_L), (size_t)256 * D * 2, (size_t)256 * D * 2, nullptr, nullptr};
            pg8::EpiMerge<0> E{(const bf16*)(mx + MX_SGB), nullptr, (bf16*)(mx + MX_M1)};
            pg8::gemm_phase<pg8::EpiMerge<0>, pg8::TileOrder, true>(c.lds, g, S, E);
            if (!last) ctx_gemm(c, (const bf16*)(mx + MX_V2), D, (const bf16*)(wb + W_OB + layer * W_SQ_L), D, D, CtxMerge<0>{(const bf16*)(mx + MX_SGB), nullptr, (bf16*)(mx + MX_M1)});
        } SEAM(P + 3);
        for (int rep_ = 0; rep_ < NREP(4); ++rep_) if (EN(4) && IN(P + 4)) { if (rep_) xcd_barrier(bar); PH_BEGIN
            pg8::Geo g{D, D, D};
            pg8::TileOrder S{32, 8, 1, c.G, c.bid, 0, 0, 0, (const char*)(mx + MX_O), (const char*)(wb + W_OA + layer * W_SQ_L), (size_t)256 * D * 2, (size_t)256 * D * 2, nullptr, nullptr};
            pg8::EpiMerge<1> E{(const bf16*)(mx + MX_SGA), (const bf16*)(mx + MX_M1), (bf16*)(mx + MX_MG)};
            pg8::gemm_phase<pg8::EpiMerge<1>, pg8::TileOrder, true>(c.lds, g, S, E);
            if (!last) ctx_gemm(c, (const bf16*)(mx + MX_O), D, (const bf16*)(wb + W_OA + layer * W_SQ_L), D, D, CtxMerge<1>{(const bf16*)(mx + MX_SGA), (const bf16*)(mx + MX_M1), (bf16*)(mx + MX_MG)});
        } SEAM(P + 4);
        for (int rep_ = 0; rep_ < 1; ++rep_) if (EN(5) && IN(P + 5)) { PH_BEGIN
            pg8::Geo g{D, D, D};
            pg8::TileOrder S{32, 8, 1, c.G, c.bid, 0, 0, 0, (const char*)(mx + MX_MG), (const char*)(wb + W_O + layer * W_SQ_L), (size_t)256 * D * 2, (size_t)256 * D * 2, nullptr, nullptr};
            pg8::EpiResid E{(float*)(ws + WS_XL), layer == 0 ? p.in[0] - (size_t)LC * D : (const float*)(ws + WS_XL), mod + (size_t)(2 * layer) * (6 * D) + 2 * D};
            pg8::gemm_phase<pg8::EpiResid, pg8::TileOrder, true>(c.lds, g, S, E);
            if (!last) ctx_gemm(c, (const bf16*)(mx + MX_MG), D, (const bf16*)(wb + W_O + layer * W_SQ_L), D, D, CtxResid{(float*)(ws + WS_XL), p.in[2], mod + (size_t)(2 * layer + 1) * (6 * D) + 2 * D});
        } SEAM(P + 5);
        for (int rep_ = 0; rep_ < NREP(6); ++rep_) if (EN(6) && IN(P + 6)) { if (rep_) xcd_barrier(bar); PH_BEGIN norm_pass(p, c, layer, 1, pm0 * 256, last, false); } SEAM(P + 6);
        if (!last) {
            for (int rep_ = 0; rep_ < NREP(7); ++rep_) if (EN(7) && IN(P + 7)) { if (rep_) xcd_barrier(bar); PH_BEGIN
                pg8::Geo g{D / 2, D / 2, D / 2};
                pg8::TileOrder S{nM, 2 * DFF / 256, pm0, c.G, c.bid, 0, 0, 0, (const char*)(ws + WS_HN), (const char*)(wb + W_GU), (size_t)256 * D, (size_t)256 * D, (const float*)(ws + WS_HSC), (const float*)(ws + WS_WSC) + SC_GU};
                pg8::EpiSwiglu E{(bf16*)(mx + FX_ACT), DFF};
                pg8::gemm_phase<pg8::EpiSwiglu, pg8::TileOrder, true, true>(c.lds, g, S, E);
            } SEAM(P + 7);
            for (int rep_ = 0; rep_ < 1; ++rep_) if (EN(8) && IN(P + 8)) { PH_BEGIN
                pg8::Geo g{DFF, DFF, DFF};
                pg8::TileOrder S{32, 8, 1, c.G, c.bid, 0, 0, 0, (const char*)(mx + FX_ACT), (const char*)(wb + W_DD), (size_t)256 * DFF * 2, (size_t)256 * DFF * 2, nullptr, nullptr};
                pg8::EpiResid E{(float*)(ws + WS_XL), (const float*)(ws + WS_XL), mod + (size_t)(2 * layer) * (6 * D) + 5 * D};
                pg8::gemm_phase<pg8::EpiResid, pg8::TileOrder, true>(c.lds, g, S, E);
                ctx_gemm(c, (const bf16*)(mx + FX_ACT), DFF, (const bf16*)(wb + W_DD), DFF, DFF, CtxResid{(float*)(ws + WS_XL), (const float*)(ws + WS_XL), mod + (size_t)(2 * layer + 1) * (6 * D) + 5 * D});
            } SEAM(P + 8);
        } else {
            const LAS int* lctl = (const LAS int*)(c0.lds + LCTL_OFF);
            for (int rep_ = 0; rep_ < NREP(7); ++rep_) if (EN(7) && IN(P + 7)) { if (rep_) xcd_barrier(bar); PH_BEGIN moe_counts(p, c); moe_route(p, c); } SEAM(P + 7);
            for (int rep_ = 0; rep_ < NREP(8); ++rep_) if (EN(8) && IN(P + 8)) { if (rep_) xcd_barrier(bar); PH_BEGIN
                if (!IN(P + 7)) moe_counts(p, c);
                const int T = __builtin_amdgcn_readfirstlane(lctl[16]);
                pg8::Geo g{D / 2, D / 2, D / 2};
                pg8::MoeOrder S{T, 2 * DFE / 256, c.G, c.bid, (const char*)(mx + FX_XS), (const char*)(wb + W_GUE), (size_t)256 * D, (size_t)256 * D, W_GUE_E, lctl + 32, (const float*)(ws + WS_XSC), (const float*)(ws + WS_WSC) + SC_GUE, 2 * DFE};
                pg8::EpiSwiglu E{(bf16*)(mx + FX_ACTE), DFE};
                pg8::gemm_phase<pg8::EpiSwiglu, pg8::MoeOrder, true, true>(c.lds, g, S, E);
            } SEAM(P + 8);
            for (int rep_ = 0; rep_ < NREP(9); ++rep_) if (EN(9) && IN(P + 9)) { if (rep_) xcd_barrier(bar); PH_BEGIN
                if (!IN(P + 7)) moe_counts(p, c);
                const int T = __builtin_amdgcn_readfirstlane(lctl[16]);
                pg8::Geo g{DFE, DFE, DFE};
                pg8::MoeOrder S{T, 8, c.G, c.bid, (const char*)(mx + FX_ACTE), (const char*)(wb + W_DE), (size_t)256 * DFE * 2, (size_t)256 * DFE * 2, W_DE_E, lctl + 32, nullptr, nullptr, 0};
                pg8::EpiStoreBf16 E{(bf16*)(mx + FX_YS), D};
                pg8::gemm_phase<pg8::EpiStoreBf16, pg8::MoeOrder, true>(c.lds, g, S, E);
            } SEAM(P + 9);
            for (int rep_ = 0; rep_ < NREP(10); ++rep_) if (EN(10) && IN(P + 10)) { if (rep_) xcd_barrier(bar); PH_BEGIN final_pass(p, c); }
        }
    }
#undef IN
#undef SEAM
}

static void forward(void* const* d_in, float* out, void* d_ws, size_t ws_size, hipStream_t st, int n_launches) {
    static int grid = 0;
    if (grid == 0) {
        if (ws_size < WS_END) { fprintf(stderr, "mk::forward: workspace too small (%zu < %zu)\n", ws_size, (size_t)WS_END); grid = -1; return; }
        int dev = 0, cus = 0;
        if (hipGetDevice(&dev) != hipSuccess || hipDeviceGetAttribute(&cus, hipDeviceAttributeMultiprocessorCount, dev) != hipSuccess) { grid = -1; return; }
        if (hipFuncSetAttribute((const void*)mega, hipFuncAttributeMaxDynamicSharedMemorySize, LDS_BYTES) != hipSuccess) { fprintf(stderr, "mk::forward: hipFuncSetAttribute failed\n"); grid = -1; return; }
        int per_cu = 0; (void)hipOccupancyMaxActiveBlocksPerMultiprocessor(&per_cu, (const void*)mega, NTHREADS, LDS_BYTES); (void)hipGetLastError();
        grid = cus;
    }
    if (grid < 0) return;
    (void)hipMemsetAsync((char*)d_ws + WS_CTL, 0, CTL_BYTES, st);
    Params p{};
    for (int i = 0; i < 25; ++i) p.in[i] = (const float*)d_in[i];
    p.out = out; p.ws = (unsigned char*)d_ws;
    if (n_launches == 1) { p.ph_lo = 0; p.ph_hi = N_PHASES; hipLaunchKernelGGL(mega, dim3(grid), dim3(NTHREADS), LDS_BYTES, st, p); }
    else for (int k = 0; k < N_PHASES; ++k) { p.ph_lo = k; p.ph_hi = k + 1; hipLaunchKernelGGL(mega, dim3(grid), dim3(NTHREADS), LDS_BYTES, st, p); }
    const hipError_t le = hipPeekAtLastError();
    if (le != hipSuccess) fprintf(stderr, "mk::forward: launch failed: %s\n", hipGetErrorName(le));
}
}

#ifndef MK_LAUNCHES
#define MK_LAUNCHES 1
#endif
#ifndef USE_SLOW
#define USE_SLOW 0
#endif
extern "C" void kernel_launch(void* const* d_in, const int* in_sizes, int n_in, void* d_out, int out_size, void* d_ws, size_t ws_size, hipStream_t stream) {
    if (n_in != 25 || out_size != SEQ * D) { fprintf(stderr, "kernel_launch: unexpected shapes (n_in %d out %d)\n", n_in, out_size); return; }
#if USE_SLOW
    slow::forward(d_in, (float*)d_out, (float*)d_ws, ws_size / 4, stream);
#else
    mk::forward(d_in, (float*)d_out, d_ws, ws_size, stream, MK_LAUNCHES);
#endif
}
```

```cpp
#include <hip/hip_runtime.h>
#include <cstdio>
#include <cstdint>

constexpr int D = 2048, LC = 256, SEQ = 8192, MT = LC + SEQ, DEPTH = 2;
constexpr int NH = 16, DN = 128, DR = 64, DV = 128, DQK = DN + DR, QL = 512, KVL = 512;
constexpr int CW = 2048, DIN = QL + KVL + DR + 3 * CW + 2 * D;
constexpr int OFF_QA = 0, OFF_CKV = 512, OFF_KR = 1024, OFF_CX = 1088, OFF_CB = OFF_CX + CW, OFF_CC = OFF_CB + CW, OFF_GA = OFF_CC + CW, OFF_GB = OFF_GA + D;
constexpr int DFF = 5632, NE = 8, DFE = 2816;
constexpr float EPS = 1e-6f;
constexpr float ATT_SCALE = 0.07216878364870322f;

namespace slow {
typedef float f32x16 __attribute__((ext_vector_type(16)));

struct GArgs { const float* A; long lda, abs_; const float* B; long sbk, sbn, bbs; const int* rowidx; const int* rioff; const int* Mptr; int M, N, K, pad; };
static_assert(sizeof(GArgs) == 96, "GArgs has no implicit padding");

template <bool BT, class Epi>
__global__ __launch_bounds__(256) void k_gemm(GArgs g, Epi epi) {
    __shared__ float As[32][65];
    __shared__ float Bs[32][65];
    const int b = blockIdx.z, m0 = blockIdx.y * 64, n0 = blockIdx.x * 64;
    const int M = g.Mptr ? g.Mptr[b] : g.M;
    if (m0 >= M) return;
    const int t = threadIdx.x, lane = t & 63, w = t >> 6, wm = w >> 1, wn = w & 1;
    const float* A = g.A + (long)b * g.abs_; const float* B = g.B + (long)b * g.bbs;
    const int ar = t >> 2, ak = (t & 3) * 8, am = m0 + ar;
    long arow = -1;
    if (am < M) { const int base = g.rioff ? g.rioff[b] : 0; arow = g.rowidx ? (long)g.rowidx[base + am] : (long)(base + am); }
    f32x16 acc;
#pragma unroll
    for (int r = 0; r < 16; ++r) acc[r] = 0.f;
    for (int k0 = 0; k0 < g.K; k0 += 32) {
        float4 a0 = make_float4(0.f, 0.f, 0.f, 0.f), a1 = a0, b0, b1;
        if (arow >= 0) { const float4* p = (const float4*)(A + arow * g.lda + k0 + ak); a0 = p[0]; a1 = p[1]; }
        if (BT) { const int bn = t >> 2, bk = (t & 3) * 8; const float4* p = (const float4*)(B + (long)(n0 + bn) * g.sbn + k0 + bk); b0 = p[0]; b1 = p[1]; }
        else    { const int bk = t >> 3, bn = (t & 7) * 8; const float4* p = (const float4*)(B + (long)(k0 + bk) * g.sbk + n0 + bn); b0 = p[0]; b1 = p[1]; }
        __syncthreads();
        As[ak + 0][ar] = a0.x; As[ak + 1][ar] = a0.y; As[ak + 2][ar] = a0.z; As[ak + 3][ar] = a0.w;
        As[ak + 4][ar] = a1.x; As[ak + 5][ar] = a1.y; As[ak + 6][ar] = a1.z; As[ak + 7][ar] = a1.w;
        if (BT) { const int bn = t >> 2, bk = (t & 3) * 8;
            Bs[bk + 0][bn] = b0.x; Bs[bk + 1][bn] = b0.y; Bs[bk + 2][bn] = b0.z; Bs[bk + 3][bn] = b0.w;
            Bs[bk + 4][bn] = b1.x; Bs[bk + 5][bn] = b1.y; Bs[bk + 6][bn] = b1.z; Bs[bk + 7][bn] = b1.w; }
        else { const int bk = t >> 3, bn = (t & 7) * 8;
            Bs[bk][bn + 0] = b0.x; Bs[bk][bn + 1] = b0.y; Bs[bk][bn + 2] = b0.z; Bs[bk][bn + 3] = b0.w;
            Bs[bk][bn + 4] = b1.x; Bs[bk][bn + 5] = b1.y; Bs[bk][bn + 6] = b1.z; Bs[bk][bn + 7] = b1.w; }
        __syncthreads();
#pragma unroll
        for (int kk = 0; kk < 32; kk += 2) {
            const float a = As[kk + (lane >> 5)][wm * 32 + (lane & 31)];
            const float bb = Bs[kk + (lane >> 5)][wn * 32 + (lane & 31)];
            acc = __builtin_amdgcn_mfma_f32_32x32x2f32(a, bb, acc, 0, 0, 0);
        }
    }
    const int base = g.rioff ? g.rioff[b] : 0;
#pragma unroll
    for (int r = 0; r < 16; ++r) {
        const int row = m0 + wm * 32 + (r & 3) + 8 * (r >> 2) + 4 * (lane >> 5), col = n0 + wn * 32 + (lane & 31);
        if (row < M) epi(b, base + row, col, acc[r]);
    }
}
struct EpiStore { float* C; long ldc, cbs; float alpha; int accum;
    __device__ void operator()(int b, int row, int col, float v) const { float* p = C + (long)b * cbs + (long)row * ldc + col; *p = accum ? *p + alpha * v : alpha * v; } };
struct EpiResid { float* X; const float* gl; const float* gc;
    __device__ void operator()(int, int row, int col, float v) const { float* p = X + (long)row * D + col; *p += (row < LC ? gc[col] : gl[col]) * v; } };

template <bool BT, class Epi> static void gemm(hipStream_t st, const GArgs& g, const Epi& e, int nbatch, int maxM) {
    dim3 grid(g.N / 64, (maxM + 63) / 64, nbatch);
    hipLaunchKernelGGL((k_gemm<BT, Epi>), grid, dim3(256), 0, st, g, e);
}

__device__ __forceinline__ float block_sum(float v, float* red) {
#pragma unroll
    for (int o = 32; o > 0; o >>= 1) v += __shfl_xor(v, o);
    __syncthreads();
    if ((threadIdx.x & 63) == 0) red[threadIdx.x >> 6] = v;
    __syncthreads();
    return red[0] + red[1] + red[2] + red[3];
}
__device__ __forceinline__ float block_max(float v, float* red) {
#pragma unroll
    for (int o = 32; o > 0; o >>= 1) v = fmaxf(v, __shfl_xor(v, o));
    __syncthreads();
    if ((threadIdx.x & 63) == 0) red[threadIdx.x >> 6] = v;
    __syncthreads();
    return fmaxf(fmaxf(red[0], red[1]), fmaxf(red[2], red[3]));
}
__device__ __forceinline__ float silu(float x) { return x / (1.f + expf(-x)); }
__device__ __forceinline__ float sigm(float x) { return 1.f / (1.f + expf(-x)); }

__global__ void k_copy_x(const float* ctx, const float* x, float* XL) {
    const long n = (long)MT * D / 4; const float4* c4 = (const float4*)ctx; const float4* x4 = (const float4*)x; float4* o = (float4*)XL; const long nc = (long)LC * D / 4;
    for (long i = blockIdx.x * 256L + threadIdx.x; i < n; i += gridDim.x * 256L) o[i] = i < nc ? c4[i] : x4[i - nc];
}
__global__ void k_ada(const float* c, const float* cctx, const float* w_ada, const float* b_ada, float* MOD) {
    const int n = blockIdx.x * 256 + threadIdx.x, lv = blockIdx.y, l = lv >> 1, v = lv & 1;
    const float* cv = v ? cctx : c; const float* W = w_ada + (long)l * D * (6 * D);
    float acc = 0.f;
    for (int k = 0; k < D; ++k) acc += silu(cv[k]) * W[(long)k * (6 * D) + n];
    MOD[(long)lv * (6 * D) + n] = acc + b_ada[l * 6 * D + n];
}
__global__ __launch_bounds__(256) void k_modnorm(const float* X, const float* g, const float* modl, const float* modc, int sh_off, int sc_off, float* H) {
    __shared__ float red[4];
    const int r = blockIdx.x; const float* x = X + (long)r * D; const float* mod = r < LC ? modc : modl;
    float v[8]; float ss = 0.f;
#pragma unroll
    for (int j = 0; j < 8; ++j) { v[j] = x[threadIdx.x + 256 * j]; ss += v[j] * v[j]; }
    ss = block_sum(ss, red);
    const float rs = rsqrtf(ss * (1.f / D) + EPS);
#pragma unroll
    for (int j = 0; j < 8; ++j) { const int c = threadIdx.x + 256 * j; H[(long)r * D + c] = (v[j] * rs * g[c]) * (1.f + mod[sc_off + c]) + mod[sh_off + c]; }
}
__global__ __launch_bounds__(256) void k_rms512(const float* P, int off, const float* g, float* out) {
    __shared__ float red[4];
    const int r = blockIdx.x; const float* x = P + (long)r * DIN + off;
    const float a = x[threadIdx.x], b = x[threadIdx.x + 256];
    const float ss = block_sum(a * a + b * b, red);
    const float rs = rsqrtf(ss * (1.f / 512.f) + EPS);
    out[(long)r * 512 + threadIdx.x] = a * rs * g[threadIdx.x]; out[(long)r * 512 + threadIdx.x + 256] = b * rs * g[threadIdx.x + 256];
}
__device__ __forceinline__ float inv_freq(int i) { return powf(10000.f, -(float)(2 * i) / 32.f); }
__global__ void k_rope_q(float* Q) {
    const long idx = blockIdx.x * 256L + threadIdx.x;
    if (idx >= (long)SEQ * NH * 32) return;
    const int i = idx & 15, part = (idx >> 4) & 1, h = (idx >> 5) & 15; const int t = (int)(idx >> 9);
    const float pos = part ? (float)(t % 64) : (float)(t / 64);
    const float ang = pos * inv_freq(i), cs = cosf(ang), sn = sinf(ang);
    float* p = Q + (long)(LC + t) * (NH * DQK) + h * DQK + DN + part * 32;
    const float x1 = p[i], x2 = p[i + 16];
    p[i] = x1 * cs - x2 * sn; p[i + 16] = x2 * cs + x1 * sn;
}
__global__ void k_rope_k(const float* P, float* KR) {
    const long idx = blockIdx.x * 256L + threadIdx.x;
    if (idx >= (long)MT * 32) return;
    const int i = idx & 15, part = (idx >> 4) & 1; const int r = (int)(idx >> 5);
    const float* p = P + (long)r * DIN + OFF_KR + part * 32; float* o = KR + (long)r * DR + part * 32;
    const float x1 = p[i], x2 = p[i + 16];
    if (r < LC) { o[i] = x1; o[i + 16] = x2; return; }
    const int t = r - LC; const float pos = part ? (float)(t % 64) : (float)(t / 64);
    const float ang = pos * inv_freq(i), cs = cosf(ang), sn = sinf(ang);
    o[i] = x1 * cs - x2 * sn; o[i + 16] = x2 * cs + x1 * sn;
}
__global__ __launch_bounds__(256) void k_softmax(float* SC, int n) {
    __shared__ float red[4];
    float* s = SC + (long)blockIdx.x * n;
    float mx = -3.0e38f;
    for (int j = threadIdx.x; j < n; j += 256) mx = fmaxf(mx, s[j]);
    mx = block_max(mx, red);
    float sum = 0.f;
    for (int j = threadIdx.x; j < n; j += 256) { const float e = expf(s[j] - mx); s[j] = e; sum += e; }
    sum = block_sum(sum, red);
    const float inv = 1.f / sum;
    for (int j = threadIdx.x; j < n; j += 256) s[j] *= inv;
}
__global__ void k_conv(const float* P, const float* wconv, float* V2) {
    const long idx = blockIdx.x * 256L + threadIdx.x; if (idx >= (long)MT * CW) return;
    const int c = idx % CW; const int r = (int)(idx / CW);
    const int lo = r < LC ? 0 : LC, hi = r < LC ? LC : MT;
    const float* p = P + (long)r * DIN;
    float acc = wconv[CW + c] * (p[OFF_CC + c] * p[OFF_CX + c]);
    if (r - 1 >= lo) acc += wconv[c] * (p[OFF_CC + c - DIN] * p[OFF_CX + c - DIN]);
    if (r + 1 < hi) acc += wconv[2 * CW + c] * (p[OFF_CC + c + DIN] * p[OFF_CX + c + DIN]);
    V2[idx] = p[OFF_CB + c] * acc;
}
__global__ void k_merge(const float* P, const float* OA, const float* OB, float* MG) {
    const long idx = blockIdx.x * 256L + threadIdx.x; if (idx >= (long)MT * D) return;
    const int c = idx % D; const long r = idx / D;
    MG[idx] = sigm(P[r * DIN + OFF_GA + c]) * OA[idx] + sigm(P[r * DIN + OFF_GB + c]) * OB[idx];
}
__global__ void k_swiglu(float* G, const float* U, long n) {
    for (long i = blockIdx.x * 256L + threadIdx.x; i < n; i += gridDim.x * 256L) G[i] = silu(G[i]) * U[i];
}
__global__ __launch_bounds__(256) void k_router(const float* H2, const float* wr, int* sel, float* gw) {
    const int t = blockIdx.x * 4 + (threadIdx.x >> 6), lane = threadIdx.x & 63;
    const float* h = H2 + (long)(LC + t) * D;
    float lg[NE];
#pragma unroll
    for (int e = 0; e < NE; ++e) lg[e] = 0.f;
    for (int k = lane; k < D; k += 64) { const float hv = h[k];
#pragma unroll
        for (int e = 0; e < NE; ++e) lg[e] += hv * wr[k * NE + e]; }
#pragma unroll
    for (int e = 0; e < NE; ++e) {
#pragma unroll
        for (int o = 32; o > 0; o >>= 1) lg[e] += __shfl_xor(lg[e], o); }
    if (lane == 0) {
        int e0 = 0; for (int e = 1; e < NE; ++e) if (lg[e] > lg[e0]) e0 = e;
        int e1 = e0 == 0 ? 1 : 0; for (int e = 0; e < NE; ++e) if (e != e0 && lg[e] > lg[e1]) e1 = e;
        const float m = lg[e0], a = 1.f, b = expf(lg[e1] - m), inv = 1.f / (a + b);
        sel[2 * t] = e0; sel[2 * t + 1] = e1; gw[2 * t] = a * inv; gw[2 * t + 1] = b * inv;
    }
}
__global__ __launch_bounds__(512) void k_sort(const int* sel, int* cnt, int* off, int* toklist, int* slot_of) {
    __shared__ int scnt[NE];
    const int e = threadIdx.x >> 6, lane = threadIdx.x & 63; const int NA = 2 * SEQ;
    int c = 0;
    for (int a0 = 0; a0 < NA; a0 += 64) c += __popcll(__ballot(sel[a0 + lane] == e));
    if (lane == 0) scnt[e] = c;
    __syncthreads();
    int base = 0; for (int j = 0; j < e; ++j) base += scnt[j];
    if (lane == 0) { cnt[e] = c; off[e] = base; }
    int pos = base;
    for (int a0 = 0; a0 < NA; a0 += 64) {
        const bool f = sel[a0 + lane] == e; const unsigned long long m = __ballot(f);
        if (f) { const int p = pos + __popcll(m & ((1ull << lane) - 1ull)); toklist[p] = LC + (a0 + lane) / 2; slot_of[a0 + lane] = p; }
        pos += __popcll(m);
    }
}
__global__ void k_moe_combine(float* XL, const float* Ys, const int* slot_of, const float* gw, const float* gt2) {
    const long idx = blockIdx.x * 256L + threadIdx.x; if (idx >= (long)SEQ * D) return;
    const int c = idx % D; const int t = (int)(idx / D);
    const float y = gw[2 * t] * Ys[(long)slot_of[2 * t] * D + c] + gw[2 * t + 1] * Ys[(long)slot_of[2 * t + 1] * D + c];
    XL[(long)(LC + t) * D + c] += gt2[c] * y;
}
__global__ __launch_bounds__(256) void k_final(const float* XL, const float* g, float* out) {
    __shared__ float red[4];
    const int r = blockIdx.x; const float* x = XL + (long)(LC + r) * D;
    float v[8]; float ss = 0.f;
#pragma unroll
    for (int j = 0; j < 8; ++j) { v[j] = x[threadIdx.x + 256 * j]; ss += v[j] * v[j]; }
    ss = block_sum(ss, red);
    const float rs = rsqrtf(ss * (1.f / D) + EPS);
#pragma unroll
    for (int j = 0; j < 8; ++j) { const int c = threadIdx.x + 256 * j; out[(long)r * D + c] = v[j] * rs * g[c]; }
}

static inline int nblk(long n) { return (int)((n + 255) / 256); }

static void forward(void* const* d_in, float* out, float* ws, size_t ws_floats, hipStream_t st) {
    const float* x = (const float*)d_in[0]; const float* c = (const float*)d_in[1]; const float* ctx = (const float*)d_in[2]; const float* cctx = (const float*)d_in[3];
    const float* w_ada = (const float*)d_in[4]; const float* b_ada = (const float*)d_in[5]; const float* g_attn = (const float*)d_in[6]; const float* w_in = (const float*)d_in[7];
    const float* g_qa = (const float*)d_in[8]; const float* w_qb = (const float*)d_in[9]; const float* g_kva = (const float*)d_in[10]; const float* w_kvb = (const float*)d_in[11];
    const float* w_conv = (const float*)d_in[12]; const float* w_oa = (const float*)d_in[13]; const float* w_ob = (const float*)d_in[14]; const float* w_o = (const float*)d_in[15];
    const float* g_ffn = (const float*)d_in[16]; const float* w_gd = (const float*)d_in[17]; const float* w_ud = (const float*)d_in[18]; const float* w_dd = (const float*)d_in[19];
    const float* w_router = (const float*)d_in[20]; const float* w_ge = (const float*)d_in[21]; const float* w_ue = (const float*)d_in[22]; const float* w_de = (const float*)d_in[23];
    const float* g_final = (const float*)d_in[24];
    size_t o = 0; auto take = [&](size_t n) { float* p = ws + o; o += (n + 63) / 64 * 64; return p; };
    float* XL = take((size_t)MT * D); float* MOD = take(4 * 6 * D); float* H = take((size_t)MT * D); float* P = take((size_t)MT * DIN);
    float* QN = take((size_t)MT * 512); float* CN = take((size_t)MT * 512); float* Q = take((size_t)MT * NH * DQK); float* KV = take((size_t)MT * NH * 256);
    float* KR = take((size_t)MT * DR); float* SC = take((size_t)NH * 256 * MT); float* ATT = take((size_t)MT * D);
    int* IB = (int*)take(4 * SEQ + 64 + 2 * SEQ + 2 * SEQ);
    if (o > ws_floats) { fprintf(stderr, "slow::forward: workspace too small (%zu > %zu floats)\n", o, ws_floats); return; }
    int* sel = IB; int* slot_of = IB + 2 * SEQ; int* toklist = IB + 4 * SEQ; int* cnt = IB + 6 * SEQ; int* off = cnt + 8; float* gw = (float*)(IB + 6 * SEQ + 64);
    float* OA = SC; float* OB = SC + (size_t)MT * D; float* V2 = SC + 2 * (size_t)MT * D; float* MG = SC + 3 * (size_t)MT * D;
    static_assert((size_t)NH * 256 * MT >= 2 * (size_t)MT * D, "SC region");
    V2 = Q; MG = KV;
    float* OUT = H; float* H2 = H; float* G = P; float* U = P + (size_t)MT * DFF; float* Y = Q; float* Ys = KV;
    static_assert((size_t)MT * DIN >= 2 * (size_t)MT * DFF, "P region holds G and U");

    hipLaunchKernelGGL(k_copy_x, dim3(2048), dim3(256), 0, st, ctx, x, XL);
    hipLaunchKernelGGL(k_ada, dim3(6 * D / 256, 4), dim3(256), 0, st, c, cctx, w_ada, b_ada, MOD);
    for (int i = 0; i < DEPTH; ++i) {
        const bool last = (i == DEPTH - 1);
        const float* modl = MOD + (size_t)(2 * i) * 6 * D; const float* modc = MOD + (size_t)(2 * i + 1) * 6 * D;
        hipLaunchKernelGGL(k_modnorm, dim3(MT), dim3(256), 0, st, XL, g_attn + i * D, modl, modc, 0, D, H);
        { GArgs g{H, D, 0, w_in + (size_t)i * D * DIN, DIN, 1, 0, nullptr, nullptr, nullptr, MT, DIN, D}; gemm<false>(st, g, EpiStore{P, DIN, 0, 1.f, 0}, 1, MT); }
        hipLaunchKernelGGL(k_rms512, dim3(MT), dim3(256), 0, st, P, OFF_QA, g_qa + i * QL, QN);
        hipLaunchKernelGGL(k_rms512, dim3(MT), dim3(256), 0, st, P, OFF_CKV, g_kva + i * KVL, CN);
        { GArgs g{QN, 512, 0, w_qb + (size_t)i * QL * NH * DQK, NH * DQK, 1, 0, nullptr, nullptr, nullptr, MT, NH * DQK, QL}; gemm<false>(st, g, EpiStore{Q, NH * DQK, 0, 1.f, 0}, 1, MT); }
        { GArgs g{CN, 512, 0, w_kvb + (size_t)i * KVL * NH * 256, NH * 256, 1, 0, nullptr, nullptr, nullptr, MT, NH * 256, KVL}; gemm<false>(st, g, EpiStore{KV, NH * 256, 0, 1.f, 0}, 1, MT); }
        hipLaunchKernelGGL(k_rope_q, dim3(nblk((long)SEQ * NH * 32)), dim3(256), 0, st, Q);
        hipLaunchKernelGGL(k_rope_k, dim3(nblk((long)MT * 32)), dim3(256), 0, st, P, KR);
        for (int ch = last ? 0 : -1; ch < SEQ / 256; ++ch) {
            const int q0 = ch < 0 ? 0 : LC + 256 * ch, nk = ch < 0 ? LC : MT;
            { GArgs g{Q + (size_t)q0 * NH * DQK, NH * DQK, DQK, KV, 1, NH * 256, 256, nullptr, nullptr, nullptr, 256, nk, DN}; gemm<true>(st, g, EpiStore{SC, nk, (long)256 * nk, ATT_SCALE, 0}, NH, 256); }
            { GArgs g{Q + (size_t)q0 * NH * DQK + DN, NH * DQK, DQK, KR, 1, DR, 0, nullptr, nullptr, nullptr, 256, nk, DR}; gemm<true>(st, g, EpiStore{SC, nk, (long)256 * nk, ATT_SCALE, 1}, NH, 256); }
            hipLaunchKernelGGL(k_softmax, dim3(NH * 256), dim3(256), 0, st, SC, nk);
            { GArgs g{SC, nk, (long)256 * nk, KV + DN, NH * 256, 1, 256, nullptr, nullptr, nullptr, 256, DV, nk}; gemm<false>(st, g, EpiStore{ATT + (size_t)q0 * D, D, DV, 1.f, 0}, NH, 256); }
        }
        { GArgs g{ATT, D, 0, w_oa + (size_t)i * D * D, D, 1, 0, nullptr, nullptr, nullptr, MT, D, D}; gemm<false>(st, g, EpiStore{OA, D, 0, 1.f, 0}, 1, MT); }
        hipLaunchKernelGGL(k_conv, dim3(nblk((long)MT * CW)), dim3(256), 0, st, P, w_conv + (size_t)i * 3 * CW, V2);
        { GArgs g{V2, CW, 0, w_ob + (size_t)i * CW * D, D, 1, 0, nullptr, nullptr, nullptr, MT, D, CW}; gemm<false>(st, g, EpiStore{OB, D, 0, 1.f, 0}, 1, MT); }
        hipLaunchKernelGGL(k_merge, dim3(nblk((long)MT * D)), dim3(256), 0, st, P, OA, OB, MG);
        { GArgs g{MG, D, 0, w_o + (size_t)i * D * D, D, 1, 0, nullptr, nullptr, nullptr, MT, D, D}; gemm<false>(st, g, EpiResid{XL, modl + 2 * D, modc + 2 * D}, 1, MT); }
        hipLaunchKernelGGL(k_modnorm, dim3(MT), dim3(256), 0, st, XL, g_ffn + i * D, modl, modc, 3 * D, 4 * D, H2);
        if (i % 2 == 0) {
            const int j = i / 2;
            { GArgs g{H2, D, 0, w_gd + (size_t)j * D * DFF, DFF, 1, 0, nullptr, nullptr, nullptr, MT, DFF, D}; gemm<false>(st, g, EpiStore{G, DFF, 0, 1.f, 0}, 1, MT); }
            { GArgs g{H2, D, 0, w_ud + (size_t)j * D * DFF, DFF, 1, 0, nullptr, nullptr, nullptr, MT, DFF, D}; gemm<false>(st, g, EpiStore{U, DFF, 0, 1.f, 0}, 1, MT); }
            hipLaunchKernelGGL(k_swiglu, dim3(4096), dim3(256), 0, st, G, U, (long)MT * DFF);
            { GArgs g{G, DFF, 0, w_dd + (size_t)j * DFF * D, D, 1, 0, nullptr, nullptr, nullptr, MT, D, DFF}; gemm<false>(st, g, EpiResid{XL, modl + 5 * D, modc + 5 * D}, 1, MT); }
        } else {
            const int j = i / 2;
            float* Ge = P; float* Ue = P + (size_t)2 * SEQ * DFE;
            hipLaunchKernelGGL(k_router, dim3(SEQ / 4), dim3(256), 0, st, H2, w_router + (size_t)j * D * NE, sel, gw);
            hipLaunchKernelGGL(k_sort, dim3(1), dim3(512), 0, st, sel, cnt, off, toklist, slot_of);
            { GArgs g{H2, D, 0, w_ge + (size_t)j * NE * D * DFE, DFE, 1, (long)D * DFE, toklist, off, cnt, 0, DFE, D}; gemm<false>(st, g, EpiStore{Ge, DFE, 0, 1.f, 0}, NE, SEQ); }
            { GArgs g{H2, D, 0, w_ue + (size_t)j * NE * D * DFE, DFE, 1, (long)D * DFE, toklist, off, cnt, 0, DFE, D}; gemm<false>(st, g, EpiStore{Ue, DFE, 0, 1.f, 0}, NE, SEQ); }
            hipLaunchKernelGGL(k_swiglu, dim3(4096), dim3(256), 0, st, Ge, Ue, (long)2 * SEQ * DFE);
            { GArgs g{Ge, DFE, 0, w_de + (size_t)j * NE * DFE * D, D, 1, (long)DFE * D, nullptr, off, cnt, 0, D, DFE}; gemm<false>(st, g, EpiStore{Ys, D, 0, 1.f, 0}, NE, SEQ); }
            hipLaunchKernelGGL(k_moe_combine, dim3(nblk((long)SEQ * D)), dim3(256), 0, st, XL, Ys, slot_of, gw, modl + 5 * D);
        }
        (void)OUT; (void)Y;
    }
    hipLaunchKernelGGL(k_final, dim3(SEQ), dim3(256), 0, st, XL, g_final, out);
}
}


namespace mk {
#define LAS __attribute__((address_space(3)))
#define GAS __attribute__((address_space(1)))
typedef unsigned short bf16;
typedef short bf16x8 __attribute__((ext_vector_type(8)));
typedef short s16x4 __attribute__((ext_vector_type(4)));
typedef float f32x2 __attribute__((ext_vector_type(2)));
typedef float f32x4 __attribute__((ext_vector_type(4)));
typedef float f32x16 __attribute__((ext_vector_type(16)));
typedef unsigned u32x2 __attribute__((ext_vector_type(2)));
typedef unsigned u32x4 __attribute__((ext_vector_type(4)));
typedef __bf16 bf16x2_t __attribute__((ext_vector_type(2)));
typedef int i32x4 __attribute__((ext_vector_type(4)));
typedef GAS unsigned gu32;

constexpr int NWAVES = 8, NTHREADS = 512;
constexpr int NT_IN = 45;
constexpr int NIN = NT_IN * 256;
constexpr int KS_ADA = 16;
constexpr int MAXT = 72;
constexpr int XS_ROWS = MAXT * 256;

constexpr size_t al256(size_t x) { return (x + 255) / 256 * 256; }
constexpr size_t WS_CTL = 0, CTL_BYTES = 1u << 20;
constexpr size_t WS_MOD = WS_CTL + CTL_BYTES;
constexpr size_t WS_PART = WS_MOD + al256((size_t)4 * 6 * D * 4);
constexpr size_t WS_ROPE = WS_PART + al256((size_t)2 * KS_ADA * 2 * 6 * D * 4);
constexpr size_t WS_SEL = WS_ROPE + al256(2 * 128 * 16 * 4);
constexpr size_t WS_GW = WS_SEL + al256((size_t)2 * SEQ * 4);
constexpr size_t WS_SLOT = WS_GW + al256((size_t)2 * SEQ * 4);
constexpr int SC_IN = 0, SC_GU = 2 * NIN, SC_GUE = SC_GU + 2 * DFF, SC_TOTAL = SC_GUE + NE * 2 * DFE;
constexpr size_t WS_HSC = WS_SLOT + al256((size_t)2 * SEQ * 4);
constexpr size_t WS_XSC = WS_HSC + al256((size_t)MT * 4);
constexpr size_t WS_WSC = WS_XSC + al256((size_t)XS_ROWS * 4);
constexpr size_t CTL_COLMAX = 65536;
static_assert(CTL_COLMAX + (size_t)SC_TOTAL * 4 <= CTL_BYTES, "column maxima inside the zeroed control region");
constexpr size_t WS_XL = WS_WSC + al256((size_t)SC_TOTAL * 4);
constexpr size_t WS_HN = WS_XL + al256((size_t)MT * D * 4);
constexpr size_t WS_MIX = WS_HN + al256((size_t)MT * D * 2);
constexpr size_t MX_QC = 0;
constexpr size_t MX_KRB = MX_QC + al256((size_t)MT * 1024 * 2);
constexpr size_t MX_SSQ = MX_KRB + al256((size_t)MT * 64 * 2);
constexpr size_t MX_U = MX_SSQ + al256((size_t)MT * 16 * 4);
constexpr size_t MX_CB = MX_U + al256((size_t)MT * D * 2);
constexpr size_t MX_SGA = MX_CB + al256((size_t)MT * D * 2);
constexpr size_t MX_SGB = MX_SGA + al256((size_t)MT * D * 2);
constexpr size_t MX_Q = MX_SGB + al256((size_t)MT * D * 2);
constexpr size_t MX_KV = MX_Q + al256((size_t)MT * 3072 * 2);
constexpr size_t MX_O = MX_KV + al256((size_t)MT * 4096 * 2);
constexpr size_t MX_V2 = MX_O + al256((size_t)MT * D * 2);
constexpr size_t MX_M1 = MX_V2 + al256((size_t)MT * D * 2);
constexpr size_t MX_MG = MX_M1 + al256((size_t)MT * D * 2);
constexpr size_t MX_END = MX_MG + al256((size_t)MT * D * 2);
constexpr size_t FX_ACT = 0;
constexpr size_t FX_XS = 0;
constexpr size_t FX_ACTE = FX_XS + al256((size_t)XS_ROWS * D * 2);
constexpr size_t FX_YS = FX_ACTE + al256((size_t)XS_ROWS * DFE * 2);
constexpr size_t FX_END = FX_YS + al256((size_t)XS_ROWS * D * 2);
static_assert(MX_SGA - MX_CB == (size_t)MT * D * 2 && MX_SGB - MX_SGA == (size_t)MT * D * 2, "CB | SGA | SGB contiguous");
static_assert(FX_END <= MX_END && (size_t)MT * DFF * 2 <= MX_END, "FFN scratch overlays the mixer scratch");
constexpr size_t WS_W = WS_MIX + MX_END;
constexpr size_t W_IN = 0, W_IN_L = (size_t)NIN * D * 2;
constexpr size_t W_QB = W_IN + 2 * W_IN_L, W_QB_L = (size_t)3072 * 512 * 2;
constexpr size_t W_KVB = W_QB + 2 * W_QB_L, W_KVB_L = (size_t)4096 * 512 * 2;
constexpr size_t W_OA = W_KVB + 2 * W_KVB_L, W_SQ_L = (size_t)D * D * 2;
constexpr size_t W_OB = W_OA + 2 * W_SQ_L, W_O = W_OB + 2 * W_SQ_L;
constexpr size_t W_GU = W_O + 2 * W_SQ_L;
constexpr size_t W_DD = W_GU + (size_t)2 * DFF * D * 2;
constexpr size_t W_GUE = W_DD + (size_t)D * DFF * 2, W_GUE_E = (size_t)2 * DFE * D * 2;
constexpr size_t W_DE = W_GUE + NE * W_GUE_E, W_DE_E = (size_t)D * DFE * 2;
constexpr size_t W_END = W_DE + NE * W_DE_E;
constexpr size_t WS_END = WS_W + W_END;

constexpr int RING_BYTES = 131072;
constexpr int LCTL_OFF = RING_BYTES;
constexpr int LDS_BYTES = 147456;

__device__ __forceinline__ unsigned cvtpk(float lo, float hi) { f32x2 v = {lo, hi}; bf16x2_t b = __builtin_convertvector(v, bf16x2_t); return __builtin_bit_cast(unsigned, b); }
__device__ __forceinline__ u32x4 pack8(f32x4 a, f32x4 b) { u32x4 w; w.x = cvtpk(a[0], a[1]); w.y = cvtpk(a[2], a[3]); w.z = cvtpk(b[0], b[1]); w.w = cvtpk(b[2], b[3]); return w; }
__device__ __forceinline__ void unpack8(u32x4 w, f32x4& a, f32x4& b) {
    a[0] = __uint_as_float(w.x << 16); a[1] = __uint_as_float(w.x & 0xffff0000u); a[2] = __uint_as_float(w.y << 16); a[3] = __uint_as_float(w.y & 0xffff0000u);
    b[0] = __uint_as_float(w.z << 16); b[1] = __uint_as_float(w.z & 0xffff0000u); b[2] = __uint_as_float(w.w << 16); b[3] = __uint_as_float(w.w & 0xffff0000u); }
__device__ __forceinline__ f32x4 unpack4(u32x2 w) { f32x4 a; a[0] = __uint_as_float(w.x << 16); a[1] = __uint_as_float(w.x & 0xffff0000u); a[2] = __uint_as_float(w.y << 16); a[3] = __uint_as_float(w.y & 0xffff0000u); return a; }
__device__ __forceinline__ float fsig(float x) { return __builtin_amdgcn_rcpf(1.f + __builtin_amdgcn_exp2f(-1.4426950408889634f * x)); }
__device__ __forceinline__ f32x4 fsig4(f32x4 x) { f32x4 r; r[0] = fsig(x[0]); r[1] = fsig(x[1]); r[2] = fsig(x[2]); r[3] = fsig(x[3]); return r; }
__device__ __forceinline__ float wave_sum(float v) {
#pragma unroll
    for (int o = 1; o < 64; o <<= 1) v += __shfl_xor(v, o);
    return v;
}
#define LDS_WAIT() asm volatile("s_waitcnt lgkmcnt(0)" ::: "memory")
#define VM_WAIT() asm volatile("s_waitcnt vmcnt(0)" ::: "memory")

namespace pg8 {
constexpr int BM = 256, BK = 64, HALF = 128, HTB = HALF * BK * 2, STAGE_BYTES = 8 * HTB, NXCD = 8, WGM = 8;
__device__ __forceinline__ int lds_byte(int r, int c) { const int st = (r >> 4) * 2 + (c >> 5), rr = r & 15, cc = c & 31, ob = rr * 64 + cc * 2; return st * 1024 + (ob ^ (((ob >> 9) & 1) << 5)); }
__device__ __forceinline__ void stage_rc(int b, int& R, int& C) { const int st = b / 1024, sb = b % 1024, swz = sb ^ (((sb >> 9) & 1) << 5); R = (st >> 1) * 16 + swz / 64; C = (st & 1) * 32 + (swz % 64) / 2; }
__device__ __forceinline__ int perm32(int rho) { const int n = rho >> 4, i = rho & 15; return 8 * (i >> 2) + 4 * n + (i & 3); }
struct Unit { int pm, pn, kind; };
struct Geo { int lda, ldb, K; };
__device__ __forceinline__ void tile_of(int L, int nM, int nN, int& pm, int& pn) {
    const int nwg = nM * nN; int wgid = L; { const int q = nwg / NXCD, r = nwg % NXCD, xcd = wgid % NXCD, off = wgid / NXCD; wgid = (xcd < r ? xcd * (q + 1) : r * (q + 1) + (xcd - r) * q) + off; }
    const int nig = WGM * nN, gid = wgid / nig, fm = gid * WGM, gsz = (nM - fm) < WGM ? (nM - fm) : WGM;
    pm = fm + ((wgid % nig) % gsz); pn = (wgid % nig) / gsz;
}
template <class Epi, class Sched, bool ALIGN_EPI, bool I8 = false>
__device__ __forceinline__ void gemm_phase(LAS unsigned char* lds, const Geo g, const Sched& S, const Epi& E) {
    int tid = threadIdx.x; asm volatile("" : "+v"(tid));
    const int wid = __builtin_amdgcn_readfirstlane(tid >> 6), lane = tid & 63, wr = wid >> 2, wc = wid & 3, fr = lane & 15, fq = lane >> 4;
    const int nt = g.K / BK;
    unsigned voffA[2], voffB[2];
#pragma unroll
    for (int i = 0; i < 2; ++i) { int R, C; stage_rc(tid * 16 + i * 8192, R, C); const int Rb = Epi::PERM ? ((R & ~31) + perm32(R & 31)) : R;
        voffA[i] = (unsigned)(R * g.lda + C) * 2u; voffB[i] = (unsigned)(Rb * g.ldb + C) * 2u; }
    const size_t kstep = (size_t)(BK * 2);
    const size_t hstepA = (size_t)HALF * g.lda * 2, hstepB = (size_t)HALF * g.ldb * 2;
    const unsigned ldsw = (unsigned)wid * 1024u;
    const int aoff = lds_byte(wr * 64 + fr, fq * 8), boff = lds_byte(wc * 32 + fr, fq * 8);
#define PG8_SA(b, h) (((b) * 2 + (h)) * HTB)
#define PG8_SB(b, h) ((4 + (b) * 2 + (h)) * HTB)
#define PG8_STAGE(bufoff, gbase, voff) do { _Pragma("unroll") for (int _i = 0; _i < 2; ++_i) \
        __builtin_amdgcn_global_load_lds((const unsigned*)((const char*)(gbase) + (voff)[_i]), (LAS unsigned*)(lds + (bufoff) + ldsw + _i * 8192), 16, 0, 0); } while (0)
#define PG8_LDA(dst, b, h) do { _Pragma("unroll") for (int m = 0; m < 4; ++m) _Pragma("unroll") for (int k = 0; k < 2; ++k) dst[m][k] = *(const LAS bf16x8*)(lds + PG8_SA(b, h) + aoff + m * 2048 + k * 1024); } while (0)
#define PG8_LDB(dst, b, h) do { _Pragma("unroll") for (int n = 0; n < 2; ++n) _Pragma("unroll") for (int k = 0; k < 2; ++k) dst[n][k] = *(const LAS bf16x8*)(lds + PG8_SB(b, h) + boff + n * 2048 + k * 1024); } while (0)
#define PG8_MMA(ai, bj, At, Bt) do { __builtin_amdgcn_s_setprio(1); _Pragma("unroll") for (int m = 0; m < 4; ++m) _Pragma("unroll") for (int n = 0; n < 2; ++n) _Pragma("unroll") for (int k = 0; k < 2; ++k) { \
        if constexpr (I8) acc[ai][bj][m][n] = __builtin_bit_cast(f32x4, __builtin_amdgcn_mfma_i32_16x16x64_i8(__builtin_bit_cast(i32x4, Bt[n][k]), __builtin_bit_cast(i32x4, At[m][k]), __builtin_bit_cast(i32x4, acc[ai][bj][m][n]), 0, 0, 0)); \
        else acc[ai][bj][m][n] = __builtin_amdgcn_mfma_f32_16x16x32_bf16(Bt[n][k], At[m][k], acc[ai][bj][m][n], 0, 0, 0); } __builtin_amdgcn_s_setprio(0); } while (0)
#define PG8_WAIT_V(n) asm volatile("s_waitcnt vmcnt(" #n ")" ::: "memory")
#define PG8_WAIT_L(n) asm volatile("s_waitcnt lgkmcnt(" #n ")" ::: "memory")
#define PG8_BAR __builtin_amdgcn_s_barrier()
#define PG8_SCHED __builtin_amdgcn_sched_barrier(0)
    Unit cur, nxt; int ui = 0;
    if (!S.next(0, cur)) return;
    float zf = 0.f; asm volatile("" : "+v"(zf));
    f32x4 acc[2][2][4][2];
#pragma unroll
    for (int a = 0; a < 2; ++a)
#pragma unroll
        for (int b = 0; b < 2; ++b)
#pragma unroll
            for (int m = 0; m < 4; ++m)
#pragma unroll
                for (int n = 0; n < 2; ++n) acc[a][b][m][n] = (f32x4){zf, zf, zf, zf};
    bf16x8 At[4][2], B0[2][2], B1[2][2];
    const char* cA = S.abase(cur); const char* cB = S.bbase(cur);
    PG8_STAGE(PG8_SB(0, 0), cB, voffB); PG8_STAGE(PG8_SB(0, 1), cB + hstepB, voffB); PG8_STAGE(PG8_SA(0, 0), cA, voffA); PG8_STAGE(PG8_SA(0, 1), cA + hstepA, voffA);
    if (wr == 1) PG8_BAR;
    PG8_WAIT_V(2); PG8_BAR;
    PG8_STAGE(PG8_SB(1, 0), cB + kstep, voffB); PG8_STAGE(PG8_SA(1, 0), cA + kstep, voffA); PG8_STAGE(PG8_SB(1, 1), cB + hstepB + kstep, voffB);
    PG8_WAIT_V(6); PG8_BAR;
    for (;;) {
        const bool has_next = S.next(ui + 1, nxt);
        const char* nA = has_next ? S.abase(nxt) : cA; const char* nB = has_next ? S.bbase(nxt) : cB;
        for (int t = 0; t < nt; t += 2) {
            const bool last = (t == nt - 2);
            const char* a1 = cA + (size_t)(t + 1) * kstep;
            const char* a2 = last ? nA : cA + (size_t)(t + 2) * kstep; const char* b2 = last ? nB : cB + (size_t)(t + 2) * kstep;
            const char* a3 = a2 + kstep; const char* b3 = b2 + kstep;
            PG8_LDB(B0, 0, 0); PG8_LDB(B1, 0, 1); PG8_SCHED; PG8_LDA(At, 0, 0); PG8_STAGE(PG8_SA(1, 1), a1 + hstepA, voffA);
            PG8_WAIT_V(8); PG8_WAIT_L(0); PG8_BAR; PG8_MMA(0, 0, At, B0); PG8_MMA(0, 1, At, B1); PG8_BAR; PG8_SCHED;
            PG8_LDA(At, 0, 1); PG8_STAGE(PG8_SB(0, 0), b2, voffB); PG8_STAGE(PG8_SB(0, 1), b2 + hstepB, voffB); PG8_STAGE(PG8_SA(0, 0), a2, voffA);
            PG8_WAIT_V(8); PG8_WAIT_L(0); PG8_BAR; PG8_MMA(1, 0, At, B0); PG8_MMA(1, 1, At, B1); PG8_BAR; PG8_SCHED;
            PG8_LDB(B0, 1, 0); PG8_LDB(B1, 1, 1); PG8_SCHED; PG8_LDA(At, 1, 0); PG8_STAGE(PG8_SA(0, 1), a2 + hstepA, voffA);
            PG8_WAIT_V(8); PG8_WAIT_L(0); PG8_BAR; PG8_MMA(0, 0, At, B0); PG8_MMA(0, 1, At, B1); PG8_BAR; PG8_SCHED;
            PG8_LDA(At, 1, 1); PG8_STAGE(PG8_SB(1, 0), b3, voffB); PG8_STAGE(PG8_SB(1, 1), b3 + hstepB, voffB); PG8_STAGE(PG8_SA(1, 0), a3, voffA);
            PG8_WAIT_V(8); PG8_WAIT_L(0); PG8_BAR; PG8_MMA(1, 0, At, B0); PG8_MMA(1, 1, At, B1); PG8_BAR; PG8_SCHED;
        }
        if constexpr (ALIGN_EPI) { if (wr == 0) PG8_BAR; }
        if constexpr (I8) {
            static_assert(Epi::PERM, "the int8 path dequantises in the PERM column layout");
            const float* sa = S.sa(cur) + wr * 64 + fr; const float* sb = S.sb(cur) + wc * 32 + 8 * fq;
            f32x4 sbv[2][2];
#pragma unroll
            for (int b = 0; b < 2; ++b)
#pragma unroll
                for (int n = 0; n < 2; ++n) sbv[b][n] = *(const f32x4*)(sb + b * HALF + 4 * n);
#pragma unroll
            for (int a = 0; a < 2; ++a)
#pragma unroll
                for (int m = 0; m < 4; ++m) { const float sr = sa[a * HALF + m * 16];
#pragma unroll
                    for (int b = 0; b < 2; ++b)
#pragma unroll
                        for (int n = 0; n < 2; ++n) { const i32x4 iv = __builtin_bit_cast(i32x4, acc[a][b][m][n]);
                            acc[a][b][m][n] = (f32x4){(float)iv[0], (float)iv[1], (float)iv[2], (float)iv[3]} * (sbv[b][n] * sr); } }
        }
        E(acc, cur, wr, wc, fr, fq);
        if (!has_next) break;
#pragma unroll
        for (int a = 0; a < 2; ++a)
#pragma unroll
            for (int b = 0; b < 2; ++b)
#pragma unroll
                for (int m = 0; m < 4; ++m)
#pragma unroll
                    for (int n = 0; n < 2; ++n) acc[a][b][m][n] = (f32x4){zf, zf, zf, zf};
        cur = nxt; cA = nA; cB = nB; ++ui;
        if constexpr (ALIGN_EPI) { if (wr == 1) PG8_BAR; }
    }
    PG8_WAIT_V(0);
    if constexpr (!ALIGN_EPI) { if (wr == 0) PG8_BAR; }
    PG8_BAR;
#undef PG8_SA
#undef PG8_SB
#undef PG8_STAGE
#undef PG8_LDA
#undef PG8_LDB
#undef PG8_MMA
#undef PG8_WAIT_V
#undef PG8_WAIT_L
#undef PG8_BAR
#undef PG8_SCHED
}

struct TileOrder {
    int nM, nN, pm0, G, c, nx, xpm, xpn0;
    const char* A; const char* B; size_t tstepA, tstepB; const float* SA; const float* SB;
    __device__ __forceinline__ const float* sa(const Unit& u) const { return SA + (size_t)u.pm * 256; }
    __device__ __forceinline__ const float* sb(const Unit& u) const { return SB + (size_t)u.pn * 256; }
    __device__ __forceinline__ bool next(int i, Unit& u) const {
        const int L = i * G + c, n1 = nM * nN;
        if (L < n1) { tile_of(L, nM, nN, u.pm, u.pn); u.pm += pm0; u.kind = 0; return true; }
        if (L < n1 + nx) { u.pm = xpm; u.pn = xpn0 + (L - n1); u.kind = 0; return true; }
        return false; }
    __device__ __forceinline__ const char* abase(const Unit& u) const { return A + (size_t)u.pm * tstepA; }
    __device__ __forceinline__ const char* bbase(const Unit& u) const { return B + (size_t)u.pn * tstepB; }
};
struct QkvOrder {
    int nMkv, nMq, pm0q, G, c; const char* QC; const char* WQB; long dkv;
    __device__ __forceinline__ bool next(int i, Unit& u) const {
        const int L = i * G + c, n1 = nMkv * 16;
        if (L < n1) { tile_of(L, nMkv, 16, u.pm, u.pn); u.kind = 0; return true; }
        if (L < n1 + nMq * 12) { tile_of(L - n1, nMq, 12, u.pm, u.pn); u.pm += pm0q; u.kind = 1; return true; }
        return false; }
    __device__ __forceinline__ const char* abase(const Unit& u) const { return QC + (size_t)u.pm * (256 * 1024 * 2) + (u.kind == 0 ? 1024 : 0); }
    __device__ __forceinline__ const char* bbase(const Unit& u) const { return WQB + (u.kind == 0 ? dkv : 0l) + (size_t)u.pn * (256 * 512 * 2); }
};
struct MoeOrder {
    int T, nN, G, c; const char* A; const char* B; size_t tstepA, tstepB, estride; const LAS int* te; const float* SA; const float* SB; int sbstride;
    __device__ __forceinline__ const float* sa(const Unit& u) const { return SA + (size_t)u.pm * 256; }
    __device__ __forceinline__ const float* sb(const Unit& u) const { const int e = __builtin_amdgcn_readfirstlane(te[u.pm]); return SB + (size_t)e * sbstride + (size_t)u.pn * 256; }
    __device__ __forceinline__ bool next(int i, Unit& u) const {
        const int L = i * G + c; if (L >= T * nN) return false;
        tile_of(L, T, nN, u.pm, u.pn); u.kind = 0; return true; }
    __device__ __forceinline__ const char* abase(const Unit& u) const { return A + (size_t)u.pm * tstepA; }
    __device__ __forceinline__ const char* bbase(const Unit& u) const { const int e = __builtin_amdgcn_readfirstlane(te[u.pm]); return B + (size_t)e * estride + (size_t)u.pn * tstepB; }
};

typedef const f32x4 (&AccRef)[2][2][4][2];
struct EpiInproj {
    static constexpr bool PERM = true;
    bf16* QC; bf16* KRB; bf16* U; bf16* CB; float* SSQ; const float* ROPE;
    __device__ __forceinline__ void operator()(AccRef acc, const Unit& u, int wr, int wc, int fr_, int fq_) const {
        int fr = fr_, fq = fq_; asm volatile("" : "+v"(fr), "+v"(fq));
        const int pn = u.pn, row0 = u.pm * BM + wr * 64 + fr;
        if (pn < 4) {
#pragma unroll
            for (int ai = 0; ai < 2; ++ai)
#pragma unroll
                for (int m = 0; m < 4; ++m) { const int row = row0 + ai * HALF + m * 16; float s = 0.f;
#pragma unroll
                    for (int bj = 0; bj < 2; ++bj) { const f32x4 v0 = acc[ai][bj][m][0], v1 = acc[ai][bj][m][1];
                        s += (v0[0] * v0[0] + v0[1] * v0[1]) + (v0[2] * v0[2] + v0[3] * v0[3]) + (v1[0] * v1[0] + v1[1] * v1[1]) + (v1[2] * v1[2] + v1[3] * v1[3]);
                        *(u32x4*)(QC + (size_t)row * 1024 + pn * 256 + bj * HALF + wc * 32 + 8 * fq) = pack8(v0, v1); }
                    s += __shfl_xor(s, 16); s += __shfl_xor(s, 32);
                    if (fq == 0) SSQ[(size_t)row * 16 + pn * 4 + wc] = s; }
        } else if (pn == 4) {
            if (wc < 2) {
#pragma unroll
                for (int ai = 0; ai < 2; ++ai)
#pragma unroll
                    for (int m = 0; m < 4; ++m) { const int row = row0 + ai * HALF + m * 16; f32x4 v0 = acc[ai][0][m][0], v1 = acc[ai][0][m][1];
                        if (row >= LC) { const int t = row - LC, pos = wc ? (t & 63) : (t >> 6);
                            const f32x4 cs = *(const f32x4*)(ROPE + pos * 16 + 4 * fq), sn = *(const f32x4*)(ROPE + 2048 + pos * 16 + 4 * fq);
                            const f32x4 a0 = v0, a1 = v1;
                            v0[0] = a0[0] * cs[0] - a0[1] * sn[0]; v0[1] = a0[1] * cs[0] + a0[0] * sn[0]; v0[2] = a0[2] * cs[1] - a0[3] * sn[1]; v0[3] = a0[3] * cs[1] + a0[2] * sn[1];
                            v1[0] = a1[0] * cs[2] - a1[1] * sn[2]; v1[1] = a1[1] * cs[2] + a1[0] * sn[2]; v1[2] = a1[2] * cs[3] - a1[3] * sn[3]; v1[3] = a1[3] * cs[3] + a1[2] * sn[3]; }
                        *(u32x4*)(KRB + (size_t)row * 64 + wc * 32 + 8 * fq) = pack8(v0, v1); }
            }
        } else if (pn < 21) {
            const int j = pn - 5;
#pragma unroll
            for (int ai = 0; ai < 2; ++ai)
#pragma unroll
                for (int m = 0; m < 4; ++m) { const int row = row0 + ai * HALF + m * 16;
                    *(u32x4*)(U + (size_t)row * D + j * 128 + wc * 32 + 8 * fq) = pack8(acc[ai][0][m][0] * acc[ai][1][m][0], acc[ai][0][m][1] * acc[ai][1][m][1]); }
        } else {
            bf16* dst = CB + (size_t)((pn - 21) >> 3) * ((size_t)MT * D); const int col = ((pn - 21) & 7) * 256; const bool sg = pn >= 29;
#pragma unroll
            for (int ai = 0; ai < 2; ++ai)
#pragma unroll
                for (int m = 0; m < 4; ++m) { const int row = row0 + ai * HALF + m * 16;
#pragma unroll
                    for (int bj = 0; bj < 2; ++bj) { f32x4 v0 = acc[ai][bj][m][0], v1 = acc[ai][bj][m][1];
                        if (sg) { v0 = fsig4(v0); v1 = fsig4(v1); }
                        *(u32x4*)(dst + (size_t)row * D + col + bj * HALF + wc * 32 + 8 * fq) = pack8(v0, v1); } }
        }
    }
};
struct EpiQkv {
    static constexpr bool PERM = true;
    bf16* Q; bf16* KV; const float* SSQ; const float* ROPE;
    __device__ __forceinline__ void operator()(AccRef acc, const Unit& u, int wr, int wc, int fr_, int fq_) const {
        int fr = fr_, fq = fq_; asm volatile("" : "+v"(fr), "+v"(fq));
        const int row0 = u.pm * BM + wr * 64 + fr, grp = u.kind == 0 ? 8 : 0;
#pragma unroll
        for (int ai = 0; ai < 2; ++ai)
#pragma unroll
            for (int m = 0; m < 4; ++m) { const int row = row0 + ai * HALF + m * 16;
                const f32x4 s0 = *(const f32x4*)(SSQ + (size_t)row * 16 + grp), s1 = *(const f32x4*)(SSQ + (size_t)row * 16 + grp + 4);
                const float rs = rsqrtf(((s0[0] + s0[1]) + (s0[2] + s0[3]) + (s1[0] + s1[1]) + (s1[2] + s1[3])) * (1.f / 512.f) + EPS);
                const float rq = (u.kind == 0) ? rs : rs * (ATT_SCALE * 1.4426950408889634f);
#pragma unroll
                for (int bj = 0; bj < 2; ++bj) { f32x4 v0 = acc[ai][bj][m][0] * rq, v1 = acc[ai][bj][m][1] * rq;
                    if (u.kind == 0) { *(u32x4*)(KV + (size_t)row * 4096 + u.pn * 256 + bj * HALF + wc * 32 + 8 * fq) = pack8(v0, v1); }
                    else { const int hb = (u.pn * 8 + bj * 4 + wc) % 6;
                        if (hb >= 4 && row >= LC) { const int t = row - LC, pos = (hb == 5) ? (t & 63) : (t >> 6);
                            const f32x4 cs = *(const f32x4*)(ROPE + pos * 16 + 4 * fq), sn = *(const f32x4*)(ROPE + 2048 + pos * 16 + 4 * fq);
                            const f32x4 a0 = v0, a1 = v1;
                            v0[0] = a0[0] * cs[0] - a0[1] * sn[0]; v0[1] = a0[1] * cs[0] + a0[0] * sn[0]; v0[2] = a0[2] * cs[1] - a0[3] * sn[1]; v0[3] = a0[3] * cs[1] + a0[2] * sn[1];
                            v1[0] = a1[0] * cs[2] - a1[1] * sn[2]; v1[1] = a1[1] * cs[2] + a1[0] * sn[2]; v1[2] = a1[2] * cs[3] - a1[3] * sn[3]; v1[3] = a1[3] * cs[3] + a1[2] * sn[3]; }
                        *(u32x4*)(Q + (size_t)row * 3072 + u.pn * 256 + bj * HALF + wc * 32 + 8 * fq) = pack8(v0, v1); } } }
    }
};
template <int MODE> struct EpiMerge {
    static constexpr bool PERM = true;
    const bf16* SG; const bf16* M1; bf16* OUT;
    __device__ __forceinline__ void operator()(AccRef acc, const Unit& u, int wr, int wc, int fr_, int fq_) const {
        int fr = fr_, fq = fq_; asm volatile("" : "+v"(fr), "+v"(fq));
        const int row0 = u.pm * BM + wr * 64 + fr;
#pragma unroll
        for (int ai = 0; ai < 2; ++ai)
#pragma unroll
            for (int m = 0; m < 4; ++m) { const int row = row0 + ai * HALF + m * 16;
#pragma unroll
                for (int bj = 0; bj < 2; ++bj) { const size_t off = (size_t)row * D + u.pn * 256 + bj * HALF + wc * 32 + 8 * fq;
                    f32x4 g0, g1; unpack8(*(const u32x4*)(SG + off), g0, g1);
                    f32x4 v0 = acc[ai][bj][m][0] * g0, v1 = acc[ai][bj][m][1] * g1;
                    if (MODE == 1) { f32x4 m0, m1; unpack8(*(const u32x4*)(M1 + off), m0, m1); v0 += m0; v1 += m1; }
                    *(u32x4*)(OUT + off) = pack8(v0, v1); } }
    }
};
struct EpiSwiglu {
    static constexpr bool PERM = true;
    bf16* ACT; int ld;
    __device__ __forceinline__ void operator()(AccRef acc, const Unit& u, int wr, int wc, int fr_, int fq_) const {
        int fr = fr_, fq = fq_; asm volatile("" : "+v"(fr), "+v"(fq));
        const int row0 = u.pm * BM + wr * 64 + fr;
#pragma unroll
        for (int ai = 0; ai < 2; ++ai)
#pragma unroll
            for (int m = 0; m < 4; ++m) { const int row = row0 + ai * HALF + m * 16;
                const f32x4 g0 = acc[ai][0][m][0], g1 = acc[ai][0][m][1];
                const f32x4 v0 = g0 * fsig4(g0) * acc[ai][1][m][0], v1 = g1 * fsig4(g1) * acc[ai][1][m][1];
                *(u32x4*)(ACT + (size_t)row * ld + u.pn * 128 + wc * 32 + 8 * fq) = pack8(v0, v1); }
    }
};
struct EpiResid {
    static constexpr bool PERM = false;
    float* XL; const float* SRC; const float* gl;
    __device__ __forceinline__ void operator()(AccRef acc, const Unit& u, int wr, int wc, int fr_, int fq_) const {
        int fr = fr_, fq = fq_; asm volatile("" : "+v"(fr), "+v"(fq));
        const int row0 = u.pm * BM + wr * 64 + fr; const float* gate = gl + ((u.pm == 0) ? 6 * D : 0);
#pragma unroll
        for (int bj = 0; bj < 2; ++bj)
#pragma unroll
            for (int n = 0; n < 2; ++n) { const int col = u.pn * 256 + bj * HALF + wc * 32 + 16 * n + 4 * fq; const f32x4 gv = *(const f32x4*)(gate + col);
#pragma unroll
                for (int ai = 0; ai < 2; ++ai)
#pragma unroll
                    for (int m = 0; m < 4; ++m) { const size_t o = (size_t)(row0 + ai * HALF + m * 16) * D + col; *(f32x4*)(XL + o) = *(const f32x4*)(SRC + o) + gv * acc[ai][bj][m][n]; } }
    }
};
struct EpiStoreBf16 {
    static constexpr bool PERM = true;
    bf16* C; int ld;
    __device__ __forceinline__ void operator()(AccRef acc, const Unit& u, int wr, int wc, int fr_, int fq_) const {
        int fr = fr_, fq = fq_; asm volatile("" : "+v"(fr), "+v"(fq));
        const int row0 = u.pm * BM + wr * 64 + fr;
#pragma unroll
        for (int ai = 0; ai < 2; ++ai)
#pragma unroll
            for (int m = 0; m < 4; ++m)
#pragma unroll
                for (int bj = 0; bj < 2; ++bj)
                    *(u32x4*)(C + (size_t)(row0 + ai * HALF + m * 16) * ld + u.pn * 256 + bj * HALF + wc * 32 + 8 * fq) = pack8(acc[ai][bj][m][0], acc[ai][bj][m][1]);
    }
};
}

namespace att {
constexpr int QBLK = 32, KVBLK = 64;
constexpr int LDQ = NH * DQK, LDK = NH * 256, LDR = DR, LDO = D;
constexpr int SHM_V = KVBLK * DV * 2, SHM_K = KVBLK * DQK * 2;
constexpr int OFF_K = 2 * SHM_V, OFF_WS = 2 * SHM_V + 2 * SHM_K, OFF_QR = OFF_WS + NWAVES * 64 * 4, OFF_DO = OFF_QR + NWAVES * 4096, SHM_ATTN = OFF_DO + NTHREADS * 20;
static_assert(SHM_ATTN <= RING_BYTES, "attention scratch inside the ring");
constexpr float THR = 8.f;
#define KSWZ(row, colB) ((row) * 384 + ((colB) ^ (((row) & 7) << 4)))
#define SBAR() __builtin_amdgcn_sched_barrier(0)
__device__ __forceinline__ int crow(int r, int hi) { return (r & 3) + 8 * (r >> 2) + 4 * hi; }
constexpr float THR2 = THR * 1.4426950408889634f;
template <bool FIRST> __device__ __forceinline__ void partialSM(f32x16& p0, f32x16& p1, float& m_reg, f32x16& negm, float& alpha) {
    float pmax = p0[0];
#pragma unroll
    for (int r = 1; r < 16; ++r) pmax = fmaxf(pmax, p0[r]);
#pragma unroll
    for (int r = 0; r < 16; ++r) pmax = fmaxf(pmax, p1[r]);
    { auto rr = __builtin_amdgcn_permlane32_swap(__float_as_uint(pmax), __float_as_uint(pmax), false, false);
      pmax = fmaxf(__uint_as_float(rr[0]), __uint_as_float(rr[1])); }
    alpha = 1.f;
    if (FIRST || !__builtin_expect(__all(pmax <= THR2), 1)) {
        const float d = FIRST ? pmax : fmaxf(pmax, 0.f);
        m_reg += d; if (!FIRST) alpha = __builtin_amdgcn_exp2f(-d);
#pragma unroll
        for (int r = 0; r < 16; ++r) { p0[r] -= d; p1[r] -= d; }
#pragma unroll
        for (int r = 0; r < 16; ++r) negm[r] = -m_reg;
    }
#pragma unroll
    for (int r = 0; r < 16; ++r) p0[r] = __builtin_amdgcn_exp2f(p0[r]);
}
__device__ __forceinline__ void finishSM(f32x16& p0, f32x16& p1, float alpha, float& l_reg, bf16x8& pa0, bf16x8& pa1, bf16x8& pa2, bf16x8& pa3) {
#pragma unroll
    for (int r = 0; r < 16; ++r) p1[r] = __builtin_amdgcn_exp2f(p1[r]);
#define PK4(P, BASE, OUT) do { u32x4 w = {cvtpk(P[BASE + 0], P[BASE + 1]), cvtpk(P[BASE + 2], P[BASE + 3]), cvtpk(P[BASE + 4], P[BASE + 5]), cvtpk(P[BASE + 6], P[BASE + 7])}; \
    OUT = __builtin_bit_cast(bf16x8, w); } while (0)
    PK4(p0, 0, pa0); PK4(p0, 8, pa1); PK4(p1, 0, pa2); PK4(p1, 8, pa3);
#undef PK4
    float sa = 0.f, sb = 0.f; const bf16x2_t ones = {(__bf16)1.0f, (__bf16)1.0f};
#define DOT4(PA) do { const u32x4 w_ = __builtin_bit_cast(u32x4, PA); \
    sa = __builtin_amdgcn_fdot2_f32_bf16(__builtin_bit_cast(bf16x2_t, w_.x), ones, sa, false); sb = __builtin_amdgcn_fdot2_f32_bf16(__builtin_bit_cast(bf16x2_t, w_.y), ones, sb, false); \
    sa = __builtin_amdgcn_fdot2_f32_bf16(__builtin_bit_cast(bf16x2_t, w_.z), ones, sa, false); sb = __builtin_amdgcn_fdot2_f32_bf16(__builtin_bit_cast(bf16x2_t, w_.w), ones, sb, false); } while (0)
    DOT4(pa0); DOT4(pa1); DOT4(pa2); DOT4(pa3);
#undef DOT4
    float ps = sa + sb;
    { auto rr = __builtin_amdgcn_permlane32_swap(__float_as_uint(ps), __float_as_uint(ps), false, false);
      ps = __uint_as_float(rr[0]) + __uint_as_float(rr[1]); }
    l_reg = l_reg * alpha + ps;
}
__device__ __forceinline__ void qkt(f32x16& p0, f32x16& p1, const LAS char* Ks, const int (&kb)[4], int krd, const bf16x8* qr, const LAS char* qrl, const f32x16& negm) {
#pragma unroll
    for (int d0 = 0; d0 < 12; ++d0) {
        const LAS char* a = d0 < 8 ? Ks + kb[d0 & 3] + (d0 >> 2) * 128 : Ks + kb[d0 - 8] + krd;
        const bf16x8 b0 = *(const LAS bf16x8*)a;
        const bf16x8 b1 = *(const LAS bf16x8*)(a + (d0 < 8 ? 32 * 256 : 32 * 128));
        if (d0 == 0) { p0 = __builtin_amdgcn_mfma_f32_32x32x16_bf16(b0, qr[0], negm, 0, 0, 0); p1 = __builtin_amdgcn_mfma_f32_32x32x16_bf16(b1, qr[0], negm, 0, 0, 0); }
        else { const bf16x8 qf = d0 < 8 ? qr[d0 & 7] : *(const LAS bf16x8*)(qrl + (d0 - 8) * 1024);
            p0 = __builtin_amdgcn_mfma_f32_32x32x16_bf16(b0, qf, p0, 0, 0, 0); p1 = __builtin_amdgcn_mfma_f32_32x32x16_bf16(b1, qf, p1, 0, 0, 0); } }
}
__device__ __forceinline__ int v_st(int k, int c) { const int kk = (k & ~0xC) | ((k & 4) << 1) | ((k & 8) >> 1); return ((kk >> 3) * 4 + (c >> 5)) * 512 + ((kk & 7) * 32 + (c & 31)) * 2; }
__device__ __forceinline__ int v_rd_base(int lane) { return ((lane & 3) << 3) | (((lane >> 2) & 3) << 6) | (((lane >> 4) & 1) << 5) | (((lane >> 5) & 1) << 8); }
constexpr int v_rd_off(int d0, int ks, int half) { return d0 * 512 + ks * 4096 + half * 2048; }
template <int OFF> __device__ __forceinline__ s16x4 tr_read(int vb) {
    s16x4 r; asm volatile("ds_read_b64_tr_b16 %0, %1 offset:%2" : "=&v"(r) : "v"(vb), "i"(OFF) : "memory"); return r;
}
template <int D0> __device__ __forceinline__ void pv_one(f32x16& od, int vb, bf16x8 pa0, bf16x8 pa1, bf16x8 pa2, bf16x8 pa3) {
    const s16x4 l0 = tr_read<v_rd_off(D0, 0, 0)>(vb), h0 = tr_read<v_rd_off(D0, 0, 1)>(vb), l1 = tr_read<v_rd_off(D0, 1, 0)>(vb), h1 = tr_read<v_rd_off(D0, 1, 1)>(vb);
    const s16x4 l2 = tr_read<v_rd_off(D0, 2, 0)>(vb), h2 = tr_read<v_rd_off(D0, 2, 1)>(vb), l3 = tr_read<v_rd_off(D0, 3, 0)>(vb), h3 = tr_read<v_rd_off(D0, 3, 1)>(vb);
    asm volatile("s_waitcnt lgkmcnt(0)" ::: "memory"); SBAR();
#define PK(L, H) (bf16x8){L[0], L[1], L[2], L[3], H[0], H[1], H[2], H[3]}
    od = __builtin_amdgcn_mfma_f32_32x32x16_bf16(PK(l0, h0), pa0, od, 0, 0, 0);
    od = __builtin_amdgcn_mfma_f32_32x32x16_bf16(PK(l1, h1), pa1, od, 0, 0, 0);
    od = __builtin_amdgcn_mfma_f32_32x32x16_bf16(PK(l2, h2), pa2, od, 0, 0, 0);
    od = __builtin_amdgcn_mfma_f32_32x32x16_bf16(PK(l3, h3), pa3, od, 0, 0, 0);
#undef PK
}
__device__ __forceinline__ void pv_d0(f32x16* o, int vb, bf16x8 pa0, bf16x8 pa1, bf16x8 pa2, bf16x8 pa3) {
    pv_one<0>(o[0], vb, pa0, pa1, pa2, pa3); pv_one<1>(o[1], vb, pa0, pa1, pa2, pa3); pv_one<2>(o[2], vb, pa0, pa1, pa2, pa3); pv_one<3>(o[3], vb, pa0, pa1, pa2, pa3);
}
constexpr int KROPE_OFF = 16384;
__device__ __forceinline__ void attn_unit(const bf16* Qb, const bf16* KVb, int hoff, const bf16* KRb, bf16* Ob, int seq, LAS char* lds) {
    int tid = threadIdx.x; asm volatile("" : "+v"(tid));
    const int wid = __builtin_amdgcn_readfirstlane(tid >> 6), lane = tid & 63, r32 = lane & 31, hi = lane >> 5;
    LAS char* V_lds = lds; LAS char* K_lds = lds + OFF_K;
        float m_reg = 0.f, l_reg = 0; f32x16 o[4]; bf16x8 qr[8]; f32x16 negm;
#pragma unroll
    for (int r = 0; r < 16; ++r) negm[r] = 0.f;
#pragma unroll
    for (int d = 0; d < 4; ++d)
#pragma unroll
        for (int r = 0; r < 16; ++r) o[d][r] = 0.f;
    const bf16* Qw = Qb + (long)(wid * QBLK + r32) * LDQ + hi * 8;
#pragma unroll
    for (int d0 = 0; d0 < 8; ++d0) qr[d0] = *(const bf16x8*)(Qw + d0 * 16);
    LAS char* qrl = lds + OFF_QR + wid * 4096 + lane * 16;
#pragma unroll
    for (int d0 = 8; d0 < 12; ++d0) *(LAS bf16x8*)(qrl + (d0 - 8) * 1024) = *(const bf16x8*)(Qw + d0 * 16);
    int kb[4];
#pragma unroll
    for (int i = 0; i < 4; ++i) kb[i] = r32 * 256 + (((2 * i + hi) ^ (r32 & 7)) << 4);
    const int krd = KROPE_OFF - r32 * 128;
    const int vb0 = (int)(uintptr_t)V_lds + v_rd_base(lane);
    unsigned gk[2], gv[2], gr;
#pragma unroll
    for (int i = 0; i < 2; ++i) { const int s = (wid + 8 * i) * 64 + lane;
        { const int row = s >> 4, lc = (s & 15) ^ (row & 7); gk[i] = (unsigned)(row * (LDK * 2) + lc * 16); }
        { const int st = s >> 5, k = (st >> 2) * 8 + ((s & 31) >> 2), cc = (st & 3) * 32 + (s & 3) * 8; gv[i] = (unsigned)(k * (LDK * 2) + cc * 2); } }
    { const int s = wid * 64 + lane, row = s >> 3, lc = (s & 7) ^ (row & 7); gr = (unsigned)(row * (LDR * 2) + lc * 16); }
    LAS u32x4* dofs = (LAS u32x4*)(lds + OFF_DO + tid * 16); LAS unsigned* dofr = (LAS unsigned*)(lds + OFF_DO + NTHREADS * 16 + tid * 4);
    *dofs = (u32x4){gk[0], gk[1], gv[0], gv[1]}; *dofr = gr;
    const unsigned ldsw = (unsigned)wid * 1024u;
    const __amdgpu_buffer_rsrc_t rkv = __builtin_amdgcn_make_buffer_rsrc((void*)KVb, 0, (int)((size_t)MT * LDK * 2), 0x00020000);
    const __amdgpu_buffer_rsrc_t rkr = __builtin_amdgcn_make_buffer_rsrc((void*)KRb, 0, (int)((size_t)MT * LDR * 2), 0x00020000);
#define DMA_K(t, slot) do { const int ko_ = (t) * (KVBLK * LDK * 2) + hoff, ro_ = (t) * (KVBLK * LDR * 2); const u32x4 of_ = *dofs; const unsigned gr_ = *dofr; \
    __builtin_amdgcn_raw_ptr_buffer_load_lds(rkv, (LAS void*)(K_lds + (slot) * SHM_K + ldsw), 16, (int)of_.x, ko_, 0, 0); \
    __builtin_amdgcn_raw_ptr_buffer_load_lds(rkv, (LAS void*)(K_lds + (slot) * SHM_K + 8192 + ldsw), 16, (int)of_.y, ko_, 0, 0); \
    __builtin_amdgcn_raw_ptr_buffer_load_lds(rkr, (LAS void*)(K_lds + (slot) * SHM_K + KROPE_OFF + ldsw), 16, (int)gr_, ro_, 0, 0); } while (0)
#define DMA_V(t, slot) do { const int vo_ = (t) * (KVBLK * LDK * 2) + hoff + DN * 2; const u32x4 of_ = *dofs; \
    __builtin_amdgcn_raw_ptr_buffer_load_lds(rkv, (LAS void*)(V_lds + (slot) * SHM_V + ldsw), 16, (int)of_.z, vo_, 0, 0); \
    __builtin_amdgcn_raw_ptr_buffer_load_lds(rkv, (LAS void*)(V_lds + (slot) * SHM_V + 8192 + ldsw), 16, (int)of_.w, vo_, 0, 0); } while (0)
#define WAITBAR() asm volatile("s_waitcnt vmcnt(0) lgkmcnt(0)\n\ts_barrier" ::: "memory")
#define RESC(a) do { if (__any((a) < 1.f)) { \
    _Pragma("unroll") for (int d = 0; d < 4; ++d) _Pragma("unroll") for (int r = 0; r < 16; ++r) o[d][r] *= (a); } } while (0)
    f32x16 pA0, pA1, pB0, pB1; float alA, alB; bf16x8 pa0, pa1, pa2, pa3; const int NT = seq / KVBLK;
    if (wid >= 4) __builtin_amdgcn_s_setprio(1);
    DMA_K(0, 0); DMA_V(0, 0); WAITBAR();
    DMA_K(1, 1);
    qkt(pA0, pA1, K_lds, kb, krd, qr, qrl, negm); partialSM<true>(pA0, pA1, m_reg, negm, alA);
    WAITBAR();
    for (int j = 1; j + 1 < NT; j += 2) {
        DMA_K(j + 1, 0); DMA_V(j, 1);
        SBAR(); qkt(pB0, pB1, K_lds + SHM_K, kb, krd, qr, qrl, negm);
        finishSM(pA0, pA1, alA, l_reg, pa0, pa1, pa2, pa3); SBAR();
        pv_d0(o, vb0, pa0, pa1, pa2, pa3); partialSM<false>(pB0, pB1, m_reg, negm, alB);
        RESC(alB); WAITBAR();
        DMA_K(j + 2, 1); DMA_V(j + 1, 0);
        SBAR(); qkt(pA0, pA1, K_lds, kb, krd, qr, qrl, negm);
        finishSM(pB0, pB1, alB, l_reg, pa0, pa1, pa2, pa3); SBAR();
        pv_d0(o, vb0 + SHM_V, pa0, pa1, pa2, pa3); partialSM<false>(pA0, pA1, m_reg, negm, alA);
        RESC(alA); WAITBAR();
    }
    DMA_V(NT - 1, 1);
    SBAR(); qkt(pB0, pB1, K_lds + SHM_K, kb, krd, qr, qrl, negm);
    finishSM(pA0, pA1, alA, l_reg, pa0, pa1, pa2, pa3); SBAR();
    pv_d0(o, vb0, pa0, pa1, pa2, pa3); partialSM<false>(pB0, pB1, m_reg, negm, alB);
    RESC(alB); WAITBAR();
    finishSM(pB0, pB1, alB, l_reg, pa0, pa1, pa2, pa3); SBAR();
    pv_d0(o, vb0 + SHM_V, pa0, pa1, pa2, pa3);
    const float rli = __builtin_amdgcn_rcpf(l_reg);
    WAITBAR();
    LAS char* stg = lds + wid * 8704 + r32 * 272 + hi * 8;
#pragma unroll
    for (int d0 = 0; d0 < 4; ++d0)
#pragma unroll
        for (int g = 0; g < 4; ++g) { u32x2 w; w.x = cvtpk(o[d0][4 * g] * rli, o[d0][4 * g + 1] * rli); w.y = cvtpk(o[d0][4 * g + 2] * rli, o[d0][4 * g + 3] * rli);
            *(LAS u32x2*)(stg + (32 * d0 + 8 * g) * 2) = w; }
    asm volatile("s_waitcnt lgkmcnt(0)" ::: "memory");
    bf16* Ow = Ob + (long)(wid * QBLK) * LDO;
#pragma unroll
    for (int i = 0; i < 8; ++i) { const int row = i * 4 + (lane >> 4), ch = lane & 15; const u32x4 v = *(const LAS u32x4*)(lds + wid * 8704 + row * 272 + ch * 16); *(u32x4*)(Ow + (long)row * LDO + ch * 8) = v; }
    WAITBAR();
    __builtin_amdgcn_s_setprio(0);
#undef DMA_K
#undef DMA_V
#undef WAITBAR
#undef RESC
}
#undef KSWZ
#undef SBAR
}

#define XB_TMO      128
#define XB_XCNT(j)  (256  + 64 * (j))
#define XB_XSUB(j)  (1280 + 64 * (j))
#define XB_XGEN(j)  (2304 + 64 * (j))
#define XB_TOP      3328
#define XB_TOPGEN   3392
#define XCD_BAR_WORDS 3456
#define XB_SPIN_CAP (1u << 18)
__device__ __forceinline__ unsigned xb_ld(unsigned* p)              { return __hip_atomic_load(p, __ATOMIC_RELAXED, __HIP_MEMORY_SCOPE_AGENT); }
__device__ __forceinline__ unsigned xb_add(unsigned* p, unsigned v) { return __hip_atomic_fetch_add(p, v, __ATOMIC_RELAXED, __HIP_MEMORY_SCOPE_AGENT); }
__device__ __forceinline__ unsigned xb_xcc_id() { return (unsigned)__builtin_amdgcn_s_getreg((3 << 11) | 20) & 0xFu; }
#define XB_SPIN(cond, bar) do { unsigned _sp = 0; while (cond) { __builtin_amdgcn_s_sleep(1); \
    if ((++_sp & 255u) == 0u) { if (xb_ld(&(bar)[XB_TMO])) break; if (_sp > XB_SPIN_CAP) { atomicAdd(&(bar)[XB_TMO], 1u); break; } } } } while (0)
struct XcdBarrier { unsigned* bar; unsigned x; volatile LAS unsigned* st; };
__device__ __forceinline__ XcdBarrier xcd_barrier_post(unsigned* bar, volatile LAS unsigned* st) {
    XcdBarrier b; b.bar = bar; b.x = xb_xcc_id(); b.st = st;
    if (threadIdx.x == 0) (void)xb_add(&bar[XB_XCNT(b.x)], 1u);
    return b;
}
__device__ __forceinline__ void xcd_barrier_complete(unsigned* bar, unsigned x, unsigned& nloc, unsigned& nx) {
    const unsigned G = gridDim.x * gridDim.y * gridDim.z;
    unsigned sum, cnt, mine, sp = 0u;
    for (;;) {
        sum = 0u; cnt = 0u; mine = 0u;
#pragma unroll
        for (unsigned j = 0; j < 16; ++j) { const unsigned c = xb_ld(&bar[XB_XCNT(j)]); sum += c; cnt += (c > 0u) ? 1u : 0u; mine = (j == x) ? c : mine; }
        if (sum == G) break;
        __builtin_amdgcn_s_sleep(1);
        if ((++sp & 255u) == 0u) { if (xb_ld(&bar[XB_TMO])) break; if (sp > XB_SPIN_CAP) { atomicAdd(&bar[XB_TMO], 1u); break; } }
    }
    nloc = mine > 0u ? mine : 1u; nx = cnt > 0u ? cnt : 1u;
}
__device__ __forceinline__ void xcd_barrier(const XcdBarrier& b) {
    asm volatile("s_waitcnt vmcnt(0)" ::: "memory");
    __syncthreads();
    if (threadIdx.x == 0) {
        unsigned* bar = b.bar;
        __builtin_amdgcn_s_waitcnt(0);
        unsigned nloc = b.st[0], nx = b.st[1];
        if (nloc == 0u) { xcd_barrier_complete(bar, b.x, nloc, nx); b.st[0] = nloc; b.st[1] = nx; }
        const unsigned old = xb_add(&bar[XB_XSUB(b.x)], 1u);
        const unsigned gen = old / nloc;
        if (old + 1u == (gen + 1u) * nloc) {
            __builtin_amdgcn_fence(__ATOMIC_RELEASE, "agent");
            asm volatile("s_waitcnt vmcnt(0)" ::: "memory");
            const unsigned og = xb_add(&bar[XB_TOP], 1u);
            const unsigned tg = og / nx;
            if (og + 1u == (tg + 1u) * nx) xb_add(&bar[XB_TOPGEN], 1u);
            else XB_SPIN(xb_ld(&bar[XB_TOPGEN]) == tg, bar);
            __builtin_amdgcn_fence(__ATOMIC_ACQUIRE, "agent");
            xb_add(&bar[XB_XGEN(b.x)], 1u);
            asm volatile("s_waitcnt vmcnt(0)" ::: "memory");
        } else {
            XB_SPIN(xb_ld(&bar[XB_XGEN(b.x)]) == gen, bar);
            __builtin_amdgcn_fence(__ATOMIC_ACQUIRE, "agent");
            asm volatile("s_waitcnt vmcnt(0)" ::: "memory");
        }
    }
    __syncthreads();
}

struct Params { const float* in[25]; float* out; unsigned char* ws; int ph_lo, ph_hi; };
static_assert(sizeof(Params) == 25 * 8 + 8 + 8 + 8, "Params has no padding");
struct Ctx { LAS unsigned char* lds; int tid, lane, wave, vcu, G, bid; };
__device__ __forceinline__ Ctx fresh(const Ctx& c) {
    Ctx f; f.lds = c.lds; int tid = c.tid; asm volatile("" : "+v"(tid)); f.tid = tid; f.lane = tid & 63; f.wave = __builtin_amdgcn_readfirstlane(tid >> 6);
    int vcu = c.vcu, G = c.G, bid = c.bid; asm volatile("" : "+v"(vcu), "+v"(G), "+v"(bid));
    f.vcu = __builtin_amdgcn_readfirstlane(vcu); f.G = __builtin_amdgcn_readfirstlane(G); f.bid = __builtin_amdgcn_readfirstlane(bid); return f; }
__device__ __forceinline__ unsigned char* fresh_ptr(unsigned char* p) { unsigned lo = (unsigned)(unsigned long long)p, hi = (unsigned)((unsigned long long)p >> 32); asm volatile("" : "+v"(lo), "+v"(hi));
    const unsigned long long v = ((unsigned long long)(unsigned)__builtin_amdgcn_readfirstlane((int)hi) << 32) | (unsigned)__builtin_amdgcn_readfirstlane((int)lo); return (unsigned char*)(GAS unsigned char*)v; }

__device__ __forceinline__ int win_dst(int s) {
    if (s < 1024) return s;
    if (s < 1088) { const int j = s - 1024, part = j >> 5, w = j & 31; return 1024 + part * 32 + 2 * (w & 15) + (w >> 4); }
    if (s < 3136) { const int c = s - 1088; return 1280 + 256 * (c >> 7) + (c & 127); }
    if (s < 5184) { return 5376 + (s - 3136); }
    if (s < 7232) { const int c = s - 5184; return 1280 + 256 * (c >> 7) + 128 + (c & 127); }
    if (s < 9280) { return 7424 + (s - 7232); }
    return 9472 + (s - 9280);
}
__device__ __forceinline__ int qb_dst(int n) { const int h = n / DQK, d = n - h * DQK; if (d < DN) return n; const int j = d - DN, part = j >> 5, w = j & 31; return h * DQK + DN + part * 32 + 2 * (w & 15) + (w >> 4); }
__device__ __forceinline__ int map_dst(int mode, int n) {
    switch (mode) { case 1: return win_dst(n); case 2: return qb_dst(n); case 3: return 256 * (n >> 7) + (n & 127); case 4: return 256 * (n >> 7) + 128 + (n & 127); default: return n; }
}
__device__ __forceinline__ void transpose_item(const float* W, int K, int N, bf16* WT, int mode, const float* gk, int item, int lane) {
    const int kblk = K / 64, nb = item / kblk, kb = item - nb * kblk, k0 = 64 * kb + 16 * (lane >> 4), n0 = 64 * nb + 4 * (lane & 15);
    const float* src = W + (size_t)k0 * N + n0;
    f32x4 v[16];
#pragma unroll
    for (int i = 0; i < 16; ++i) v[i] = *(const f32x4*)(src + (size_t)i * N);
    if (gk) {
#pragma unroll
        for (int i = 0; i < 16; ++i) v[i] *= gk[k0 + i]; }
#pragma unroll
    for (int x = 0; x < 4; ++x) { bf16* d = WT + (size_t)map_dst(mode, n0 + x) * K + k0;
        u32x4 lo, hi;
        lo.x = cvtpk(v[0][x], v[1][x]); lo.y = cvtpk(v[2][x], v[3][x]); lo.z = cvtpk(v[4][x], v[5][x]); lo.w = cvtpk(v[6][x], v[7][x]);
        hi.x = cvtpk(v[8][x], v[9][x]); hi.y = cvtpk(v[10][x], v[11][x]); hi.z = cvtpk(v[12][x], v[13][x]); hi.w = cvtpk(v[14][x], v[15][x]);
        *(u32x4*)d = lo; *(u32x4*)(d + 8) = hi; }
}
struct Strip { const float* W; int N, mode, nb; signed char* w8; float* wsc; };
constexpr int ST_IN = DIN / 64, ST_GD = DFF / 64, ST_GE = DFE / 64, N_STRIPS = 2 * ST_IN + 2 * ST_GD + NE * 2 * ST_GE;
__device__ __forceinline__ Strip strip_of(const Params& p, int sid) {
    unsigned char* wb = p.ws + WS_W; float* wsc = (float*)(p.ws + WS_WSC);
    Strip q;
    if (sid < 2 * ST_IN) { const int l = sid / ST_IN; q.nb = sid - l * ST_IN; q.W = p.in[7] + (size_t)l * D * DIN; q.N = DIN; q.mode = 1; q.w8 = (signed char*)(wb + W_IN + l * W_IN_L); q.wsc = wsc + SC_IN + l * NIN; return q; }
    sid -= 2 * ST_IN;
    if (sid < 2 * ST_GD) { const int which = sid / ST_GD; q.nb = sid - which * ST_GD; q.W = p.in[17 + which]; q.N = DFF; q.mode = 3 + which; q.w8 = (signed char*)(wb + W_GU); q.wsc = wsc + SC_GU; return q; }
    sid -= 2 * ST_GD;
    { const int e = sid / (2 * ST_GE); sid -= e * (2 * ST_GE); const int which = sid / ST_GE; q.nb = sid - which * ST_GE; q.W = p.in[21 + which] + (size_t)e * D * DFE; q.N = DFE; q.mode = 3 + which;
      q.w8 = (signed char*)(wb + W_GUE + e * W_GUE_E); q.wsc = wsc + SC_GUE + e * 2 * DFE; return q; }
}
__device__ __forceinline__ unsigned pack4i8(float a, float b, float c, float d) {
    const int ia = (int)__builtin_rintf(a), ib = (int)__builtin_rintf(b), ic = (int)__builtin_rintf(c), id = (int)__builtin_rintf(d);
    return ((unsigned)ia & 0xffu) | (((unsigned)ib & 0xffu) << 8) | (((unsigned)ic & 0xffu) << 16) | ((unsigned)id << 24); }
__device__ __forceinline__ void quant_strip(const Strip& q, const Ctx& c, LAS float* cmax  ) {
    const int qd = c.lane >> 4, c4 = 4 * (c.lane & 15), n0 = 64 * q.nb + c4;
    const float* src = q.W + (size_t)(256 * c.wave + 16 * qd) * q.N + n0;
    f32x4 m = {0.f, 0.f, 0.f, 0.f};
#pragma unroll 1
    for (int sb = 0; sb < 4; ++sb) { f32x4 v[16];
#pragma unroll
        for (int i = 0; i < 16; ++i) v[i] = *(const f32x4*)(src + (size_t)(64 * sb + i) * q.N);
#pragma unroll
        for (int i = 0; i < 16; ++i) m = __builtin_elementwise_max(m, __builtin_elementwise_abs(v[i])); }
#pragma unroll
    for (int x = 0; x < 4; ++x) { float t = m[x]; t = fmaxf(t, __shfl_xor(t, 16)); t = fmaxf(t, __shfl_xor(t, 32)); m[x] = t; }
    if (c.lane < 16) *(LAS f32x4*)(cmax + c.wave * 64 + c4) = m;
    __syncthreads();
    f32x4 am = *(const LAS f32x4*)(cmax + c4);
#pragma unroll
    for (int w = 1; w < 8; ++w) am = __builtin_elementwise_max(am, *(const LAS f32x4*)(cmax + w * 64 + c4));
    f32x4 inv; int dst[4];
#pragma unroll
    for (int x = 0; x < 4; ++x) { inv[x] = am[x] > 0.f ? 127.f / am[x] : 0.f; dst[x] = map_dst(q.mode, n0 + x); }
    if (c.wave == 0 && c.lane < 16) {
#pragma unroll
        for (int x = 0; x < 4; ++x) q.wsc[dst[x]] = am[x] * (1.f / 127.f); }
#pragma unroll 1
    for (int sb = 0; sb < 4; ++sb) { f32x4 v[16];
#pragma unroll
        for (int i = 0; i < 16; ++i) v[i] = *(const f32x4*)(src + (size_t)(64 * sb + i) * q.N);
        const int k0 = 256 * c.wave + 64 * sb + 16 * qd;
#pragma unroll
        for (int x = 0; x < 4; ++x) { const float iv = inv[x];
            u32x4 o; o.x = pack4i8(v[0][x] * iv, v[1][x] * iv, v[2][x] * iv, v[3][x] * iv); o.y = pack4i8(v[4][x] * iv, v[5][x] * iv, v[6][x] * iv, v[7][x] * iv);
            o.z = pack4i8(v[8][x] * iv, v[9][x] * iv, v[10][x] * iv, v[11][x] * iv); o.w = pack4i8(v[12][x] * iv, v[13][x] * iv, v[14][x] * iv, v[15][x] * iv);
            *(u32x4*)(q.w8 + (size_t)dst[x] * D + k0) = o; } }
    __syncthreads();
}
constexpr int I_QB = (QL / 64) * (NH * DQK / 64), I_KVB = (KVL / 64) * (NH * 256 / 64), I_SQ = (D / 64) * (D / 64), I_L = I_QB + I_KVB + 3 * I_SQ;
constexpr int I_DD = (DFF / 64) * (D / 64), I_DE = (DFE / 64) * (D / 64);
constexpr int N_ADA = 2 * KS_ADA * 48, N_SMALL = N_ADA + 2 * I_L + I_DD + NE * I_DE, SMALL_BATCH = 32, N_BATCH = (N_SMALL + SMALL_BATCH - 1) / SMALL_BATCH, N_QUEUE = N_STRIPS + N_BATCH;
__device__ __forceinline__ void small_item(const Params& p, const Ctx& c, int it, const LAS float* sil) {
    unsigned char* ws = p.ws; unsigned char* wb = ws + WS_W;
    if (it < N_ADA) {
        float* part = (float*)(ws + WS_PART); const int cg = it % 48, lk = it / 48, kc = lk % KS_ADA, l = lk / KS_ADA;
        const float* W = p.in[4] + (size_t)l * D * (6 * D) + (size_t)(kc * 128) * (6 * D) + cg * 256 + c.lane * 4;
        float zf = 0.f; asm volatile("" : "+v"(zf)); f32x4 al = {zf, zf, zf, zf}, ac = al;
#pragma unroll 8
        for (int k = 0; k < 128; ++k) { const f32x4 w = *(const f32x4*)(W + (size_t)k * (6 * D)); al += w * sil[kc * 128 + k]; ac += w * sil[D + kc * 128 + k]; }
        *(f32x4*)(part + ((size_t)(l * KS_ADA + kc) * 2 + 0) * (6 * D) + cg * 256 + c.lane * 4) = al;
        *(f32x4*)(part + ((size_t)(l * KS_ADA + kc) * 2 + 1) * (6 * D) + cg * 256 + c.lane * 4) = ac; return; }
    int r = it - N_ADA;
    if (r < 2 * I_L) { const int l = r / I_L; r -= l * I_L;
        if (r < I_QB) { transpose_item(p.in[9] + (size_t)l * QL * NH * DQK, QL, NH * DQK, (bf16*)(wb + W_QB + l * W_QB_L), 2, p.in[8] + l * QL, r, c.lane); return; } r -= I_QB;
        if (r < I_KVB) { transpose_item(p.in[11] + (size_t)l * KVL * NH * 256, KVL, NH * 256, (bf16*)(wb + W_KVB + l * W_KVB_L), 0, p.in[10] + l * KVL, r, c.lane); return; } r -= I_KVB;
        const int which = r / I_SQ; r -= which * I_SQ;
        transpose_item(p.in[13 + which] + (size_t)l * D * D, D, D, (bf16*)(wb + (which == 0 ? W_OA : which == 1 ? W_OB : W_O) + l * W_SQ_L), 0, nullptr, r, c.lane); return; }
    r -= 2 * I_L;
    if (r < I_DD) { transpose_item(p.in[19], DFF, D, (bf16*)(wb + W_DD), 0, nullptr, r, c.lane); return; }
    r -= I_DD;
    { const int e = r / I_DE; r -= e * I_DE; transpose_item(p.in[23] + (size_t)e * DFE * D, DFE, D, (bf16*)(wb + W_DE + e * W_DE_E), 0, nullptr, r, c.lane); }
}
constexpr int CW_QHEAD = 2048;
__device__ __forceinline__ void p0_prologue(const Params& p, const Ctx& c) {
    unsigned char* ws = p.ws; unsigned char* wb = ws + WS_W;
    const int gt = c.vcu * NTHREADS + c.tid, NGT = c.G * NTHREADS;
    LAS float* sil = (LAS float*)(c.lds + 98304);
    LAS float* cmax = (LAS float*)(c.lds + 114688);
    LAS int* qslot = (LAS int*)(c.lds + 116736);
    for (int k = c.tid; k < 2 * D; k += NTHREADS) { const float x = k < D ? p.in[1][k] : p.in[3][k - D]; sil[k] = x / (1.f + expf(-x)); }
    { float* rope = (float*)(ws + WS_ROPE);
      for (int i = gt; i < 2048; i += NGT) { const int pos = i >> 4, k = i & 15; const float ang = (float)pos * powf(10000.f, -(float)(2 * k) / 32.f); rope[i] = cosf(ang); rope[2048 + i] = sinf(ang); } }
    { const int n16 = 192 * D / 16; unsigned zu = 0u; asm volatile("" : "+v"(zu));
      for (int i = gt; i < 2 * n16; i += NGT) { const int l = i / n16, r = i - l * n16; *(u32x4*)(wb + W_IN + l * W_IN_L + (size_t)1088 * D + (size_t)r * 16) = (u32x4){zu, zu, zu, zu}; }
      for (int i = gt; i < 2 * 192; i += NGT) { const int l = i / 192, r = i - l * 192; ((float*)(ws + WS_WSC))[SC_IN + l * NIN + 1088 + r] = __uint_as_float(zu); } }
    __syncthreads();
    unsigned* head = (unsigned*)(ws + WS_CTL) + CW_QHEAD;
    for (;;) {
        if (c.tid == 0) *qslot = (int)__hip_atomic_fetch_add(head, 1u, __ATOMIC_RELAXED, __HIP_MEMORY_SCOPE_AGENT);
        __syncthreads();
        const int id = __builtin_amdgcn_readfirstlane(*qslot);
        __syncthreads();
        if (id >= N_QUEUE) break;
        if (id < N_STRIPS) { quant_strip(strip_of(p, id), c, cmax); continue; }
        const int base = (id - N_STRIPS) * SMALL_BATCH;
#pragma unroll 1
        for (int j = 0; j < SMALL_BATCH / NWAVES; ++j) { const int it = base + j * NWAVES + c.wave; if (it < N_SMALL) small_item(p, c, it, sil); }
    }
}
__device__ __forceinline__ void p1_mod(const Params& p, const Ctx& c) {
    const float* part = (const float*)(p.ws + WS_PART); float* mod = (float*)(p.ws + WS_MOD);
    for (int i = c.vcu * NTHREADS + c.tid; i < 4 * 6 * D; i += c.G * NTHREADS) { const int n = i % (6 * D), lv = i / (6 * D), l = lv >> 1, v = lv & 1;
        float s = p.in[5][l * 6 * D + n];
#pragma unroll
        for (int kc = 0; kc < KS_ADA; ++kc) s += part[((size_t)(l * KS_ADA + kc) * 2 + v) * (6 * D) + n];
        mod[i] = s; }
}
__device__ __forceinline__ void norm_pass(const Params& p, const Ctx& c, int layer, int which, int row_lo, bool moe, bool local_mod) {
    const float* XL = (const float*)(p.ws + WS_XL); unsigned char* HN = p.ws + WS_HN; float* HSC = (float*)(p.ws + WS_HSC); const float* mod = (const float*)(p.ws + WS_MOD);
    const bool from_in = (layer == 0 && which == 0);
    const float* g = (which ? p.in[16] : p.in[6]) + layer * D;
    const int gw = c.vcu * NWAVES + c.wave, NGW = c.G * NWAVES;
    LAS float* lmod = (LAS float*)(c.lds + 65536);
    if (local_mod) { const float* part = (const float*)(p.ws + WS_PART);
        for (int i = c.tid; i < 4 * D; i += NTHREADS) { const int vec = i / D, v = vec >> 1, n = ((vec & 1) ? D : 0) + (i - vec * D);
            float sacc = p.in[5][layer * 6 * D + n];
#pragma unroll
            for (int kc = 0; kc < KS_ADA; ++kc) sacc += part[((size_t)(layer * KS_ADA + kc) * 2 + v) * (6 * D) + n];
            lmod[i] = sacc; }
        __syncthreads(); }
    LAS float* wrt = (LAS float*)c.lds;
    if (moe) { const float* wr = p.in[20];
        for (int i = c.tid; i < D * NE / 4; i += NTHREADS) { const f32x4 w = *(const f32x4*)(wr + 4 * i); const int k = i >> 1, e0 = (i & 1) * 4;
            wrt[(e0 + 0) * D + k] = w[0]; wrt[(e0 + 1) * D + k] = w[1]; wrt[(e0 + 2) * D + k] = w[2]; wrt[(e0 + 3) * D + k] = w[3]; }
        __syncthreads(); }
    for (int r = row_lo + gw; r < MT; r += NGW) {
        const f32x4* xr = (const f32x4*)(from_in ? (r < LC ? p.in[2] + (size_t)r * D : p.in[0] + (size_t)(r - LC) * D) : XL + (size_t)r * D) + c.lane;
        const float* mv = mod + (size_t)(layer * 2 + (r < LC ? 1 : 0)) * (6 * D) + (which ? 3 * D : 0);
        f32x4 v[8]; float ss = 0.f;
#pragma unroll
        for (int j = 0; j < 8; ++j) { v[j] = xr[64 * j]; ss += (v[j][0] * v[j][0] + v[j][1] * v[j][1]) + (v[j][2] * v[j][2] + v[j][3] * v[j][3]); }
        const float rs = rsqrtf(wave_sum(ss) * (1.f / D) + EPS);
        float amax = 0.f;
#pragma unroll
        for (int j = 0; j < 8; ++j) { const int col = 4 * c.lane + 256 * j;
            const f32x4 gv = *(const f32x4*)(g + col);
            const f32x4 sh = local_mod ? *(const LAS f32x4*)(lmod + (r < LC ? 2 * D : 0) + col) : *(const f32x4*)(mv + col), sc = local_mod ? *(const LAS f32x4*)(lmod + (r < LC ? 3 * D : D) + col) : *(const f32x4*)(mv + D + col);
            v[j] = (v[j] * rs * gv) * (sc + 1.f) + sh;
            amax = fmaxf(fmaxf(amax, fmaxf(fabsf(v[j][0]), fabsf(v[j][1]))), fmaxf(fabsf(v[j][2]), fabsf(v[j][3]))); }
#pragma unroll
        for (int o = 1; o < 64; o <<= 1) amax = fmaxf(amax, __shfl_xor(amax, o));
        const float inv = amax > 0.f ? 127.f / amax : 0.f;
        unsigned* o4 = (unsigned*)(HN + (size_t)r * D) + c.lane;
#pragma unroll
        for (int j = 0; j < 8; ++j) o4[64 * j] = pack4i8(v[j][0] * inv, v[j][1] * inv, v[j][2] * inv, v[j][3] * inv);
        if (c.lane == 0) HSC[r] = amax * (1.f / 127.f);
        if (moe) {
            float lg[NE];
#pragma unroll
            for (int e = 0; e < NE; ++e) { float a = 0.f;
#pragma unroll
                for (int j = 0; j < 8; ++j) { const f32x4 w = *(const LAS f32x4*)(wrt + e * D + 4 * c.lane + 256 * j); a += (v[j][0] * w[0] + v[j][1] * w[1]) + (v[j][2] * w[2] + v[j][3] * w[3]); }
                lg[e] = a; }
#pragma unroll
            for (int e = 0; e < NE; ++e) lg[e] = wave_sum(lg[e]);
            int e0 = 0; float m0 = lg[0];
#pragma unroll
            for (int e = 1; e < NE; ++e) if (lg[e] > m0) { m0 = lg[e]; e0 = e; }
            int e1 = -1; float m1 = -3.0e38f;
#pragma unroll
            for (int e = 0; e < NE; ++e) if (e != e0 && lg[e] > m1) { m1 = lg[e]; e1 = e; }
            if (c.lane == 0) { const int t = r - LC; const float b = expf(m1 - m0), inv = 1.f / (1.f + b);
                int* sel = (int*)(p.ws + WS_SEL); float* gwt = (float*)(p.ws + WS_GW);
                sel[2 * t] = e0; sel[2 * t + 1] = e1; gwt[2 * t] = inv; gwt[2 * t + 1] = b * inv; }
        }
    }
}
__device__ __forceinline__ void conv_pass(const Params& p, const Ctx& c, int layer, int row_lo) {
    const bf16* U = (const bf16*)(p.ws + WS_MIX + MX_U); const bf16* CBp = (const bf16*)(p.ws + WS_MIX + MX_CB); bf16* V2 = (bf16*)(p.ws + WS_MIX + MX_V2);
    const float* wc = p.in[12] + (size_t)layer * 3 * CW;
    const int gw = c.vcu * NWAVES + c.wave, NGW = c.G * NWAVES, nitems = ((MT - row_lo) / 16) * 4;
    for (int it = gw; it < nitems; it += NGW) {
        const int q = it & 3, r0 = row_lo + (it >> 2) * 16, ch = q * 512 + c.lane * 8;
        const int lo = r0 < LC ? 0 : LC, hi = r0 < LC ? LC : MT;
        const f32x4 w0a = *(const f32x4*)(wc + ch), w0b = *(const f32x4*)(wc + ch + 4), w1a = *(const f32x4*)(wc + CW + ch), w1b = *(const f32x4*)(wc + CW + ch + 4), w2a = *(const f32x4*)(wc + 2 * CW + ch), w2b = *(const f32x4*)(wc + 2 * CW + ch + 4);
        float zf = 0.f; asm volatile("" : "+v"(zf)); const f32x4 z4 = {zf, zf, zf, zf}; f32x4 pa = z4, pb = pa, ca, cb, na, nb;
        if (r0 - 1 >= lo) unpack8(*(const u32x4*)(U + (size_t)(r0 - 1) * CW + ch), pa, pb);
        unpack8(*(const u32x4*)(U + (size_t)r0 * CW + ch), ca, cb);
#pragma unroll 4
        for (int r = r0; r < r0 + 16; ++r) {
            na = z4; nb = na;
            if (r + 1 < hi) unpack8(*(const u32x4*)(U + (size_t)(r + 1) * CW + ch), na, nb);
            f32x4 ga, gb; unpack8(*(const u32x4*)(CBp + (size_t)r * CW + ch), ga, gb);
            const f32x4 ya = ga * (w0a * pa + w1a * ca + w2a * na), yb = gb * (w0b * pb + w1b * cb + w2b * nb);
            *(u32x4*)(V2 + (size_t)r * CW + ch) = pack8(ya, yb);
            pa = ca; pb = cb; ca = na; cb = nb; }
    }
}
__device__ __forceinline__ void moe_counts(const Params& p, const Ctx& c) {
    const int* sel = (const int*)(p.ws + WS_SEL);
    LAS int* H = (LAS int*)c.lds;
    LAS int* tot = (LAS int*)(c.lds + 16384);
    LAS int* lctl = (LAS int*)(c.lds + LCTL_OFF);
    { int h[NE];
#pragma unroll
      for (int e = 0; e < NE; ++e) h[e] = 0;
#pragma unroll
      for (int i = 0; i < 8; ++i) { const int4 v = *(const int4*)(sel + c.tid * 32 + i * 4);
#pragma unroll
          for (int e = 0; e < NE; ++e) h[e] += (v.x == e) + (v.y == e) + (v.z == e) + (v.w == e); }
#pragma unroll
      for (int e = 0; e < NE; ++e) H[c.tid * 8 + e] = h[e]; }
    __syncthreads();
    { int s = 0;
#pragma unroll
      for (int i = 0; i < 8; ++i) s += H[(c.lane * 8 + i) * 8 + c.wave];
#pragma unroll
      for (int o = 1; o < 64; o <<= 1) s += __shfl_xor(s, o);
      if (c.lane == 0) tot[c.wave] = s; }
    __syncthreads();
    if (c.tid == 0) { int off = 0;
#pragma unroll
        for (int e = 0; e < NE; ++e) { lctl[128 + e] = off; off += (tot[e] + 255) >> 8; }
        lctl[128 + NE] = off; lctl[16] = off; }
    __syncthreads();
    if (c.tid < MAXT) { int e = 0;
#pragma unroll
        for (int x = 1; x < NE; ++x) e += (c.tid >= lctl[128 + x]) ? 1 : 0;
        lctl[32 + c.tid] = e; }
    __syncthreads();
}
__device__ __forceinline__ void moe_route(const Params& p, const Ctx& c) {
    const int* sel = (const int*)(p.ws + WS_SEL); int* slot = (int*)(p.ws + WS_SLOT);
    const unsigned char* HN = p.ws + WS_HN; unsigned char* XS = p.ws + WS_MIX + FX_XS; const float* HSC = (const float*)(p.ws + WS_HSC); float* XSC = (float*)(p.ws + WS_XSC);
    LAS int* H = (LAS int*)c.lds; LAS int* tot = (LAS int*)(c.lds + 16384); LAS int* lctl = (LAS int*)(c.lds + LCTL_OFF);
    for (int b = c.bid; b < 2 * SEQ / 64; b += c.G) {
        { int s = 0;
#pragma unroll
          for (int i = 0; i < 8; ++i) { const int t = c.lane * 8 + i; s += (t < 2 * b) ? H[t * 8 + c.wave] : 0; }
#pragma unroll
          for (int o = 1; o < 64; o <<= 1) s += __shfl_xor(s, o);
          if (c.lane == 0) tot[8 + c.wave] = s; }
        __syncthreads();
        if (c.wave == 0) { const int a = 64 * b + c.lane, e = sel[a]; int rank = 0;
#pragma unroll
            for (int x = 0; x < NE; ++x) { const unsigned long long m = __ballot(e == x); if (e == x) rank = tot[8 + x] + __popcll(m & ((1ull << c.lane) - 1ull)); }
            const int s = 256 * lctl[128 + e] + rank; slot[a] = s; tot[16 + c.lane] = s; }
        __syncthreads();
#pragma unroll
        for (int i = 0; i < 8; ++i) { const int j = c.wave * 8 + i, a = 64 * b + j, tok = a >> 1, s = tot[16 + j];
            const u32x4* src = (const u32x4*)(HN + (size_t)(LC + tok) * D) + c.lane; u32x4* dst = (u32x4*)(XS + (size_t)s * D) + c.lane;
            const u32x4 v0 = src[0], v1 = src[64]; dst[0] = v0; dst[64] = v1;
            if (c.lane == 0) XSC[s] = HSC[LC + tok]; }
        __syncthreads();
    }
}
__device__ __forceinline__ void final_pass(const Params& p, const Ctx& c) {
    const float* XL = (const float*)(p.ws + WS_XL); const bf16* YS = (const bf16*)(p.ws + WS_MIX + FX_YS);
    const int* slot = (const int*)(p.ws + WS_SLOT); const float* gwt = (const float*)(p.ws + WS_GW);
    const float* gt2 = (const float*)(p.ws + WS_MOD) + (size_t)2 * (6 * D) + 5 * D; const float* gf = p.in[24];
    const int gw = c.vcu * NWAVES + c.wave, NGW = c.G * NWAVES;
    for (int t = gw; t < SEQ; t += NGW) {
        const int s0 = slot[2 * t], s1 = slot[2 * t + 1]; const float g0 = gwt[2 * t], g1 = gwt[2 * t + 1];
        const f32x4* xr = (const f32x4*)(XL + (size_t)(LC + t) * D) + c.lane;
        const u32x2* y0 = (const u32x2*)(YS + (size_t)s0 * D) + c.lane; const u32x2* y1 = (const u32x2*)(YS + (size_t)s1 * D) + c.lane;
        f32x4 v[8]; float ss = 0.f;
#pragma unroll
        for (int j = 0; j < 8; ++j) { const f32x4 gv = *(const f32x4*)(gt2 + 4 * c.lane + 256 * j);
            v[j] = xr[64 * j] + gv * (unpack4(y0[64 * j]) * g0 + unpack4(y1[64 * j]) * g1);
            ss += (v[j][0] * v[j][0] + v[j][1] * v[j][1]) + (v[j][2] * v[j][2] + v[j][3] * v[j][3]); }
        const float rs = rsqrtf(wave_sum(ss) * (1.f / D) + EPS);
        f32x4* o = (f32x4*)(p.out + (size_t)t * D) + c.lane;
#pragma unroll
        for (int j = 0; j < 8; ++j) o[64 * j] = v[j] * rs * *(const f32x4*)(gf + 4 * c.lane + 256 * j);
    }
}


template <class Epi>
__device__ __forceinline__ void ctx_gemm(const Ctx& c, const bf16* A, int lda, const bf16* Bt, int ldb, int K, const Epi& E) {
    const int fr = c.lane & 15, fq = c.lane >> 4, wr = c.wave >> 2, wc = c.wave & 3;
    for (int j = c.vcu; j < 256; j += c.G) {
        const int m0 = (j >> 5) * 32 + wr * 16, n0 = (j & 31) * 64 + wc * 16;
        const bf16* ap = A + (size_t)(m0 + fr) * lda + 8 * fq; const bf16* bp = Bt + (size_t)(n0 + fr) * ldb + 8 * fq;
        float zf = 0.f; asm volatile("" : "+v"(zf));
        f32x4 acc0 = {zf, zf, zf, zf}, acc1 = acc0;
#pragma unroll 4
        for (int k0 = 0; k0 < K; k0 += 64) {
            const bf16x8 a0 = *(const bf16x8*)(ap + k0), b0 = *(const bf16x8*)(bp + k0), a1 = *(const bf16x8*)(ap + k0 + 32), b1 = *(const bf16x8*)(bp + k0 + 32);
            acc0 = __builtin_amdgcn_mfma_f32_16x16x32_bf16(b0, a0, acc0, 0, 0, 0);
            acc1 = __builtin_amdgcn_mfma_f32_16x16x32_bf16(b1, a1, acc1, 0, 0, 0);
        }
        E(m0 + fr, n0 + 4 * fq, acc0 + acc1);
    }
}
template <int MODE> struct CtxMerge { const bf16* SG; const bf16* M1; bf16* OUT;
    __device__ __forceinline__ void operator()(int row, int col, f32x4 acc) const { const size_t off = (size_t)row * D + col;
        f32x4 v = acc * unpack4(*(const u32x2*)(SG + off)); if (MODE == 1) v += unpack4(*(const u32x2*)(M1 + off));
        u32x2 w; w.x = cvtpk(v[0], v[1]); w.y = cvtpk(v[2], v[3]); *(u32x2*)(OUT + off) = w; } };
struct CtxResid { float* XL; const float* SRC; const float* gate;
    __device__ __forceinline__ void operator()(int row, int col, f32x4 acc) const { const size_t o = (size_t)row * D + col; *(f32x4*)(XL + o) = *(const f32x4*)(SRC + o) + *(const f32x4*)(gate + col) * acc; } };

constexpr int N_PHASES = 22;
__global__ void __launch_bounds__(NTHREADS, 2) mega(Params p) {
    extern __shared__ __attribute__((aligned(16))) unsigned char lds_raw[];
    Ctx c0; c0.lds = (LAS unsigned char*)lds_raw; c0.tid = threadIdx.x; c0.lane = c0.tid & 63; c0.wave = __builtin_amdgcn_readfirstlane(c0.tid >> 6);
    c0.G = gridDim.x; c0.bid = blockIdx.x; c0.vcu = (c0.G % 8 == 0) ? (c0.bid % 8) * (c0.G / 8) + c0.bid / 8 : c0.bid;
    { const Ctx& c = c0; unsigned char* ws = p.ws;
    for (int u = c.tid; u < (LDS_BYTES - LCTL_OFF) / 4; u += NTHREADS) ((LAS unsigned*)(c.lds + LCTL_OFF))[u] = 0u;
    __syncthreads();
    }
    XcdBarrier bar = xcd_barrier_post((unsigned*)(p.ws + WS_CTL) + 4096, (volatile LAS unsigned*)(c0.lds + LCTL_OFF));
    const int lo = p.ph_lo, hi = p.ph_hi;
#ifndef MK_EN
#define MK_EN 0xFFFFFF
#endif
#define EN(j) (((MK_EN) >> (j)) & 1)
#ifndef MK_DUP
#define MK_DUP 0
#endif
#define NREP(j) ((((MK_DUP) >> (j)) & 1) ? 2 : 1)
#define IN(k) (lo <= (k) && (k) < hi)
#define SEAM(k) do { if (IN(k) && IN((k) + 1)) xcd_barrier(bar); } while (0)
#define PH_BEGIN const Ctx c = fresh(c0); unsigned char* ws = fresh_ptr(p.ws); unsigned char* wb = ws + WS_W; unsigned char* mx = ws + WS_MIX; const float* mod = (const float*)(ws + WS_MOD); (void)wb; (void)mx; (void)mod;
    for (int rep_ = 0; rep_ < NREP(20); ++rep_) if (EN(20) && IN(0)) { if (rep_) { xcd_barrier(bar); if (c0.bid == 0 && c0.tid == 0) __hip_atomic_store((unsigned*)(p.ws + WS_CTL) + CW_QHEAD, 0u, __ATOMIC_RELAXED, __HIP_MEMORY_SCOPE_AGENT); xcd_barrier(bar); } PH_BEGIN p0_prologue(p, c); } SEAM(0);
#if defined(MK_XBAR)
    for (int xb_ = 0; xb_ < 16; ++xb_) xcd_barrier(bar);
#endif
#pragma unroll
    for (int layer = 0; layer < DEPTH; ++layer) {
        const int P = 2 + 9 * layer; const bool last = (layer == DEPTH - 1);
        const int pm0 = last ? 1 : 0, nM = last ? 32 : 33;
        for (int rep_ = 0; rep_ < NREP(0); ++rep_) if (EN(0) && IN(P + 0)) { if (rep_) xcd_barrier(bar); PH_BEGIN if (layer == 0) p1_mod(p, c); norm_pass(p, c, layer, 0, 0, false, layer == 0); } SEAM(P + 0);
        for (int rep_ = 0; rep_ < NREP(1); ++rep_) if (EN(1) && IN(P + 1)) { if (rep_) xcd_barrier(bar); PH_BEGIN
            pg8::Geo g{D / 2, D / 2, D / 2};
            pg8::TileOrder S{nM, NT_IN, pm0, c.G, c.bid, last ? 3 : 0, 0, 2, (const char*)(ws + WS_HN), (const char*)(wb + W_IN + layer * W_IN_L), (size_t)256 * D, (size_t)256 * D, (const float*)(ws + WS_HSC), (const float*)(ws + WS_WSC) + SC_IN + layer * NIN};
            pg8::EpiInproj E{(bf16*)(mx + MX_QC), (bf16*)(mx + MX_KRB), (bf16*)(mx + MX_U), (bf16*)(mx + MX_CB), (float*)(mx + MX_SSQ), (const float*)(ws + WS_ROPE)};
            pg8::gemm_phase<pg8::EpiInproj, pg8::TileOrder, true, true>(c.lds, g, S, E);
        } SEAM(P + 1);
        for (int rep_ = 0; rep_ < NREP(2); ++rep_) if (EN(2) && IN(P + 2)) { if (rep_) xcd_barrier(bar); PH_BEGIN
            pg8::Geo g{1024, 512, 512};
            pg8::QkvOrder S{33, nM, pm0, c.G, c.bid, (const char*)(mx + MX_QC), (const char*)(wb + W_QB + layer * W_QB_L), (long)(W_KVB + layer * W_KVB_L) - (long)(W_QB + layer * W_QB_L)};
            pg8::EpiQkv E{(bf16*)(mx + MX_Q), (bf16*)(mx + MX_KV), (const float*)(mx + MX_SSQ), (const float*)(ws + WS_ROPE)};
            pg8::gemm_phase<pg8::EpiQkv, pg8::QkvOrder, true>(c.lds, g, S, E);
            conv_pass(p, c, layer, pm0 * 256);
        } SEAM(P + 2);
        for (int rep_ = 0; rep_ < NREP(3); ++rep_) if (EN(3) && IN(P + 3)) { if (rep_) xcd_barrier(bar); PH_BEGIN
            const bf16* Q = (const bf16*)(mx + MX_Q); const bf16* KV = (const bf16*)(mx + MX_KV); const bf16* KR = (const bf16*)(mx + MX_KRB); bf16* O = (bf16*)(mx + MX_O);
            for (int i = 0;; ++i) { const int u = i * c.G + c.vcu; if (u >= NH * 32) break;
                const int h = u >> 5, q0 = LC + 256 * (u & 31);
                att::attn_unit(Q + (size_t)q0 * att::LDQ + h * DQK, KV, h * 512, KR, O + (size_t)q0 * D + h * DV, MT, (LAS char*)c.lds); }
            if (!last) for (int i = 0;; ++i) { const int h = i * c.G + c.vcu; if (h >= NH) break;
                att::attn_unit(Q + h * DQK, KV, h * 512, KR, O + h * DV, LC, (LAS char*)c.lds); }
            pg8::Geo g{D, D, D};
            pg8::TileOrder S{32, 8, 1, c.G, c.bid, 0, 0, 0, (const char*)(mx + MX_V2), (const char*)(wb + W_OB + layer * W_SQ_L), (size_t)256 * D * 2, (size_t)256 * D * 2, nullptr, nullptr};
            pg8::EpiMerge<0> E{(const bf16*)(mx + MX_SGB), nullptr, (bf16*)(mx + MX_M1)};
            pg8::gemm_phase<pg8::EpiMerge<0>, pg8::TileOrder, true>(c.lds, g, S, E);
            if (!last) ctx_gemm(c, (const bf16*)(mx + MX_V2), D, (const bf16*)(wb + W_OB + layer * W_SQ_L), D, D, CtxMerge<0>{(const bf16*)(mx + MX_SGB), nullptr, (bf16*)(mx + MX_M1)});
        } SEAM(P + 3);
        for (int rep_ = 0; rep_ < NREP(4); ++rep_) if (EN(4) && IN(P + 4)) { if (rep_) xcd_barrier(bar); PH_BEGIN
            pg8::Geo g{D, D, D};
            pg8::TileOrder S{32, 8, 1, c.G, c.bid, 0, 0, 0, (const char*)(mx + MX_O), (const char*)(wb + W_OA + layer * W_SQ_L), (size_t)256 * D * 2, (size_t)256 * D * 2, nullptr, nullptr};
            pg8::EpiMerge<1> E{(const bf16*)(mx + MX_SGA), (const bf16*)(mx + MX_M1), (bf16*)(mx + MX_MG)};
            pg8::gemm_phase<pg8::EpiMerge<1>, pg8::TileOrder, true>(c.lds, g, S, E);
            if (!last) ctx_gemm(c, (const bf16*)(mx + MX_O), D, (const bf16*)(wb + W_OA + layer * W_SQ_L), D, D, CtxMerge<1>{(const bf16*)(mx + MX_SGA), (const bf16*)(mx + MX_M1), (bf16*)(mx + MX_MG)});
        } SEAM(P + 4);
        for (int rep_ = 0; rep_ < 1; ++rep_) if (EN(5) && IN(P + 5)) { PH_BEGIN
            pg8::Geo g{D, D, D};
            pg8::TileOrder S{32, 8, 1, c.G, c.bid, 0, 0, 0, (const char*)(mx + MX_MG), (const char*)(wb + W_O + layer * W_SQ_L), (size_t)256 * D * 2, (size_t)256 * D * 2, nullptr, nullptr};
            pg8::EpiResid E{(float*)(ws + WS_XL), layer == 0 ? p.in[0] - (size_t)LC * D : (const float*)(ws + WS_XL), mod + (size_t)(2 * layer) * (6 * D) + 2 * D};
            pg8::gemm_phase<pg8::EpiResid, pg8::TileOrder, true>(c.lds, g, S, E);
            if (!last) ctx_gemm(c, (const bf16*)(mx + MX_MG), D, (const bf16*)(wb + W_O + layer * W_SQ_L), D, D, CtxResid{(float*)(ws + WS_XL), p.in[2], mod + (size_t)(2 * layer + 1) * (6 * D) + 2 * D});
        } SEAM(P + 5);
        for (int rep_ = 0; rep_ < NREP(6); ++rep_) if (EN(6) && IN(P + 6)) { if (rep_) xcd_barrier(bar); PH_BEGIN norm_pass(p, c, layer, 1, pm0 * 256, last, false); } SEAM(P + 6);
        if (!last) {
            for (int rep_ = 0; rep_ < NREP(7); ++rep_) if (EN(7) && IN(P + 7)) { if (rep_) xcd_barrier(bar); PH_BEGIN
                pg8::Geo g{D / 2, D / 2, D / 2};
                pg8::TileOrder S{nM, 2 * DFF / 256, pm0, c.G, c.bid, 0, 0, 0, (const char*)(ws + WS_HN), (const char*)(wb + W_GU), (size_t)256 * D, (size_t)256 * D, (const float*)(ws + WS_HSC), (const float*)(ws + WS_WSC) + SC_GU};
                pg8::EpiSwiglu E{(bf16*)(mx + FX_ACT), DFF};
                pg8::gemm_phase<pg8::EpiSwiglu, pg8::TileOrder, true, true>(c.lds, g, S, E);
            } SEAM(P + 7);
            for (int rep_ = 0; rep_ < 1; ++rep_) if (EN(8) && IN(P + 8)) { PH_BEGIN
                pg8::Geo g{DFF, DFF, DFF};
                pg8::TileOrder S{32, 8, 1, c.G, c.bid, 0, 0, 0, (const char*)(mx + FX_ACT), (const char*)(wb + W_DD), (size_t)256 * DFF * 2, (size_t)256 * DFF * 2, nullptr, nullptr};
                pg8::EpiResid E{(float*)(ws + WS_XL), (const float*)(ws + WS_XL), mod + (size_t)(2 * layer) * (6 * D) + 5 * D};
                pg8::gemm_phase<pg8::EpiResid, pg8::TileOrder, true>(c.lds, g, S, E);
                ctx_gemm(c, (const bf16*)(mx + FX_ACT), DFF, (const bf16*)(wb + W_DD), DFF, DFF, CtxResid{(float*)(ws + WS_XL), (const float*)(ws + WS_XL), mod + (size_t)(2 * layer + 1) * (6 * D) + 5 * D});
            } SEAM(P + 8);
        } else {
            const LAS int* lctl = (const LAS int*)(c0.lds + LCTL_OFF);
            for (int rep_ = 0; rep_ < NREP(7); ++rep_) if (EN(7) && IN(P + 7)) { if (rep_) xcd_barrier(bar); PH_BEGIN moe_counts(p, c); moe_route(p, c); } SEAM(P + 7);
            for (int rep_ = 0; rep_ < NREP(8); ++rep_) if (EN(8) && IN(P + 8)) { if (rep_) xcd_barrier(bar); PH_BEGIN
                if (!IN(P + 7)) moe_counts(p, c);
                const int T = __builtin_amdgcn_readfirstlane(lctl[16]);
                pg8::Geo g{D / 2, D / 2, D / 2};
                pg8::MoeOrder S{T, 2 * DFE / 256, c.G, c.bid, (const char*)(mx + FX_XS), (const char*)(wb + W_GUE), (size_t)256 * D, (size_t)256 * D, W_GUE_E, lctl + 32, (const float*)(ws + WS_XSC), (const float*)(ws + WS_WSC) + SC_GUE, 2 * DFE};
                pg8::EpiSwiglu E{(bf16*)(mx + FX_ACTE), DFE};
                pg8::gemm_phase<pg8::EpiSwiglu, pg8::MoeOrder, true, true>(c.lds, g, S, E);
            } SEAM(P + 8);
            for (int rep_ = 0; rep_ < NREP(9); ++rep_) if (EN(9) && IN(P + 9)) { if (rep_) xcd_barrier(bar); PH_BEGIN
                if (!IN(P + 7)) moe_counts(p, c);
                const int T = __builtin_amdgcn_readfirstlane(lctl[16]);
                pg8::Geo g{DFE, DFE, DFE};
                pg8::MoeOrder S{T, 8, c.G, c.bid, (const char*)(mx + FX_ACTE), (const char*)(wb + W_DE), (size_t)256 * DFE * 2, (size_t)256 * DFE * 2, W_DE_E, lctl + 32, nullptr, nullptr, 0};
                pg8::EpiStoreBf16 E{(bf16*)(mx + FX_YS), D};
                pg8::gemm_phase<pg8::EpiStoreBf16, pg8::MoeOrder, true>(c.lds, g, S, E);
            } SEAM(P + 9);
            for (int rep_ = 0; rep_ < NREP(10); ++rep_) if (EN(10) && IN(P + 10)) { if (rep_) xcd_barrier(bar); PH_BEGIN final_pass(p, c); }
        }
    }
#undef IN
#undef SEAM
}

static void forward(void* const* d_in, float* out, void* d_ws, size_t ws_size, hipStream_t st, int n_launches) {
    static int grid = 0;
    if (grid == 0) {
        if (ws_size < WS_END) { fprintf(stderr, "mk::forward: workspace too small (%zu < %zu)\n", ws_size, (size_t)WS_END); grid = -1; return; }
        int dev = 0, cus = 0;
        if (hipGetDevice(&dev) != hipSuccess || hipDeviceGetAttribute(&cus, hipDeviceAttributeMultiprocessorCount, dev) != hipSuccess) { grid = -1; return; }
        if (hipFuncSetAttribute((const void*)mega, hipFuncAttributeMaxDynamicSharedMemorySize, LDS_BYTES) != hipSuccess) { fprintf(stderr, "mk::forward: hipFuncSetAttribute failed\n"); grid = -1; return; }
        int per_cu = 0; (void)hipOccupancyMaxActiveBlocksPerMultiprocessor(&per_cu, (const void*)mega, NTHREADS, LDS_BYTES); (void)hipGetLastError();
        grid = cus;
    }
    if (grid < 0) return;
    (void)hipMemsetAsync((char*)d_ws + WS_CTL, 0, CTL_BYTES, st);
    Params p{};
    for (int i = 0; i < 25; ++i) p.in[i] = (const float*)d_in[i];
    p.out = out; p.ws = (unsigned char*)d_ws;
    if (n_launches == 1) { p.ph_lo = 0; p.ph_hi = N_PHASES; hipLaunchKernelGGL(mega, dim3(grid), dim3(NTHREADS), LDS_BYTES, st, p); }
    else for (int k = 0; k < N_PHASES; ++k) { p.ph_lo = k; p.ph_hi = k + 1; hipLaunchKernelGGL(mega, dim3(grid), dim3(NTHREADS), LDS_BYTES, st, p); }
    const hipError_t le = hipPeekAtLastError();
    if (le != hipSuccess) fprintf(stderr, "mk::forward: launch failed: %s\n", hipGetErrorName(le));
}
}

#ifndef MK_LAUNCHES
#define MK_LAUNCHES 1
#endif
#ifndef USE_SLOW
#define USE_SLOW 0
#endif
extern "C" void kernel_launch(void* const* d_in, const int* in_sizes, int n_in, void* d_out, int out_size, void* d_ws, size_t ws_size, hipStream_t stream) {
    if (n_in != 25 || out_size != SEQ * D) { fprintf(stderr, "kernel_launch: unexpected shapes (n_in %d out %d)\n", n_in, out_size); return; }
#if USE_SLOW
    slow::forward(d_in, (float*)d_out, (float*)d_ws, ws_size / 4, stream);
#else
    mk::forward(d_in, (float*)d_out, d_ws, ws_size, stream, MK_LAUNCHES);
#endif
}
```

```cpp
#include <hip/hip_runtime.h>
#include <cstdio>
#include <cstdint>

constexpr int D = 2048, LC = 256, SEQ = 8192, MT = LC + SEQ, DEPTH = 2;
constexpr int NH = 16, DN = 128, DR = 64, DV = 128, DQK = DN + DR, QL = 512, KVL = 512;
constexpr int CW = 2048, DIN = QL + KVL + DR + 3 * CW + 2 * D;
constexpr int OFF_QA = 0, OFF_CKV = 512, OFF_KR = 1024, OFF_CX = 1088, OFF_CB = OFF_CX + CW, OFF_CC = OFF_CB + CW, OFF_GA = OFF_CC + CW, OFF_GB = OFF_GA + D;
constexpr int DFF = 5632, NE = 8, DFE = 2816;
constexpr float EPS = 1e-6f;
constexpr float ATT_SCALE = 0.07216878364870322f;

namespace slow {
typedef float f32x16 __attribute__((ext_vector_type(16)));

struct GArgs { const float* A; long lda, abs_; const float* B; long sbk, sbn, bbs; const int* rowidx; const int* rioff; const int* Mptr; int M, N, K, pad; };
static_assert(sizeof(GArgs) == 96, "GArgs has no implicit padding");

template <bool BT, class Epi>
__global__ __launch_bounds__(256) void k_gemm(GArgs g, Epi epi) {
    __shared__ float As[32][65];
    __shared__ float Bs[32][65];
    const int b = blockIdx.z, m0 = blockIdx.y * 64, n0 = blockIdx.x * 64;
    const int M = g.Mptr ? g.Mptr[b] : g.M;
    if (m0 >= M) return;
    const int t = threadIdx.x, lane = t & 63, w = t >> 6, wm = w >> 1, wn = w & 1;
    const float* A = g.A + (long)b * g.abs_; const float* B = g.B + (long)b * g.bbs;
    const int ar = t >> 2, ak = (t & 3) * 8, am = m0 + ar;
    long arow = -1;
    if (am < M) { const int base = g.rioff ? g.rioff[b] : 0; arow = g.rowidx ? (long)g.rowidx[base + am] : (long)(base + am); }
    f32x16 acc;
#pragma unroll
    for (int r = 0; r < 16; ++r) acc[r] = 0.f;
    for (int k0 = 0; k0 < g.K; k0 += 32) {
        float4 a0 = make_float4(0.f, 0.f, 0.f, 0.f), a1 = a0, b0, b1;
        if (arow >= 0) { const float4* p = (const float4*)(A + arow * g.lda + k0 + ak); a0 = p[0]; a1 = p[1]; }
        if (BT) { const int bn = t >> 2, bk = (t & 3) * 8; const float4* p = (const float4*)(B + (long)(n0 + bn) * g.sbn + k0 + bk); b0 = p[0]; b1 = p[1]; }
        else    { const int bk = t >> 3, bn = (t & 7) * 8; const float4* p = (const float4*)(B + (long)(k0 + bk) * g.sbk + n0 + bn); b0 = p[0]; b1 = p[1]; }
        __syncthreads();
        As[ak + 0][ar] = a0.x; As[ak + 1][ar] = a0.y; As[ak + 2][ar] = a0.z; As[ak + 3][ar] = a0.w;
        As[ak + 4][ar] = a1.x; As[ak + 5][ar] = a1.y; As[ak + 6][ar] = a1.z; As[ak + 7][ar] = a1.w;
        if (BT) { const int bn = t >> 2, bk = (t & 3) * 8;
            Bs[bk + 0][bn] = b0.x; Bs[bk + 1][bn] = b0.y; Bs[bk + 2][bn] = b0.z; Bs[bk + 3][bn] = b0.w;
            Bs[bk + 4][bn] = b1.x; Bs[bk + 5][bn] = b1.y; Bs[bk + 6][bn] = b1.z; Bs[bk + 7][bn] = b1.w; }
        else { const int bk = t >> 3, bn = (t & 7) * 8;
            Bs[bk][bn + 0] = b0.x; Bs[bk][bn + 1] = b0.y; Bs[bk][bn + 2] = b0.z; Bs[bk][bn + 3] = b0.w;
            Bs[bk][bn + 4] = b1.x; Bs[bk][bn + 5] = b1.y; Bs[bk][bn + 6] = b1.z; Bs[bk][bn + 7] = b1.w; }
        __syncthreads();
#pragma unroll
        for (int kk = 0; kk < 32; kk += 2) {
            const float a = As[kk + (lane >> 5)][wm * 32 + (lane & 31)];
            const float bb = Bs[kk + (lane >> 5)][wn * 32 + (lane & 31)];
            acc = __builtin_amdgcn_mfma_f32_32x32x2f32(a, bb, acc, 0, 0, 0);
        }
    }
    const int base = g.rioff ? g.rioff[b] : 0;
#pragma unroll
    for (int r = 0; r < 16; ++r) {
        const int row = m0 + wm * 32 + (r & 3) + 8 * (r >> 2) + 4 * (lane >> 5), col = n0 + wn * 32 + (lane & 31);
        if (row < M) epi(b, base + row, col, acc[r]);
    }
}
struct EpiStore { float* C; long ldc, cbs; float alpha; int accum;
    __device__ void operator()(int b, int row, int col, float v) const { float* p = C + (long)b * cbs + (long)row * ldc + col; *p = accum ? *p + alpha * v : alpha * v; } };
struct EpiResid { float* X; const float* gl; const float* gc;
    __device__ void operator()(int, int row, int col, float v) const { float* p = X + (long)row * D + col; *p += (row < LC ? gc[col] : gl[col]) * v; } };

template <bool BT, class Epi> static void gemm(hipStream_t st, const GArgs& g, const Epi& e, int nbatch, int maxM) {
    dim3 grid(g.N / 64, (maxM + 63) / 64, nbatch);
    hipLaunchKernelGGL((k_gemm<BT, Epi>), grid, dim3(256), 0, st, g, e);
}

__device__ __forceinline__ float block_sum(float v, float* red) {
#pragma unroll
    for (int o = 32; o > 0; o >>= 1) v += __shfl_xor(v, o);
    __syncthreads();
    if ((threadIdx.x & 63) == 0) red[threadIdx.x >> 6] = v;
    __syncthreads();
    return red[0] + red[1] + red[2] + red[3];
}
__device__ __forceinline__ float block_max(float v, float* red) {
#pragma unroll
    for (int o = 32; o > 0; o >>= 1) v = fmaxf(v, __shfl_xor(v, o));
    __syncthreads();
    if ((threadIdx.x & 63) == 0) red[threadIdx.x >> 6] = v;
    __syncthreads();
    return fmaxf(fmaxf(red[0], red[1]), fmaxf(red[2], red[3]));
}
__device__ __forceinline__ float silu(float x) { return x / (1.f + expf(-x)); }
__device__ __forceinline__ float sigm(float x) { return 1.f / (1.f + expf(-x)); }

__global__ void k_copy_x(const float* ctx, const float* x, float* XL) {
    const long n = (long)MT * D / 4; const float4* c4 = (const float4*)ctx; const float4* x4 = (const float4*)x; float4* o = (float4*)XL; const long nc = (long)LC * D / 4;
    for (long i = blockIdx.x * 256L + threadIdx.x; i < n; i += gridDim.x * 256L) o[i] = i < nc ? c4[i] : x4[i - nc];
}
__global__ void k_ada(const float* c, const float* cctx, const float* w_ada, const float* b_ada, float* MOD) {
    const int n = blockIdx.x * 256 + threadIdx.x, lv = blockIdx.y, l = lv >> 1, v = lv & 1;
    const float* cv = v ? cctx : c; const float* W = w_ada + (long)l * D * (6 * D);
    float acc = 0.f;
    for (int k = 0; k < D; ++k) acc += silu(cv[k]) * W[(long)k * (6 * D) + n];
    MOD[(long)lv * (6 * D) + n] = acc + b_ada[l * 6 * D + n];
}
__global__ __launch_bounds__(256) void k_modnorm(const float* X, const float* g, const float* modl, const float* modc, int sh_off, int sc_off, float* H) {
    __shared__ float red[4];
    const int r = blockIdx.x; const float* x = X + (long)r * D; const float* mod = r < LC ? modc : modl;
    float v[8]; float ss = 0.f;
#pragma unroll
    for (int j = 0; j < 8; ++j) { v[j] = x[threadIdx.x + 256 * j]; ss += v[j] * v[j]; }
    ss = block_sum(ss, red);
    const float rs = rsqrtf(ss * (1.f / D) + EPS);
#pragma unroll
    for (int j = 0; j < 8; ++j) { const int c = threadIdx.x + 256 * j; H[(long)r * D + c] = (v[j] * rs * g[c]) * (1.f + mod[sc_off + c]) + mod[sh_off + c]; }
}
__global__ __launch_bounds__(256) void k_rms512(const float* P, int off, const float* g, float* out) {
    __shared__ float red[4];
    const int r = blockIdx.x; const float* x = P + (long)r * DIN + off;
    const float a = x[threadIdx.x], b = x[threadIdx.x + 256];
    const float ss = block_sum(a * a + b * b, red);
    const float rs = rsqrtf(ss * (1.f / 512.f) + EPS);
    out[(long)r * 512 + threadIdx.x] = a * rs * g[threadIdx.x]; out[(long)r * 512 + threadIdx.x + 256] = b * rs * g[threadIdx.x + 256];
}
__device__ __forceinline__ float inv_freq(int i) { return powf(10000.f, -(float)(2 * i) / 32.f); }
__global__ void k_rope_q(float* Q) {
    const long idx = blockIdx.x * 256L + threadIdx.x;
    if (idx >= (long)SEQ * NH * 32) return;
    const int i = idx & 15, part = (idx >> 4) & 1, h = (idx >> 5) & 15; const int t = (int)(idx >> 9);
    const float pos = part ? (float)(t % 64) : (float)(t / 64);
    const float ang = pos * inv_freq(i), cs = cosf(ang), sn = sinf(ang);
    float* p = Q + (long)(LC + t) * (NH * DQK) + h * DQK + DN + part * 32;
    const float x1 = p[i], x2 = p[i + 16];
    p[i] = x1 * cs - x2 * sn; p[i + 16] = x2 * cs + x1 * sn;
}
__global__ void k_rope_k(const float* P, float* KR) {
    const long idx = blockIdx.x * 256L + threadIdx.x;
    if (idx >= (long)MT * 32) return;
    const int i = idx & 15, part = (idx >> 4) & 1; const int r = (int)(idx >> 5);
    const float* p = P + (long)r * DIN + OFF_KR + part * 32; float* o = KR + (long)r * DR + part * 32;
    const float x1 = p[i], x2 = p[i + 16];
    if (r < LC) { o[i] = x1; o[i + 16] = x2; return; }
    const int t = r - LC; const float pos = part ? (float)(t % 64) : (float)(t / 64);
    const float ang = pos * inv_freq(i), cs = cosf(ang), sn = sinf(ang);
    o[i] = x1 * cs - x2 * sn; o[i + 16] = x2 * cs + x1 * sn;
}
__global__ __launch_bounds__(256) void k_softmax(float* SC, int n) {
    __shared__ float red[4];
    float* s = SC + (long)blockIdx.x * n;
    float mx = -3.0e38f;
    for (int j = threadIdx.x; j < n; j += 256) mx = fmaxf(mx, s[j]);
    mx = block_max(mx, red);
    float sum = 0.f;
    for (int j = threadIdx.x; j < n; j += 256) { const float e = expf(s[j] - mx); s[j] = e; sum += e; }
    sum = block_sum(sum, red);
    const float inv = 1.f / sum;
    for (int j = threadIdx.x; j < n; j += 256) s[j] *= inv;
}
__global__ void k_conv(const float* P, const float* wconv, float* V2) {
    const long idx = blockIdx.x * 256L + threadIdx.x; if (idx >= (long)MT * CW) return;
    const int c = idx % CW; const int r = (int)(idx / CW);
    const int lo = r < LC ? 0 : LC, hi = r < LC ? LC : MT;
    const float* p = P + (long)r * DIN;
    float acc = wconv[CW + c] * (p[OFF_CC + c] * p[OFF_CX + c]);
    if (r - 1 >= lo) acc += wconv[c] * (p[OFF_CC + c - DIN] * p[OFF_CX + c - DIN]);
    if (r + 1 < hi) acc += wconv[2 * CW + c] * (p[OFF_CC + c + DIN] * p[OFF_CX + c + DIN]);
    V2[idx] = p[OFF_CB + c] * acc;
}
__global__ void k_merge(const float* P, const float* OA, const float* OB, float* MG) {
    const long idx = blockIdx.x * 256L + threadIdx.x; if (idx >= (long)MT * D) return;
    const int c = idx % D; const long r = idx / D;
    MG[idx] = sigm(P[r * DIN + OFF_GA + c]) * OA[idx] + sigm(P[r * DIN + OFF_GB + c]) * OB[idx];
}
__global__ void k_swiglu(float* G, const float* U, long n) {
    for (long i = blockIdx.x * 256L + threadIdx.x; i < n; i += gridDim.x * 256L) G[i] = silu(G[i]) * U[i];
}
__global__ __launch_bounds__(256) void k_router(const float* H2, const float* wr, int* sel, float* gw) {
    const int t = blockIdx.x * 4 + (threadIdx.x >> 6), lane = threadIdx.x & 63;
    const float* h = H2 + (long)(LC + t) * D;
    float lg[NE];
#pragma unroll
    for (int e = 0; e < NE; ++e) lg[e] = 0.f;
    for (int k = lane; k < D; k += 64) { const float hv = h[k];
#pragma unroll
        for (int e = 0; e < NE; ++e) lg[e] += hv * wr[k * NE + e]; }
#pragma unroll
    for (int e = 0; e < NE; ++e) {
#pragma unroll
        for (int o = 32; o > 0; o >>= 1) lg[e] += __shfl_xor(lg[e], o); }
    if (lane == 0) {
        int e0 = 0; for (int e = 1; e < NE; ++e) if (lg[e] > lg[e0]) e0 = e;
        int e1 = e0 == 0 ? 1 : 0; for (int e = 0; e < NE; ++e) if (e != e0 && lg[e] > lg[e1]) e1 = e;
        const float m = lg[e0], a = 1.f, b = expf(lg[e1] - m), inv = 1.f / (a + b);
        sel[2 * t] = e0; sel[2 * t + 1] = e1; gw[2 * t] = a * inv; gw[2 * t + 1] = b * inv;
    }
}
__global__ __launch_bounds__(512) void k_sort(const int* sel, int* cnt, int* off, int* toklist, int* slot_of) {
    __shared__ int scnt[NE];
    const int e = threadIdx.x >> 6, lane = threadIdx.x & 63; const int NA = 2 * SEQ;
    int c = 0;
    for (int a0 = 0; a0 < NA; a0 += 64) c += __popcll(__ballot(sel[a0 + lane] == e));
    if (lane == 0) scnt[e] = c;
    __syncthreads();
    int base = 0; for (int j = 0; j < e; ++j) base += scnt[j];
    if (lane == 0) { cnt[e] = c; off[e] = base; }
    int pos = base;
    for (int a0 = 0; a0 < NA; a0 += 64) {
        const bool f = sel[a0 + lane] == e; const unsigned long long m = __ballot(f);
        if (f) { const int p = pos + __popcll(m & ((1ull << lane) - 1ull)); toklist[p] = LC + (a0 + lane) / 2; slot_of[a0 + lane] = p; }
        pos += __popcll(m);
    }
}
__global__ void k_moe_combine(float* XL, const float* Ys, const int* slot_of, const float* gw, const float* gt2) {
    const long idx = blockIdx.x * 256L + threadIdx.x; if (idx >= (long)SEQ * D) return;
    const int c = idx % D; const int t = (int)(idx / D);
    const float y = gw[2 * t] * Ys[(long)slot_of[2 * t] * D + c] + gw[2 * t + 1] * Ys[(long)slot_of[2 * t + 1] * D + c];
    XL[(long)(LC + t) * D + c] += gt2[c] * y;
}
__global__ __launch_bounds__(256) void k_final(const float* XL, const float* g, float* out) {
    __shared__ float red[4];
    const int r = blockIdx.x; const float* x = XL + (long)(LC + r) * D;
    float v[8]; float ss = 0.f;
#pragma unroll
    for (int j = 0; j < 8; ++j) { v[j] = x[threadIdx.x + 256 * j]; ss += v[j] * v[j]; }
    ss = block_sum(ss, red);
    const float rs = rsqrtf(ss * (1.f / D) + EPS);
#pragma unroll
    for (int j = 0; j < 8; ++j) { const int c = threadIdx.x + 256 * j; out[(long)r * D + c] = v[j] * rs * g[c]; }
}

static inline int nblk(long n) { return (int)((n + 255) / 256); }

static void forward(void* const* d_in, float* out, float* ws, size_t ws_floats, hipStream_t st) {
    const float* x = (const float*)d_in[0]; const float* c = (const float*)d_in[1]; const float* ctx = (const float*)d_in[2]; const float* cctx = (const float*)d_in[3];
    const float* w_ada = (const float*)d_in[4]; const float* b_ada = (const float*)d_in[5]; const float* g_attn = (const float*)d_in[6]; const float* w_in = (const float*)d_in[7];
    const float* g_qa = (const float*)d_in[8]; const float* w_qb = (const float*)d_in[9]; const float* g_kva = (const float*)d_in[10]; const float* w_kvb = (const float*)d_in[11];
    const float* w_conv = (const float*)d_in[12]; const float* w_oa = (const float*)d_in[13]; const float* w_ob = (const float*)d_in[14]; const float* w_o = (const float*)d_in[15];
    const float* g_ffn = (const float*)d_in[16]; const float* w_gd = (const float*)d_in[17]; const float* w_ud = (const float*)d_in[18]; const float* w_dd = (const float*)d_in[19];
    const float* w_router = (const float*)d_in[20]; const float* w_ge = (const float*)d_in[21]; const float* w_ue = (const float*)d_in[22]; const float* w_de = (const float*)d_in[23];
    const float* g_final = (const float*)d_in[24];
    size_t o = 0; auto take = [&](size_t n) { float* p = ws + o; o += (n + 63) / 64 * 64; return p; };
    float* XL = take((size_t)MT * D); float* MOD = take(4 * 6 * D); float* H = take((size_t)MT * D); float* P = take((size_t)MT * DIN);
    float* QN = take((size_t)MT * 512); float* CN = take((size_t)MT * 512); float* Q = take((size_t)MT * NH * DQK); float* KV = take((size_t)MT * NH * 256);
    float* KR = take((size_t)MT * DR); float* SC = take((size_t)NH * 256 * MT); float* ATT = take((size_t)MT * D);
    int* IB = (int*)take(4 * SEQ + 64 + 2 * SEQ + 2 * SEQ);
    if (o > ws_floats) { fprintf(stderr, "slow::forward: workspace too small (%zu > %zu floats)\n", o, ws_floats); return; }
    int* sel = IB; int* slot_of = IB + 2 * SEQ; int* toklist = IB + 4 * SEQ; int* cnt = IB + 6 * SEQ; int* off = cnt + 8; float* gw = (float*)(IB + 6 * SEQ + 64);
    float* OA = SC; float* OB = SC + (size_t)MT * D; float* V2 = SC + 2 * (size_t)MT * D; float* MG = SC + 3 * (size_t)MT * D;
    static_assert((size_t)NH * 256 * MT >= 2 * (size_t)MT * D, "SC region");
    V2 = Q; MG = KV;
    float* OUT = H; float* H2 = H; float* G = P; float* U = P + (size_t)MT * DFF; float* Y = Q; float* Ys = KV;
    static_assert((size_t)MT * DIN >= 2 * (size_t)MT * DFF, "P region holds G and U");

    hipLaunchKernelGGL(k_copy_x, dim3(2048), dim3(256), 0, st, ctx, x, XL);
    hipLaunchKernelGGL(k_ada, dim3(6 * D / 256, 4), dim3(256), 0, st, c, cctx, w_ada, b_ada, MOD);
    for (int i = 0; i < DEPTH; ++i) {
        const bool last = (i == DEPTH - 1);
        const float* modl = MOD + (size_t)(2 * i) * 6 * D; const float* modc = MOD + (size_t)(2 * i + 1) * 6 * D;
        hipLaunchKernelGGL(k_modnorm, dim3(MT), dim3(256), 0, st, XL, g_attn + i * D, modl, modc, 0, D, H);
        { GArgs g{H, D, 0, w_in + (size_t)i * D * DIN, DIN, 1, 0, nullptr, nullptr, nullptr, MT, DIN, D}; gemm<false>(st, g, EpiStore{P, DIN, 0, 1.f, 0}, 1, MT); }
        hipLaunchKernelGGL(k_rms512, dim3(MT), dim3(256), 0, st, P, OFF_QA, g_qa + i * QL, QN);
        hipLaunchKernelGGL(k_rms512, dim3(MT), dim3(256), 0, st, P, OFF_CKV, g_kva + i * KVL, CN);
        { GArgs g{QN, 512, 0, w_qb + (size_t)i * QL * NH * DQK, NH * DQK, 1, 0, nullptr, nullptr, nullptr, MT, NH * DQK, QL}; gemm<false>(st, g, EpiStore{Q, NH * DQK, 0, 1.f, 0}, 1, MT); }
        { GArgs g{CN, 512, 0, w_kvb + (size_t)i * KVL * NH * 256, NH * 256, 1, 0, nullptr, nullptr, nullptr, MT, NH * 256, KVL}; gemm<false>(st, g, EpiStore{KV, NH * 256, 0, 1.f, 0}, 1, MT); }
        hipLaunchKernelGGL(k_rope_q, dim3(nblk((long)SEQ * NH * 32)), dim3(256), 0, st, Q);
        hipLaunchKernelGGL(k_rope_k, dim3(nblk((long)MT * 32)), dim3(256), 0, st, P, KR);
        for (int ch = last ? 0 : -1; ch < SEQ / 256; ++ch) {
            const int q0 = ch < 0 ? 0 : LC + 256 * ch, nk = ch < 0 ? LC : MT;
            { GArgs g{Q + (size_t)q0 * NH * DQK, NH * DQK, DQK, KV, 1, NH * 256, 256, nullptr, nullptr, nullptr, 256, nk, DN}; gemm<true>(st, g, EpiStore{SC, nk, (long)256 * nk, ATT_SCALE, 0}, NH, 256); }
            { GArgs g{Q + (size_t)q0 * NH * DQK + DN, NH * DQK, DQK, KR, 1, DR, 0, nullptr, nullptr, nullptr, 256, nk, DR}; gemm<true>(st, g, EpiStore{SC, nk, (long)256 * nk, ATT_SCALE, 1}, NH, 256); }
            hipLaunchKernelGGL(k_softmax, dim3(NH * 256), dim3(256), 0, st, SC, nk);
            { GArgs g{SC, nk, (long)256 * nk, KV + DN, NH * 256, 1, 256, nullptr, nullptr, nullptr, 256, DV, nk}; gemm<false>(st, g, EpiStore{ATT + (size_t)q0 * D, D, DV, 1.f, 0}, NH, 256); }
        }
        { GArgs g{ATT, D, 0, w_oa + (size_t)i * D * D, D, 1, 0, nullptr, nullptr, nullptr, MT, D, D}; gemm<false>(st, g, EpiStore{OA, D, 0, 1.f, 0}, 1, MT); }
        hipLaunchKernelGGL(k_conv, dim3(nblk((long)MT * CW)), dim3(256), 0, st, P, w_conv + (size_t)i * 3 * CW, V2);
        { GArgs g{V2, CW, 0, w_ob + (size_t)i * CW * D, D, 1, 0, nullptr, nullptr, nullptr, MT, D, CW}; gemm<false>(st, g, EpiStore{OB, D, 0, 1.f, 0}, 1, MT); }
        hipLaunchKernelGGL(k_merge, dim3(nblk((long)MT * D)), dim3(256), 0, st, P, OA, OB, MG);
        { GArgs g{MG, D, 0, w_o + (size_t)i * D * D, D, 1, 0, nullptr, nullptr, nullptr, MT, D, D}; gemm<false>(st, g, EpiResid{XL, modl + 2 * D, modc + 2 * D}, 1, MT); }
        hipLaunchKernelGGL(k_modnorm, dim3(MT), dim3(256), 0, st, XL, g_ffn + i * D, modl, modc, 3 * D, 4 * D, H2);
        if (i % 2 == 0) {
            const int j = i / 2;
            { GArgs g{H2, D, 0, w_gd + (size_t)j * D * DFF, DFF, 1, 0, nullptr, nullptr, nullptr, MT, DFF, D}; gemm<false>(st, g, EpiStore{G, DFF, 0, 1.f, 0}, 1, MT); }
            { GArgs g{H2, D, 0, w_ud + (size_t)j * D * DFF, DFF, 1, 0, nullptr, nullptr, nullptr, MT, DFF, D}; gemm<false>(st, g, EpiStore{U, DFF, 0, 1.f, 0}, 1, MT); }
            hipLaunchKernelGGL(k_swiglu, dim3(4096), dim3(256), 0, st, G, U, (long)MT * DFF);
            { GArgs g{G, DFF, 0, w_dd + (size_t)j * DFF * D, D, 1, 0, nullptr, nullptr, nullptr, MT, D, DFF}; gemm<false>(st, g, EpiResid{XL, modl + 5 * D, modc + 5 * D}, 1, MT); }
        } else {
            const int j = i / 2;
            float* Ge = P; float* Ue = P + (size_t)2 * SEQ * DFE;
            hipLaunchKernelGGL(k_router, dim3(SEQ / 4), dim3(256), 0, st, H2, w_router + (size_t)j * D * NE, sel, gw);
            hipLaunchKernelGGL(k_sort, dim3(1), dim3(512), 0, st, sel, cnt, off, toklist, slot_of);
            { GArgs g{H2, D, 0, w_ge + (size_t)j * NE * D * DFE, DFE, 1, (long)D * DFE, toklist, off, cnt, 0, DFE, D}; gemm<false>(st, g, EpiStore{Ge, DFE, 0, 1.f, 0}, NE, SEQ); }
            { GArgs g{H2, D, 0, w_ue + (size_t)j * NE * D * DFE, DFE, 1, (long)D * DFE, toklist, off, cnt, 0, DFE, D}; gemm<false>(st, g, EpiStore{Ue, DFE, 0, 1.f, 0}, NE, SEQ); }
            hipLaunchKernelGGL(k_swiglu, dim3(4096), dim3(256), 0, st, Ge, Ue, (long)2 * SEQ * DFE);
            { GArgs g{Ge, DFE, 0, w_de + (size_t)j * NE * DFE * D, D, 1, (long)DFE * D, nullptr, off, cnt, 0, D, DFE}; gemm<false>(st, g, EpiStore{Ys, D, 0, 1.f, 0}, NE, SEQ); }
            hipLaunchKernelGGL(k_moe_combine, dim3(nblk((long)SEQ * D)), dim3(256), 0, st, XL, Ys, slot_of, gw, modl + 5 * D);
        }
        (void)OUT; (void)Y;
    }
    hipLaunchKernelGGL(k_final, dim3(SEQ), dim3(256), 0, st, XL, g_final, out);
}
}


namespace mk {
#define LAS __attribute__((address_space(3)))
#define GAS __attribute__((address_space(1)))
typedef unsigned short bf16;
typedef short bf16x8 __attribute__((ext_vector_type(8)));
typedef short s16x4 __attribute__((ext_vector_type(4)));
typedef float f32x2 __attribute__((ext_vector_type(2)));
typedef float f32x4 __attribute__((ext_vector_type(4)));
typedef float f32x16 __attribute__((ext_vector_type(16)));
typedef unsigned u32x2 __attribute__((ext_vector_type(2)));
typedef unsigned u32x4 __attribute__((ext_vector_type(4)));
typedef __bf16 bf16x2_t __attribute__((ext_vector_type(2)));
typedef int i32x4 __attribute__((ext_vector_type(4)));
typedef GAS unsigned gu32;

constexpr int NWAVES = 8, NTHREADS = 512;
constexpr int NT_IN = 45;
constexpr int NIN = NT_IN * 256;
constexpr int KS_ADA = 16;
constexpr int MAXT = 72;
constexpr int XS_ROWS = MAXT * 256;

constexpr size_t al256(size_t x) { return (x + 255) / 256 * 256; }
constexpr size_t WS_CTL = 0, CTL_BYTES = 1u << 20;
constexpr size_t WS_MOD = WS_CTL + CTL_BYTES;
constexpr size_t WS_PART = WS_MOD + al256((size_t)4 * 6 * D * 4);
constexpr size_t WS_ROPE = WS_PART + al256((size_t)2 * KS_ADA * 2 * 6 * D * 4);
constexpr size_t WS_SEL = WS_ROPE + al256(2 * 128 * 16 * 4);
constexpr size_t WS_GW = WS_SEL + al256((size_t)2 * SEQ * 4);
constexpr size_t WS_SLOT = WS_GW + al256((size_t)2 * SEQ * 4);
constexpr int SC_IN = 0, SC_GU = 2 * NIN, SC_GUE = SC_GU + 2 * DFF, SC_TOTAL = SC_GUE + NE * 2 * DFE;
constexpr size_t WS_HSC = WS_SLOT + al256((size_t)2 * SEQ * 4);
constexpr size_t WS_XSC = WS_HSC + al256((size_t)MT * 4);
constexpr size_t WS_WSC = WS_XSC + al256((size_t)XS_ROWS * 4);
constexpr size_t CTL_COLMAX = 65536;
static_assert(CTL_COLMAX + (size_t)SC_TOTAL * 4 <= CTL_BYTES, "column maxima inside the zeroed control region");
constexpr size_t WS_XL = WS_WSC + al256((size_t)SC_TOTAL * 4);
constexpr size_t WS_HN = WS_XL + al256((size_t)MT * D * 4);
constexpr size_t WS_MIX = WS_HN + al256((size_t)MT * D * 2);
constexpr size_t MX_QC = 0;
constexpr size_t MX_KRB = MX_QC + al256((size_t)MT * 1024 * 2);
constexpr size_t MX_SSQ = MX_KRB + al256((size_t)MT * 64 * 2);
constexpr size_t MX_U = MX_SSQ + al256((size_t)MT * 16 * 4);
constexpr size_t MX_CB = MX_U + al256((size_t)MT * D * 2);
constexpr size_t MX_SGA = MX_CB + al256((size_t)MT * D * 2);
constexpr size_t MX_SGB = MX_SGA + al256((size_t)MT * D * 2);
constexpr size_t MX_Q = MX_SGB + al256((size_t)MT * D * 2);
constexpr size_t MX_KV = MX_Q + al256((size_t)MT * 3072 * 2);
constexpr size_t MX_O = MX_KV + al256((size_t)MT * 4096 * 2);
constexpr size_t MX_V2 = MX_O + al256((size_t)MT * D * 2);
constexpr size_t MX_M1 = MX_V2 + al256((size_t)MT * D * 2);
constexpr size_t MX_MG = MX_M1 + al256((size_t)MT * D * 2);
constexpr size_t MX_END = MX_MG + al256((size_t)MT * D * 2);
constexpr size_t FX_ACT = 0;
constexpr size_t FX_XS = 0;
constexpr size_t FX_ACTE = FX_XS + al256((size_t)XS_ROWS * D * 2);
constexpr size_t FX_YS = FX_ACTE + al256((size_t)XS_ROWS * DFE * 2);
constexpr size_t FX_END = FX_YS + al256((size_t)XS_ROWS * D * 2);
static_assert(MX_SGA - MX_CB == (size_t)MT * D * 2 && MX_SGB - MX_SGA == (size_t)MT * D * 2, "CB | SGA | SGB contiguous");
static_assert(FX_END <= MX_END && (size_t)MT * DFF * 2 <= MX_END, "FFN scratch overlays the mixer scratch");
constexpr size_t WS_W = WS_MIX + MX_END;
constexpr size_t W_IN = 0, W_IN_L = (size_t)NIN * D * 2;
constexpr size_t W_QB = W_IN + 2 * W_IN_L, W_QB_L = (size_t)3072 * 512 * 2;
constexpr size_t W_KVB = W_QB + 2 * W_QB_L, W_KVB_L = (size_t)4096 * 512 * 2;
constexpr size_t W_OA = W_KVB + 2 * W_KVB_L, W_SQ_L = (size_t)D * D * 2;
constexpr size_t W_OB = W_OA + 2 * W_SQ_L, W_O = W_OB + 2 * W_SQ_L;
constexpr size_t W_GU = W_O + 2 * W_SQ_L;
constexpr size_t W_DD = W_GU + (size_t)2 * DFF * D * 2;
constexpr size_t W_GUE = W_DD + (size_t)D * DFF * 2, W_GUE_E = (size_t)2 * DFE * D * 2;
constexpr size_t W_DE = W_GUE + NE * W_GUE_E, W_DE_E = (size_t)D * DFE * 2;
constexpr size_t W_END = W_DE + NE * W_DE_E;
constexpr size_t WS_END = WS_W + W_END;

constexpr int RING_BYTES = 131072;
constexpr int LCTL_OFF = RING_BYTES;
constexpr int LDS_BYTES = 147456;

__device__ __forceinline__ unsigned cvtpk(float lo, float hi) { f32x2 v = {lo, hi}; bf16x2_t b = __builtin_convertvector(v, bf16x2_t); return __builtin_bit_cast(unsigned, b); }
__device__ __forceinline__ u32x4 pack8(f32x4 a, f32x4 b) { u32x4 w; w.x = cvtpk(a[0], a[1]); w.y = cvtpk(a[2], a[3]); w.z = cvtpk(b[0], b[1]); w.w = cvtpk(b[2], b[3]); return w; }
__device__ __forceinline__ void unpack8(u32x4 w, f32x4& a, f32x4& b) {
    a[0] = __uint_as_float(w.x << 16); a[1] = __uint_as_float(w.x & 0xffff0000u); a[2] = __uint_as_float(w.y << 16); a[3] = __uint_as_float(w.y & 0xffff0000u);
    b[0] = __uint_as_float(w.z << 16); b[1] = __uint_as_float(w.z & 0xffff0000u); b[2] = __uint_as_float(w.w << 16); b[3] = __uint_as_float(w.w & 0xffff0000u); }
__device__ __forceinline__ f32x4 unpack4(u32x2 w) { f32x4 a; a[0] = __uint_as_float(w.x << 16); a[1] = __uint_as_float(w.x & 0xffff0000u); a[2] = __uint_as_float(w.y << 16); a[3] = __uint_as_float(w.y & 0xffff0000u); return a; }
__device__ __forceinline__ float fsig(float x) { return __builtin_amdgcn_rcpf(1.f + __builtin_amdgcn_exp2f(-1.4426950408889634f * x)); }
__device__ __forceinline__ f32x4 fsig4(f32x4 x) { f32x4 r; r[0] = fsig(x[0]); r[1] = fsig(x[1]); r[2] = fsig(x[2]); r[3] = fsig(x[3]); return r; }
__device__ __forceinline__ float wave_sum(float v) {
#pragma unroll
    for (int o = 1; o < 64; o <<= 1) v += __shfl_xor(v, o);
    return v;
}
#define LDS_WAIT() asm volatile("s_waitcnt lgkmcnt(0)" ::: "memory")
#define VM_WAIT() asm volatile("s_waitcnt vmcnt(0)" ::: "memory")

namespace pg8 {
constexpr int BM = 256, BK = 64, HALF = 128, HTB = HALF * BK * 2, STAGE_BYTES = 8 * HTB, NXCD = 8, WGM = 8;
__device__ __forceinline__ int lds_byte(int r, int c) { const int st = (r >> 4) * 2 + (c >> 5), rr = r & 15, cc = c & 31, ob = rr * 64 + cc * 2; return st * 1024 + (ob ^ (((ob >> 9) & 1) << 5)); }
__device__ __forceinline__ void stage_rc(int b, int& R, int& C) { const int st = b / 1024, sb = b % 1024, swz = sb ^ (((sb >> 9) & 1) << 5); R = (st >> 1) * 16 + swz / 64; C = (st & 1) * 32 + (swz % 64) / 2; }
__device__ __forceinline__ int perm32(int rho) { const int n = rho >> 4, i = rho & 15; return 8 * (i >> 2) + 4 * n + (i & 3); }
struct Unit { int pm, pn, kind; };
struct Geo { int lda, ldb, K; };
__device__ __forceinline__ void tile_of(int L, int nM, int nN, int& pm, int& pn) {
    const int nwg = nM * nN; int wgid = L; { const int q = nwg / NXCD, r = nwg % NXCD, xcd = wgid % NXCD, off = wgid / NXCD; wgid = (xcd < r ? xcd * (q + 1) : r * (q + 1) + (xcd - r) * q) + off; }
    const int nig = WGM * nN, gid = wgid / nig, fm = gid * WGM, gsz = (nM - fm) < WGM ? (nM - fm) : WGM;
    pm = fm + ((wgid % nig) % gsz); pn = (wgid % nig) / gsz;
}
template <class Epi, class Sched, bool ALIGN_EPI, bool I8 = false>
__device__ __forceinline__ void gemm_phase(LAS unsigned char* lds, const Geo g, const Sched& S, const Epi& E) {
    int tid = threadIdx.x; asm volatile("" : "+v"(tid));
    const int wid = __builtin_amdgcn_readfirstlane(tid >> 6), lane = tid & 63, wr = wid >> 2, wc = wid & 3, fr = lane & 15, fq = lane >> 4;
    const int nt = g.K / BK;
    unsigned voffA[2], voffB[2];
#pragma unroll
    for (int i = 0; i < 2; ++i) { int R, C; stage_rc(tid * 16 + i * 8192, R, C); const int Rb = Epi::PERM ? ((R & ~31) + perm32(R & 31)) : R;
        voffA[i] = (unsigned)(R * g.lda + C) * 2u; voffB[i] = (unsigned)(Rb * g.ldb + C) * 2u; }
    const size_t kstep = (size_t)(BK * 2);
    const size_t hstepA = (size_t)HALF * g.lda * 2, hstepB = (size_t)HALF * g.ldb * 2;
    const unsigned ldsw = (unsigned)wid * 1024u;
    const int aoff = lds_byte(wr * 64 + fr, fq * 8), boff = lds_byte(wc * 32 + fr, fq * 8);
#define PG8_SA(b, h) (((b) * 2 + (h)) * HTB)
#define PG8_SB(b, h) ((4 + (b) * 2 + (h)) * HTB)
#define PG8_STAGE(bufoff, gbase, voff) do { _Pragma("unroll") for (int _i = 0; _i < 2; ++_i) \
        __builtin_amdgcn_global_load_lds((const unsigned*)((const char*)(gbase) + (voff)[_i]), (LAS unsigned*)(lds + (bufoff) + ldsw + _i * 8192), 16, 0, 0); } while (0)
#define PG8_LDA(dst, b, h) do { _Pragma("unroll") for (int m = 0; m < 4; ++m) _Pragma("unroll") for (int k = 0; k < 2; ++k) dst[m][k] = *(const LAS bf16x8*)(lds + PG8_SA(b, h) + aoff + m * 2048 + k * 1024); } while (0)
#define PG8_LDB(dst, b, h) do { _Pragma("unroll") for (int n = 0; n < 2; ++n) _Pragma("unroll") for (int k = 0; k < 2; ++k) dst[n][k] = *(const LAS bf16x8*)(lds + PG8_SB(b, h) + boff + n * 2048 + k * 1024); } while (0)
#define PG8_MMA(ai, bj, At, Bt) do { __builtin_amdgcn_s_setprio(1); _Pragma("unroll") for (int m = 0; m < 4; ++m) _Pragma("unroll") for (int n = 0; n < 2; ++n) _Pragma("unroll") for (int k = 0; k < 2; ++k) { \
        if constexpr (I8) acc[ai][bj][m][n] = __builtin_bit_cast(f32x4, __builtin_amdgcn_mfma_i32_16x16x64_i8(__builtin_bit_cast(i32x4, Bt[n][k]), __builtin_bit_cast(i32x4, At[m][k]), __builtin_bit_cast(i32x4, acc[ai][bj][m][n]), 0, 0, 0)); \
        else acc[ai][bj][m][n] = __builtin_amdgcn_mfma_f32_16x16x32_bf16(Bt[n][k], At[m][k], acc[ai][bj][m][n], 0, 0, 0); } __builtin_amdgcn_s_setprio(0); } while (0)
#define PG8_WAIT_V(n) asm volatile("s_waitcnt vmcnt(" #n ")" ::: "memory")
#define PG8_WAIT_L(n) asm volatile("s_waitcnt lgkmcnt(" #n ")" ::: "memory")
#define PG8_BAR __builtin_amdgcn_s_barrier()
#define PG8_SCHED __builtin_amdgcn_sched_barrier(0)
    Unit cur, nxt; int ui = 0;
    if (!S.next(0, cur)) return;
    float zf = 0.f; asm volatile("" : "+v"(zf));
    f32x4 acc[2][2][4][2];
#pragma unroll
    for (int a = 0; a < 2; ++a)
#pragma unroll
        for (int b = 0; b < 2; ++b)
#pragma unroll
            for (int m = 0; m < 4; ++m)
#pragma unroll
                for (int n = 0; n < 2; ++n) acc[a][b][m][n] = (f32x4){zf, zf, zf, zf};
    bf16x8 At[4][2], B0[2][2], B1[2][2];
    const char* cA = S.abase(cur); const char* cB = S.bbase(cur);
    PG8_STAGE(PG8_SB(0, 0), cB, voffB); PG8_STAGE(PG8_SB(0, 1), cB + hstepB, voffB); PG8_STAGE(PG8_SA(0, 0), cA, voffA); PG8_STAGE(PG8_SA(0, 1), cA + hstepA, voffA);
    if (wr == 1) PG8_BAR;
    PG8_WAIT_V(2); PG8_BAR;
    PG8_STAGE(PG8_SB(1, 0), cB + kstep, voffB); PG8_STAGE(PG8_SA(1, 0), cA + kstep, voffA); PG8_STAGE(PG8_SB(1, 1), cB + hstepB + kstep, voffB);
    PG8_WAIT_V(6); PG8_BAR;
    for (;;) {
        const bool has_next = S.next(ui + 1, nxt);
        const char* nA = has_next ? S.abase(nxt) : cA; const char* nB = has_next ? S.bbase(nxt) : cB;
        for (int t = 0; t < nt; t += 2) {
            const bool last = (t == nt - 2);
            const char* a1 = cA + (size_t)(t + 1) * kstep;
            const char* a2 = last ? nA : cA + (size_t)(t + 2) * kstep; const char* b2 = last ? nB : cB + (size_t)(t + 2) * kstep;
            const char* a3 = a2 + kstep; const char* b3 = b2 + kstep;
            PG8_LDB(B0, 0, 0); PG8_LDB(B1, 0, 1); PG8_SCHED; PG8_LDA(At, 0, 0); PG8_STAGE(PG8_SA(1, 1), a1 + hstepA, voffA);
            PG8_WAIT_V(8); PG8_WAIT_L(0); PG8_BAR; PG8_MMA(0, 0, At, B0); PG8_MMA(0, 1, At, B1); PG8_BAR; PG8_SCHED;
            PG8_LDA(At, 0, 1); PG8_STAGE(PG8_SB(0, 0), b2, voffB); PG8_STAGE(PG8_SB(0, 1), b2 + hstepB, voffB); PG8_STAGE(PG8_SA(0, 0), a2, voffA);
            PG8_WAIT_V(8); PG8_WAIT_L(0); PG8_BAR; PG8_MMA(1, 0, At, B0); PG8_MMA(1, 1, At, B1); PG8_BAR; PG8_SCHED;
            PG8_LDB(B0, 1, 0); PG8_LDB(B1, 1, 1); PG8_SCHED; PG8_LDA(At, 1, 0); PG8_STAGE(PG8_SA(0, 1), a2 + hstepA, voffA);
            PG8_WAIT_V(8); PG8_WAIT_L(0); PG8_BAR; PG8_MMA(0, 0, At, B0); PG8_MMA(0, 1, At, B1); PG8_BAR; PG8_SCHED;
            PG8_LDA(At, 1, 1); PG8_STAGE(PG8_SB(1, 0), b3, voffB); PG8_STAGE(PG8_SB(1, 1), b3 + hstepB, voffB); PG8_STAGE(PG8_SA(1, 0), a3, voffA);
            PG8_WAIT_V(8); PG8_WAIT_L(0); PG8_BAR; PG8_MMA(1, 0, At, B0); PG8_MMA(1, 1, At, B1); PG8_BAR; PG8_SCHED;
        }
        if constexpr (ALIGN_EPI) { if (wr == 0) PG8_BAR; }
        if constexpr (I8) {
            static_assert(Epi::PERM, "the int8 path dequantises in the PERM column layout");
            const float* sa = S.sa(cur) + wr * 64 + fr; const float* sb = S.sb(cur) + wc * 32 + 8 * fq;
            f32x4 sbv[2][2];
#pragma unroll
            for (int b = 0; b < 2; ++b)
#pragma unroll
                for (int n = 0; n < 2; ++n) sbv[b][n] = *(const f32x4*)(sb + b * HALF + 4 * n);
#pragma unroll
            for (int a = 0; a < 2; ++a)
#pragma unroll
                for (int m = 0; m < 4; ++m) { const float sr = sa[a * HALF + m * 16];
#pragma unroll
                    for (int b = 0; b < 2; ++b)
#pragma unroll
                        for (int n = 0; n < 2; ++n) { const i32x4 iv = __builtin_bit_cast(i32x4, acc[a][b][m][n]);
                            acc[a][b][m][n] = (f32x4){(float)iv[0], (float)iv[1], (float)iv[2], (float)iv[3]} * (sbv[b][n] * sr); } }
        }
        E(acc, cur, wr, wc, fr, fq);
        if (!has_next) break;
#pragma unroll
        for (int a = 0; a < 2; ++a)
#pragma unroll
            for (int b = 0; b < 2; ++b)
#pragma unroll
                for (int m = 0; m < 4; ++m)
#pragma unroll
                    for (int n = 0; n < 2; ++n) acc[a][b][m][n] = (f32x4){zf, zf, zf, zf};
        cur = nxt; cA = nA; cB = nB; ++ui;
        if constexpr (ALIGN_EPI) { if (wr == 1) PG8_BAR; }
    }
    PG8_WAIT_V(0);
    if constexpr (!ALIGN_EPI) { if (wr == 0) PG8_BAR; }
    PG8_BAR;
#undef PG8_SA
#undef PG8_SB
#undef PG8_STAGE
#undef PG8_LDA
#undef PG8_LDB
#undef PG8_MMA
#undef PG8_WAIT_V
#undef PG8_WAIT_L
#undef PG8_BAR
#undef PG8_SCHED
}

struct TileOrder {
    int nM, nN, pm0, G, c, nx, xpm, xpn0;
    const char* A; const char* B; size_t tstepA, tstepB; const float* SA; const float* SB;
    __device__ __forceinline__ const float* sa(const Unit& u) const { return SA + (size_t)u.pm * 256; }
    __device__ __forceinline__ const float* sb(const Unit& u) const { return SB + (size_t)u.pn * 256; }
    __device__ __forceinline__ bool next(int i, Unit& u) const {
        const int L = i * G + c, n1 = nM * nN;
        if (L < n1) { tile_of(L, nM, nN, u.pm, u.pn); u.pm += pm0; u.kind = 0; return true; }
        if (L < n1 + nx) { u.pm = xpm; u.pn = xpn0 + (L - n1); u.kind = 0; return true; }
        return false; }
    __device__ __forceinline__ const char* abase(const Unit& u) const { return A + (size_t)u.pm * tstepA; }
    __device__ __forceinline__ const char* bbase(const Unit& u) const { return B + (size_t)u.pn * tstepB; }
};
struct QkvOrder {
    int nMkv, nMq, pm0q, G, c; const char* QC; const char* WQB; long dkv;
    __device__ __forceinline__ bool next(int i, Unit& u) const {
        const int L = i * G + c, n1 = nMkv * 16;
        if (L < n1) { tile_of(L, nMkv, 16, u.pm, u.pn); u.kind = 0; return true; }
        if (L < n1 + nMq * 12) { tile_of(L - n1, nMq, 12, u.pm, u.pn); u.pm += pm0q; u.kind = 1; return true; }
        return false; }
    __device__ __forceinline__ const char* abase(const Unit& u) const { return QC + (size_t)u.pm * (256 * 1024 * 2) + (u.kind == 0 ? 1024 : 0); }
    __device__ __forceinline__ const char* bbase(const Unit& u) const { return WQB + (u.kind == 0 ? dkv : 0l) + (size_t)u.pn * (256 * 512 * 2); }
};
struct MoeOrder {
    int T, nN, G, c; const char* A; const char* B; size_t tstepA, tstepB, estride; const LAS int* te; const float* SA; const float* SB; int sbstride;
    __device__ __forceinline__ const float* sa(const Unit& u) const { return SA + (size_t)u.pm * 256; }
    __device__ __forceinline__ const float* sb(const Unit& u) const { const int e = __builtin_amdgcn_readfirstlane(te[u.pm]); return SB + (size_t)e * sbstride + (size_t)u.pn * 256; }
    __device__ __forceinline__ bool next(int i, Unit& u) const {
        const int L = i * G + c; if (L >= T * nN) return false;
        tile_of(L, T, nN, u.pm, u.pn); u.kind = 0; return true; }
    __device__ __forceinline__ const char* abase(const Unit& u) const { return A + (size_t)u.pm * tstepA; }
    __device__ __forceinline__ const char* bbase(const Unit& u) const { const int e = __builtin_amdgcn_readfirstlane(te[u.pm]); return B + (size_t)e * estride + (size_t)u.pn * tstepB; }
};

typedef const f32x4 (&AccRef)[2][2][4][2];
struct EpiInproj {
    static constexpr bool PERM = true;
    bf16* QC; bf16* KRB; bf16* U; bf16* CB; float* SSQ; const float* ROPE;
    __device__ __forceinline__ void operator()(AccRef acc, const Unit& u, int wr, int wc, int fr_, int fq_) const {
        int fr = fr_, fq = fq_; asm volatile("" : "+v"(fr), "+v"(fq));
        const int pn = u.pn, row0 = u.pm * BM + wr * 64 + fr;
        if (pn < 4) {
#pragma unroll
            for (int ai = 0; ai < 2; ++ai)
#pragma unroll
                for (int m = 0; m < 4; ++m) { const int row = row0 + ai * HALF + m * 16; float s = 0.f;
#pragma unroll
                    for (int bj = 0; bj < 2; ++bj) { const f32x4 v0 = acc[ai][bj][m][0], v1 = acc[ai][bj][m][1];
                        s += (v0[0] * v0[0] + v0[1] * v0[1]) + (v0[2] * v0[2] + v0[3] * v0[3]) + (v1[0] * v1[0] + v1[1] * v1[1]) + (v1[2] * v1[2] + v1[3] * v1[3]);
                        *(u32x4*)(QC + (size_t)row * 1024 + pn * 256 + bj * HALF + wc * 32 + 8 * fq) = pack8(v0, v1); }
                    s += __shfl_xor(s, 16); s += __shfl_xor(s, 32);
                    if (fq == 0) SSQ[(size_t)row * 16 + pn * 4 + wc] = s; }
        } else if (pn == 4) {
            if (wc < 2) {
#pragma unroll
                for (int ai = 0; ai < 2; ++ai)
#pragma unroll
                    for (int m = 0; m < 4; ++m) { const int row = row0 + ai * HALF + m * 16; f32x4 v0 = acc[ai][0][m][0], v1 = acc[ai][0][m][1];
                        if (row >= LC) { const int t = row - LC, pos = wc ? (t & 63) : (t >> 6);
                            const f32x4 cs = *(const f32x4*)(ROPE + pos * 16 + 4 * fq), sn = *(const f32x4*)(ROPE + 2048 + pos * 16 + 4 * fq);
                            const f32x4 a0 = v0, a1 = v1;
                            v0[0] = a0[0] * cs[0] - a0[1] * sn[0]; v0[1] = a0[1] * cs[0] + a0[0] * sn[0]; v0[2] = a0[2] * cs[1] - a0[3] * sn[1]; v0[3] = a0[3] * cs[1] + a0[2] * sn[1];
                            v1[0] = a1[0] * cs[2] - a1[1] * sn[2]; v1[1] = a1[1] * cs[2] + a1[0] * sn[2]; v1[2] = a1[2] * cs[3] - a1[3] * sn[3]; v1[3] = a1[3] * cs[3] + a1[2] * sn[3]; }
                        *(u32x4*)(KRB + (size_t)row * 64 + wc * 32 + 8 * fq) = pack8(v0, v1); }
            }
        } else if (pn < 21) {
            const int j = pn - 5;
#pragma unroll
            for (int ai = 0; ai < 2; ++ai)
#pragma unroll
                for (int m = 0; m < 4; ++m) { const int row = row0 + ai * HALF + m * 16;
                    *(u32x4*)(U + (size_t)row * D + j * 128 + wc * 32 + 8 * fq) = pack8(acc[ai][0][m][0] * acc[ai][1][m][0], acc[ai][0][m][1] * acc[ai][1][m][1]); }
        } else {
            bf16* dst = CB + (size_t)((pn - 21) >> 3) * ((size_t)MT * D); const int col = ((pn - 21) & 7) * 256; const bool sg = pn >= 29;
#pragma unroll
            for (int ai = 0; ai < 2; ++ai)
#pragma unroll
                for (int m = 0; m < 4; ++m) { const int row = row0 + ai * HALF + m * 16;
#pragma unroll
                    for (int bj = 0; bj < 2; ++bj) { f32x4 v0 = acc[ai][bj][m][0], v1 = acc[ai][bj][m][1];
                        if (sg) { v0 = fsig4(v0); v1 = fsig4(v1); }
                        *(u32x4*)(dst + (size_t)row * D + col + bj * HALF + wc * 32 + 8 * fq) = pack8(v0, v1); } }
        }
    }
};
struct EpiQkv {
    static constexpr bool PERM = true;
    bf16* Q; bf16* KV; const float* SSQ; const float* ROPE;
    __device__ __forceinline__ void operator()(AccRef acc, const Unit& u, int wr, int wc, int fr_, int fq_) const {
        int fr = fr_, fq = fq_; asm volatile("" : "+v"(fr), "+v"(fq));
        const int row0 = u.pm * BM + wr * 64 + fr, grp = u.kind == 0 ? 8 : 0;
#pragma unroll
        for (int ai = 0; ai < 2; ++ai)
#pragma unroll
            for (int m = 0; m < 4; ++m) { const int row = row0 + ai * HALF + m * 16;
                const f32x4 s0 = *(const f32x4*)(SSQ + (size_t)row * 16 + grp), s1 = *(const f32x4*)(SSQ + (size_t)row * 16 + grp + 4);
                const float rs = rsqrtf(((s0[0] + s0[1]) + (s0[2] + s0[3]) + (s1[0] + s1[1]) + (s1[2] + s1[3])) * (1.f / 512.f) + EPS);
                const float rq = (u.kind == 0) ? rs : rs * (ATT_SCALE * 1.4426950408889634f);
#pragma unroll
                for (int bj = 0; bj < 2; ++bj) { f32x4 v0 = acc[ai][bj][m][0] * rq, v1 = acc[ai][bj][m][1] * rq;
                    if (u.kind == 0) { *(u32x4*)(KV + (size_t)row * 4096 + u.pn * 256 + bj * HALF + wc * 32 + 8 * fq) = pack8(v0, v1); }
                    else { const int hb = (u.pn * 8 + bj * 4 + wc) % 6;
                        if (hb >= 4 && row >= LC) { const int t = row - LC, pos = (hb == 5) ? (t & 63) : (t >> 6);
                            const f32x4 cs = *(const f32x4*)(ROPE + pos * 16 + 4 * fq), sn = *(const f32x4*)(ROPE + 2048 + pos * 16 + 4 * fq);
                            const f32x4 a0 = v0, a1 = v1;
                            v0[0] = a0[0] * cs[0] - a0[1] * sn[0]; v0[1] = a0[1] * cs[0] + a0[0] * sn[0]; v0[2] = a0[2] * cs[1] - a0[3] * sn[1]; v0[3] = a0[3] * cs[1] + a0[2] * sn[1];
                            v1[0] = a1[0] * cs[2] - a1[1] * sn[2]; v1[1] = a1[1] * cs[2] + a1[0] * sn[2]; v1[2] = a1[2] * cs[3] - a1[3] * sn[3]; v1[3] = a1[3] * cs[3] + a1[2] * sn[3]; }
                        *(u32x4*)(Q + (size_t)row * 3072 + u.pn * 256 + bj * HALF + wc * 32 + 8 * fq) = pack8(v0, v1); } } }
    }
};
template <int MODE> struct EpiMerge {
    static constexpr bool PERM = true;
    const bf16* SG; const bf16* M1; bf16* OUT;
    __device__ __forceinline__ void operator()(AccRef acc, const Unit& u, int wr, int wc, int fr_, int fq_) const {
        int fr = fr_, fq = fq_; asm volatile("" : "+v"(fr), "+v"(fq));
        const int row0 = u.pm * BM + wr * 64 + fr;
#pragma unroll
        for (int ai = 0; ai < 2; ++ai)
#pragma unroll
            for (int m = 0; m < 4; ++m) { const int row = row0 + ai * HALF + m * 16;
#pragma unroll
                for (int bj = 0; bj < 2; ++bj) { const size_t off = (size_t)row * D + u.pn * 256 + bj * HALF + wc * 32 + 8 * fq;
                    f32x4 g0, g1; unpack8(*(const u32x4*)(SG + off), g0, g1);
                    f32x4 v0 = acc[ai][bj][m][0] * g0, v1 = acc[ai][bj][m][1] * g1;
                    if (MODE == 1) { f32x4 m0, m1; unpack8(*(const u32x4*)(M1 + off), m0, m1); v0 += m0; v1 += m1; }
                    *(u32x4*)(OUT + off) = pack8(v0, v1); } }
    }
};
struct EpiSwiglu {
    static constexpr bool PERM = true;
    bf16* ACT; int ld;
    __device__ __forceinline__ void operator()(AccRef acc, const Unit& u, int wr, int wc, int fr_, int fq_) const {
        int fr = fr_, fq = fq_; asm volatile("" : "+v"(fr), "+v"(fq));
        const int row0 = u.pm * BM + wr * 64 + fr;
#pragma unroll
        for (int ai = 0; ai < 2; ++ai)
#pragma unroll
            for (int m = 0; m < 4; ++m) { const int row = row0 + ai * HALF + m * 16;
                const f32x4 g0 = acc[ai][0][m][0], g1 = acc[ai][0][m][1];
                const f32x4 v0 = g0 * fsig4(g0) * acc[ai][1][m][0], v1 = g1 * fsig4(g1) * acc[ai][1][m][1];
                *(u32x4*)(ACT + (size_t)row * ld + u.pn * 128 + wc * 32 + 8 * fq) = pack8(v0, v1); }
    }
};
struct EpiResid {
    static constexpr bool PERM = false;
    float* XL; const float* SRC; const float* gl;
    __device__ __forceinline__ void operator()(AccRef acc, const Unit& u, int wr, int wc, int fr_, int fq_) const {
        int fr = fr_, fq = fq_; asm volatile("" : "+v"(fr), "+v"(fq));
        const int row0 = u.pm * BM + wr * 64 + fr; const float* gate = gl + ((u.pm == 0) ? 6 * D : 0);
#pragma unroll
        for (int bj = 0; bj < 2; ++bj)
#pragma unroll
            for (int n = 0; n < 2; ++n) { const int col = u.pn * 256 + bj * HALF + wc * 32 + 16 * n + 4 * fq; const f32x4 gv = *(const f32x4*)(gate + col);
#pragma unroll
                for (int ai = 0; ai < 2; ++ai)
#pragma unroll
                    for (int m = 0; m < 4; ++m) { const size_t o = (size_t)(row0 + ai * HALF + m * 16) * D + col; *(f32x4*)(XL + o) = *(const f32x4*)(SRC + o) + gv * acc[ai][bj][m][n]; } }
    }
};
struct EpiStoreBf16 {
    static constexpr bool PERM = true;
    bf16* C; int ld;
    __device__ __forceinline__ void operator()(AccRef acc, const Unit& u, int wr, int wc, int fr_, int fq_) const {
        int fr = fr_, fq = fq_; asm volatile("" : "+v"(fr), "+v"(fq));
        const int row0 = u.pm * BM + wr * 64 + fr;
#pragma unroll
        for (int ai = 0; ai < 2; ++ai)
#pragma unroll
            for (int m = 0; m < 4; ++m)
#pragma unroll
                for (int bj = 0; bj < 2; ++bj)
                    *(u32x4*)(C + (size_t)(row0 + ai * HALF + m * 16) * ld + u.pn * 256 + bj * HALF + wc * 32 + 8 * fq) = pack8(acc[ai][bj][m][0], acc[ai][bj][m][1]);
    }
};
}

namespace att {
constexpr int QBLK = 32, KVBLK = 64;
constexpr int LDQ = NH * DQK, LDK = NH * 256, LDR = DR, LDO = D;
constexpr int SHM_V = KVBLK * DV * 2, SHM_K = KVBLK * DQK * 2;
constexpr int OFF_K = 2 * SHM_V, OFF_WS = 2 * SHM_V + 2 * SHM_K, OFF_QR = OFF_WS + NWAVES * 64 * 4, OFF_DO = OFF_QR + NWAVES * 4096, SHM_ATTN = OFF_DO + NTHREADS * 20;
static_assert(SHM_ATTN <= RING_BYTES, "attention scratch inside the ring");
constexpr float THR = 8.f;
#define KSWZ(row, colB) ((row) * 384 + ((colB) ^ (((row) & 7) << 4)))
#define SBAR() __builtin_amdgcn_sched_barrier(0)
__device__ __forceinline__ int crow(int r, int hi) { return (r & 3) + 8 * (r >> 2) + 4 * hi; }
constexpr float THR2 = THR * 1.4426950408889634f;
template <bool FIRST> __device__ __forceinline__ void partialSM(f32x16& p0, f32x16& p1, float& m_reg, f32x16& negm, float& alpha) {
    float pmax = p0[0];
#pragma unroll
    for (int r = 1; r < 16; ++r) pmax = fmaxf(pmax, p0[r]);
#pragma unroll
    for (int r = 0; r < 16; ++r) pmax = fmaxf(pmax, p1[r]);
    { auto rr = __builtin_amdgcn_permlane32_swap(__float_as_uint(pmax), __float_as_uint(pmax), false, false);
      pmax = fmaxf(__uint_as_float(rr[0]), __uint_as_float(rr[1])); }
    alpha = 1.f;
    if (FIRST || !__builtin_expect(__all(pmax <= THR2), 1)) {
        const float d = FIRST ? pmax : fmaxf(pmax, 0.f);
        m_reg += d; if (!FIRST) alpha = __builtin_amdgcn_exp2f(-d);
#pragma unroll
        for (int r = 0; r < 16; ++r) { p0[r] -= d; p1[r] -= d; }
#pragma unroll
        for (int r = 0; r < 16; ++r) negm[r] = -m_reg;
    }
#pragma unroll
    for (int r = 0; r < 16; ++r) p0[r] = __builtin_amdgcn_exp2f(p0[r]);
}
__device__ __forceinline__ void finishSM(f32x16& p0, f32x16& p1, float alpha, float& l_reg, bf16x8& pa0, bf16x8& pa1, bf16x8& pa2, bf16x8& pa3) {
#pragma unroll
    for (int r = 0; r < 16; ++r) p1[r] = __builtin_amdgcn_exp2f(p1[r]);
    float ps = 0;
#pragma unroll
    for (int r = 0; r < 16; ++r) ps += p0[r];
#pragma unroll
    for (int r = 0; r < 16; ++r) ps += p1[r];
    { auto rr = __builtin_amdgcn_permlane32_swap(__float_as_uint(ps), __float_as_uint(ps), false, false);
      ps = __uint_as_float(rr[0]) + __uint_as_float(rr[1]); }
    l_reg = l_reg * alpha + ps;
#define PK4(P, BASE, OUT) do { u32x4 w = {cvtpk(P[BASE + 0], P[BASE + 1]), cvtpk(P[BASE + 2], P[BASE + 3]), cvtpk(P[BASE + 4], P[BASE + 5]), cvtpk(P[BASE + 6], P[BASE + 7])}; \
    OUT = __builtin_bit_cast(bf16x8, w); } while (0)
    PK4(p0, 0, pa0); PK4(p0, 8, pa1); PK4(p1, 0, pa2); PK4(p1, 8, pa3);
#undef PK4
}
__device__ __forceinline__ void qkt(f32x16& p0, f32x16& p1, const LAS char* Ks, const int (&kb)[4], int krd, const bf16x8* qr, const LAS char* qrl, const f32x16& negm) {
#pragma unroll
    for (int d0 = 0; d0 < 12; ++d0) {
        const LAS char* a = d0 < 8 ? Ks + kb[d0 & 3] + (d0 >> 2) * 128 : Ks + kb[d0 - 8] + krd;
        const bf16x8 b0 = *(const LAS bf16x8*)a;
        const bf16x8 b1 = *(const LAS bf16x8*)(a + (d0 < 8 ? 32 * 256 : 32 * 128));
        if (d0 == 0) { p0 = __builtin_amdgcn_mfma_f32_32x32x16_bf16(b0, qr[0], negm, 0, 0, 0); p1 = __builtin_amdgcn_mfma_f32_32x32x16_bf16(b1, qr[0], negm, 0, 0, 0); }
        else { const bf16x8 qf = d0 < 8 ? qr[d0 & 7] : *(const LAS bf16x8*)(qrl + (d0 - 8) * 1024);
            p0 = __builtin_amdgcn_mfma_f32_32x32x16_bf16(b0, qf, p0, 0, 0, 0); p1 = __builtin_amdgcn_mfma_f32_32x32x16_bf16(b1, qf, p1, 0, 0, 0); } }
}
__device__ __forceinline__ int v_st(int k, int c) { const int kk = (k & ~0xC) | ((k & 4) << 1) | ((k & 8) >> 1); return ((kk >> 3) * 4 + (c >> 5)) * 512 + ((kk & 7) * 32 + (c & 31)) * 2; }
__device__ __forceinline__ int v_rd_base(int lane) { return ((lane & 3) << 3) | (((lane >> 2) & 3) << 6) | (((lane >> 4) & 1) << 5) | (((lane >> 5) & 1) << 8); }
constexpr int v_rd_off(int d0, int ks, int half) { return d0 * 512 + ks * 4096 + half * 2048; }
template <int OFF> __device__ __forceinline__ s16x4 tr_read(int vb) {
    s16x4 r; asm volatile("ds_read_b64_tr_b16 %0, %1 offset:%2" : "=&v"(r) : "v"(vb), "i"(OFF) : "memory"); return r;
}
template <int D0> __device__ __forceinline__ void pv_one(f32x16& od, int vb, bf16x8 pa0, bf16x8 pa1, bf16x8 pa2, bf16x8 pa3) {
    const s16x4 l0 = tr_read<v_rd_off(D0, 0, 0)>(vb), h0 = tr_read<v_rd_off(D0, 0, 1)>(vb), l1 = tr_read<v_rd_off(D0, 1, 0)>(vb), h1 = tr_read<v_rd_off(D0, 1, 1)>(vb);
    const s16x4 l2 = tr_read<v_rd_off(D0, 2, 0)>(vb), h2 = tr_read<v_rd_off(D0, 2, 1)>(vb), l3 = tr_read<v_rd_off(D0, 3, 0)>(vb), h3 = tr_read<v_rd_off(D0, 3, 1)>(vb);
    asm volatile("s_waitcnt lgkmcnt(0)" ::: "memory"); SBAR();
#define PK(L, H) (bf16x8){L[0], L[1], L[2], L[3], H[0], H[1], H[2], H[3]}
    od = __builtin_amdgcn_mfma_f32_32x32x16_bf16(PK(l0, h0), pa0, od, 0, 0, 0);
    od = __builtin_amdgcn_mfma_f32_32x32x16_bf16(PK(l1, h1), pa1, od, 0, 0, 0);
    od = __builtin_amdgcn_mfma_f32_32x32x16_bf16(PK(l2, h2), pa2, od, 0, 0, 0);
    od = __builtin_amdgcn_mfma_f32_32x32x16_bf16(PK(l3, h3), pa3, od, 0, 0, 0);
#undef PK
}
__device__ __forceinline__ void pv_d0(f32x16* o, int vb, bf16x8 pa0, bf16x8 pa1, bf16x8 pa2, bf16x8 pa3) {
    pv_one<0>(o[0], vb, pa0, pa1, pa2, pa3); pv_one<1>(o[1], vb, pa0, pa1, pa2, pa3); pv_one<2>(o[2], vb, pa0, pa1, pa2, pa3); pv_one<3>(o[3], vb, pa0, pa1, pa2, pa3);
}
constexpr int KROPE_OFF = 16384;
__device__ __forceinline__ void attn_unit(const bf16* Qb, const bf16* KVb, int hoff, const bf16* KRb, bf16* Ob, int seq, LAS char* lds) {
    int tid = threadIdx.x; asm volatile("" : "+v"(tid));
    const int wid = __builtin_amdgcn_readfirstlane(tid >> 6), lane = tid & 63, r32 = lane & 31, hi = lane >> 5;
    LAS char* V_lds = lds; LAS char* K_lds = lds + OFF_K;
        float m_reg = 0.f, l_reg = 0; f32x16 o[4]; bf16x8 qr[8]; f32x16 negm;
#pragma unroll
    for (int r = 0; r < 16; ++r) negm[r] = 0.f;
#pragma unroll
    for (int d = 0; d < 4; ++d)
#pragma unroll
        for (int r = 0; r < 16; ++r) o[d][r] = 0.f;
    const bf16* Qw = Qb + (long)(wid * QBLK + r32) * LDQ + hi * 8;
#pragma unroll
    for (int d0 = 0; d0 < 8; ++d0) qr[d0] = *(const bf16x8*)(Qw + d0 * 16);
    LAS char* qrl = lds + OFF_QR + wid * 4096 + lane * 16;
#pragma unroll
    for (int d0 = 8; d0 < 12; ++d0) *(LAS bf16x8*)(qrl + (d0 - 8) * 1024) = *(const bf16x8*)(Qw + d0 * 16);
    int kb[4];
#pragma unroll
    for (int i = 0; i < 4; ++i) kb[i] = r32 * 256 + (((2 * i + hi) ^ (r32 & 7)) << 4);
    const int krd = KROPE_OFF - r32 * 128;
    const int vb0 = (int)(uintptr_t)V_lds + v_rd_base(lane);
    unsigned gk[2], gv[2], gr;
#pragma unroll
    for (int i = 0; i < 2; ++i) { const int s = (wid + 8 * i) * 64 + lane;
        { const int row = s >> 4, lc = (s & 15) ^ (row & 7); gk[i] = (unsigned)(row * (LDK * 2) + lc * 16); }
        { const int st = s >> 5, k = (st >> 2) * 8 + ((s & 31) >> 2), cc = (st & 3) * 32 + (s & 3) * 8; gv[i] = (unsigned)(k * (LDK * 2) + cc * 2); } }
    { const int s = wid * 64 + lane, row = s >> 3, lc = (s & 7) ^ (row & 7); gr = (unsigned)(row * (LDR * 2) + lc * 16); }
    LAS u32x4* dofs = (LAS u32x4*)(lds + OFF_DO + tid * 16); LAS unsigned* dofr = (LAS unsigned*)(lds + OFF_DO + NTHREADS * 16 + tid * 4);
    *dofs = (u32x4){gk[0], gk[1], gv[0], gv[1]}; *dofr = gr;
    const unsigned ldsw = (unsigned)wid * 1024u;
    const __amdgpu_buffer_rsrc_t rkv = __builtin_amdgcn_make_buffer_rsrc((void*)KVb, 0, (int)((size_t)MT * LDK * 2), 0x00020000);
    const __amdgpu_buffer_rsrc_t rkr = __builtin_amdgcn_make_buffer_rsrc((void*)KRb, 0, (int)((size_t)MT * LDR * 2), 0x00020000);
#define DMA_K(t, slot) do { const int ko_ = (t) * (KVBLK * LDK * 2) + hoff, ro_ = (t) * (KVBLK * LDR * 2); const u32x4 of_ = *dofs; const unsigned gr_ = *dofr; \
    __builtin_amdgcn_raw_ptr_buffer_load_lds(rkv, (LAS void*)(K_lds + (slot) * SHM_K + ldsw), 16, (int)of_.x, ko_, 0, 0); \
    __builtin_amdgcn_raw_ptr_buffer_load_lds(rkv, (LAS void*)(K_lds + (slot) * SHM_K + 8192 + ldsw), 16, (int)of_.y, ko_, 0, 0); \
    __builtin_amdgcn_raw_ptr_buffer_load_lds(rkr, (LAS void*)(K_lds + (slot) * SHM_K + KROPE_OFF + ldsw), 16, (int)gr_, ro_, 0, 0); } while (0)
#define DMA_V(t, slot) do { const int vo_ = (t) * (KVBLK * LDK * 2) + hoff + DN * 2; const u32x4 of_ = *dofs; \
    __builtin_amdgcn_raw_ptr_buffer_load_lds(rkv, (LAS void*)(V_lds + (slot) * SHM_V + ldsw), 16, (int)of_.z, vo_, 0, 0); \
    __builtin_amdgcn_raw_ptr_buffer_load_lds(rkv, (LAS void*)(V_lds + (slot) * SHM_V + 8192 + ldsw), 16, (int)of_.w, vo_, 0, 0); } while (0)
#define WAITBAR() asm volatile("s_waitcnt vmcnt(0) lgkmcnt(0)\n\ts_barrier" ::: "memory")
#define RESC(a) do { if (__any((a) < 1.f)) { \
    _Pragma("unroll") for (int d = 0; d < 4; ++d) _Pragma("unroll") for (int r = 0; r < 16; ++r) o[d][r] *= (a); } } while (0)
    f32x16 pA0, pA1, pB0, pB1; float alA, alB; bf16x8 pa0, pa1, pa2, pa3; const int NT = seq / KVBLK;
    if (wid >= 4) __builtin_amdgcn_s_setprio(1);
    DMA_K(0, 0); DMA_V(0, 0); WAITBAR();
    DMA_K(1, 1);
    qkt(pA0, pA1, K_lds, kb, krd, qr, qrl, negm); partialSM<true>(pA0, pA1, m_reg, negm, alA);
    WAITBAR();
    for (int j = 1; j + 1 < NT; j += 2) {
        DMA_K(j + 1, 0); DMA_V(j, 1);
        SBAR(); qkt(pB0, pB1, K_lds + SHM_K, kb, krd, qr, qrl, negm);
        finishSM(pA0, pA1, alA, l_reg, pa0, pa1, pa2, pa3); SBAR();
        pv_d0(o, vb0, pa0, pa1, pa2, pa3); partialSM<false>(pB0, pB1, m_reg, negm, alB);
        RESC(alB); WAITBAR();
        DMA_K(j + 2, 1); DMA_V(j + 1, 0);
        SBAR(); qkt(pA0, pA1, K_lds, kb, krd, qr, qrl, negm);
        finishSM(pB0, pB1, alB, l_reg, pa0, pa1, pa2, pa3); SBAR();
        pv_d0(o, vb0 + SHM_V, pa0, pa1, pa2, pa3); partialSM<false>(pA0, pA1, m_reg, negm, alA);
        RESC(alA); WAITBAR();
    }
    DMA_V(NT - 1, 1);
    SBAR(); qkt(pB0, pB1, K_lds + SHM_K, kb, krd, qr, qrl, negm);
    finishSM(pA0, pA1, alA, l_reg, pa0, pa1, pa2, pa3); SBAR();
    pv_d0(o, vb0, pa0, pa1, pa2, pa3); partialSM<false>(pB0, pB1, m_reg, negm, alB);
    RESC(alB); WAITBAR();
    finishSM(pB0, pB1, alB, l_reg, pa0, pa1, pa2, pa3); SBAR();
    pv_d0(o, vb0 + SHM_V, pa0, pa1, pa2, pa3);
    const float rli = __builtin_amdgcn_rcpf(l_reg);
    WAITBAR();
    LAS char* stg = lds + wid * 8704 + r32 * 272 + hi * 8;
#pragma unroll
    for (int d0 = 0; d0 < 4; ++d0)
#pragma unroll
        for (int g = 0; g < 4; ++g) { u32x2 w; w.x = cvtpk(o[d0][4 * g] * rli, o[d0][4 * g + 1] * rli); w.y = cvtpk(o[d0][4 * g + 2] * rli, o[d0][4 * g + 3] * rli);
            *(LAS u32x2*)(stg + (32 * d0 + 8 * g) * 2) = w; }
    asm volatile("s_waitcnt lgkmcnt(0)" ::: "memory");
    bf16* Ow = Ob + (long)(wid * QBLK) * LDO;
#pragma unroll
    for (int i = 0; i < 8; ++i) { const int row = i * 4 + (lane >> 4), ch = lane & 15; const u32x4 v = *(const LAS u32x4*)(lds + wid * 8704 + row * 272 + ch * 16); *(u32x4*)(Ow + (long)row * LDO + ch * 8) = v; }
    WAITBAR();
    __builtin_amdgcn_s_setprio(0);
#undef DMA_K
#undef DMA_V
#undef WAITBAR
#undef RESC
}
#undef KSWZ
#undef SBAR
}

#define XB_TMO      128
#define XB_XCNT(j)  (256  + 64 * (j))
#define XB_XSUB(j)  (1280 + 64 * (j))
#define XB_XGEN(j)  (2304 + 64 * (j))
#define XB_TOP      3328
#define XB_TOPGEN   3392
#define XCD_BAR_WORDS 3456
#define XB_SPIN_CAP (1u << 18)
__device__ __forceinline__ unsigned xb_ld(unsigned* p)              { return __hip_atomic_load(p, __ATOMIC_RELAXED, __HIP_MEMORY_SCOPE_AGENT); }
__device__ __forceinline__ unsigned xb_add(unsigned* p, unsigned v) { return __hip_atomic_fetch_add(p, v, __ATOMIC_RELAXED, __HIP_MEMORY_SCOPE_AGENT); }
__device__ __forceinline__ unsigned xb_xcc_id() { return (unsigned)__builtin_amdgcn_s_getreg((3 << 11) | 20) & 0xFu; }
#define XB_SPIN(cond, bar) do { unsigned _sp = 0; while (cond) { __builtin_amdgcn_s_sleep(1); \
    if ((++_sp & 255u) == 0u) { if (xb_ld(&(bar)[XB_TMO])) break; if (_sp > XB_SPIN_CAP) { atomicAdd(&(bar)[XB_TMO], 1u); break; } } } } while (0)
struct XcdBarrier { unsigned* bar; unsigned x; volatile LAS unsigned* st; };
__device__ __forceinline__ XcdBarrier xcd_barrier_post(unsigned* bar, volatile LAS unsigned* st) {
    XcdBarrier b; b.bar = bar; b.x = xb_xcc_id(); b.st = st;
    if (threadIdx.x == 0) (void)xb_add(&bar[XB_XCNT(b.x)], 1u);
    return b;
}
__device__ __forceinline__ void xcd_barrier_complete(unsigned* bar, unsigned x, unsigned& nloc, unsigned& nx) {
    const unsigned G = gridDim.x * gridDim.y * gridDim.z;
    unsigned sum, cnt, mine, sp = 0u;
    for (;;) {
        sum = 0u; cnt = 0u; mine = 0u;
#pragma unroll
        for (unsigned j = 0; j < 16; ++j) { const unsigned c = xb_ld(&bar[XB_XCNT(j)]); sum += c; cnt += (c > 0u) ? 1u : 0u; mine = (j == x) ? c : mine; }
        if (sum == G) break;
        __builtin_amdgcn_s_sleep(1);
        if ((++sp & 255u) == 0u) { if (xb_ld(&bar[XB_TMO])) break; if (sp > XB_SPIN_CAP) { atomicAdd(&bar[XB_TMO], 1u); break; } }
    }
    nloc = mine > 0u ? mine : 1u; nx = cnt > 0u ? cnt : 1u;
}
__device__ __forceinline__ void xcd_barrier(const XcdBarrier& b) {
    asm volatile("s_waitcnt vmcnt(0)" ::: "memory");
    __syncthreads();
    if (threadIdx.x == 0) {
        unsigned* bar = b.bar;
        __builtin_amdgcn_s_waitcnt(0);
        unsigned nloc = b.st[0], nx = b.st[1];
        if (nloc == 0u) { xcd_barrier_complete(bar, b.x, nloc, nx); b.st[0] = nloc; b.st[1] = nx; }
        const unsigned old = xb_add(&bar[XB_XSUB(b.x)], 1u);
        const unsigned gen = old / nloc;
        if (old + 1u == (gen + 1u) * nloc) {
            __builtin_amdgcn_fence(__ATOMIC_RELEASE, "agent");
            asm volatile("s_waitcnt vmcnt(0)" ::: "memory");
            const unsigned og = xb_add(&bar[XB_TOP], 1u);
            const unsigned tg = og / nx;
            if (og + 1u == (tg + 1u) * nx) xb_add(&bar[XB_TOPGEN], 1u);
            else XB_SPIN(xb_ld(&bar[XB_TOPGEN]) == tg, bar);
            __builtin_amdgcn_fence(__ATOMIC_ACQUIRE, "agent");
            xb_add(&bar[XB_XGEN(b.x)], 1u);
            asm volatile("s_waitcnt vmcnt(0)" ::: "memory");
        } else {
            XB_SPIN(xb_ld(&bar[XB_XGEN(b.x)]) == gen, bar);
            __builtin_amdgcn_fence(__ATOMIC_ACQUIRE, "agent");
            asm volatile("s_waitcnt vmcnt(0)" ::: "memory");
        }
    }
    __syncthreads();
}

struct Params { const float* in[25]; float* out; unsigned char* ws; int ph_lo, ph_hi; };
static_assert(sizeof(Params) == 25 * 8 + 8 + 8 + 8, "Params has no padding");
struct Ctx { LAS unsigned char* lds; int tid, lane, wave, vcu, G, bid; };
__device__ __forceinline__ Ctx fresh(const Ctx& c) {
    Ctx f; f.lds = c.lds; int tid = c.tid; asm volatile("" : "+v"(tid)); f.tid = tid; f.lane = tid & 63; f.wave = __builtin_amdgcn_readfirstlane(tid >> 6);
    int vcu = c.vcu, G = c.G, bid = c.bid; asm volatile("" : "+v"(vcu), "+v"(G), "+v"(bid));
    f.vcu = __builtin_amdgcn_readfirstlane(vcu); f.G = __builtin_amdgcn_readfirstlane(G); f.bid = __builtin_amdgcn_readfirstlane(bid); return f; }
__device__ __forceinline__ unsigned char* fresh_ptr(unsigned char* p) { unsigned lo = (unsigned)(unsigned long long)p, hi = (unsigned)((unsigned long long)p >> 32); asm volatile("" : "+v"(lo), "+v"(hi));
    const unsigned long long v = ((unsigned long long)(unsigned)__builtin_amdgcn_readfirstlane((int)hi) << 32) | (unsigned)__builtin_amdgcn_readfirstlane((int)lo); return (unsigned char*)(GAS unsigned char*)v; }

__device__ __forceinline__ int win_dst(int s) {
    if (s < 1024) return s;
    if (s < 1088) { const int j = s - 1024, part = j >> 5, w = j & 31; return 1024 + part * 32 + 2 * (w & 15) + (w >> 4); }
    if (s < 3136) { const int c = s - 1088; return 1280 + 256 * (c >> 7) + (c & 127); }
    if (s < 5184) { return 5376 + (s - 3136); }
    if (s < 7232) { const int c = s - 5184; return 1280 + 256 * (c >> 7) + 128 + (c & 127); }
    if (s < 9280) { return 7424 + (s - 7232); }
    return 9472 + (s - 9280);
}
__device__ __forceinline__ int qb_dst(int n) { const int h = n / DQK, d = n - h * DQK; if (d < DN) return n; const int j = d - DN, part = j >> 5, w = j & 31; return h * DQK + DN + part * 32 + 2 * (w & 15) + (w >> 4); }
__device__ __forceinline__ int map_dst(int mode, int n) {
    switch (mode) { case 1: return win_dst(n); case 2: return qb_dst(n); case 3: return 256 * (n >> 7) + (n & 127); case 4: return 256 * (n >> 7) + 128 + (n & 127); default: return n; }
}
__device__ __forceinline__ void transpose_item(const float* W, int K, int N, bf16* WT, int mode, const float* gk, int item, int lane) {
    const int kblk = K / 64, nb = item / kblk, kb = item - nb * kblk, k0 = 64 * kb + 16 * (lane >> 4), n0 = 64 * nb + 4 * (lane & 15);
    const float* src = W + (size_t)k0 * N + n0;
    f32x4 v[16];
#pragma unroll
    for (int i = 0; i < 16; ++i) v[i] = *(const f32x4*)(src + (size_t)i * N);
    if (gk) {
#pragma unroll
        for (int i = 0; i < 16; ++i) v[i] *= gk[k0 + i]; }
#pragma unroll
    for (int x = 0; x < 4; ++x) { bf16* d = WT + (size_t)map_dst(mode, n0 + x) * K + k0;
        u32x4 lo, hi;
        lo.x = cvtpk(v[0][x], v[1][x]); lo.y = cvtpk(v[2][x], v[3][x]); lo.z = cvtpk(v[4][x], v[5][x]); lo.w = cvtpk(v[6][x], v[7][x]);
        hi.x = cvtpk(v[8][x], v[9][x]); hi.y = cvtpk(v[10][x], v[11][x]); hi.z = cvtpk(v[12][x], v[13][x]); hi.w = cvtpk(v[14][x], v[15][x]);
        *(u32x4*)d = lo; *(u32x4*)(d + 8) = hi; }
}
struct Strip { const float* W; int N, mode, nb; signed char* w8; float* wsc; };
constexpr int ST_IN = DIN / 64, ST_GD = DFF / 64, ST_GE = DFE / 64, N_STRIPS = 2 * ST_IN + 2 * ST_GD + NE * 2 * ST_GE;
__device__ __forceinline__ Strip strip_of(const Params& p, int sid) {
    unsigned char* wb = p.ws + WS_W; float* wsc = (float*)(p.ws + WS_WSC);
    Strip q;
    if (sid < 2 * ST_IN) { const int l = sid / ST_IN; q.nb = sid - l * ST_IN; q.W = p.in[7] + (size_t)l * D * DIN; q.N = DIN; q.mode = 1; q.w8 = (signed char*)(wb + W_IN + l * W_IN_L); q.wsc = wsc + SC_IN + l * NIN; return q; }
    sid -= 2 * ST_IN;
    if (sid < 2 * ST_GD) { const int which = sid / ST_GD; q.nb = sid - which * ST_GD; q.W = p.in[17 + which]; q.N = DFF; q.mode = 3 + which; q.w8 = (signed char*)(wb + W_GU); q.wsc = wsc + SC_GU; return q; }
    sid -= 2 * ST_GD;
    { const int e = sid / (2 * ST_GE); sid -= e * (2 * ST_GE); const int which = sid / ST_GE; q.nb = sid - which * ST_GE; q.W = p.in[21 + which] + (size_t)e * D * DFE; q.N = DFE; q.mode = 3 + which;
      q.w8 = (signed char*)(wb + W_GUE + e * W_GUE_E); q.wsc = wsc + SC_GUE + e * 2 * DFE; return q; }
}
__device__ __forceinline__ unsigned pack4i8(float a, float b, float c, float d) {
    const int ia = (int)__builtin_rintf(a), ib = (int)__builtin_rintf(b), ic = (int)__builtin_rintf(c), id = (int)__builtin_rintf(d);
    return ((unsigned)ia & 0xffu) | (((unsigned)ib & 0xffu) << 8) | (((unsigned)ic & 0xffu) << 16) | ((unsigned)id << 24); }
__device__ __forceinline__ void quant_strip(const Strip& q, const Ctx& c, LAS float* cmax  ) {
    const int qd = c.lane >> 4, c4 = 4 * (c.lane & 15), n0 = 64 * q.nb + c4;
    const float* src = q.W + (size_t)(256 * c.wave + 16 * qd) * q.N + n0;
    f32x4 m = {0.f, 0.f, 0.f, 0.f};
#pragma unroll 1
    for (int sb = 0; sb < 4; ++sb) { f32x4 v[16];
#pragma unroll
        for (int i = 0; i < 16; ++i) v[i] = *(const f32x4*)(src + (size_t)(64 * sb + i) * q.N);
#pragma unroll
        for (int i = 0; i < 16; ++i) m = __builtin_elementwise_max(m, __builtin_elementwise_abs(v[i])); }
#pragma unroll
    for (int x = 0; x < 4; ++x) { float t = m[x]; t = fmaxf(t, __shfl_xor(t, 16)); t = fmaxf(t, __shfl_xor(t, 32)); m[x] = t; }
    if (c.lane < 16) *(LAS f32x4*)(cmax + c.wave * 64 + c4) = m;
    __syncthreads();
    f32x4 am = *(const LAS f32x4*)(cmax + c4);
#pragma unroll
    for (int w = 1; w < 8; ++w) am = __builtin_elementwise_max(am, *(const LAS f32x4*)(cmax + w * 64 + c4));
    f32x4 inv; int dst[4];
#pragma unroll
    for (int x = 0; x < 4; ++x) { inv[x] = am[x] > 0.f ? 127.f / am[x] : 0.f; dst[x] = map_dst(q.mode, n0 + x); }
    if (c.wave == 0 && c.lane < 16) {
#pragma unroll
        for (int x = 0; x < 4; ++x) q.wsc[dst[x]] = am[x] * (1.f / 127.f); }
#pragma unroll 1
    for (int sb = 0; sb < 4; ++sb) { f32x4 v[16];
#pragma unroll
        for (int i = 0; i < 16; ++i) v[i] = *(const f32x4*)(src + (size_t)(64 * sb + i) * q.N);
        const int k0 = 256 * c.wave + 64 * sb + 16 * qd;
#pragma unroll
        for (int x = 0; x < 4; ++x) { const float iv = inv[x];
            u32x4 o; o.x = pack4i8(v[0][x] * iv, v[1][x] * iv, v[2][x] * iv, v[3][x] * iv); o.y = pack4i8(v[4][x] * iv, v[5][x] * iv, v[6][x] * iv, v[7][x] * iv);
            o.z = pack4i8(v[8][x] * iv, v[9][x] * iv, v[10][x] * iv, v[11][x] * iv); o.w = pack4i8(v[12][x] * iv, v[13][x] * iv, v[14][x] * iv, v[15][x] * iv);
            *(u32x4*)(q.w8 + (size_t)dst[x] * D + k0) = o; } }
    __syncthreads();
}
constexpr int I_QB = (QL / 64) * (NH * DQK / 64), I_KVB = (KVL / 64) * (NH * 256 / 64), I_SQ = (D / 64) * (D / 64), I_L = I_QB + I_KVB + 3 * I_SQ;
constexpr int I_DD = (DFF / 64) * (D / 64), I_DE = (DFE / 64) * (D / 64);
constexpr int N_ADA = 2 * KS_ADA * 48, N_SMALL = N_ADA + 2 * I_L + I_DD + NE * I_DE, SMALL_BATCH = 32, N_BATCH = (N_SMALL + SMALL_BATCH - 1) / SMALL_BATCH, N_QUEUE = N_STRIPS + N_BATCH;
__device__ __forceinline__ void small_item(const Params& p, const Ctx& c, int it, const LAS float* sil) {
    unsigned char* ws = p.ws; unsigned char* wb = ws + WS_W;
    if (it < N_ADA) {
        float* part = (float*)(ws + WS_PART); const int cg = it % 48, lk = it / 48, kc = lk % KS_ADA, l = lk / KS_ADA;
        const float* W = p.in[4] + (size_t)l * D * (6 * D) + (size_t)(kc * 128) * (6 * D) + cg * 256 + c.lane * 4;
        float zf = 0.f; asm volatile("" : "+v"(zf)); f32x4 al = {zf, zf, zf, zf}, ac = al;
#pragma unroll 8
        for (int k = 0; k < 128; ++k) { const f32x4 w = *(const f32x4*)(W + (size_t)k * (6 * D)); al += w * sil[kc * 128 + k]; ac += w * sil[D + kc * 128 + k]; }
        *(f32x4*)(part + ((size_t)(l * KS_ADA + kc) * 2 + 0) * (6 * D) + cg * 256 + c.lane * 4) = al;
        *(f32x4*)(part + ((size_t)(l * KS_ADA + kc) * 2 + 1) * (6 * D) + cg * 256 + c.lane * 4) = ac; return; }
    int r = it - N_ADA;
    if (r < 2 * I_L) { const int l = r / I_L; r -= l * I_L;
        if (r < I_QB) { transpose_item(p.in[9] + (size_t)l * QL * NH * DQK, QL, NH * DQK, (bf16*)(wb + W_QB + l * W_QB_L), 2, p.in[8] + l * QL, r, c.lane); return; } r -= I_QB;
        if (r < I_KVB) { transpose_item(p.in[11] + (size_t)l * KVL * NH * 256, KVL, NH * 256, (bf16*)(wb + W_KVB + l * W_KVB_L), 0, p.in[10] + l * KVL, r, c.lane); return; } r -= I_KVB;
        const int which = r / I_SQ; r -= which * I_SQ;
        transpose_item(p.in[13 + which] + (size_t)l * D * D, D, D, (bf16*)(wb + (which == 0 ? W_OA : which == 1 ? W_OB : W_O) + l * W_SQ_L), 0, nullptr, r, c.lane); return; }
    r -= 2 * I_L;
    if (r < I_DD) { transpose_item(p.in[19], DFF, D, (bf16*)(wb + W_DD), 0, nullptr, r, c.lane); return; }
    r -= I_DD;
    { const int e = r / I_DE; r -= e * I_DE; transpose_item(p.in[23] + (size_t)e * DFE * D, DFE, D, (bf16*)(wb + W_DE + e * W_DE_E), 0, nullptr, r, c.lane); }
}
constexpr int CW_QHEAD = 2048;
__device__ __forceinline__ void p0_prologue(const Params& p, const Ctx& c) {
    unsigned char* ws = p.ws; unsigned char* wb = ws + WS_W;
    const int gt = c.vcu * NTHREADS + c.tid, NGT = c.G * NTHREADS;
    LAS float* sil = (LAS float*)(c.lds + 98304);
    LAS float* cmax = (LAS float*)(c.lds + 114688);
    LAS int* qslot = (LAS int*)(c.lds + 116736);
    for (int k = c.tid; k < 2 * D; k += NTHREADS) { const float x = k < D ? p.in[1][k] : p.in[3][k - D]; sil[k] = x / (1.f + expf(-x)); }
    { float* rope = (float*)(ws + WS_ROPE);
      for (int i = gt; i < 2048; i += NGT) { const int pos = i >> 4, k = i & 15; const float ang = (float)pos * powf(10000.f, -(float)(2 * k) / 32.f); rope[i] = cosf(ang); rope[2048 + i] = sinf(ang); } }
    { const int n16 = 192 * D / 16; unsigned zu = 0u; asm volatile("" : "+v"(zu));
      for (int i = gt; i < 2 * n16; i += NGT) { const int l = i / n16, r = i - l * n16; *(u32x4*)(wb + W_IN + l * W_IN_L + (size_t)1088 * D + (size_t)r * 16) = (u32x4){zu, zu, zu, zu}; }
      for (int i = gt; i < 2 * 192; i += NGT) { const int l = i / 192, r = i - l * 192; ((float*)(ws + WS_WSC))[SC_IN + l * NIN + 1088 + r] = __uint_as_float(zu); } }
    __syncthreads();
    unsigned* head = (unsigned*)(ws + WS_CTL) + CW_QHEAD;
    for (;;) {
        if (c.tid == 0) *qslot = (int)__hip_atomic_fetch_add(head, 1u, __ATOMIC_RELAXED, __HIP_MEMORY_SCOPE_AGENT);
        __syncthreads();
        const int id = __builtin_amdgcn_readfirstlane(*qslot);
        __syncthreads();
        if (id >= N_QUEUE) break;
        if (id < N_STRIPS) { quant_strip(strip_of(p, id), c, cmax); continue; }
        const int base = (id - N_STRIPS) * SMALL_BATCH;
#pragma unroll 1
        for (int j = 0; j < SMALL_BATCH / NWAVES; ++j) { const int it = base + j * NWAVES + c.wave; if (it < N_SMALL) small_item(p, c, it, sil); }
    }
}
__device__ __forceinline__ void p1_mod(const Params& p, const Ctx& c) {
    const float* part = (const float*)(p.ws + WS_PART); float* mod = (float*)(p.ws + WS_MOD);
    for (int i = c.vcu * NTHREADS + c.tid; i < 4 * 6 * D; i += c.G * NTHREADS) { const int n = i % (6 * D), lv = i / (6 * D), l = lv >> 1, v = lv & 1;
        float s = p.in[5][l * 6 * D + n];
#pragma unroll
        for (int kc = 0; kc < KS_ADA; ++kc) s += part[((size_t)(l * KS_ADA + kc) * 2 + v) * (6 * D) + n];
        mod[i] = s; }
}
__device__ __forceinline__ void norm_pass(const Params& p, const Ctx& c, int layer, int which, int row_lo, bool moe, bool local_mod) {
    const float* XL = (const float*)(p.ws + WS_XL); unsigned char* HN = p.ws + WS_HN; float* HSC = (float*)(p.ws + WS_HSC); const float* mod = (const float*)(p.ws + WS_MOD);
    const bool from_in = (layer == 0 && which == 0);
    const float* g = (which ? p.in[16] : p.in[6]) + layer * D;
    const int gw = c.vcu * NWAVES + c.wave, NGW = c.G * NWAVES;
    LAS float* lmod = (LAS float*)(c.lds + 65536);
    if (local_mod) { const float* part = (const float*)(p.ws + WS_PART);
        for (int i = c.tid; i < 4 * D; i += NTHREADS) { const int vec = i / D, v = vec >> 1, n = ((vec & 1) ? D : 0) + (i - vec * D);
            float sacc = p.in[5][layer * 6 * D + n];
#pragma unroll
            for (int kc = 0; kc < KS_ADA; ++kc) sacc += part[((size_t)(layer * KS_ADA + kc) * 2 + v) * (6 * D) + n];
            lmod[i] = sacc; }
        __syncthreads(); }
    LAS float* wrt = (LAS float*)c.lds;
    if (moe) { const float* wr = p.in[20];
        for (int i = c.tid; i < D * NE / 4; i += NTHREADS) { const f32x4 w = *(const f32x4*)(wr + 4 * i); const int k = i >> 1, e0 = (i & 1) * 4;
            wrt[(e0 + 0) * D + k] = w[0]; wrt[(e0 + 1) * D + k] = w[1]; wrt[(e0 + 2) * D + k] = w[2]; wrt[(e0 + 3) * D + k] = w[3]; }
        __syncthreads(); }
    for (int r = row_lo + gw; r < MT; r += NGW) {
        const f32x4* xr = (const f32x4*)(from_in ? (r < LC ? p.in[2] + (size_t)r * D : p.in[0] + (size_t)(r - LC) * D) : XL + (size_t)r * D) + c.lane;
        const float* mv = mod + (size_t)(layer * 2 + (r < LC ? 1 : 0)) * (6 * D) + (which ? 3 * D : 0);
        f32x4 v[8]; float ss = 0.f;
#pragma unroll
        for (int j = 0; j < 8; ++j) { v[j] = xr[64 * j]; ss += (v[j][0] * v[j][0] + v[j][1] * v[j][1]) + (v[j][2] * v[j][2] + v[j][3] * v[j][3]); }
        const float rs = rsqrtf(wave_sum(ss) * (1.f / D) + EPS);
        float amax = 0.f;
#pragma unroll
        for (int j = 0; j < 8; ++j) { const int col = 4 * c.lane + 256 * j;
            const f32x4 gv = *(const f32x4*)(g + col);
            const f32x4 sh = local_mod ? *(const LAS f32x4*)(lmod + (r < LC ? 2 * D : 0) + col) : *(const f32x4*)(mv + col), sc = local_mod ? *(const LAS f32x4*)(lmod + (r < LC ? 3 * D : D) + col) : *(const f32x4*)(mv + D + col);
            v[j] = (v[j] * rs * gv) * (sc + 1.f) + sh;
            amax = fmaxf(fmaxf(amax, fmaxf(fabsf(v[j][0]), fabsf(v[j][1]))), fmaxf(fabsf(v[j][2]), fabsf(v[j][3]))); }
#pragma unroll
        for (int o = 1; o < 64; o <<= 1) amax = fmaxf(amax, __shfl_xor(amax, o));
        const float inv = amax > 0.f ? 127.f / amax : 0.f;
        unsigned* o4 = (unsigned*)(HN + (size_t)r * D) + c.lane;
#pragma unroll
        for (int j = 0; j < 8; ++j) o4[64 * j] = pack4i8(v[j][0] * inv, v[j][1] * inv, v[j][2] * inv, v[j][3] * inv);
        if (c.lane == 0) HSC[r] = amax * (1.f / 127.f);
        if (moe) {
            float lg[NE];
#pragma unroll
            for (int e = 0; e < NE; ++e) { float a = 0.f;
#pragma unroll
                for (int j = 0; j < 8; ++j) { const f32x4 w = *(const LAS f32x4*)(wrt + e * D + 4 * c.lane + 256 * j); a += (v[j][0] * w[0] + v[j][1] * w[1]) + (v[j][2] * w[2] + v[j][3] * w[3]); }
                lg[e] = a; }
#pragma unroll
            for (int e = 0; e < NE; ++e) lg[e] = wave_sum(lg[e]);
            int e0 = 0; float m0 = lg[0];
#pragma unroll
            for (int e = 1; e < NE; ++e) if (lg[e] > m0) { m0 = lg[e]; e0 = e; }
            int e1 = -1; float m1 = -3.0e38f;
#pragma unroll
            for (int e = 0; e < NE; ++e) if (e != e0 && lg[e] > m1) { m1 = lg[e]; e1 = e; }
            if (c.lane == 0) { const int t = r - LC; const float b = expf(m1 - m0), inv = 1.f / (1.f + b);
                int* sel = (int*)(p.ws + WS_SEL); float* gwt = (float*)(p.ws + WS_GW);
                sel[2 * t] = e0; sel[2 * t + 1] = e1; gwt[2 * t] = inv; gwt[2 * t + 1] = b * inv; }
        }
    }
}
__device__ __forceinline__ void conv_pass(const Params& p, const Ctx& c, int layer, int row_lo) {
    const bf16* U = (const bf16*)(p.ws + WS_MIX + MX_U); const bf16* CBp = (const bf16*)(p.ws + WS_MIX + MX_CB); bf16* V2 = (bf16*)(p.ws + WS_MIX + MX_V2);
    const float* wc = p.in[12] + (size_t)layer * 3 * CW;
    const int gw = c.vcu * NWAVES + c.wave, NGW = c.G * NWAVES, nitems = ((MT - row_lo) / 16) * 4;
    for (int it = gw; it < nitems; it += NGW) {
        const int q = it & 3, r0 = row_lo + (it >> 2) * 16, ch = q * 512 + c.lane * 8;
        const int lo = r0 < LC ? 0 : LC, hi = r0 < LC ? LC : MT;
        const f32x4 w0a = *(const f32x4*)(wc + ch), w0b = *(const f32x4*)(wc + ch + 4), w1a = *(const f32x4*)(wc + CW + ch), w1b = *(const f32x4*)(wc + CW + ch + 4), w2a = *(const f32x4*)(wc + 2 * CW + ch), w2b = *(const f32x4*)(wc + 2 * CW + ch + 4);
        float zf = 0.f; asm volatile("" : "+v"(zf)); const f32x4 z4 = {zf, zf, zf, zf}; f32x4 pa = z4, pb = pa, ca, cb, na, nb;
        if (r0 - 1 >= lo) unpack8(*(const u32x4*)(U + (size_t)(r0 - 1) * CW + ch), pa, pb);
        unpack8(*(const u32x4*)(U + (size_t)r0 * CW + ch), ca, cb);
#pragma unroll 4
        for (int r = r0; r < r0 + 16; ++r) {
            na = z4; nb = na;
            if (r + 1 < hi) unpack8(*(const u32x4*)(U + (size_t)(r + 1) * CW + ch), na, nb);
            f32x4 ga, gb; unpack8(*(const u32x4*)(CBp + (size_t)r * CW + ch), ga, gb);
            const f32x4 ya = ga * (w0a * pa + w1a * ca + w2a * na), yb = gb * (w0b * pb + w1b * cb + w2b * nb);
            *(u32x4*)(V2 + (size_t)r * CW + ch) = pack8(ya, yb);
            pa = ca; pb = cb; ca = na; cb = nb; }
    }
}
__device__ __forceinline__ void moe_counts(const Params& p, const Ctx& c) {
    const int* sel = (const int*)(p.ws + WS_SEL);
    LAS int* H = (LAS int*)c.lds;
    LAS int* tot = (LAS int*)(c.lds + 16384);
    LAS int* lctl = (LAS int*)(c.lds + LCTL_OFF);
    { int h[NE];
#pragma unroll
      for (int e = 0; e < NE; ++e) h[e] = 0;
#pragma unroll
      for (int i = 0; i < 8; ++i) { const int4 v = *(const int4*)(sel + c.tid * 32 + i * 4);
#pragma unroll
          for (int e = 0; e < NE; ++e) h[e] += (v.x == e) + (v.y == e) + (v.z == e) + (v.w == e); }
#pragma unroll
      for (int e = 0; e < NE; ++e) H[c.tid * 8 + e] = h[e]; }
    __syncthreads();
    { int s = 0;
#pragma unroll
      for (int i = 0; i < 8; ++i) s += H[(c.lane * 8 + i) * 8 + c.wave];
#pragma unroll
      for (int o = 1; o < 64; o <<= 1) s += __shfl_xor(s, o);
      if (c.lane == 0) tot[c.wave] = s; }
    __syncthreads();
    if (c.tid == 0) { int off = 0;
#pragma unroll
        for (int e = 0; e < NE; ++e) { lctl[128 + e] = off; off += (tot[e] + 255) >> 8; }
        lctl[128 + NE] = off; lctl[16] = off; }
    __syncthreads();
    if (c.tid < MAXT) { int e = 0;
#pragma unroll
        for (int x = 1; x < NE; ++x) e += (c.tid >= lctl[128 + x]) ? 1 : 0;
        lctl[32 + c.tid] = e; }
    __syncthreads();
}
__device__ __forceinline__ void moe_route(const Params& p, const Ctx& c) {
    const int* sel = (const int*)(p.ws + WS_SEL); int* slot = (int*)(p.ws + WS_SLOT);
    const unsigned char* HN = p.ws + WS_HN; unsigned char* XS = p.ws + WS_MIX + FX_XS; const float* HSC = (const float*)(p.ws + WS_HSC); float* XSC = (float*)(p.ws + WS_XSC);
    LAS int* H = (LAS int*)c.lds; LAS int* tot = (LAS int*)(c.lds + 16384); LAS int* lctl = (LAS int*)(c.lds + LCTL_OFF);
    for (int b = c.bid; b < 2 * SEQ / 64; b += c.G) {
        { int s = 0;
#pragma unroll
          for (int i = 0; i < 8; ++i) { const int t = c.lane * 8 + i; s += (t < 2 * b) ? H[t * 8 + c.wave] : 0; }
#pragma unroll
          for (int o = 1; o < 64; o <<= 1) s += __shfl_xor(s, o);
          if (c.lane == 0) tot[8 + c.wave] = s; }
        __syncthreads();
        if (c.wave == 0) { const int a = 64 * b + c.lane, e = sel[a]; int rank = 0;
#pragma unroll
            for (int x = 0; x < NE; ++x) { const unsigned long long m = __ballot(e == x); if (e == x) rank = tot[8 + x] + __popcll(m & ((1ull << c.lane) - 1ull)); }
            const int s = 256 * lctl[128 + e] + rank; slot[a] = s; tot[16 + c.lane] = s; }
        __syncthreads();
#pragma unroll
        for (int i = 0; i < 8; ++i) { const int j = c.wave * 8 + i, a = 64 * b + j, tok = a >> 1, s = tot[16 + j];
            const u32x4* src = (const u32x4*)(HN + (size_t)(LC + tok) * D) + c.lane; u32x4* dst = (u32x4*)(XS + (size_t)s * D) + c.lane;
            const u32x4 v0 = src[0], v1 = src[64]; dst[0] = v0; dst[64] = v1;
            if (c.lane == 0) XSC[s] = HSC[LC + tok]; }
        __syncthreads();
    }
}
__device__ __forceinline__ void final_pass(const Params& p, const Ctx& c) {
    const float* XL = (const float*)(p.ws + WS_XL); const bf16* YS = (const bf16*)(p.ws + WS_MIX + FX_YS);
    const int* slot = (const int*)(p.ws + WS_SLOT); const float* gwt = (const float*)(p.ws + WS_GW);
    const float* gt2 = (const float*)(p.ws + WS_MOD) + (size_t)2 * (6 * D) + 5 * D; const float* gf = p.in[24];
    const int gw = c.vcu * NWAVES + c.wave, NGW = c.G * NWAVES;
    for (int t = gw; t < SEQ; t += NGW) {
        const int s0 = slot[2 * t], s1 = slot[2 * t + 1]; const float g0 = gwt[2 * t], g1 = gwt[2 * t + 1];
        const f32x4* xr = (const f32x4*)(XL + (size_t)(LC + t) * D) + c.lane;
        const u32x2* y0 = (const u32x2*)(YS + (size_t)s0 * D) + c.lane; const u32x2* y1 = (const u32x2*)(YS + (size_t)s1 * D) + c.lane;
        f32x4 v[8]; float ss = 0.f;
#pragma unroll
        for (int j = 0; j < 8; ++j) { const f32x4 gv = *(const f32x4*)(gt2 + 4 * c.lane + 256 * j);
            v[j] = xr[64 * j] + gv * (unpack4(y0[64 * j]) * g0 + unpack4(y1[64 * j]) * g1);
            ss += (v[j][0] * v[j][0] + v[j][1] * v[j][1]) + (v[j][2] * v[j][2] + v[j][3] * v[j][3]); }
        const float rs = rsqrtf(wave_sum(ss) * (1.f / D) + EPS);
        f32x4* o = (f32x4*)(p.out + (size_t)t * D) + c.lane;
#pragma unroll
        for (int j = 0; j < 8; ++j) o[64 * j] = v[j] * rs * *(const f32x4*)(gf + 4 * c.lane + 256 * j);
    }
}


template <class Epi>
__device__ __forceinline__ void ctx_gemm(const Ctx& c, const bf16* A, int lda, const bf16* Bt, int ldb, int K, const Epi& E) {
    int tid = c.tid; asm volatile("" : "+v"(tid));
    const int lane = tid & 63, wid = __builtin_amdgcn_readfirstlane(tid >> 6), fr = lane & 15, fq = lane >> 4, wr = wid >> 2, wc = wid & 3;
    constexpr int STG = 24576, NSTG = 4;
    const int nk = K / 128;
    for (int j = c.vcu; j < 256; j += c.G) {
        const int mb = (j >> 5) * 32, nb = (j & 31) * 64;
        const int sA = wid * 64 + lane, rA = sA >> 4, cA = (sA & 15) ^ (rA & 15);
        const bf16* gA = A + (size_t)(mb + rA) * lda + cA * 8;
        const bf16* gB0 = Bt + (size_t)(nb + rA) * ldb + cA * 8;
        const bf16* gB1 = gB0 + (size_t)32 * ldb;
        LAS unsigned char* lw = c.lds + wid * 1024;
#define CG_STAGE(t) do { const int kk_ = ((t) < nk ? (t) : nk - 1) * 128; LAS unsigned char* d_ = lw + ((t) & (NSTG - 1)) * STG; \
        __builtin_amdgcn_global_load_lds((const unsigned*)(gA + kk_), (LAS unsigned*)(d_), 16, 0, 0); \
        __builtin_amdgcn_global_load_lds((const unsigned*)(gB0 + kk_), (LAS unsigned*)(d_ + 8192), 16, 0, 0); \
        __builtin_amdgcn_global_load_lds((const unsigned*)(gB1 + kk_), (LAS unsigned*)(d_ + 16384), 16, 0, 0); } while (0)
        CG_STAGE(0); CG_STAGE(1); CG_STAGE(2);
        const int ra = (wr * 16 + fr) * 256, rb = 8192 + (wc * 16 + fr) * 256;
        float zf = 0.f; asm volatile("" : "+v"(zf));
        f32x4 acc0 = {zf, zf, zf, zf}, acc1 = acc0;
#pragma unroll 1
        for (int t = 0; t < nk; ++t) {
            asm volatile("s_waitcnt vmcnt(6)\n\ts_barrier" ::: "memory");
            CG_STAGE(t + 3);
            const LAS unsigned char* sb = c.lds + (t & (NSTG - 1)) * STG;
            bf16x8 af[4], bf[4];
#pragma unroll
            for (int ks = 0; ks < 4; ++ks) { const int pc = ((4 * ks + fq) ^ fr) * 16; af[ks] = *(const LAS bf16x8*)(sb + ra + pc); bf[ks] = *(const LAS bf16x8*)(sb + rb + pc); }
            acc0 = __builtin_amdgcn_mfma_f32_16x16x32_bf16(bf[0], af[0], acc0, 0, 0, 0);
            acc1 = __builtin_amdgcn_mfma_f32_16x16x32_bf16(bf[1], af[1], acc1, 0, 0, 0);
            acc0 = __builtin_amdgcn_mfma_f32_16x16x32_bf16(bf[2], af[2], acc0, 0, 0, 0);
            acc1 = __builtin_amdgcn_mfma_f32_16x16x32_bf16(bf[3], af[3], acc1, 0, 0, 0);
        }
#undef CG_STAGE
        asm volatile("s_waitcnt vmcnt(0)\n\ts_barrier" ::: "memory");
        E(mb + wr * 16 + fr, nb + wc * 16 + 4 * fq, acc0 + acc1);
    }
}
template <int MODE> struct CtxMerge { const bf16* SG; const bf16* M1; bf16* OUT;
    __device__ __forceinline__ void operator()(int row, int col, f32x4 acc) const { const size_t off = (size_t)row * D + col;
        f32x4 v = acc * unpack4(*(const u32x2*)(SG + off)); if (MODE == 1) v += unpack4(*(const u32x2*)(M1 + off));
        u32x2 w; w.x = cvtpk(v[0], v[1]); w.y = cvtpk(v[2], v[3]); *(u32x2*)(OUT + off) = w; } };
struct CtxResid { float* XL; const float* SRC; const float* gate;
    __device__ __forceinline__ void operator()(int row, int col, f32x4 acc) const { const size_t o = (size_t)row * D + col; *(f32x4*)(XL + o) = *(const f32x4*)(SRC + o) + *(const f32x4*)(gate + col) * acc; } };

constexpr int N_PHASES = 22;
__global__ void __launch_bounds__(NTHREADS, 2) mega(Params p) {
    extern __shared__ __attribute__((aligned(16))) unsigned char lds_raw[];
    Ctx c0; c0.lds = (LAS unsigned char*)lds_raw; c0.tid = threadIdx.x; c0.lane = c0.tid & 63; c0.wave = __builtin_amdgcn_readfirstlane(c0.tid >> 6);
    c0.G = gridDim.x; c0.bid = blockIdx.x; c0.vcu = (c0.G % 8 == 0) ? (c0.bid % 8) * (c0.G / 8) + c0.bid / 8 : c0.bid;
    { const Ctx& c = c0; unsigned char* ws = p.ws;
    for (int u = c.tid; u < (LDS_BYTES - LCTL_OFF) / 4; u += NTHREADS) ((LAS unsigned*)(c.lds + LCTL_OFF))[u] = 0u;
    __syncthreads();
    }
    XcdBarrier bar = xcd_barrier_post((unsigned*)(p.ws + WS_CTL) + 4096, (volatile LAS unsigned*)(c0.lds + LCTL_OFF));
    const int lo = p.ph_lo, hi = p.ph_hi;
#ifndef MK_EN
#define MK_EN 0xFFFFFF
#endif
#define EN(j) (((MK_EN) >> (j)) & 1)
#ifndef MK_DUP
#define MK_DUP 0
#endif
#define NREP(j) ((((MK_DUP) >> (j)) & 1) ? 2 : 1)
#define IN(k) (lo <= (k) && (k) < hi)
#define SEAM(k) do { if (IN(k) && IN((k) + 1)) xcd_barrier(bar); } while (0)
#define PH_BEGIN const Ctx c = fresh(c0); unsigned char* ws = fresh_ptr(p.ws); unsigned char* wb = ws + WS_W; unsigned char* mx = ws + WS_MIX; const float* mod = (const float*)(ws + WS_MOD); (void)wb; (void)mx; (void)mod;
    for (int rep_ = 0; rep_ < NREP(20); ++rep_) if (EN(20) && IN(0)) { if (rep_) { xcd_barrier(bar); if (c0.bid == 0 && c0.tid == 0) __hip_atomic_store((unsigned*)(p.ws + WS_CTL) + CW_QHEAD, 0u, __ATOMIC_RELAXED, __HIP_MEMORY_SCOPE_AGENT); xcd_barrier(bar); } PH_BEGIN p0_prologue(p, c); } SEAM(0);
#if defined(MK_XBAR)
    for (int xb_ = 0; xb_ < 16; ++xb_) xcd_barrier(bar);
#endif
#pragma unroll
    for (int layer = 0; layer < DEPTH; ++layer) {
        const int P = 2 + 9 * layer; const bool last = (layer == DEPTH - 1);
        const int pm0 = last ? 1 : 0, nM = last ? 32 : 33;
        for (int rep_ = 0; rep_ < NREP(0); ++rep_) if (EN(0) && IN(P + 0)) { if (rep_) xcd_barrier(bar); PH_BEGIN if (layer == 0) p1_mod(p, c); norm_pass(p, c, layer, 0, 0, false, layer == 0); } SEAM(P + 0);
        for (int rep_ = 0; rep_ < NREP(1); ++rep_) if (EN(1) && IN(P + 1)) { if (rep_) xcd_barrier(bar); PH_BEGIN
            pg8::Geo g{D / 2, D / 2, D / 2};
            pg8::TileOrder S{nM, NT_IN, pm0, c.G, c.bid, last ? 3 : 0, 0, 2, (const char*)(ws + WS_HN), (const char*)(wb + W_IN + layer * W_IN_L), (size_t)256 * D, (size_t)256 * D, (const float*)(ws + WS_HSC), (const float*)(ws + WS_WSC) + SC_IN + layer * NIN};
            pg8::EpiInproj E{(bf16*)(mx + MX_QC), (bf16*)(mx + MX_KRB), (bf16*)(mx + MX_U), (bf16*)(mx + MX_CB), (float*)(mx + MX_SSQ), (const float*)(ws + WS_ROPE)};
            pg8::gemm_phase<pg8::EpiInproj, pg8::TileOrder, true, true>(c.lds, g, S, E);
        } SEAM(P + 1);
        for (int rep_ = 0; rep_ < NREP(2); ++rep_) if (EN(2) && IN(P + 2)) { if (rep_) xcd_barrier(bar); PH_BEGIN
            pg8::Geo g{1024, 512, 512};
            pg8::QkvOrder S{33, nM, pm0, c.G, c.bid, (const char*)(mx + MX_QC), (const char*)(wb + W_QB + layer * W_QB_L), (long)(W_KVB + layer * W_KVB_L) - (long)(W_QB + layer * W_QB_L)};
            pg8::EpiQkv E{(bf16*)(mx + MX_Q), (bf16*)(mx + MX_KV), (const float*)(mx + MX_SSQ), (const float*)(ws + WS_ROPE)};
            pg8::gemm_phase<pg8::EpiQkv, pg8::QkvOrder, true>(c.lds, g, S, E);
            conv_pass(p, c, layer, pm0 * 256);
        } SEAM(P + 2);
        for (int rep_ = 0; rep_ < NREP(3); ++rep_) if (EN(3) && IN(P + 3)) { if (rep_) xcd_barrier(bar); PH_BEGIN
            const bf16* Q = (const bf16*)(mx + MX_Q); const bf16* KV = (const bf16*)(mx + MX_KV); const bf16* KR = (const bf16*)(mx + MX_KRB); bf16* O = (bf16*)(mx + MX_O);
            for (int i = 0;; ++i) { const int u = i * c.G + c.vcu; if (u >= NH * 32) break;
                const int h = u >> 5, q0 = LC + 256 * (u & 31);
                att::attn_unit(Q + (size_t)q0 * att::LDQ + h * DQK, KV, h * 512, KR, O + (size_t)q0 * D + h * DV, MT, (LAS char*)c.lds); }
            if (!last) for (int i = 0;; ++i) { const int h = i * c.G + c.vcu; if (h >= NH) break;
                att::attn_unit(Q + h * DQK, KV, h * 512, KR, O + h * DV, LC, (LAS char*)c.lds); }
            pg8::Geo g{D, D, D};
            pg8::TileOrder S{32, 8, 1, c.G, c.bid, 0, 0, 0, (const char*)(mx + MX_V2), (const char*)(wb + W_OB + layer * W_SQ_L), (size_t)256 * D * 2, (size_t)256 * D * 2, nullptr, nullptr};
            pg8::EpiMerge<0> E{(const bf16*)(mx + MX_SGB), nullptr, (bf16*)(mx + MX_M1)};
            pg8::gemm_phase<pg8::EpiMerge<0>, pg8::TileOrder, true>(c.lds, g, S, E);
            if (!last) ctx_gemm(c, (const bf16*)(mx + MX_V2), D, (const bf16*)(wb + W_OB + layer * W_SQ_L), D, D, CtxMerge<0>{(const bf16*)(mx + MX_SGB), nullptr, (bf16*)(mx + MX_M1)});
        } SEAM(P + 3);
        for (int rep_ = 0; rep_ < NREP(4); ++rep_) if (EN(4) && IN(P + 4)) { if (rep_) xcd_barrier(bar); PH_BEGIN
            pg8::Geo g{D, D, D};
            pg8::TileOrder S{32, 8, 1, c.G, c.bid, 0, 0, 0, (const char*)(mx + MX_O), (const char*)(wb + W_OA + layer * W_SQ_L), (size_t)256 * D * 2, (size_t)256 * D * 2, nullptr, nullptr};
            pg8::EpiMerge<1> E{(const bf16*)(mx + MX_SGA), (const bf16*)(mx + MX_M1), (bf16*)(mx + MX_MG)};
            pg8::gemm_phase<pg8::EpiMerge<1>, pg8::TileOrder, true>(c.lds, g, S, E);
            if (!last) ctx_gemm(c, (const bf16*)(mx + MX_O), D, (const bf16*)(wb + W_OA + layer * W_SQ_L), D, D, CtxMerge<1>{(const bf16*)(mx + MX_SGA), (const bf16*)(mx + MX_M1), (bf16*)(mx + MX_MG)});
        } SEAM(P + 4);
        for (int rep_ = 0; rep_ < 1; ++rep_) if (EN(5) && IN(P + 5)) { PH_BEGIN
            pg8::Geo g{D, D, D};
            pg8::TileOrder S{32, 8, 1, c.G, c.bid, 0, 0, 0, (const char*)(mx + MX_MG), (const char*)(wb + W_O + layer * W_SQ_L), (size_t)256 * D * 2, (size_t)256 * D * 2, nullptr, nullptr};
            pg8::EpiResid E{(float*)(ws + WS_XL), layer == 0 ? p.in[0] - (size_t)LC * D : (const float*)(ws + WS_XL), mod + (size_t)(2 * layer) * (6 * D) + 2 * D};
            pg8::gemm_phase<pg8::EpiResid, pg8::TileOrder, true>(c.lds, g, S, E);
            if (!last) ctx_gemm(c, (const bf16*)(mx + MX_MG), D, (const bf16*)(wb + W_O + layer * W_SQ_L), D, D, CtxResid{(float*)(ws + WS_XL), p.in[2], mod + (size_t)(2 * layer + 1) * (6 * D) + 2 * D});
        } SEAM(P + 5);
        for (int rep_ = 0; rep_ < NREP(6); ++rep_) if (EN(6) && IN(P + 6)) { if (rep_) xcd_barrier(bar); PH_BEGIN norm_pass(p, c, layer, 1, pm0 * 256, last, false); } SEAM(P + 6);
        if (!last) {
            for (int rep_ = 0; rep_ < NREP(7); ++rep_) if (EN(7) && IN(P + 7)) { if (rep_) xcd_barrier(bar); PH_BEGIN
                pg8::Geo g{D / 2, D / 2, D / 2};
                pg8::TileOrder S{nM, 2 * DFF / 256, pm0, c.G, c.bid, 0, 0, 0, (const char*)(ws + WS_HN), (const char*)(wb + W_GU), (size_t)256 * D, (size_t)256 * D, (const float*)(ws + WS_HSC), (const float*)(ws + WS_WSC) + SC_GU};
                pg8::EpiSwiglu E{(bf16*)(mx + FX_ACT), DFF};
                pg8::gemm_phase<pg8::EpiSwiglu, pg8::TileOrder, true, true>(c.lds, g, S, E);
            } SEAM(P + 7);
            for (int rep_ = 0; rep_ < 1; ++rep_) if (EN(8) && IN(P + 8)) { PH_BEGIN
                pg8::Geo g{DFF, DFF, DFF};
                pg8::TileOrder S{32, 8, 1, c.G, c.bid, 0, 0, 0, (const char*)(mx + FX_ACT), (const char*)(wb + W_DD), (size_t)256 * DFF * 2, (size_t)256 * DFF * 2, nullptr, nullptr};
                pg8::EpiResid E{(float*)(ws + WS_XL), (const float*)(ws + WS_XL), mod + (size_t)(2 * layer) * (6 * D) + 5 * D};
                pg8::gemm_phase<pg8::EpiResid, pg8::TileOrder, true>(c.lds, g, S, E);
                ctx_gemm(c, (const bf16*)(mx + FX_ACT), DFF, (const bf16*)(wb + W_DD), DFF, DFF, CtxResid{(float*)(ws + WS_XL), (const float*)(ws + WS_XL), mod + (size_t)(2 * layer + 1) * (6 * D) + 5 * D});
            } SEAM(P + 8);
        } else {
            const LAS int* lctl = (const LAS int*)(c0.lds + LCTL_OFF);
            for (int rep_ = 0; rep_ < NREP(7); ++rep_) if (EN(7) && IN(P + 7)) { if (rep_) xcd_barrier(bar); PH_BEGIN moe_counts(p, c); moe_route(p, c); } SEAM(P + 7);
            for (int rep_ = 0; rep_ < NREP(8); ++rep_) if (EN(8) && IN(P + 8)) { if (rep_) xcd_barrier(bar); PH_BEGIN
                if (!IN(P + 7)) moe_counts(p, c);
                const int T = __builtin_amdgcn_readfirstlane(lctl[16]);
                pg8::Geo g{D / 2, D / 2, D / 2};
                pg8::MoeOrder S{T, 2 * DFE / 256, c.G, c.bid, (const char*)(mx + FX_XS), (const char*)(wb + W_GUE), (size_t)256 * D, (size_t)256 * D, W_GUE_E, lctl + 32, (const float*)(ws + WS_XSC), (const float*)(ws + WS_WSC) + SC_GUE, 2 * DFE};
                pg8::EpiSwiglu E{(bf16*)(mx + FX_ACTE), DFE};
                pg8::gemm_phase<pg8::EpiSwiglu, pg8::MoeOrder, true, true>(c.lds, g, S, E);
            } SEAM(P + 8);
            for (int rep_ = 0; rep_ < NREP(9); ++rep_) if (EN(9) && IN(P + 9)) { if (rep_) xcd_barrier(bar); PH_BEGIN
                if (!IN(P + 7)) moe_counts(p, c);
                const int T = __builtin_amdgcn_readfirstlane(lctl[16]);
                pg8::Geo g{DFE, DFE, DFE};
                pg8::MoeOrder S{T, 8, c.G, c.bid, (const char*)(mx + FX_ACTE), (const char*)(wb + W_DE), (size_t)256 * DFE * 2, (size_t)256 * DFE * 2, W_DE_E, lctl + 32, nullptr, nullptr, 0};
                pg8::EpiStoreBf16 E{(bf16*)(mx + FX_YS), D};
                pg8::gemm_phase<pg8::EpiStoreBf16, pg8::MoeOrder, true>(c.lds, g, S, E);
            } SEAM(P + 9);
            for (int rep_ = 0; rep_ < NREP(10); ++rep_) if (EN(10) && IN(P + 10)) { if (rep_) xcd_barrier(bar); PH_BEGIN final_pass(p, c); }
        }
    }
#undef IN
#undef SEAM
}

static void forward(void* const* d_in, float* out, void* d_ws, size_t ws_size, hipStream_t st, int n_launches) {
    static int grid = 0;
    if (grid == 0) {
        if (ws_size < WS_END) { fprintf(stderr, "mk::forward: workspace too small (%zu < %zu)\n", ws_size, (size_t)WS_END); grid = -1; return; }
        int dev = 0, cus = 0;
        if (hipGetDevice(&dev) != hipSuccess || hipDeviceGetAttribute(&cus, hipDeviceAttributeMultiprocessorCount, dev) != hipSuccess) { grid = -1; return; }
        if (hipFuncSetAttribute((const void*)mega, hipFuncAttributeMaxDynamicSharedMemorySize, LDS_BYTES) != hipSuccess) { fprintf(stderr, "mk::forward: hipFuncSetAttribute failed\n"); grid = -1; return; }
        int per_cu = 0; (void)hipOccupancyMaxActiveBlocksPerMultiprocessor(&per_cu, (const void*)mega, NTHREADS, LDS_BYTES); (void)hipGetLastError();
        grid = cus;
    }
    if (grid < 0) return;
    (void)hipMemsetAsync((char*)d_ws + WS_CTL, 0, CTL_BYTES, st);
    Params p{};
    for (int i = 0; i < 25; ++i) p.in[i] = (const float*)d_in[i];
    p.out = out; p.ws = (unsigned char*)d_ws;
    if (n_launches == 1) { p.ph_lo = 0; p.ph_hi = N_PHASES; hipLaunchKernelGGL(mega, dim3(grid), dim3(NTHREADS), LDS_BYTES, st, p); }
    else for (int k = 0; k < N_PHASES; ++k) { p.ph_lo = k; p.ph_hi = k + 1; hipLaunchKernelGGL(mega, dim3(grid), dim3(NTHREADS), LDS_BYTES, st, p); }
    const hipError_t le = hipPeekAtLastError();
    if (le != hipSuccess) fprintf(stderr, "mk::forward: launch failed: %s\n", hipGetErrorName(le));
}
}

#ifndef MK_LAUNCHES
#define MK_LAUNCHES 1
#endif
#ifndef USE_SLOW
#define USE_SLOW 0
#endif
extern "C" void kernel_launch(void* const* d_in, const int* in_sizes, int n_in, void* d_out, int out_size, void* d_ws, size_t ws_size, hipStream_t stream) {
    if (n_in != 25 || out_size != SEQ * D) { fprintf(stderr, "kernel_launch: unexpected shapes (n_in %d out %d)\n", n_in, out_size); return; }
#if USE_SLOW
    slow::forward(d_in, (float*)d_out, (float*)d_ws, ws_size / 4, stream);
#else
    mk::forward(d_in, (float*)d_out, d_ws, ws_size, stream, MK_LAUNCHES);
#endif
}
```

```cpp
#include <hip/hip_runtime.h>
#include <cstdio>
#include <cstdint>

constexpr int D = 2048, LC = 256, SEQ = 8192, MT = LC + SEQ, DEPTH = 2;
constexpr int NH = 16, DN = 128, DR = 64, DV = 128, DQK = DN + DR, QL = 512, KVL = 512;
constexpr int CW = 2048, DIN = QL + KVL + DR + 3 * CW + 2 * D;
constexpr int OFF_QA = 0, OFF_CKV = 512, OFF_KR = 1024, OFF_CX = 1088, OFF_CB = OFF_CX + CW, OFF_CC = OFF_CB + CW, OFF_GA = OFF_CC + CW, OFF_GB = OFF_GA + D;
constexpr int DFF = 5632, NE = 8, DFE = 2816;
constexpr float EPS = 1e-6f;
constexpr float ATT_SCALE = 0.07216878364870322f;

namespace slow {
typedef float f32x16 __attribute__((ext_vector_type(16)));

struct GArgs { const float* A; long lda, abs_; const float* B; long sbk, sbn, bbs; const int* rowidx; const int* rioff; const int* Mptr; int M, N, K, pad; };
static_assert(sizeof(GArgs) == 96, "GArgs has no implicit padding");

template <bool BT, class Epi>
__global__ __launch_bounds__(256) void k_gemm(GArgs g, Epi epi) {
    __shared__ float As[32][65];
    __shared__ float Bs[32][65];
    const int b = blockIdx.z, m0 = blockIdx.y * 64, n0 = blockIdx.x * 64;
    const int M = g.Mptr ? g.Mptr[b] : g.M;
    if (m0 >= M) return;
    const int t = threadIdx.x, lane = t & 63, w = t >> 6, wm = w >> 1, wn = w & 1;
    const float* A = g.A + (long)b * g.abs_; const float* B = g.B + (long)b * g.bbs;
    const int ar = t >> 2, ak = (t & 3) * 8, am = m0 + ar;
    long arow = -1;
    if (am < M) { const int base = g.rioff ? g.rioff[b] : 0; arow = g.rowidx ? (long)g.rowidx[base + am] : (long)(base + am); }
    f32x16 acc;
#pragma unroll
    for (int r = 0; r < 16; ++r) acc[r] = 0.f;
    for (int k0 = 0; k0 < g.K; k0 += 32) {
        float4 a0 = make_float4(0.f, 0.f, 0.f, 0.f), a1 = a0, b0, b1;
        if (arow >= 0) { const float4* p = (const float4*)(A + arow * g.lda + k0 + ak); a0 = p[0]; a1 = p[1]; }
        if (BT) { const int bn = t >> 2, bk = (t & 3) * 8; const float4* p = (const float4*)(B + (long)(n0 + bn) * g.sbn + k0 + bk); b0 = p[0]; b1 = p[1]; }
        else    { const int bk = t >> 3, bn = (t & 7) * 8; const float4* p = (const float4*)(B + (long)(k0 + bk) * g.sbk + n0 + bn); b0 = p[0]; b1 = p[1]; }
        __syncthreads();
        As[ak + 0][ar] = a0.x; As[ak + 1][ar] = a0.y; As[ak + 2][ar] = a0.z; As[ak + 3][ar] = a0.w;
        As[ak + 4][ar] = a1.x; As[ak + 5][ar] = a1.y; As[ak + 6][ar] = a1.z; As[ak + 7][ar] = a1.w;
        if (BT) { const int bn = t >> 2, bk = (t & 3) * 8;
            Bs[bk + 0][bn] = b0.x; Bs[bk + 1][bn] = b0.y; Bs[bk + 2][bn] = b0.z; Bs[bk + 3][bn] = b0.w;
            Bs[bk + 4][bn] = b1.x; Bs[bk + 5][bn] = b1.y; Bs[bk + 6][bn] = b1.z; Bs[bk + 7][bn] = b1.w; }
        else { const int bk = t >> 3, bn = (t & 7) * 8;
            Bs[bk][bn + 0] = b0.x; Bs[bk][bn + 1] = b0.y; Bs[bk][bn + 2] = b0.z; Bs[bk][bn + 3] = b0.w;
            Bs[bk][bn + 4] = b1.x; Bs[bk][bn + 5] = b1.y; Bs[bk][bn + 6] = b1.z; Bs[bk][bn + 7] = b1.w; }
        __syncthreads();
#pragma unroll
        for (int kk = 0; kk < 32; kk += 2) {
            const float a = As[kk + (lane >> 5)][wm * 32 + (lane & 31)];
            const float bb = Bs[kk + (lane >> 5)][wn * 32 + (lane & 31)];
            acc = __builtin_amdgcn_mfma_f32_32x32x2f32(a, bb, acc, 0, 0, 0);
        }
    }
    const int base = g.rioff ? g.rioff[b] : 0;
#pragma unroll
    for (int r = 0; r < 16; ++r) {
        const int row = m0 + wm * 32 + (r & 3) + 8 * (r >> 2) + 4 * (lane >> 5), col = n0 + wn * 32 + (lane & 31);
        if (row < M) epi(b, base + row, col, acc[r]);
    }
}
struct EpiStore { float* C; long ldc, cbs; float alpha; int accum;
    __device__ void operator()(int b, int row, int col, float v) const { float* p = C + (long)b * cbs + (long)row * ldc + col; *p = accum ? *p + alpha * v : alpha * v; } };
struct EpiResid { float* X; const float* gl; const float* gc;
    __device__ void operator()(int, int row, int col, float v) const { float* p = X + (long)row * D + col; *p += (row < LC ? gc[col] : gl[col]) * v; } };

template <bool BT, class Epi> static void gemm(hipStream_t st, const GArgs& g, const Epi& e, int nbatch, int maxM) {
    dim3 grid(g.N / 64, (maxM + 63) / 64, nbatch);
    hipLaunchKernelGGL((k_gemm<BT, Epi>), grid, dim3(256), 0, st, g, e);
}

__device__ __forceinline__ float block_sum(float v, float* red) {
#pragma unroll
    for (int o = 32; o > 0; o >>= 1) v += __shfl_xor(v, o);
    __syncthreads();
    if ((threadIdx.x & 63) == 0) red[threadIdx.x >> 6] = v;
    __syncthreads();
    return red[0] + red[1] + red[2] + red[3];
}
__device__ __forceinline__ float block_max(float v, float* red) {
#pragma unroll
    for (int o = 32; o > 0; o >>= 1) v = fmaxf(v, __shfl_xor(v, o));
    __syncthreads();
    if ((threadIdx.x & 63) == 0) red[threadIdx.x >> 6] = v;
    __syncthreads();
    return fmaxf(fmaxf(red[0], red[1]), fmaxf(red[2], red[3]));
}
__device__ __forceinline__ float silu(float x) { return x / (1.f + expf(-x)); }
__device__ __forceinline__ float sigm(float x) { return 1.f / (1.f + expf(-x)); }

__global__ void k_copy_x(const float* ctx, const float* x, float* XL) {
    const long n = (long)MT * D / 4; const float4* c4 = (const float4*)ctx; const float4* x4 = (const float4*)x; float4* o = (float4*)XL; const long nc = (long)LC * D / 4;
    for (long i = blockIdx.x * 256L + threadIdx.x; i < n; i += gridDim.x * 256L) o[i] = i < nc ? c4[i] : x4[i - nc];
}
__global__ void k_ada(const float* c, const float* cctx, const float* w_ada, const float* b_ada, float* MOD) {
    const int n = blockIdx.x * 256 + threadIdx.x, lv = blockIdx.y, l = lv >> 1, v = lv & 1;
    const float* cv = v ? cctx : c; const float* W = w_ada + (long)l * D * (6 * D);
    float acc = 0.f;
    for (int k = 0; k < D; ++k) acc += silu(cv[k]) * W[(long)k * (6 * D) + n];
    MOD[(long)lv * (6 * D) + n] = acc + b_ada[l * 6 * D + n];
}
__global__ __launch_bounds__(256) void k_modnorm(const float* X, const float* g, const float* modl, const float* modc, int sh_off, int sc_off, float* H) {
    __shared__ float red[4];
    const int r = blockIdx.x; const float* x = X + (long)r * D; const float* mod = r < LC ? modc : modl;
    float v[8]; float ss = 0.f;
#pragma unroll
    for (int j = 0; j < 8; ++j) { v[j] = x[threadIdx.x + 256 * j]; ss += v[j] * v[j]; }
    ss = block_sum(ss, red);
    const float rs = rsqrtf(ss * (1.f / D) + EPS);
#pragma unroll
    for (int j = 0; j < 8; ++j) { const int c = threadIdx.x + 256 * j; H[(long)r * D + c] = (v[j] * rs * g[c]) * (1.f + mod[sc_off + c]) + mod[sh_off + c]; }
}
__global__ __launch_bounds__(256) void k_rms512(const float* P, int off, const float* g, float* out) {
    __shared__ float red[4];
    const int r = blockIdx.x; const float* x = P + (long)r * DIN + off;
    const float a = x[threadIdx.x], b = x[threadIdx.x + 256];
    const float ss = block_sum(a * a + b * b, red);
    const float rs = rsqrtf(ss * (1.f / 512.f) + EPS);
    out[(long)r * 512 + threadIdx.x] = a * rs * g[threadIdx.x]; out[(long)r * 512 + threadIdx.x + 256] = b * rs * g[threadIdx.x + 256];
}
__device__ __forceinline__ float inv_freq(int i) { return powf(10000.f, -(float)(2 * i) / 32.f); }
__global__ void k_rope_q(float* Q) {
    const long idx = blockIdx.x * 256L + threadIdx.x;
    if (idx >= (long)SEQ * NH * 32) return;
    const int i = idx & 15, part = (idx >> 4) & 1, h = (idx >> 5) & 15; const int t = (int)(idx >> 9);
    const float pos = part ? (float)(t % 64) : (float)(t / 64);
    const float ang = pos * inv_freq(i), cs = cosf(ang), sn = sinf(ang);
    float* p = Q + (long)(LC + t) * (NH * DQK) + h * DQK + DN + part * 32;
    const float x1 = p[i], x2 = p[i + 16];
    p[i] = x1 * cs - x2 * sn; p[i + 16] = x2 * cs + x1 * sn;
}
__global__ void k_rope_k(const float* P, float* KR) {
    const long idx = blockIdx.x * 256L + threadIdx.x;
    if (idx >= (long)MT * 32) return;
    const int i = idx & 15, part = (idx >> 4) & 1; const int r = (int)(idx >> 5);
    const float* p = P + (long)r * DIN + OFF_KR + part * 32; float* o = KR + (long)r * DR + part * 32;
    const float x1 = p[i], x2 = p[i + 16];
    if (r < LC) { o[i] = x1; o[i + 16] = x2; return; }
    const int t = r - LC; const float pos = part ? (float)(t % 64) : (float)(t / 64);
    const float ang = pos * inv_freq(i), cs = cosf(ang), sn = sinf(ang);
    o[i] = x1 * cs - x2 * sn; o[i + 16] = x2 * cs + x1 * sn;
}
__global__ __launch_bounds__(256) void k_softmax(float* SC, int n) {
    __shared__ float red[4];
    float* s = SC + (long)blockIdx.x * n;
    float mx = -3.0e38f;
    for (int j = threadIdx.x; j < n; j += 256) mx = fmaxf(mx, s[j]);
    mx = block_max(mx, red);
    float sum = 0.f;
    for (int j = threadIdx.x; j < n; j += 256) { const float e = expf(s[j] - mx); s[j] = e; sum += e; }
    sum = block_sum(sum, red);
    const float inv = 1.f / sum;
    for (int j = threadIdx.x; j < n; j += 256) s[j] *= inv;
}
__global__ void k_conv(const float* P, const float* wconv, float* V2) {
    const long idx = blockIdx.x * 256L + threadIdx.x; if (idx >= (long)MT * CW) return;
    const int c = idx % CW; const int r = (int)(idx / CW);
    const int lo = r < LC ? 0 : LC, hi = r < LC ? LC : MT;
    const float* p = P + (long)r * DIN;
    float acc = wconv[CW + c] * (p[OFF_CC + c] * p[OFF_CX + c]);
    if (r - 1 >= lo) acc += wconv[c] * (p[OFF_CC + c - DIN] * p[OFF_CX + c - DIN]);
    if (r + 1 < hi) acc += wconv[2 * CW + c] * (p[OFF_CC + c + DIN] * p[OFF_CX + c + DIN]);
    V2[idx] = p[OFF_CB + c] * acc;
}
__global__ void k_merge(const float* P, const float* OA, const float* OB, float* MG) {
    const long idx = blockIdx.x * 256L + threadIdx.x; if (idx >= (long)MT * D) return;
    const int c = idx % D; const long r = idx / D;
    MG[idx] = sigm(P[r * DIN + OFF_GA + c]) * OA[idx] + sigm(P[r * DIN + OFF_GB + c]) * OB[idx];
}
__global__ void k_swiglu(float* G, const float* U, long n) {
    for (long i = blockIdx.x * 256L + threadIdx.x; i < n; i += gridDim.x * 256L) G[i] = silu(G[i]) * U[i];
}
__global__ __launch_bounds__(256) void k_router(const float* H2, const float* wr, int* sel, float* gw) {
    const int t = blockIdx.x * 4 + (threadIdx.x >> 6), lane = threadIdx.x & 63;
    const float* h = H2 + (long)(LC + t) * D;
    float lg[NE];
#pragma unroll
    for (int e = 0; e < NE; ++e) lg[e] = 0.f;
    for (int k = lane; k < D; k += 64) { const float hv = h[k];
#pragma unroll
        for (int e = 0; e < NE; ++e) lg[e] += hv * wr[k * NE + e]; }
#pragma unroll
    for (int e = 0; e < NE; ++e) {
#pragma unroll
        for (int o = 32; o > 0; o >>= 1) lg[e] += __shfl_xor(lg[e], o); }
    if (lane == 0) {
        int e0 = 0; for (int e = 1; e < NE; ++e) if (lg[e] > lg[e0]) e0 = e;
        int e1 = e0 == 0 ? 1 : 0; for (int e = 0; e < NE; ++e) if (e != e0 && lg[e] > lg[e1]) e1 = e;
        const float m = lg[e0], a = 1.f, b = expf(lg[e1] - m), inv = 1.f / (a + b);
        sel[2 * t] = e0; sel[2 * t + 1] = e1; gw[2 * t] = a * inv; gw[2 * t + 1] = b * inv;
    }
}
__global__ __launch_bounds__(512) void k_sort(const int* sel, int* cnt, int* off, int* toklist, int* slot_of) {
    __shared__ int scnt[NE];
    const int e = threadIdx.x >> 6, lane = threadIdx.x & 63; const int NA = 2 * SEQ;
    int c = 0;
    for (int a0 = 0; a0 < NA; a0 += 64) c += __popcll(__ballot(sel[a0 + lane] == e));
    if (lane == 0) scnt[e] = c;
    __syncthreads();
    int base = 0; for (int j = 0; j < e; ++j) base += scnt[j];
    if (lane == 0) { cnt[e] = c; off[e] = base; }
    int pos = base;
    for (int a0 = 0; a0 < NA; a0 += 64) {
        const bool f = sel[a0 + lane] == e; const unsigned long long m = __ballot(f);
        if (f) { const int p = pos + __popcll(m & ((1ull << lane) - 1ull)); toklist[p] = LC + (a0 + lane) / 2; slot_of[a0 + lane] = p; }
        pos += __popcll(m);
    }
}
__global__ void k_moe_combine(float* XL, const float* Ys, const int* slot_of, const float* gw, const float* gt2) {
    const long idx = blockIdx.x * 256L + threadIdx.x; if (idx >= (long)SEQ * D) return;
    const int c = idx % D; const int t = (int)(idx / D);
    const float y = gw[2 * t] * Ys[(long)slot_of[2 * t] * D + c] + gw[2 * t + 1] * Ys[(long)slot_of[2 * t + 1] * D + c];
    XL[(long)(LC + t) * D + c] += gt2[c] * y;
}
__global__ __launch_bounds__(256) void k_final(const float* XL, const float* g, float* out) {
    __shared__ float red[4];
    const int r = blockIdx.x; const float* x = XL + (long)(LC + r) * D;
    float v[8]; float ss = 0.f;
#pragma unroll
    for (int j = 0; j < 8; ++j) { v[j] = x[threadIdx.x + 256 * j]; ss += v[j] * v[j]; }
    ss = block_sum(ss, red);
    const float rs = rsqrtf(ss * (1.f / D) + EPS);
#pragma unroll
    for (int j = 0; j < 8; ++j) { const int c = threadIdx.x + 256 * j; out[(long)r * D + c] = v[j] * rs * g[c]; }
}

static inline int nblk(long n) { return (int)((n + 255) / 256); }

static void forward(void* const* d_in, float* out, float* ws, size_t ws_floats, hipStream_t st) {
    const float* x = (const float*)d_in[0]; const float* c = (const float*)d_in[1]; const float* ctx = (const float*)d_in[2]; const float* cctx = (const float*)d_in[3];
    const float* w_ada = (const float*)d_in[4]; const float* b_ada = (const float*)d_in[5]; const float* g_attn = (const float*)d_in[6]; const float* w_in = (const float*)d_in[7];
    const float* g_qa = (const float*)d_in[8]; const float* w_qb = (const float*)d_in[9]; const float* g_kva = (const float*)d_in[10]; const float* w_kvb = (const float*)d_in[11];
    const float* w_conv = (const float*)d_in[12]; const float* w_oa = (const float*)d_in[13]; const float* w_ob = (const float*)d_in[14]; const float* w_o = (const float*)d_in[15];
    const float* g_ffn = (const float*)d_in[16]; const float* w_gd = (const float*)d_in[17]; const float* w_ud = (const float*)d_in[18]; const float* w_dd = (const float*)d_in[19];
    const float* w_router = (const float*)d_in[20]; const float* w_ge = (const float*)d_in[21]; const float* w_ue = (const float*)d_in[22]; const float* w_de = (const float*)d_in[23];
    const float* g_final = (const float*)d_in[24];
    size_t o = 0; auto take = [&](size_t n) { float* p = ws + o; o += (n + 63) / 64 * 64; return p; };
    float* XL = take((size_t)MT * D); float* MOD = take(4 * 6 * D); float* H = take((size_t)MT * D); float* P = take((size_t)MT * DIN);
    float* QN = take((size_t)MT * 512); float* CN = take((size_t)MT * 512); float* Q = take((size_t)MT * NH * DQK); float* KV = take((size_t)MT * NH * 256);
    float* KR = take((size_t)MT * DR); float* SC = take((size_t)NH * 256 * MT); float* ATT = take((size_t)MT * D);
    int* IB = (int*)take(4 * SEQ + 64 + 2 * SEQ + 2 * SEQ);
    if (o > ws_floats) { fprintf(stderr, "slow::forward: workspace too small (%zu > %zu floats)\n", o, ws_floats); return; }
    int* sel = IB; int* slot_of = IB + 2 * SEQ; int* toklist = IB + 4 * SEQ; int* cnt = IB + 6 * SEQ; int* off = cnt + 8; float* gw = (float*)(IB + 6 * SEQ + 64);
    float* OA = SC; float* OB = SC + (size_t)MT * D; float* V2 = SC + 2 * (size_t)MT * D; float* MG = SC + 3 * (size_t)MT * D;
    static_assert((size_t)NH * 256 * MT >= 2 * (size_t)MT * D, "SC region");
    V2 = Q; MG = KV;
    float* OUT = H; float* H2 = H; float* G = P; float* U = P + (size_t)MT * DFF; float* Y = Q; float* Ys = KV;
    static_assert((size_t)MT * DIN >= 2 * (size_t)MT * DFF, "P region holds G and U");

    hipLaunchKernelGGL(k_copy_x, dim3(2048), dim3(256), 0, st, ctx, x, XL);
    hipLaunchKernelGGL(k_ada, dim3(6 * D / 256, 4), dim3(256), 0, st, c, cctx, w_ada, b_ada, MOD);
    for (int i = 0; i < DEPTH; ++i) {
        const bool last = (i == DEPTH - 1);
        const float* modl = MOD + (size_t)(2 * i) * 6 * D; const float* modc = MOD + (size_t)(2 * i + 1) * 6 * D;
        hipLaunchKernelGGL(k_modnorm, dim3(MT), dim3(256), 0, st, XL, g_attn + i * D, modl, modc, 0, D, H);
        { GArgs g{H, D, 0, w_in + (size_t)i * D * DIN, DIN, 1, 0, nullptr, nullptr, nullptr, MT, DIN, D}; gemm<false>(st, g, EpiStore{P, DIN, 0, 1.f, 0}, 1, MT); }
        hipLaunchKernelGGL(k_rms512, dim3(MT), dim3(256), 0, st, P, OFF_QA, g_qa + i * QL, QN);
        hipLaunchKernelGGL(k_rms512, dim3(MT), dim3(256), 0, st, P, OFF_CKV, g_kva + i * KVL, CN);
        { GArgs g{QN, 512, 0, w_qb + (size_t)i * QL * NH * DQK, NH * DQK, 1, 0, nullptr, nullptr, nullptr, MT, NH * DQK, QL}; gemm<false>(st, g, EpiStore{Q, NH * DQK, 0, 1.f, 0}, 1, MT); }
        { GArgs g{CN, 512, 0, w_kvb + (size_t)i * KVL * NH * 256, NH * 256, 1, 0, nullptr, nullptr, nullptr, MT, NH * 256, KVL}; gemm<false>(st, g, EpiStore{KV, NH * 256, 0, 1.f, 0}, 1, MT); }
        hipLaunchKernelGGL(k_rope_q, dim3(nblk((long)SEQ * NH * 32)), dim3(256), 0, st, Q);
        hipLaunchKernelGGL(k_rope_k, dim3(nblk((long)MT * 32)), dim3(256), 0, st, P, KR);
        for (int ch = last ? 0 : -1; ch < SEQ / 256; ++ch) {
            const int q0 = ch < 0 ? 0 : LC + 256 * ch, nk = ch < 0 ? LC : MT;
            { GArgs g{Q + (size_t)q0 * NH * DQK, NH * DQK, DQK, KV, 1, NH * 256, 256, nullptr, nullptr, nullptr, 256, nk, DN}; gemm<true>(st, g, EpiStore{SC, nk, (long)256 * nk, ATT_SCALE, 0}, NH, 256); }
            { GArgs g{Q + (size_t)q0 * NH * DQK + DN, NH * DQK, DQK, KR, 1, DR, 0, nullptr, nullptr, nullptr, 256, nk, DR}; gemm<true>(st, g, EpiStore{SC, nk, (long)256 * nk, ATT_SCALE, 1}, NH, 256); }
            hipLaunchKernelGGL(k_softmax, dim3(NH * 256), dim3(256), 0, st, SC, nk);
            { GArgs g{SC, nk, (long)256 * nk, KV + DN, NH * 256, 1, 256, nullptr, nullptr, nullptr, 256, DV, nk}; gemm<false>(st, g, EpiStore{ATT + (size_t)q0 * D, D, DV, 1.f, 0}, NH, 256); }
        }
        { GArgs g{ATT, D, 0, w_oa + (size_t)i * D * D, D, 1, 0, nullptr, nullptr, nullptr, MT, D, D}; gemm<false>(st, g, EpiStore{OA, D, 0, 1.f, 0}, 1, MT); }
        hipLaunchKernelGGL(k_conv, dim3(nblk((long)MT * CW)), dim3(256), 0, st, P, w_conv + (size_t)i * 3 * CW, V2);
        { GArgs g{V2, CW, 0, w_ob + (size_t)i * CW * D, D, 1, 0, nullptr, nullptr, nullptr, MT, D, CW}; gemm<false>(st, g, EpiStore{OB, D, 0, 1.f, 0}, 1, MT); }
        hipLaunchKernelGGL(k_merge, dim3(nblk((long)MT * D)), dim3(256), 0, st, P, OA, OB, MG);
        { GArgs g{MG, D, 0, w_o + (size_t)i * D * D, D, 1, 0, nullptr, nullptr, nullptr, MT, D, D}; gemm<false>(st, g, EpiResid{XL, modl + 2 * D, modc + 2 * D}, 1, MT); }
        hipLaunchKernelGGL(k_modnorm, dim3(MT), dim3(256), 0, st, XL, g_ffn + i * D, modl, modc, 3 * D, 4 * D, H2);
        if (i % 2 == 0) {
            const int j = i / 2;
            { GArgs g{H2, D, 0, w_gd + (size_t)j * D * DFF, DFF, 1, 0, nullptr, nullptr, nullptr, MT, DFF, D}; gemm<false>(st, g, EpiStore{G, DFF, 0, 1.f, 0}, 1, MT); }
            { GArgs g{H2, D, 0, w_ud + (size_t)j * D * DFF, DFF, 1, 0, nullptr, nullptr, nullptr, MT, DFF, D}; gemm<false>(st, g, EpiStore{U, DFF, 0, 1.f, 0}, 1, MT); }
            hipLaunchKernelGGL(k_swiglu, dim3(4096), dim3(256), 0, st, G, U, (long)MT * DFF);
            { GArgs g{G, DFF, 0, w_dd + (size_t)j * DFF * D, D, 1, 0, nullptr, nullptr, nullptr, MT, D, DFF}; gemm<false>(st, g, EpiResid{XL, modl + 5 * D, modc + 5 * D}, 1, MT); }
        } else {
            const int j = i / 2;
            float* Ge = P; float* Ue = P + (size_t)2 * SEQ * DFE;
            hipLaunchKernelGGL(k_router, dim3(SEQ / 4), dim3(256), 0, st, H2, w_router + (size_t)j * D * NE, sel, gw);
            hipLaunchKernelGGL(k_sort, dim3(1), dim3(512), 0, st, sel, cnt, off, toklist, slot_of);
            { GArgs g{H2, D, 0, w_ge + (size_t)j * NE * D * DFE, DFE, 1, (long)D * DFE, toklist, off, cnt, 0, DFE, D}; gemm<false>(st, g, EpiStore{Ge, DFE, 0, 1.f, 0}, NE, SEQ); }
            { GArgs g{H2, D, 0, w_ue + (size_t)j * NE * D * DFE, DFE, 1, (long)D * DFE, toklist, off, cnt, 0, DFE, D}; gemm<false>(st, g, EpiStore{Ue, DFE, 0, 1.f, 0}, NE, SEQ); }
            hipLaunchKernelGGL(k_swiglu, dim3(4096), dim3(256), 0, st, Ge, Ue, (long)2 * SEQ * DFE);
            { GArgs g{Ge, DFE, 0, w_de + (size_t)j * NE * DFE * D, D, 1, (long)DFE * D, nullptr, off, cnt, 0, D, DFE}; gemm<false>(st, g, EpiStore{Ys, D, 0, 1.f, 0}, NE, SEQ); }
            hipLaunchKernelGGL(k_moe_combine, dim3(nblk((long)SEQ * D)), dim3(256), 0, st, XL, Ys, slot_of, gw, modl + 5 * D);
        }
        (void)OUT; (void)Y;
    }
    hipLaunchKernelGGL(k_final, dim3(SEQ), dim3(256), 0, st, XL, g_final, out);
}
}


namespace mk {
#define LAS __attribute__((address_space(3)))
#define GAS __attribute__((address_space(1)))
typedef unsigned short bf16;
typedef short bf16x8 __attribute__((ext_vector_type(8)));
typedef short s16x4 __attribute__((ext_vector_type(4)));
typedef float f32x2 __attribute__((ext_vector_type(2)));
typedef float f32x4 __attribute__((ext_vector_type(4)));
typedef float f32x16 __attribute__((ext_vector_type(16)));
typedef unsigned u32x2 __attribute__((ext_vector_type(2)));
typedef unsigned u32x4 __attribute__((ext_vector_type(4)));
typedef __bf16 bf16x2_t __attribute__((ext_vector_type(2)));
typedef int i32x4 __attribute__((ext_vector_type(4)));
typedef GAS unsigned gu32;

constexpr int NWAVES = 8, NTHREADS = 512;
constexpr int NT_IN = 45;
constexpr int NIN = NT_IN * 256;
constexpr int KS_ADA = 16;
constexpr int MAXT = 72;
constexpr int XS_ROWS = MAXT * 256;

constexpr size_t al256(size_t x) { return (x + 255) / 256 * 256; }
constexpr size_t WS_CTL = 0, CTL_BYTES = 1u << 20;
constexpr size_t WS_MOD = WS_CTL + CTL_BYTES;
constexpr size_t WS_PART = WS_MOD + al256((size_t)4 * 6 * D * 4);
constexpr size_t WS_ROPE = WS_PART + al256((size_t)2 * KS_ADA * 2 * 6 * D * 4);
constexpr size_t WS_SEL = WS_ROPE + al256(2 * 128 * 16 * 4);
constexpr size_t WS_GW = WS_SEL + al256((size_t)2 * SEQ * 4);
constexpr size_t WS_SLOT = WS_GW + al256((size_t)2 * SEQ * 4);
constexpr int SC_IN = 0, SC_GU = 2 * NIN, SC_GUE = SC_GU + 2 * DFF, SC_TOTAL = SC_GUE + NE * 2 * DFE;
constexpr size_t WS_HSC = WS_SLOT + al256((size_t)2 * SEQ * 4);
constexpr size_t WS_XSC = WS_HSC + al256((size_t)MT * 4);
constexpr size_t WS_WSC = WS_XSC + al256((size_t)XS_ROWS * 4);
constexpr size_t CTL_COLMAX = 65536;
static_assert(CTL_COLMAX + (size_t)SC_TOTAL * 4 <= CTL_BYTES, "column maxima inside the zeroed control region");
constexpr size_t WS_XL = WS_WSC + al256((size_t)SC_TOTAL * 4);
constexpr size_t WS_HN = WS_XL + al256((size_t)MT * D * 4);
constexpr size_t WS_MIX = WS_HN + al256((size_t)MT * D * 2);
constexpr size_t MX_QC = 0;
constexpr size_t MX_KRB = MX_QC + al256((size_t)MT * 1024 * 2);
constexpr size_t MX_SSQ = MX_KRB + al256((size_t)MT * 64 * 2);
constexpr size_t MX_U = MX_SSQ + al256((size_t)MT * 16 * 4);
constexpr size_t MX_CB = MX_U + al256((size_t)MT * D * 2);
constexpr size_t MX_SGA = MX_CB + al256((size_t)MT * D * 2);
constexpr size_t MX_SGB = MX_SGA + al256((size_t)MT * D * 2);
constexpr size_t MX_Q = MX_SGB + al256((size_t)MT * D * 2);
constexpr size_t MX_KV = MX_Q + al256((size_t)MT * 3072 * 2);
constexpr size_t MX_O = MX_KV + al256((size_t)MT * 4096 * 2);
constexpr size_t MX_V2 = MX_O + al256((size_t)MT * D * 2);
constexpr size_t MX_M1 = MX_V2 + al256((size_t)MT * D * 2);
constexpr size_t MX_MG = MX_M1 + al256((size_t)MT * D * 2);
constexpr size_t MX_END = MX_MG + al256((size_t)MT * D * 2);
constexpr size_t FX_ACT = 0;
constexpr size_t FX_XS = 0;
constexpr size_t FX_ACTE = FX_XS + al256((size_t)XS_ROWS * D * 2);
constexpr size_t FX_YS = FX_ACTE + al256((size_t)XS_ROWS * DFE * 2);
constexpr size_t FX_END = FX_YS + al256((size_t)XS_ROWS * D * 2);
static_assert(MX_SGA - MX_CB == (size_t)MT * D * 2 && MX_SGB - MX_SGA == (size_t)MT * D * 2, "CB | SGA | SGB contiguous");
static_assert(FX_END <= MX_END && (size_t)MT * DFF * 2 <= MX_END, "FFN scratch overlays the mixer scratch");
constexpr size_t WS_W = WS_MIX + MX_END;
constexpr size_t W_IN = 0, W_IN_L = (size_t)NIN * D * 2;
constexpr size_t W_QB = W_IN + 2 * W_IN_L, W_QB_L = (size_t)3072 * 512 * 2;
constexpr size_t W_KVB = W_QB + 2 * W_QB_L, W_KVB_L = (size_t)4096 * 512 * 2;
constexpr size_t W_OA = W_KVB + 2 * W_KVB_L, W_SQ_L = (size_t)D * D * 2;
constexpr size_t W_OB = W_OA + 2 * W_SQ_L, W_O = W_OB + 2 * W_SQ_L;
constexpr size_t W_GU = W_O + 2 * W_SQ_L;
constexpr size_t W_DD = W_GU + (size_t)2 * DFF * D * 2;
constexpr size_t W_GUE = W_DD + (size_t)D * DFF * 2, W_GUE_E = (size_t)2 * DFE * D * 2;
constexpr size_t W_DE = W_GUE + NE * W_GUE_E, W_DE_E = (size_t)D * DFE * 2;
constexpr size_t W_END = W_DE + NE * W_DE_E;
constexpr size_t WS_END = WS_W + W_END;

constexpr int RING_BYTES = 131072;
constexpr int LCTL_OFF = RING_BYTES;
constexpr int LDS_BYTES = 147456;

__device__ __forceinline__ unsigned cvtpk(float lo, float hi) { f32x2 v = {lo, hi}; bf16x2_t b = __builtin_convertvector(v, bf16x2_t); return __builtin_bit_cast(unsigned, b); }
__device__ __forceinline__ u32x4 pack8(f32x4 a, f32x4 b) { u32x4 w; w.x = cvtpk(a[0], a[1]); w.y = cvtpk(a[2], a[3]); w.z = cvtpk(b[0], b[1]); w.w = cvtpk(b[2], b[3]); return w; }
__device__ __forceinline__ void unpack8(u32x4 w, f32x4& a, f32x4& b) {
    a[0] = __uint_as_float(w.x << 16); a[1] = __uint_as_float(w.x & 0xffff0000u); a[2] = __uint_as_float(w.y << 16); a[3] = __uint_as_float(w.y & 0xffff0000u);
    b[0] = __uint_as_float(w.z << 16); b[1] = __uint_as_float(w.z & 0xffff0000u); b[2] = __uint_as_float(w.w << 16); b[3] = __uint_as_float(w.w & 0xffff0000u); }
__device__ __forceinline__ f32x4 unpack4(u32x2 w) { f32x4 a; a[0] = __uint_as_float(w.x << 16); a[1] = __uint_as_float(w.x & 0xffff0000u); a[2] = __uint_as_float(w.y << 16); a[3] = __uint_as_float(w.y & 0xffff0000u); return a; }
__device__ __forceinline__ float fsig(float x) { return __builtin_amdgcn_rcpf(1.f + __builtin_amdgcn_exp2f(-1.4426950408889634f * x)); }
__device__ __forceinline__ f32x4 fsig4(f32x4 x) { f32x4 r; r[0] = fsig(x[0]); r[1] = fsig(x[1]); r[2] = fsig(x[2]); r[3] = fsig(x[3]); return r; }
__device__ __forceinline__ float wave_sum(float v) {
#pragma unroll
    for (int o = 1; o < 64; o <<= 1) v += __shfl_xor(v, o);
    return v;
}
#define LDS_WAIT() asm volatile("s_waitcnt lgkmcnt(0)" ::: "memory")
#define VM_WAIT() asm volatile("s_waitcnt vmcnt(0)" ::: "memory")

namespace pg8 {
constexpr int BM = 256, BK = 64, HALF = 128, HTB = HALF * BK * 2, STAGE_BYTES = 8 * HTB, NXCD = 8, WGM = 8;
__device__ __forceinline__ int lds_byte(int r, int c) { const int st = (r >> 4) * 2 + (c >> 5), rr = r & 15, cc = c & 31, ob = rr * 64 + cc * 2; return st * 1024 + (ob ^ (((ob >> 9) & 1) << 5)); }
__device__ __forceinline__ void stage_rc(int b, int& R, int& C) { const int st = b / 1024, sb = b % 1024, swz = sb ^ (((sb >> 9) & 1) << 5); R = (st >> 1) * 16 + swz / 64; C = (st & 1) * 32 + (swz % 64) / 2; }
__device__ __forceinline__ int perm32(int rho) { const int n = rho >> 4, i = rho & 15; return 8 * (i >> 2) + 4 * n + (i & 3); }
struct Unit { int pm, pn, kind; };
struct Geo { int lda, ldb, K; };
__device__ __forceinline__ void tile_of(int L, int nM, int nN, int& pm, int& pn) {
    const int nwg = nM * nN; int wgid = L; { const int q = nwg / NXCD, r = nwg % NXCD, xcd = wgid % NXCD, off = wgid / NXCD; wgid = (xcd < r ? xcd * (q + 1) : r * (q + 1) + (xcd - r) * q) + off; }
    const int nig = WGM * nN, gid = wgid / nig, fm = gid * WGM, gsz = (nM - fm) < WGM ? (nM - fm) : WGM;
    pm = fm + ((wgid % nig) % gsz); pn = (wgid % nig) / gsz;
}
template <class Epi, class Sched, bool ALIGN_EPI, bool I8 = false>
__device__ __forceinline__ void gemm_phase(LAS unsigned char* lds, const Geo g, const Sched& S, const Epi& E) {
    int tid = threadIdx.x; asm volatile("" : "+v"(tid));
    const int wid = __builtin_amdgcn_readfirstlane(tid >> 6), lane = tid & 63, wr = wid >> 2, wc = wid & 3, fr = lane & 15, fq = lane >> 4;
    const int nt = g.K / BK;
    unsigned voffA[2], voffB[2];
#pragma unroll
    for (int i = 0; i < 2; ++i) { int R, C; stage_rc(tid * 16 + i * 8192, R, C); const int Rb = Epi::PERM ? ((R & ~31) + perm32(R & 31)) : R;
        voffA[i] = (unsigned)(R * g.lda + C) * 2u; voffB[i] = (unsigned)(Rb * g.ldb + C) * 2u; }
    const size_t kstep = (size_t)(BK * 2);
    const size_t hstepA = (size_t)HALF * g.lda * 2, hstepB = (size_t)HALF * g.ldb * 2;
    const unsigned ldsw = (unsigned)wid * 1024u;
    const int aoff = lds_byte(wr * 64 + fr, fq * 8), boff = lds_byte(wc * 32 + fr, fq * 8);
#define PG8_SA(b, h) (((b) * 2 + (h)) * HTB)
#define PG8_SB(b, h) ((4 + (b) * 2 + (h)) * HTB)
#define PG8_STAGE(bufoff, gbase, voff) do { _Pragma("unroll") for (int _i = 0; _i < 2; ++_i) \
        __builtin_amdgcn_global_load_lds((const unsigned*)((const char*)(gbase) + (voff)[_i]), (LAS unsigned*)(lds + (bufoff) + ldsw + _i * 8192), 16, 0, 0); } while (0)
#define PG8_LDA(dst, b, h) do { _Pragma("unroll") for (int m = 0; m < 4; ++m) _Pragma("unroll") for (int k = 0; k < 2; ++k) dst[m][k] = *(const LAS bf16x8*)(lds + PG8_SA(b, h) + aoff + m * 2048 + k * 1024); } while (0)
#define PG8_LDB(dst, b, h) do { _Pragma("unroll") for (int n = 0; n < 2; ++n) _Pragma("unroll") for (int k = 0; k < 2; ++k) dst[n][k] = *(const LAS bf16x8*)(lds + PG8_SB(b, h) + boff + n * 2048 + k * 1024); } while (0)
#define PG8_MMA(ai, bj, At, Bt) do { __builtin_amdgcn_s_setprio(1); _Pragma("unroll") for (int m = 0; m < 4; ++m) _Pragma("unroll") for (int n = 0; n < 2; ++n) _Pragma("unroll") for (int k = 0; k < 2; ++k) { \
        if constexpr (I8) acc[ai][bj][m][n] = __builtin_bit_cast(f32x4, __builtin_amdgcn_mfma_i32_16x16x64_i8(__builtin_bit_cast(i32x4, Bt[n][k]), __builtin_bit_cast(i32x4, At[m][k]), __builtin_bit_cast(i32x4, acc[ai][bj][m][n]), 0, 0, 0)); \
        else acc[ai][bj][m][n] = __builtin_amdgcn_mfma_f32_16x16x32_bf16(Bt[n][k], At[m][k], acc[ai][bj][m][n], 0, 0, 0); } __builtin_amdgcn_s_setprio(0); } while (0)
#define PG8_WAIT_V(n) asm volatile("s_waitcnt vmcnt(" #n ")" ::: "memory")
#define PG8_WAIT_L(n) asm volatile("s_waitcnt lgkmcnt(" #n ")" ::: "memory")
#define PG8_BAR __builtin_amdgcn_s_barrier()
#define PG8_SCHED __builtin_amdgcn_sched_barrier(0)
    Unit cur, nxt; int ui = 0;
    if (!S.next(0, cur)) return;
    float zf = 0.f; asm volatile("" : "+v"(zf));
    f32x4 acc[2][2][4][2];
#pragma unroll
    for (int a = 0; a < 2; ++a)
#pragma unroll
        for (int b = 0; b < 2; ++b)
#pragma unroll
            for (int m = 0; m < 4; ++m)
#pragma unroll
                for (int n = 0; n < 2; ++n) acc[a][b][m][n] = (f32x4){zf, zf, zf, zf};
    bf16x8 At[4][2], B0[2][2], B1[2][2];
    const char* cA = S.abase(cur); const char* cB = S.bbase(cur);
    PG8_STAGE(PG8_SB(0, 0), cB, voffB); PG8_STAGE(PG8_SB(0, 1), cB + hstepB, voffB); PG8_STAGE(PG8_SA(0, 0), cA, voffA); PG8_STAGE(PG8_SA(0, 1), cA + hstepA, voffA);
    if (wr == 1) PG8_BAR;
    PG8_WAIT_V(2); PG8_BAR;
    PG8_STAGE(PG8_SB(1, 0), cB + kstep, voffB); PG8_STAGE(PG8_SA(1, 0), cA + kstep, voffA); PG8_STAGE(PG8_SB(1, 1), cB + hstepB + kstep, voffB);
    PG8_WAIT_V(6); PG8_BAR;
    for (;;) {
        const bool has_next = S.next(ui + 1, nxt);
        const char* nA = has_next ? S.abase(nxt) : cA; const char* nB = has_next ? S.bbase(nxt) : cB;
        for (int t = 0; t < nt; t += 2) {
            const bool last = (t == nt - 2);
            const char* a1 = cA + (size_t)(t + 1) * kstep;
            const char* a2 = last ? nA : cA + (size_t)(t + 2) * kstep; const char* b2 = last ? nB : cB + (size_t)(t + 2) * kstep;
            const char* a3 = a2 + kstep; const char* b3 = b2 + kstep;
            PG8_LDB(B0, 0, 0); PG8_LDB(B1, 0, 1); PG8_SCHED; PG8_LDA(At, 0, 0); PG8_STAGE(PG8_SA(1, 1), a1 + hstepA, voffA);
            PG8_WAIT_V(8); PG8_WAIT_L(0); PG8_BAR; PG8_MMA(0, 0, At, B0); PG8_MMA(0, 1, At, B1); PG8_BAR; PG8_SCHED;
            PG8_LDA(At, 0, 1); PG8_STAGE(PG8_SB(0, 0), b2, voffB); PG8_STAGE(PG8_SB(0, 1), b2 + hstepB, voffB); PG8_STAGE(PG8_SA(0, 0), a2, voffA);
            PG8_WAIT_V(8); PG8_WAIT_L(0); PG8_BAR; PG8_MMA(1, 0, At, B0); PG8_MMA(1, 1, At, B1); PG8_BAR; PG8_SCHED;
            PG8_LDB(B0, 1, 0); PG8_LDB(B1, 1, 1); PG8_SCHED; PG8_LDA(At, 1, 0); PG8_STAGE(PG8_SA(0, 1), a2 + hstepA, voffA);
            PG8_WAIT_V(8); PG8_WAIT_L(0); PG8_BAR; PG8_MMA(0, 0, At, B0); PG8_MMA(0, 1, At, B1); PG8_BAR; PG8_SCHED;
            PG8_LDA(At, 1, 1); PG8_STAGE(PG8_SB(1, 0), b3, voffB); PG8_STAGE(PG8_SB(1, 1), b3 + hstepB, voffB); PG8_STAGE(PG8_SA(1, 0), a3, voffA);
            PG8_WAIT_V(8); PG8_WAIT_L(0); PG8_BAR; PG8_MMA(1, 0, At, B0); PG8_MMA(1, 1, At, B1); PG8_BAR; PG8_SCHED;
        }
        if constexpr (ALIGN_EPI) { if (wr == 0) PG8_BAR; }
        if constexpr (I8) {
            static_assert(Epi::PERM, "the int8 path dequantises in the PERM column layout");
            const float* sa = S.sa(cur) + wr * 64 + fr; const float* sb = S.sb(cur) + wc * 32 + 8 * fq;
            f32x4 sbv[2][2];
#pragma unroll
            for (int b = 0; b < 2; ++b)
#pragma unroll
                for (int n = 0; n < 2; ++n) sbv[b][n] = *(const f32x4*)(sb + b * HALF + 4 * n);
#pragma unroll
            for (int a = 0; a < 2; ++a)
#pragma unroll
                for (int m = 0; m < 4; ++m) { const float sr = sa[a * HALF + m * 16];
#pragma unroll
                    for (int b = 0; b < 2; ++b)
#pragma unroll
                        for (int n = 0; n < 2; ++n) { const i32x4 iv = __builtin_bit_cast(i32x4, acc[a][b][m][n]);
                            acc[a][b][m][n] = (f32x4){(float)iv[0], (float)iv[1], (float)iv[2], (float)iv[3]} * (sbv[b][n] * sr); } }
        }
        E(acc, cur, wr, wc, fr, fq);
        if (!has_next) break;
#pragma unroll
        for (int a = 0; a < 2; ++a)
#pragma unroll
            for (int b = 0; b < 2; ++b)
#pragma unroll
                for (int m = 0; m < 4; ++m)
#pragma unroll
                    for (int n = 0; n < 2; ++n) acc[a][b][m][n] = (f32x4){zf, zf, zf, zf};
        cur = nxt; cA = nA; cB = nB; ++ui;
        if constexpr (ALIGN_EPI) { if (wr == 1) PG8_BAR; }
    }
    PG8_WAIT_V(0);
    if constexpr (!ALIGN_EPI) { if (wr == 0) PG8_BAR; }
    PG8_BAR;
#undef PG8_SA
#undef PG8_SB
#undef PG8_STAGE
#undef PG8_LDA
#undef PG8_LDB
#undef PG8_MMA
#undef PG8_WAIT_V
#undef PG8_WAIT_L
#undef PG8_BAR
#undef PG8_SCHED
}

struct TileOrder {
    int nM, nN, pm0, G, c, nx, xpm, xpn0;
    const char* A; const char* B; size_t tstepA, tstepB; const float* SA; const float* SB;
    __device__ __forceinline__ const float* sa(const Unit& u) const { return SA + (size_t)u.pm * 256; }
    __device__ __forceinline__ const float* sb(const Unit& u) const { return SB + (size_t)u.pn * 256; }
    __device__ __forceinline__ bool next(int i, Unit& u) const {
        const int L = i * G + c, n1 = nM * nN;
        if (L < n1) { tile_of(L, nM, nN, u.pm, u.pn); u.pm += pm0; u.kind = 0; return true; }
        if (L < n1 + nx) { u.pm = xpm; u.pn = xpn0 + (L - n1); u.kind = 0; return true; }
        return false; }
    __device__ __forceinline__ const char* abase(const Unit& u) const { return A + (size_t)u.pm * tstepA; }
    __device__ __forceinline__ const char* bbase(const Unit& u) const { return B + (size_t)u.pn * tstepB; }
};
struct QkvOrder {
    int nMkv, nMq, pm0q, G, c; const char* QC; const char* WQB; long dkv;
    __device__ __forceinline__ bool next(int i, Unit& u) const {
        const int L = i * G + c, n1 = nMkv * 16;
        if (L < n1) { tile_of(L, nMkv, 16, u.pm, u.pn); u.kind = 0; return true; }
        if (L < n1 + nMq * 12) { tile_of(L - n1, nMq, 12, u.pm, u.pn); u.pm += pm0q; u.kind = 1; return true; }
        return false; }
    __device__ __forceinline__ const char* abase(const Unit& u) const { return QC + (size_t)u.pm * (256 * 1024 * 2) + (u.kind == 0 ? 1024 : 0); }
    __device__ __forceinline__ const char* bbase(const Unit& u) const { return WQB + (u.kind == 0 ? dkv : 0l) + (size_t)u.pn * (256 * 512 * 2); }
};
struct MoeOrder {
    int T, nN, G, c; const char* A; const char* B; size_t tstepA, tstepB, estride; const LAS int* te; const float* SA; const float* SB; int sbstride;
    __device__ __forceinline__ const float* sa(const Unit& u) const { return SA + (size_t)u.pm * 256; }
    __device__ __forceinline__ const float* sb(const Unit& u) const { const int e = __builtin_amdgcn_readfirstlane(te[u.pm]); return SB + (size_t)e * sbstride + (size_t)u.pn * 256; }
    __device__ __forceinline__ bool next(int i, Unit& u) const {
        const int L = i * G + c; if (L >= T * nN) return false;
        tile_of(L, T, nN, u.pm, u.pn); u.kind = 0; return true; }
    __device__ __forceinline__ const char* abase(const Unit& u) const { return A + (size_t)u.pm * tstepA; }
    __device__ __forceinline__ const char* bbase(const Unit& u) const { const int e = __builtin_amdgcn_readfirstlane(te[u.pm]); return B + (size_t)e * estride + (size_t)u.pn * tstepB; }
};

typedef const f32x4 (&AccRef)[2][2][4][2];
struct EpiInproj {
    static constexpr bool PERM = true;
    bf16* QC; bf16* KRB; bf16* U; bf16* CB; float* SSQ; const float* ROPE;
    __device__ __forceinline__ void operator()(AccRef acc, const Unit& u, int wr, int wc, int fr_, int fq_) const {
        int fr = fr_, fq = fq_; asm volatile("" : "+v"(fr), "+v"(fq));
        const int pn = u.pn, row0 = u.pm * BM + wr * 64 + fr;
        if (pn < 4) {
#pragma unroll
            for (int ai = 0; ai < 2; ++ai)
#pragma unroll
                for (int m = 0; m < 4; ++m) { const int row = row0 + ai * HALF + m * 16; float s = 0.f;
#pragma unroll
                    for (int bj = 0; bj < 2; ++bj) { const f32x4 v0 = acc[ai][bj][m][0], v1 = acc[ai][bj][m][1];
                        s += (v0[0] * v0[0] + v0[1] * v0[1]) + (v0[2] * v0[2] + v0[3] * v0[3]) + (v1[0] * v1[0] + v1[1] * v1[1]) + (v1[2] * v1[2] + v1[3] * v1[3]);
                        *(u32x4*)(QC + (size_t)row * 1024 + pn * 256 + bj * HALF + wc * 32 + 8 * fq) = pack8(v0, v1); }
                    s += __shfl_xor(s, 16); s += __shfl_xor(s, 32);
                    if (fq == 0) SSQ[(size_t)row * 16 + pn * 4 + wc] = s; }
        } else if (pn == 4) {
            if (wc < 2) {
#pragma unroll
                for (int ai = 0; ai < 2; ++ai)
#pragma unroll
                    for (int m = 0; m < 4; ++m) { const int row = row0 + ai * HALF + m * 16; f32x4 v0 = acc[ai][0][m][0], v1 = acc[ai][0][m][1];
                        if (row >= LC) { const int t = row - LC, pos = wc ? (t & 63) : (t >> 6);
                            const f32x4 cs = *(const f32x4*)(ROPE + pos * 16 + 4 * fq), sn = *(const f32x4*)(ROPE + 2048 + pos * 16 + 4 * fq);
                            const f32x4 a0 = v0, a1 = v1;
                            v0[0] = a0[0] * cs[0] - a0[1] * sn[0]; v0[1] = a0[1] * cs[0] + a0[0] * sn[0]; v0[2] = a0[2] * cs[1] - a0[3] * sn[1]; v0[3] = a0[3] * cs[1] + a0[2] * sn[1];
                            v1[0] = a1[0] * cs[2] - a1[1] * sn[2]; v1[1] = a1[1] * cs[2] + a1[0] * sn[2]; v1[2] = a1[2] * cs[3] - a1[3] * sn[3]; v1[3] = a1[3] * cs[3] + a1[2] * sn[3]; }
                        *(u32x4*)(KRB + (size_t)row * 64 + wc * 32 + 8 * fq) = pack8(v0, v1); }
            }
        } else if (pn < 21) {
            const int j = pn - 5;
#pragma unroll
            for (int ai = 0; ai < 2; ++ai)
#pragma unroll
                for (int m = 0; m < 4; ++m) { const int row = row0 + ai * HALF + m * 16;
                    *(u32x4*)(U + (size_t)row * D + j * 128 + wc * 32 + 8 * fq) = pack8(acc[ai][0][m][0] * acc[ai][1][m][0], acc[ai][0][m][1] * acc[ai][1][m][1]); }
        } else {
            bf16* dst = CB + (size_t)((pn - 21) >> 3) * ((size_t)MT * D); const int col = ((pn - 21) & 7) * 256; const bool sg = pn >= 29;
#pragma unroll
            for (int ai = 0; ai < 2; ++ai)
#pragma unroll
                for (int m = 0; m < 4; ++m) { const int row = row0 + ai * HALF + m * 16;
#pragma unroll
                    for (int bj = 0; bj < 2; ++bj) { f32x4 v0 = acc[ai][bj][m][0], v1 = acc[ai][bj][m][1];
                        if (sg) { v0 = fsig4(v0); v1 = fsig4(v1); }
                        *(u32x4*)(dst + (size_t)row * D + col + bj * HALF + wc * 32 + 8 * fq) = pack8(v0, v1); } }
        }
    }
};
struct EpiQkv {
    static constexpr bool PERM = true;
    bf16* Q; bf16* KV; const float* SSQ; const float* ROPE;
    __device__ __forceinline__ void operator()(AccRef acc, const Unit& u, int wr, int wc, int fr_, int fq_) const {
        int fr = fr_, fq = fq_; asm volatile("" : "+v"(fr), "+v"(fq));
        const int row0 = u.pm * BM + wr * 64 + fr, grp = u.kind == 0 ? 8 : 0;
#pragma unroll
        for (int ai = 0; ai < 2; ++ai)
#pragma unroll
            for (int m = 0; m < 4; ++m) { const int row = row0 + ai * HALF + m * 16;
                const f32x4 s0 = *(const f32x4*)(SSQ + (size_t)row * 16 + grp), s1 = *(const f32x4*)(SSQ + (size_t)row * 16 + grp + 4);
                const float rs = rsqrtf(((s0[0] + s0[1]) + (s0[2] + s0[3]) + (s1[0] + s1[1]) + (s1[2] + s1[3])) * (1.f / 512.f) + EPS);
                const float rq = (u.kind == 0) ? rs : rs * (ATT_SCALE * 1.4426950408889634f);
#pragma unroll
                for (int bj = 0; bj < 2; ++bj) { f32x4 v0 = acc[ai][bj][m][0] * rq, v1 = acc[ai][bj][m][1] * rq;
                    if (u.kind == 0) { *(u32x4*)(KV + (size_t)row * 4096 + u.pn * 256 + bj * HALF + wc * 32 + 8 * fq) = pack8(v0, v1); }
                    else { const int hb = (u.pn * 8 + bj * 4 + wc) % 6;
                        if (hb >= 4 && row >= LC) { const int t = row - LC, pos = (hb == 5) ? (t & 63) : (t >> 6);
                            const f32x4 cs = *(const f32x4*)(ROPE + pos * 16 + 4 * fq), sn = *(const f32x4*)(ROPE + 2048 + pos * 16 + 4 * fq);
                            const f32x4 a0 = v0, a1 = v1;
                            v0[0] = a0[0] * cs[0] - a0[1] * sn[0]; v0[1] = a0[1] * cs[0] + a0[0] * sn[0]; v0[2] = a0[2] * cs[1] - a0[3] * sn[1]; v0[3] = a0[3] * cs[1] + a0[2] * sn[1];
                            v1[0] = a1[0] * cs[2] - a1[1] * sn[2]; v1[1] = a1[1] * cs[2] + a1[0] * sn[2]; v1[2] = a1[2] * cs[3] - a1[3] * sn[3]; v1[3] = a1[3] * cs[3] + a1[2] * sn[3]; }
                        *(u32x4*)(Q + (size_t)row * 3072 + u.pn * 256 + bj * HALF + wc * 32 + 8 * fq) = pack8(v0, v1); } } }
    }
};
template <int MODE> struct EpiMerge {
    static constexpr bool PERM = true;
    const bf16* SG; const bf16* M1; bf16* OUT;
    __device__ __forceinline__ void operator()(AccRef acc, const Unit& u, int wr, int wc, int fr_, int fq_) const {
        int fr = fr_, fq = fq_; asm volatile("" : "+v"(fr), "+v"(fq));
        const int row0 = u.pm * BM + wr * 64 + fr;
#pragma unroll
        for (int ai = 0; ai < 2; ++ai)
#pragma unroll
            for (int m = 0; m < 4; ++m) { const int row = row0 + ai * HALF + m * 16;
#pragma unroll
                for (int bj = 0; bj < 2; ++bj) { const size_t off = (size_t)row * D + u.pn * 256 + bj * HALF + wc * 32 + 8 * fq;
                    f32x4 g0, g1; unpack8(*(const u32x4*)(SG + off), g0, g1);
                    f32x4 v0 = acc[ai][bj][m][0] * g0, v1 = acc[ai][bj][m][1] * g1;
                    if (MODE == 1) { f32x4 m0, m1; unpack8(*(const u32x4*)(M1 + off), m0, m1); v0 += m0; v1 += m1; }
                    *(u32x4*)(OUT + off) = pack8(v0, v1); } }
    }
};
struct EpiSwiglu {
    static constexpr bool PERM = true;
    bf16* ACT; int ld;
    __device__ __forceinline__ void operator()(AccRef acc, const Unit& u, int wr, int wc, int fr_, int fq_) const {
        int fr = fr_, fq = fq_; asm volatile("" : "+v"(fr), "+v"(fq));
        const int row0 = u.pm * BM + wr * 64 + fr;
#pragma unroll
        for (int ai = 0; ai < 2; ++ai)
#pragma unroll
            for (int m = 0; m < 4; ++m) { const int row = row0 + ai * HALF + m * 16;
                const f32x4 g0 = acc[ai][0][m][0], g1 = acc[ai][0][m][1];
                const f32x4 v0 = g0 * fsig4(g0) * acc[ai][1][m][0], v1 = g1 * fsig4(g1) * acc[ai][1][m][1];
                *(u32x4*)(ACT + (size_t)row * ld + u.pn * 128 + wc * 32 + 8 * fq) = pack8(v0, v1); }
    }
};
struct EpiResid {
    static constexpr bool PERM = false;
    float* XL; const float* SRC; const float* gl;
    __device__ __forceinline__ void operator()(AccRef acc, const Unit& u, int wr, int wc, int fr_, int fq_) const {
        int fr = fr_, fq = fq_; asm volatile("" : "+v"(fr), "+v"(fq));
        const int row0 = u.pm * BM + wr * 64 + fr; const float* gate = gl + ((u.pm == 0) ? 6 * D : 0);
#pragma unroll
        for (int bj = 0; bj < 2; ++bj)
#pragma unroll
            for (int n = 0; n < 2; ++n) { const int col = u.pn * 256 + bj * HALF + wc * 32 + 16 * n + 4 * fq; const f32x4 gv = *(const f32x4*)(gate + col);
#pragma unroll
                for (int ai = 0; ai < 2; ++ai)
#pragma unroll
                    for (int m = 0; m < 4; ++m) { const size_t o = (size_t)(row0 + ai * HALF + m * 16) * D + col; *(f32x4*)(XL + o) = *(const f32x4*)(SRC + o) + gv * acc[ai][bj][m][n]; } }
    }
};
struct EpiStoreBf16 {
    static constexpr bool PERM = true;
    bf16* C; int ld;
    __device__ __forceinline__ void operator()(AccRef acc, const Unit& u, int wr, int wc, int fr_, int fq_) const {
        int fr = fr_, fq = fq_; asm volatile("" : "+v"(fr), "+v"(fq));
        const int row0 = u.pm * BM + wr * 64 + fr;
#pragma unroll
        for (int ai = 0; ai < 2; ++ai)
#pragma unroll
            for (int m = 0; m < 4; ++m)
#pragma unroll
                for (int bj = 0; bj < 2; ++bj)
                    *(u32x4*)(C + (size_t)(row0 + ai * HALF + m * 16) * ld + u.pn * 256 + bj * HALF + wc * 32 + 8 * fq) = pack8(acc[ai][bj][m][0], acc[ai][bj][m][1]);
    }
};
}

namespace att {
constexpr int QBLK = 32, KVBLK = 64;
constexpr int LDQ = NH * DQK, LDK = NH * 256, LDR = DR, LDO = D;
constexpr int SHM_V = KVBLK * DV * 2, SHM_K = KVBLK * DQK * 2;
constexpr int OFF_K = 2 * SHM_V, OFF_WS = 2 * SHM_V + 2 * SHM_K, OFF_QR = OFF_WS + NWAVES * 64 * 4, OFF_DO = OFF_QR + NWAVES * 4096, SHM_ATTN = OFF_DO + NTHREADS * 20;
static_assert(SHM_ATTN <= RING_BYTES, "attention scratch inside the ring");
constexpr float THR = 8.f;
constexpr int KROPE_OFF = 16384;
#define KSWZ(row, colB) ((row) * 384 + ((colB) ^ (((row) & 7) << 4)))
#define SBAR() __builtin_amdgcn_sched_barrier(0)
__device__ __forceinline__ int crow(int r, int hi) { return (r & 3) + 8 * (r >> 2) + 4 * hi; }
constexpr float THR2 = THR * 1.4426950408889634f;
template <bool FIRST> __device__ __forceinline__ void partialSM(f32x16& p0, f32x16& p1, float& m_reg, f32x16& negm, float& alpha) {
    float pmax = p0[0];
#pragma unroll
    for (int r = 1; r < 16; ++r) pmax = fmaxf(pmax, p0[r]);
#pragma unroll
    for (int r = 0; r < 16; ++r) pmax = fmaxf(pmax, p1[r]);
    { auto rr = __builtin_amdgcn_permlane32_swap(__float_as_uint(pmax), __float_as_uint(pmax), false, false);
      pmax = fmaxf(__uint_as_float(rr[0]), __uint_as_float(rr[1])); }
    alpha = 1.f;
    if (FIRST || !__builtin_expect(__all(pmax <= THR2), 1)) {
        const float d = FIRST ? pmax : fmaxf(pmax, 0.f);
        m_reg += d; if (!FIRST) alpha = __builtin_amdgcn_exp2f(-d);
#pragma unroll
        for (int r = 0; r < 16; ++r) { p0[r] -= d; p1[r] -= d; }
#pragma unroll
        for (int r = 0; r < 16; ++r) negm[r] = -m_reg;
    }
#pragma unroll
    for (int r = 0; r < 16; ++r) p0[r] = __builtin_amdgcn_exp2f(p0[r]);
}
__device__ __forceinline__ void finishSM(f32x16& p0, f32x16& p1, float alpha, float& l_reg, bf16x8& pa0, bf16x8& pa1, bf16x8& pa2, bf16x8& pa3) {
#pragma unroll
    for (int r = 0; r < 16; ++r) p1[r] = __builtin_amdgcn_exp2f(p1[r]);
    float ps = 0;
#pragma unroll
    for (int r = 0; r < 16; ++r) ps += p0[r];
#pragma unroll
    for (int r = 0; r < 16; ++r) ps += p1[r];
    { auto rr = __builtin_amdgcn_permlane32_swap(__float_as_uint(ps), __float_as_uint(ps), false, false);
      ps = __uint_as_float(rr[0]) + __uint_as_float(rr[1]); }
    l_reg = l_reg * alpha + ps;
#define PK4(P, BASE, OUT) do { u32x4 w = {cvtpk(P[BASE + 0], P[BASE + 1]), cvtpk(P[BASE + 2], P[BASE + 3]), cvtpk(P[BASE + 4], P[BASE + 5]), cvtpk(P[BASE + 6], P[BASE + 7])}; \
    OUT = __builtin_bit_cast(bf16x8, w); } while (0)
    PK4(p0, 0, pa0); PK4(p0, 8, pa1); PK4(p1, 0, pa2); PK4(p1, 8, pa3);
#undef PK4
}
__device__ __forceinline__ void qkt(f32x16& p0, f32x16& p1, const LAS char* Ks, const int (&kb)[4], int krd, const bf16x8* qr, const LAS char* qrl, const f32x16& negm) {
#pragma unroll
    for (int d0 = 0; d0 < 12; ++d0) {
        const LAS char* a = d0 < 8 ? Ks + kb[d0 & 3] + (d0 >> 2) * 128 : Ks + kb[d0 - 8] + krd;
        const bf16x8 b0 = *(const LAS bf16x8*)a;
        const bf16x8 b1 = *(const LAS bf16x8*)(a + (d0 < 8 ? 32 * 256 : 32 * 128));
        if (d0 == 0) { p0 = __builtin_amdgcn_mfma_f32_32x32x16_bf16(b0, qr[0], negm, 0, 0, 0); p1 = __builtin_amdgcn_mfma_f32_32x32x16_bf16(b1, qr[0], negm, 0, 0, 0); }
        else { const bf16x8 qf = d0 < 8 ? qr[d0 & 7] : *(const LAS bf16x8*)(qrl + (d0 - 8) * 1024);
            p0 = __builtin_amdgcn_mfma_f32_32x32x16_bf16(b0, qf, p0, 0, 0, 0); p1 = __builtin_amdgcn_mfma_f32_32x32x16_bf16(b1, qf, p1, 0, 0, 0); } }
}
template <int OFF> __device__ __forceinline__ bf16x8 dsr128(int addr) { bf16x8 r; asm volatile("ds_read_b128 %0, %1 offset:%2" : "=v"(r) : "v"(addr), "i"(OFF) : "memory"); return r; }
#define QK_WAIT(n) do { asm volatile("s_waitcnt lgkmcnt(" #n ")" ::: "memory"); SBAR(); } while (0)
template <int SLOT> __device__ __forceinline__ void qkt2(f32x16& p0, f32x16& p1, const int (&nb)[4], const int (&rb)[4], int qrl, const bf16x8* qr, const f32x16& negm) {
    constexpr int S = SLOT * SHM_K;
    bf16x8 a0, a1, b0, b1, qa, qb;
#define RD_N(s, K0, K1) do { K0 = dsr128<S + ((s) >> 2) * 128>(nb[(s) & 3]); K1 = dsr128<S + ((s) >> 2) * 128 + 8192>(nb[(s) & 3]); } while (0)
#define RD_R(s, K0, K1, Q) do { K0 = dsr128<S + KROPE_OFF>(rb[(s) - 8]); K1 = dsr128<S + KROPE_OFF + 4096>(rb[(s) - 8]); Q = dsr128<((s) - 8) * 1024>(qrl); } while (0)
#define MM(K0, K1, Q) do { p0 = __builtin_amdgcn_mfma_f32_32x32x16_bf16(K0, Q, p0, 0, 0, 0); p1 = __builtin_amdgcn_mfma_f32_32x32x16_bf16(K1, Q, p1, 0, 0, 0); SBAR(); } while (0)
    RD_N(0, a0, a1); RD_N(1, b0, b1);
    QK_WAIT(2); p0 = __builtin_amdgcn_mfma_f32_32x32x16_bf16(a0, qr[0], negm, 0, 0, 0); p1 = __builtin_amdgcn_mfma_f32_32x32x16_bf16(a1, qr[0], negm, 0, 0, 0); SBAR(); RD_N(2, a0, a1);
    QK_WAIT(2); MM(b0, b1, qr[1]); RD_N(3, b0, b1);
    QK_WAIT(2); MM(a0, a1, qr[2]); RD_N(4, a0, a1);
    QK_WAIT(2); MM(b0, b1, qr[3]); RD_N(5, b0, b1);
    QK_WAIT(2); MM(a0, a1, qr[4]); RD_N(6, a0, a1);
    QK_WAIT(2); MM(b0, b1, qr[5]); RD_N(7, b0, b1);
    QK_WAIT(2); MM(a0, a1, qr[6]); RD_R(8, a0, a1, qa);
    QK_WAIT(3); MM(b0, b1, qr[7]); RD_R(9, b0, b1, qb);
    QK_WAIT(3); MM(a0, a1, qa); RD_R(10, a0, a1, qa);
    QK_WAIT(3); MM(b0, b1, qb); RD_R(11, b0, b1, qb);
    QK_WAIT(3); MM(a0, a1, qa);
    QK_WAIT(0); MM(b0, b1, qb);
#undef RD_N
#undef RD_R
#undef MM
}
__device__ __forceinline__ int v_st(int k, int c) { const int kk = (k & ~0xC) | ((k & 4) << 1) | ((k & 8) >> 1); return ((kk >> 3) * 4 + (c >> 5)) * 512 + ((kk & 7) * 32 + (c & 31)) * 2; }
__device__ __forceinline__ int v_rd_base(int lane) { return ((lane & 3) << 3) | (((lane >> 2) & 3) << 6) | (((lane >> 4) & 1) << 5) | (((lane >> 5) & 1) << 8); }
constexpr int v_rd_off(int d0, int ks, int half) { return d0 * 512 + ks * 4096 + half * 2048; }
template <int OFF> __device__ __forceinline__ s16x4 tr_read(int vb) {
    s16x4 r; asm volatile("ds_read_b64_tr_b16 %0, %1 offset:%2" : "=&v"(r) : "v"(vb), "i"(OFF) : "memory"); return r;
}
template <int D0> __device__ __forceinline__ void pv_one(f32x16& od, int vb, bf16x8 pa0, bf16x8 pa1, bf16x8 pa2, bf16x8 pa3) {
    const s16x4 l0 = tr_read<v_rd_off(D0, 0, 0)>(vb), h0 = tr_read<v_rd_off(D0, 0, 1)>(vb), l1 = tr_read<v_rd_off(D0, 1, 0)>(vb), h1 = tr_read<v_rd_off(D0, 1, 1)>(vb);
    const s16x4 l2 = tr_read<v_rd_off(D0, 2, 0)>(vb), h2 = tr_read<v_rd_off(D0, 2, 1)>(vb), l3 = tr_read<v_rd_off(D0, 3, 0)>(vb), h3 = tr_read<v_rd_off(D0, 3, 1)>(vb);
    asm volatile("s_waitcnt lgkmcnt(0)" ::: "memory"); SBAR();
#define PK(L, H) (bf16x8){L[0], L[1], L[2], L[3], H[0], H[1], H[2], H[3]}
    od = __builtin_amdgcn_mfma_f32_32x32x16_bf16(PK(l0, h0), pa0, od, 0, 0, 0);
    od = __builtin_amdgcn_mfma_f32_32x32x16_bf16(PK(l1, h1), pa1, od, 0, 0, 0);
    od = __builtin_amdgcn_mfma_f32_32x32x16_bf16(PK(l2, h2), pa2, od, 0, 0, 0);
    od = __builtin_amdgcn_mfma_f32_32x32x16_bf16(PK(l3, h3), pa3, od, 0, 0, 0);
#undef PK
}
__device__ __forceinline__ void pv_d0(f32x16* o, int vb, bf16x8 pa0, bf16x8 pa1, bf16x8 pa2, bf16x8 pa3) {
    pv_one<0>(o[0], vb, pa0, pa1, pa2, pa3); pv_one<1>(o[1], vb, pa0, pa1, pa2, pa3); pv_one<2>(o[2], vb, pa0, pa1, pa2, pa3); pv_one<3>(o[3], vb, pa0, pa1, pa2, pa3);
}
__device__ __forceinline__ void attn_unit(const bf16* Qb, const bf16* KVb, int hoff, const bf16* KRb, bf16* Ob, int seq, LAS char* lds) {
    int tid = threadIdx.x; asm volatile("" : "+v"(tid));
    const int wid = __builtin_amdgcn_readfirstlane(tid >> 6), lane = tid & 63, r32 = lane & 31, hi = lane >> 5;
    LAS char* V_lds = lds; LAS char* K_lds = lds + OFF_K;
        float m_reg = 0.f, l_reg = 0; f32x16 o[4]; bf16x8 qr[8]; f32x16 negm;
#pragma unroll
    for (int r = 0; r < 16; ++r) negm[r] = 0.f;
#pragma unroll
    for (int d = 0; d < 4; ++d)
#pragma unroll
        for (int r = 0; r < 16; ++r) o[d][r] = 0.f;
    const bf16* Qw = Qb + (long)(wid * QBLK + r32) * LDQ + hi * 8;
#pragma unroll
    for (int d0 = 0; d0 < 8; ++d0) qr[d0] = *(const bf16x8*)(Qw + d0 * 16);
    LAS char* qrl = lds + OFF_QR + wid * 4096 + lane * 16;
#pragma unroll
    for (int d0 = 8; d0 < 12; ++d0) *(LAS bf16x8*)(qrl + (d0 - 8) * 1024) = *(const bf16x8*)(Qw + d0 * 16);
    int kb[4];
#pragma unroll
    for (int i = 0; i < 4; ++i) kb[i] = r32 * 256 + (((2 * i + hi) ^ (r32 & 7)) << 4);
    const int krd = KROPE_OFF - r32 * 128; (void)krd;
    int nbase[4], rbase[4];
#pragma unroll
    for (int i = 0; i < 4; ++i) { nbase[i] = (int)(uintptr_t)K_lds + kb[i]; rbase[i] = nbase[i] - r32 * 128; }
    const int vb0 = (int)(uintptr_t)V_lds + v_rd_base(lane);
    unsigned gk[2], gv[2], gr;
#pragma unroll
    for (int i = 0; i < 2; ++i) { const int s = (wid + 8 * i) * 64 + lane;
        { const int row = s >> 4, lc = (s & 15) ^ (row & 7); gk[i] = (unsigned)(row * (LDK * 2) + lc * 16); }
        { const int st = s >> 5, k = (st >> 2) * 8 + ((s & 31) >> 2), cc = (st & 3) * 32 + (s & 3) * 8; gv[i] = (unsigned)(k * (LDK * 2) + cc * 2); } }
    { const int s = wid * 64 + lane, row = s >> 3, lc = (s & 7) ^ (row & 7); gr = (unsigned)(row * (LDR * 2) + lc * 16); }
    LAS u32x4* dofs = (LAS u32x4*)(lds + OFF_DO + tid * 16); LAS unsigned* dofr = (LAS unsigned*)(lds + OFF_DO + NTHREADS * 16 + tid * 4);
    *dofs = (u32x4){gk[0], gk[1], gv[0], gv[1]}; *dofr = gr;
    const unsigned ldsw = (unsigned)wid * 1024u;
    const __amdgpu_buffer_rsrc_t rkv = __builtin_amdgcn_make_buffer_rsrc((void*)KVb, 0, (int)((size_t)MT * LDK * 2), 0x00020000);
    const __amdgpu_buffer_rsrc_t rkr = __builtin_amdgcn_make_buffer_rsrc((void*)KRb, 0, (int)((size_t)MT * LDR * 2), 0x00020000);
#define DMA_K(t, slot) do { const int ko_ = (t) * (KVBLK * LDK * 2) + hoff, ro_ = (t) * (KVBLK * LDR * 2); const u32x4 of_ = *dofs; const unsigned gr_ = *dofr; \
    __builtin_amdgcn_raw_ptr_buffer_load_lds(rkv, (LAS void*)(K_lds + (slot) * SHM_K + ldsw), 16, (int)of_.x, ko_, 0, 0); \
    __builtin_amdgcn_raw_ptr_buffer_load_lds(rkv, (LAS void*)(K_lds + (slot) * SHM_K + 8192 + ldsw), 16, (int)of_.y, ko_, 0, 0); \
    __builtin_amdgcn_raw_ptr_buffer_load_lds(rkr, (LAS void*)(K_lds + (slot) * SHM_K + KROPE_OFF + ldsw), 16, (int)gr_, ro_, 0, 0); } while (0)
#define DMA_V(t, slot) do { const int vo_ = (t) * (KVBLK * LDK * 2) + hoff + DN * 2; const u32x4 of_ = *dofs; \
    __builtin_amdgcn_raw_ptr_buffer_load_lds(rkv, (LAS void*)(V_lds + (slot) * SHM_V + ldsw), 16, (int)of_.z, vo_, 0, 0); \
    __builtin_amdgcn_raw_ptr_buffer_load_lds(rkv, (LAS void*)(V_lds + (slot) * SHM_V + 8192 + ldsw), 16, (int)of_.w, vo_, 0, 0); } while (0)
#define WAITBAR() asm volatile("s_waitcnt vmcnt(0) lgkmcnt(0)\n\ts_barrier" ::: "memory")
#define RESC(a) do { if (__any((a) < 1.f)) { \
    _Pragma("unroll") for (int d = 0; d < 4; ++d) _Pragma("unroll") for (int r = 0; r < 16; ++r) o[d][r] *= (a); } } while (0)
    f32x16 pA0, pA1, pB0, pB1; float alA, alB; bf16x8 pa0, pa1, pa2, pa3; const int NT = seq / KVBLK;
    if (wid >= 4) __builtin_amdgcn_s_setprio(1);
    DMA_K(0, 0); DMA_V(0, 0); WAITBAR();
    DMA_K(1, 1);
    att::qkt2<0>(pA0, pA1, nbase, rbase, (int)(uintptr_t)qrl, qr, negm); partialSM<true>(pA0, pA1, m_reg, negm, alA);
    WAITBAR();
    for (int j = 1; j + 1 < NT; j += 2) {
        DMA_K(j + 1, 0); DMA_V(j, 1);
        SBAR(); att::qkt2<1>(pB0, pB1, nbase, rbase, (int)(uintptr_t)qrl, qr, negm);
        finishSM(pA0, pA1, alA, l_reg, pa0, pa1, pa2, pa3); SBAR();
        pv_d0(o, vb0, pa0, pa1, pa2, pa3); partialSM<false>(pB0, pB1, m_reg, negm, alB);
        RESC(alB); WAITBAR();
        DMA_K(j + 2, 1); DMA_V(j + 1, 0);
        SBAR(); att::qkt2<0>(pA0, pA1, nbase, rbase, (int)(uintptr_t)qrl, qr, negm);
        finishSM(pB0, pB1, alB, l_reg, pa0, pa1, pa2, pa3); SBAR();
        pv_d0(o, vb0 + SHM_V, pa0, pa1, pa2, pa3); partialSM<false>(pA0, pA1, m_reg, negm, alA);
        RESC(alA); WAITBAR();
    }
    DMA_V(NT - 1, 1);
    SBAR(); att::qkt2<1>(pB0, pB1, nbase, rbase, (int)(uintptr_t)qrl, qr, negm);
    finishSM(pA0, pA1, alA, l_reg, pa0, pa1, pa2, pa3); SBAR();
    pv_d0(o, vb0, pa0, pa1, pa2, pa3); partialSM<false>(pB0, pB1, m_reg, negm, alB);
    RESC(alB); WAITBAR();
    finishSM(pB0, pB1, alB, l_reg, pa0, pa1, pa2, pa3); SBAR();
    pv_d0(o, vb0 + SHM_V, pa0, pa1, pa2, pa3);
    const float rli = __builtin_amdgcn_rcpf(l_reg);
    WAITBAR();
    LAS char* stg = lds + wid * 8704 + r32 * 272 + hi * 8;
#pragma unroll
    for (int d0 = 0; d0 < 4; ++d0)
#pragma unroll
        for (int g = 0; g < 4; ++g) { u32x2 w; w.x = cvtpk(o[d0][4 * g] * rli, o[d0][4 * g + 1] * rli); w.y = cvtpk(o[d0][4 * g + 2] * rli, o[d0][4 * g + 3] * rli);
            *(LAS u32x2*)(stg + (32 * d0 + 8 * g) * 2) = w; }
    asm volatile("s_waitcnt lgkmcnt(0)" ::: "memory");
    bf16* Ow = Ob + (long)(wid * QBLK) * LDO;
#pragma unroll
    for (int i = 0; i < 8; ++i) { const int row = i * 4 + (lane >> 4), ch = lane & 15; const u32x4 v = *(const LAS u32x4*)(lds + wid * 8704 + row * 272 + ch * 16); *(u32x4*)(Ow + (long)row * LDO + ch * 8) = v; }
    WAITBAR();
    __builtin_amdgcn_s_setprio(0);
#undef DMA_K
#undef DMA_V
#undef WAITBAR
#undef RESC
}
#undef KSWZ
#undef SBAR
}

#define XB_TMO      128
#define XB_XCNT(j)  (256  + 64 * (j))
#define XB_XSUB(j)  (1280 + 64 * (j))
#define XB_XGEN(j)  (2304 + 64 * (j))
#define XB_TOP      3328
#define XB_TOPGEN   3392
#define XCD_BAR_WORDS 3456
#define XB_SPIN_CAP (1u << 18)
__device__ __forceinline__ unsigned xb_ld(unsigned* p)              { return __hip_atomic_load(p, __ATOMIC_RELAXED, __HIP_MEMORY_SCOPE_AGENT); }
__device__ __forceinline__ unsigned xb_add(unsigned* p, unsigned v) { return __hip_atomic_fetch_add(p, v, __ATOMIC_RELAXED, __HIP_MEMORY_SCOPE_AGENT); }
__device__ __forceinline__ unsigned xb_xcc_id() { return (unsigned)__builtin_amdgcn_s_getreg((3 << 11) | 20) & 0xFu; }
#define XB_SPIN(cond, bar) do { unsigned _sp = 0; while (cond) { __builtin_amdgcn_s_sleep(1); \
    if ((++_sp & 255u) == 0u) { if (xb_ld(&(bar)[XB_TMO])) break; if (_sp > XB_SPIN_CAP) { atomicAdd(&(bar)[XB_TMO], 1u); break; } } } } while (0)
struct XcdBarrier { unsigned* bar; unsigned x; volatile LAS unsigned* st; };
__device__ __forceinline__ XcdBarrier xcd_barrier_post(unsigned* bar, volatile LAS unsigned* st) {
    XcdBarrier b; b.bar = bar; b.x = xb_xcc_id(); b.st = st;
    if (threadIdx.x == 0) (void)xb_add(&bar[XB_XCNT(b.x)], 1u);
    return b;
}
__device__ __forceinline__ void xcd_barrier_complete(unsigned* bar, unsigned x, unsigned& nloc, unsigned& nx) {
    const unsigned G = gridDim.x * gridDim.y * gridDim.z;
    unsigned sum, cnt, mine, sp = 0u;
    for (;;) {
        sum = 0u; cnt = 0u; mine = 0u;
#pragma unroll
        for (unsigned j = 0; j < 16; ++j) { const unsigned c = xb_ld(&bar[XB_XCNT(j)]); sum += c; cnt += (c > 0u) ? 1u : 0u; mine = (j == x) ? c : mine; }
        if (sum == G) break;
        __builtin_amdgcn_s_sleep(1);
        if ((++sp & 255u) == 0u) { if (xb_ld(&bar[XB_TMO])) break; if (sp > XB_SPIN_CAP) { atomicAdd(&bar[XB_TMO], 1u); break; } }
    }
    nloc = mine > 0u ? mine : 1u; nx = cnt > 0u ? cnt : 1u;
}
__device__ __forceinline__ void xcd_barrier(const XcdBarrier& b) {
    asm volatile("s_waitcnt vmcnt(0)" ::: "memory");
    __syncthreads();
    if (threadIdx.x == 0) {
        unsigned* bar = b.bar;
        __builtin_amdgcn_s_waitcnt(0);
        unsigned nloc = b.st[0], nx = b.st[1];
        if (nloc == 0u) { xcd_barrier_complete(bar, b.x, nloc, nx); b.st[0] = nloc; b.st[1] = nx; }
        const unsigned old = xb_add(&bar[XB_XSUB(b.x)], 1u);
        const unsigned gen = old / nloc;
        if (old + 1u == (gen + 1u) * nloc) {
            __builtin_amdgcn_fence(__ATOMIC_RELEASE, "agent");
            asm volatile("s_waitcnt vmcnt(0)" ::: "memory");
            const unsigned og = xb_add(&bar[XB_TOP], 1u);
            const unsigned tg = og / nx;
            if (og + 1u == (tg + 1u) * nx) xb_add(&bar[XB_TOPGEN], 1u);
            else XB_SPIN(xb_ld(&bar[XB_TOPGEN]) == tg, bar);
            __builtin_amdgcn_fence(__ATOMIC_ACQUIRE, "agent");
            xb_add(&bar[XB_XGEN(b.x)], 1u);
            asm volatile("s_waitcnt vmcnt(0)" ::: "memory");
        } else {
            XB_SPIN(xb_ld(&bar[XB_XGEN(b.x)]) == gen, bar);
            __builtin_amdgcn_fence(__ATOMIC_ACQUIRE, "agent");
            asm volatile("s_waitcnt vmcnt(0)" ::: "memory");
        }
    }
    __syncthreads();
}

struct Params { const float* in[25]; float* out; unsigned char* ws; int ph_lo, ph_hi; };
static_assert(sizeof(Params) == 25 * 8 + 8 + 8 + 8, "Params has no padding");
struct Ctx { LAS unsigned char* lds; int tid, lane, wave, vcu, G, bid; };
__device__ __forceinline__ Ctx fresh(const Ctx& c) {
    Ctx f; f.lds = c.lds; int tid = c.tid; asm volatile("" : "+v"(tid)); f.tid = tid; f.lane = tid & 63; f.wave = __builtin_amdgcn_readfirstlane(tid >> 6);
    int vcu = c.vcu, G = c.G, bid = c.bid; asm volatile("" : "+v"(vcu), "+v"(G), "+v"(bid));
    f.vcu = __builtin_amdgcn_readfirstlane(vcu); f.G = __builtin_amdgcn_readfirstlane(G); f.bid = __builtin_amdgcn_readfirstlane(bid); return f; }
__device__ __forceinline__ unsigned char* fresh_ptr(unsigned char* p) { unsigned lo = (unsigned)(unsigned long long)p, hi = (unsigned)((unsigned long long)p >> 32); asm volatile("" : "+v"(lo), "+v"(hi));
    const unsigned long long v = ((unsigned long long)(unsigned)__builtin_amdgcn_readfirstlane((int)hi) << 32) | (unsigned)__builtin_amdgcn_readfirstlane((int)lo); return (unsigned char*)(GAS unsigned char*)v; }

__device__ __forceinline__ int win_dst(int s) {
    if (s < 1024) return s;
    if (s < 1088) { const int j = s - 1024, part = j >> 5, w = j & 31; return 1024 + part * 32 + 2 * (w & 15) + (w >> 4); }
    if (s < 3136) { const int c = s - 1088; return 1280 + 256 * (c >> 7) + (c & 127); }
    if (s < 5184) { return 5376 + (s - 3136); }
    if (s < 7232) { const int c = s - 5184; return 1280 + 256 * (c >> 7) + 128 + (c & 127); }
    if (s < 9280) { return 7424 + (s - 7232); }
    return 9472 + (s - 9280);
}
__device__ __forceinline__ int qb_dst(int n) { const int h = n / DQK, d = n - h * DQK; if (d < DN) return n; const int j = d - DN, part = j >> 5, w = j & 31; return h * DQK + DN + part * 32 + 2 * (w & 15) + (w >> 4); }
__device__ __forceinline__ int map_dst(int mode, int n) {
    switch (mode) { case 1: return win_dst(n); case 2: return qb_dst(n); case 3: return 256 * (n >> 7) + (n & 127); case 4: return 256 * (n >> 7) + 128 + (n & 127); default: return n; }
}
__device__ __forceinline__ void transpose_item(const float* W, int K, int N, bf16* WT, int mode, const float* gk, int item, int lane) {
    const int kblk = K / 64, nb = item / kblk, kb = item - nb * kblk, k0 = 64 * kb + 16 * (lane >> 4), n0 = 64 * nb + 4 * (lane & 15);
    const float* src = W + (size_t)k0 * N + n0;
    f32x4 v[16];
#pragma unroll
    for (int i = 0; i < 16; ++i) v[i] = *(const f32x4*)(src + (size_t)i * N);
    if (gk) {
#pragma unroll
        for (int i = 0; i < 16; ++i) v[i] *= gk[k0 + i]; }
#pragma unroll
    for (int x = 0; x < 4; ++x) { bf16* d = WT + (size_t)map_dst(mode, n0 + x) * K + k0;
        u32x4 lo, hi;
        lo.x = cvtpk(v[0][x], v[1][x]); lo.y = cvtpk(v[2][x], v[3][x]); lo.z = cvtpk(v[4][x], v[5][x]); lo.w = cvtpk(v[6][x], v[7][x]);
        hi.x = cvtpk(v[8][x], v[9][x]); hi.y = cvtpk(v[10][x], v[11][x]); hi.z = cvtpk(v[12][x], v[13][x]); hi.w = cvtpk(v[14][x], v[15][x]);
        *(u32x4*)d = lo; *(u32x4*)(d + 8) = hi; }
}
struct Strip { const float* W; int N, mode, nb; signed char* w8; float* wsc; };
constexpr int ST_IN = DIN / 64, ST_GD = DFF / 64, ST_GE = DFE / 64, N_STRIPS = 2 * ST_IN + 2 * ST_GD + NE * 2 * ST_GE;
__device__ __forceinline__ Strip strip_of(const Params& p, int sid) {
    unsigned char* wb = p.ws + WS_W; float* wsc = (float*)(p.ws + WS_WSC);
    Strip q;
    if (sid < 2 * ST_IN) { const int l = sid / ST_IN; q.nb = sid - l * ST_IN; q.W = p.in[7] + (size_t)l * D * DIN; q.N = DIN; q.mode = 1; q.w8 = (signed char*)(wb + W_IN + l * W_IN_L); q.wsc = wsc + SC_IN + l * NIN; return q; }
    sid -= 2 * ST_IN;
    if (sid < 2 * ST_GD) { const int which = sid / ST_GD; q.nb = sid - which * ST_GD; q.W = p.in[17 + which]; q.N = DFF; q.mode = 3 + which; q.w8 = (signed char*)(wb + W_GU); q.wsc = wsc + SC_GU; return q; }
    sid -= 2 * ST_GD;
    { const int e = sid / (2 * ST_GE); sid -= e * (2 * ST_GE); const int which = sid / ST_GE; q.nb = sid - which * ST_GE; q.W = p.in[21 + which] + (size_t)e * D * DFE; q.N = DFE; q.mode = 3 + which;
      q.w8 = (signed char*)(wb + W_GUE + e * W_GUE_E); q.wsc = wsc + SC_GUE + e * 2 * DFE; return q; }
}
__device__ __forceinline__ unsigned pack4i8(float a, float b, float c, float d) {
    const int ia = (int)__builtin_rintf(a), ib = (int)__builtin_rintf(b), ic = (int)__builtin_rintf(c), id = (int)__builtin_rintf(d);
    return ((unsigned)ia & 0xffu) | (((unsigned)ib & 0xffu) << 8) | (((unsigned)ic & 0xffu) << 16) | ((unsigned)id << 24); }
__device__ __forceinline__ void quant_strip(const Strip& q, const Ctx& c, LAS float* cmax  ) {
    const int qd = c.lane >> 4, c4 = 4 * (c.lane & 15), n0 = 64 * q.nb + c4;
    const float* src = q.W + (size_t)(256 * c.wave + 16 * qd) * q.N + n0;
    f32x4 m = {0.f, 0.f, 0.f, 0.f};
#pragma unroll 1
    for (int sb = 0; sb < 4; ++sb) { f32x4 v[16];
#pragma unroll
        for (int i = 0; i < 16; ++i) v[i] = *(const f32x4*)(src + (size_t)(64 * sb + i) * q.N);
#pragma unroll
        for (int i = 0; i < 16; ++i) m = __builtin_elementwise_max(m, __builtin_elementwise_abs(v[i])); }
#pragma unroll
    for (int x = 0; x < 4; ++x) { float t = m[x]; t = fmaxf(t, __shfl_xor(t, 16)); t = fmaxf(t, __shfl_xor(t, 32)); m[x] = t; }
    if (c.lane < 16) *(LAS f32x4*)(cmax + c.wave * 64 + c4) = m;
    __syncthreads();
    f32x4 am = *(const LAS f32x4*)(cmax + c4);
#pragma unroll
    for (int w = 1; w < 8; ++w) am = __builtin_elementwise_max(am, *(const LAS f32x4*)(cmax + w * 64 + c4));
    f32x4 inv; int dst[4];
#pragma unroll
    for (int x = 0; x < 4; ++x) { inv[x] = am[x] > 0.f ? 127.f / am[x] : 0.f; dst[x] = map_dst(q.mode, n0 + x); }
    if (c.wave == 0 && c.lane < 16) {
#pragma unroll
        for (int x = 0; x < 4; ++x) q.wsc[dst[x]] = am[x] * (1.f / 127.f); }
#pragma unroll 1
    for (int sb = 0; sb < 4; ++sb) { f32x4 v[16];
#pragma unroll
        for (int i = 0; i < 16; ++i) v[i] = *(const f32x4*)(src + (size_t)(64 * sb + i) * q.N);
        const int k0 = 256 * c.wave + 64 * sb + 16 * qd;
#pragma unroll
        for (int x = 0; x < 4; ++x) { const float iv = inv[x];
            u32x4 o; o.x = pack4i8(v[0][x] * iv, v[1][x] * iv, v[2][x] * iv, v[3][x] * iv); o.y = pack4i8(v[4][x] * iv, v[5][x] * iv, v[6][x] * iv, v[7][x] * iv);
            o.z = pack4i8(v[8][x] * iv, v[9][x] * iv, v[10][x] * iv, v[11][x] * iv); o.w = pack4i8(v[12][x] * iv, v[13][x] * iv, v[14][x] * iv, v[15][x] * iv);
            *(u32x4*)(q.w8 + (size_t)dst[x] * D + k0) = o; } }
    __syncthreads();
}
constexpr int I_QB = (QL / 64) * (NH * DQK / 64), I_KVB = (KVL / 64) * (NH * 256 / 64), I_SQ = (D / 64) * (D / 64), I_L = I_QB + I_KVB + 3 * I_SQ;
constexpr int I_DD = (DFF / 64) * (D / 64), I_DE = (DFE / 64) * (D / 64);
constexpr int N_ADA = 2 * KS_ADA * 48, N_SMALL = N_ADA + 2 * I_L + I_DD + NE * I_DE, SMALL_BATCH = 32, N_BATCH = (N_SMALL + SMALL_BATCH - 1) / SMALL_BATCH, N_QUEUE = N_STRIPS + N_BATCH;
__device__ __forceinline__ void small_item(const Params& p, const Ctx& c, int it, const LAS float* sil) {
    unsigned char* ws = p.ws; unsigned char* wb = ws + WS_W;
    if (it < N_ADA) {
        float* part = (float*)(ws + WS_PART); const int cg = it % 48, lk = it / 48, kc = lk % KS_ADA, l = lk / KS_ADA;
        const float* W = p.in[4] + (size_t)l * D * (6 * D) + (size_t)(kc * 128) * (6 * D) + cg * 256 + c.lane * 4;
        float zf = 0.f; asm volatile("" : "+v"(zf)); f32x4 al = {zf, zf, zf, zf}, ac = al;
#pragma unroll 8
        for (int k = 0; k < 128; ++k) { const f32x4 w = *(const f32x4*)(W + (size_t)k * (6 * D)); al += w * sil[kc * 128 + k]; ac += w * sil[D + kc * 128 + k]; }
        *(f32x4*)(part + ((size_t)(l * KS_ADA + kc) * 2 + 0) * (6 * D) + cg * 256 + c.lane * 4) = al;
        *(f32x4*)(part + ((size_t)(l * KS_ADA + kc) * 2 + 1) * (6 * D) + cg * 256 + c.lane * 4) = ac; return; }
    int r = it - N_ADA;
    if (r < 2 * I_L) { const int l = r / I_L; r -= l * I_L;
        if (r < I_QB) { transpose_item(p.in[9] + (size_t)l * QL * NH * DQK, QL, NH * DQK, (bf16*)(wb + W_QB + l * W_QB_L), 2, p.in[8] + l * QL, r, c.lane); return; } r -= I_QB;
        if (r < I_KVB) { transpose_item(p.in[11] + (size_t)l * KVL * NH * 256, KVL, NH * 256, (bf16*)(wb + W_KVB + l * W_KVB_L), 0, p.in[10] + l * KVL, r, c.lane); return; } r -= I_KVB;
        const int which = r / I_SQ; r -= which * I_SQ;
        transpose_item(p.in[13 + which] + (size_t)l * D * D, D, D, (bf16*)(wb + (which == 0 ? W_OA : which == 1 ? W_OB : W_O) + l * W_SQ_L), 0, nullptr, r, c.lane); return; }
    r -= 2 * I_L;
    if (r < I_DD) { transpose_item(p.in[19], DFF, D, (bf16*)(wb + W_DD), 0, nullptr, r, c.lane); return; }
    r -= I_DD;
    { const int e = r / I_DE; r -= e * I_DE; transpose_item(p.in[23] + (size_t)e * DFE * D, DFE, D, (bf16*)(wb + W_DE + e * W_DE_E), 0, nullptr, r, c.lane); }
}
constexpr int CW_QHEAD = 2048;
__device__ __forceinline__ void p0_prologue(const Params& p, const Ctx& c) {
    unsigned char* ws = p.ws; unsigned char* wb = ws + WS_W;
    const int gt = c.vcu * NTHREADS + c.tid, NGT = c.G * NTHREADS;
    LAS float* sil = (LAS float*)(c.lds + 98304);
    LAS float* cmax = (LAS float*)(c.lds + 114688);
    LAS int* qslot = (LAS int*)(c.lds + 116736);
    for (int k = c.tid; k < 2 * D; k += NTHREADS) { const float x = k < D ? p.in[1][k] : p.in[3][k - D]; sil[k] = x / (1.f + expf(-x)); }
    { float* rope = (float*)(ws + WS_ROPE);
      for (int i = gt; i < 2048; i += NGT) { const int pos = i >> 4, k = i & 15; const float ang = (float)pos * powf(10000.f, -(float)(2 * k) / 32.f); rope[i] = cosf(ang); rope[2048 + i] = sinf(ang); } }
    { const int n16 = 192 * D / 16; unsigned zu = 0u; asm volatile("" : "+v"(zu));
      for (int i = gt; i < 2 * n16; i += NGT) { const int l = i / n16, r = i - l * n16; *(u32x4*)(wb + W_IN + l * W_IN_L + (size_t)1088 * D + (size_t)r * 16) = (u32x4){zu, zu, zu, zu}; }
      for (int i = gt; i < 2 * 192; i += NGT) { const int l = i / 192, r = i - l * 192; ((float*)(ws + WS_WSC))[SC_IN + l * NIN + 1088 + r] = __uint_as_float(zu); } }
    __syncthreads();
    unsigned* head = (unsigned*)(ws + WS_CTL) + CW_QHEAD;
    for (;;) {
        if (c.tid == 0) *qslot = (int)__hip_atomic_fetch_add(head, 1u, __ATOMIC_RELAXED, __HIP_MEMORY_SCOPE_AGENT);
        __syncthreads();
        const int id = __builtin_amdgcn_readfirstlane(*qslot);
        __syncthreads();
        if (id >= N_QUEUE) break;
        if (id < N_STRIPS) { quant_strip(strip_of(p, id), c, cmax); continue; }
        const int base = (id - N_STRIPS) * SMALL_BATCH;
#pragma unroll 1
        for (int j = 0; j < SMALL_BATCH / NWAVES; ++j) { const int it = base + j * NWAVES + c.wave; if (it < N_SMALL) small_item(p, c, it, sil); }
    }
}
__device__ __forceinline__ void p1_mod(const Params& p, const Ctx& c) {
    const float* part = (const float*)(p.ws + WS_PART); float* mod = (float*)(p.ws + WS_MOD);
    for (int i = c.vcu * NTHREADS + c.tid; i < 4 * 6 * D; i += c.G * NTHREADS) { const int n = i % (6 * D), lv = i / (6 * D), l = lv >> 1, v = lv & 1;
        float s = p.in[5][l * 6 * D + n];
#pragma unroll
        for (int kc = 0; kc < KS_ADA; ++kc) s += part[((size_t)(l * KS_ADA + kc) * 2 + v) * (6 * D) + n];
        mod[i] = s; }
}
__device__ __forceinline__ void norm_pass(const Params& p, const Ctx& c, int layer, int which, int row_lo, bool moe, bool local_mod) {
    const float* XL = (const float*)(p.ws + WS_XL); unsigned char* HN = p.ws + WS_HN; float* HSC = (float*)(p.ws + WS_HSC); const float* mod = (const float*)(p.ws + WS_MOD);
    const bool from_in = (layer == 0 && which == 0);
    const float* g = (which ? p.in[16] : p.in[6]) + layer * D;
    const int gw = c.vcu * NWAVES + c.wave, NGW = c.G * NWAVES;
    LAS float* lmod = (LAS float*)(c.lds + 65536);
    if (local_mod) { const float* part = (const float*)(p.ws + WS_PART);
        for (int i = c.tid; i < 4 * D; i += NTHREADS) { const int vec = i / D, v = vec >> 1, n = ((vec & 1) ? D : 0) + (i - vec * D);
            float sacc = p.in[5][layer * 6 * D + n];
#pragma unroll
            for (int kc = 0; kc < KS_ADA; ++kc) sacc += part[((size_t)(layer * KS_ADA + kc) * 2 + v) * (6 * D) + n];
            lmod[i] = sacc; }
        __syncthreads(); }
    LAS float* wrt = (LAS float*)c.lds;
    if (moe) { const float* wr = p.in[20];
        for (int i = c.tid; i < D * NE / 4; i += NTHREADS) { const f32x4 w = *(const f32x4*)(wr + 4 * i); const int k = i >> 1, e0 = (i & 1) * 4;
            wrt[(e0 + 0) * D + k] = w[0]; wrt[(e0 + 1) * D + k] = w[1]; wrt[(e0 + 2) * D + k] = w[2]; wrt[(e0 + 3) * D + k] = w[3]; }
        __syncthreads(); }
    for (int r = row_lo + gw; r < MT; r += NGW) {
        const f32x4* xr = (const f32x4*)(from_in ? (r < LC ? p.in[2] + (size_t)r * D : p.in[0] + (size_t)(r - LC) * D) : XL + (size_t)r * D) + c.lane;
        const float* mv = mod + (size_t)(layer * 2 + (r < LC ? 1 : 0)) * (6 * D) + (which ? 3 * D : 0);
        f32x4 v[8]; float ss = 0.f;
#pragma unroll
        for (int j = 0; j < 8; ++j) { v[j] = xr[64 * j]; ss += (v[j][0] * v[j][0] + v[j][1] * v[j][1]) + (v[j][2] * v[j][2] + v[j][3] * v[j][3]); }
        const float rs = rsqrtf(wave_sum(ss) * (1.f / D) + EPS);
        float amax = 0.f;
#pragma unroll
        for (int j = 0; j < 8; ++j) { const int col = 4 * c.lane + 256 * j;
            const f32x4 gv = *(const f32x4*)(g + col);
            const f32x4 sh = local_mod ? *(const LAS f32x4*)(lmod + (r < LC ? 2 * D : 0) + col) : *(const f32x4*)(mv + col), sc = local_mod ? *(const LAS f32x4*)(lmod + (r < LC ? 3 * D : D) + col) : *(const f32x4*)(mv + D + col);
            v[j] = (v[j] * rs * gv) * (sc + 1.f) + sh;
            amax = fmaxf(fmaxf(amax, fmaxf(fabsf(v[j][0]), fabsf(v[j][1]))), fmaxf(fabsf(v[j][2]), fabsf(v[j][3]))); }
#pragma unroll
        for (int o = 1; o < 64; o <<= 1) amax = fmaxf(amax, __shfl_xor(amax, o));
        const float inv = amax > 0.f ? 127.f / amax : 0.f;
        unsigned* o4 = (unsigned*)(HN + (size_t)r * D) + c.lane;
#pragma unroll
        for (int j = 0; j < 8; ++j) o4[64 * j] = pack4i8(v[j][0] * inv, v[j][1] * inv, v[j][2] * inv, v[j][3] * inv);
        if (c.lane == 0) HSC[r] = amax * (1.f / 127.f);
        if (moe) {
            float lg[NE];
#pragma unroll
            for (int e = 0; e < NE; ++e) { float a = 0.f;
#pragma unroll
                for (int j = 0; j < 8; ++j) { const f32x4 w = *(const LAS f32x4*)(wrt + e * D + 4 * c.lane + 256 * j); a += (v[j][0] * w[0] + v[j][1] * w[1]) + (v[j][2] * w[2] + v[j][3] * w[3]); }
                lg[e] = a; }
#pragma unroll
            for (int e = 0; e < NE; ++e) lg[e] = wave_sum(lg[e]);
            int e0 = 0; float m0 = lg[0];
#pragma unroll
            for (int e = 1; e < NE; ++e) if (lg[e] > m0) { m0 = lg[e]; e0 = e; }
            int e1 = -1; float m1 = -3.0e38f;
#pragma unroll
            for (int e = 0; e < NE; ++e) if (e != e0 && lg[e] > m1) { m1 = lg[e]; e1 = e; }
            if (c.lane == 0) { const int t = r - LC; const float b = expf(m1 - m0), inv = 1.f / (1.f + b);
                int* sel = (int*)(p.ws + WS_SEL); float* gwt = (float*)(p.ws + WS_GW);
                sel[2 * t] = e0; sel[2 * t + 1] = e1; gwt[2 * t] = inv; gwt[2 * t + 1] = b * inv; }
        }
    }
}
__device__ __forceinline__ void conv_pass(const Params& p, const Ctx& c, int layer, int row_lo) {
    const bf16* U = (const bf16*)(p.ws + WS_MIX + MX_U); const bf16* CBp = (const bf16*)(p.ws + WS_MIX + MX_CB); bf16* V2 = (bf16*)(p.ws + WS_MIX + MX_V2);
    const float* wc = p.in[12] + (size_t)layer * 3 * CW;
    const int gw = c.vcu * NWAVES + c.wave, NGW = c.G * NWAVES, nitems = ((MT - row_lo) / 16) * 4;
    for (int it = gw; it < nitems; it += NGW) {
        const int q = it & 3, r0 = row_lo + (it >> 2) * 16, ch = q * 512 + c.lane * 8;
        const int lo = r0 < LC ? 0 : LC, hi = r0 < LC ? LC : MT;
        const f32x4 w0a = *(const f32x4*)(wc + ch), w0b = *(const f32x4*)(wc + ch + 4), w1a = *(const f32x4*)(wc + CW + ch), w1b = *(const f32x4*)(wc + CW + ch + 4), w2a = *(const f32x4*)(wc + 2 * CW + ch), w2b = *(const f32x4*)(wc + 2 * CW + ch + 4);
        float zf = 0.f; asm volatile("" : "+v"(zf)); const f32x4 z4 = {zf, zf, zf, zf}; f32x4 pa = z4, pb = pa, ca, cb, na, nb;
        if (r0 - 1 >= lo) unpack8(*(const u32x4*)(U + (size_t)(r0 - 1) * CW + ch), pa, pb);
        unpack8(*(const u32x4*)(U + (size_t)r0 * CW + ch), ca, cb);
#pragma unroll 4
        for (int r = r0; r < r0 + 16; ++r) {
            na = z4; nb = na;
            if (r + 1 < hi) unpack8(*(const u32x4*)(U + (size_t)(r + 1) * CW + ch), na, nb);
            f32x4 ga, gb; unpack8(*(const u32x4*)(CBp + (size_t)r * CW + ch), ga, gb);
            const f32x4 ya = ga * (w0a * pa + w1a * ca + w2a * na), yb = gb * (w0b * pb + w1b * cb + w2b * nb);
            *(u32x4*)(V2 + (size_t)r * CW + ch) = pack8(ya, yb);
            pa = ca; pb = cb; ca = na; cb = nb; }
    }
}
__device__ __forceinline__ void moe_counts(const Params& p, const Ctx& c) {
    const int* sel = (const int*)(p.ws + WS_SEL);
    LAS int* H = (LAS int*)c.lds;
    LAS int* tot = (LAS int*)(c.lds + 16384);
    LAS int* lctl = (LAS int*)(c.lds + LCTL_OFF);
    { int h[NE];
#pragma unroll
      for (int e = 0; e < NE; ++e) h[e] = 0;
#pragma unroll
      for (int i = 0; i < 8; ++i) { const int4 v = *(const int4*)(sel + c.tid * 32 + i * 4);
#pragma unroll
          for (int e = 0; e < NE; ++e) h[e] += (v.x == e) + (v.y == e) + (v.z == e) + (v.w == e); }
#pragma unroll
      for (int e = 0; e < NE; ++e) H[c.tid * 8 + e] = h[e]; }
    __syncthreads();
    { int s = 0;
#pragma unroll
      for (int i = 0; i < 8; ++i) s += H[(c.lane * 8 + i) * 8 + c.wave];
#pragma unroll
      for (int o = 1; o < 64; o <<= 1) s += __shfl_xor(s, o);
      if (c.lane == 0) tot[c.wave] = s; }
    __syncthreads();
    if (c.tid == 0) { int off = 0;
#pragma unroll
        for (int e = 0; e < NE; ++e) { lctl[128 + e] = off; off += (tot[e] + 255) >> 8; }
        lctl[128 + NE] = off; lctl[16] = off; }
    __syncthreads();
    if (c.tid < MAXT) { int e = 0;
#pragma unroll
        for (int x = 1; x < NE; ++x) e += (c.tid >= lctl[128 + x]) ? 1 : 0;
        lctl[32 + c.tid] = e; }
    __syncthreads();
}
__device__ __forceinline__ void moe_route(const Params& p, const Ctx& c) {
    const int* sel = (const int*)(p.ws + WS_SEL); int* slot = (int*)(p.ws + WS_SLOT);
    const unsigned char* HN = p.ws + WS_HN; unsigned char* XS = p.ws + WS_MIX + FX_XS; const float* HSC = (const float*)(p.ws + WS_HSC); float* XSC = (float*)(p.ws + WS_XSC);
    LAS int* H = (LAS int*)c.lds; LAS int* tot = (LAS int*)(c.lds + 16384); LAS int* lctl = (LAS int*)(c.lds + LCTL_OFF);
    for (int b = c.bid; b < 2 * SEQ / 64; b += c.G) {
        { int s = 0;
#pragma unroll
          for (int i = 0; i < 8; ++i) { const int t = c.lane * 8 + i; s += (t < 2 * b) ? H[t * 8 + c.wave] : 0; }
#pragma unroll
          for (int o = 1; o < 64; o <<= 1) s += __shfl_xor(s, o);
          if (c.lane == 0) tot[8 + c.wave] = s; }
        __syncthreads();
        if (c.wave == 0) { const int a = 64 * b + c.lane, e = sel[a]; int rank = 0;
#pragma unroll
            for (int x = 0; x < NE; ++x) { const unsigned long long m = __ballot(e == x); if (e == x) rank = tot[8 + x] + __popcll(m & ((1ull << c.lane) - 1ull)); }
            const int s = 256 * lctl[128 + e] + rank; slot[a] = s; tot[16 + c.lane] = s; }
        __syncthreads();
#pragma unroll
        for (int i = 0; i < 8; ++i) { const int j = c.wave * 8 + i, a = 64 * b + j, tok = a >> 1, s = tot[16 + j];
            const u32x4* src = (const u32x4*)(HN + (size_t)(LC + tok) * D) + c.lane; u32x4* dst = (u32x4*)(XS + (size_t)s * D) + c.lane;
            const u32x4 v0 = src[0], v1 = src[64]; dst[0] = v0; dst[64] = v1;
            if (c.lane == 0) XSC[s] = HSC[LC + tok]; }
        __syncthreads();
    }
}
__device__ __forceinline__ void final_pass(const Params& p, const Ctx& c) {
    const float* XL = (const float*)(p.ws + WS_XL); const bf16* YS = (const bf16*)(p.ws + WS_MIX + FX_YS);
    const int* slot = (const int*)(p.ws + WS_SLOT); const float* gwt = (const float*)(p.ws + WS_GW);
    const float* gt2 = (const float*)(p.ws + WS_MOD) + (size_t)2 * (6 * D) + 5 * D; const float* gf = p.in[24];
    const int gw = c.vcu * NWAVES + c.wave, NGW = c.G * NWAVES;
    for (int t = gw; t < SEQ; t += NGW) {
        const int s0 = slot[2 * t], s1 = slot[2 * t + 1]; const float g0 = gwt[2 * t], g1 = gwt[2 * t + 1];
        const f32x4* xr = (const f32x4*)(XL + (size_t)(LC + t) * D) + c.lane;
        const u32x2* y0 = (const u32x2*)(YS + (size_t)s0 * D) + c.lane; const u32x2* y1 = (const u32x2*)(YS + (size_t)s1 * D) + c.lane;
        f32x4 v[8]; float ss = 0.f;
#pragma unroll
        for (int j = 0; j < 8; ++j) { const f32x4 gv = *(const f32x4*)(gt2 + 4 * c.lane + 256 * j);
            v[j] = xr[64 * j] + gv * (unpack4(y0[64 * j]) * g0 + unpack4(y1[64 * j]) * g1);
            ss += (v[j][0] * v[j][0] + v[j][1] * v[j][1]) + (v[j][2] * v[j][2] + v[j][3] * v[j][3]); }
        const float rs = rsqrtf(wave_sum(ss) * (1.f / D) + EPS);
        f32x4* o = (f32x4*)(p.out + (size_t)t * D) + c.lane;
#pragma unroll
        for (int j = 0; j < 8; ++j) o[64 * j] = v[j] * rs * *(const f32x4*)(gf + 4 * c.lane + 256 * j);
    }
}


template <class Epi>
__device__ __forceinline__ void ctx_gemm(const Ctx& c, const bf16* A, int lda, const bf16* Bt, int ldb, int K, const Epi& E) {
    int tid = c.tid; asm volatile("" : "+v"(tid));
    const int lane = tid & 63, wid = __builtin_amdgcn_readfirstlane(tid >> 6), fr = lane & 15, fq = lane >> 4, wr = wid >> 2, wc = wid & 3;
    constexpr int STG = 24576, NSTG = 4;
    const int nk = K / 128;
    for (int j = c.vcu; j < 256; j += c.G) {
        const int mb = (j >> 5) * 32, nb = (j & 31) * 64;
        const int sA = wid * 64 + lane, rA = sA >> 4, cA = (sA & 15) ^ (rA & 15);
        const bf16* gA = A + (size_t)(mb + rA) * lda + cA * 8;
        const bf16* gB0 = Bt + (size_t)(nb + rA) * ldb + cA * 8;
        const bf16* gB1 = gB0 + (size_t)32 * ldb;
        LAS unsigned char* lw = c.lds + wid * 1024;
#define CG_STAGE(t) do { const int kk_ = ((t) < nk ? (t) : nk - 1) * 128; LAS unsigned char* d_ = lw + ((t) & (NSTG - 1)) * STG; \
        __builtin_amdgcn_global_load_lds((const unsigned*)(gA + kk_), (LAS unsigned*)(d_), 16, 0, 0); \
        __builtin_amdgcn_global_load_lds((const unsigned*)(gB0 + kk_), (LAS unsigned*)(d_ + 8192), 16, 0, 0); \
        __builtin_amdgcn_global_load_lds((const unsigned*)(gB1 + kk_), (LAS unsigned*)(d_ + 16384), 16, 0, 0); } while (0)
        CG_STAGE(0); CG_STAGE(1); CG_STAGE(2);
        const int ra = (wr * 16 + fr) * 256, rb = 8192 + (wc * 16 + fr) * 256;
        float zf = 0.f; asm volatile("" : "+v"(zf));
        f32x4 acc0 = {zf, zf, zf, zf}, acc1 = acc0;
#pragma unroll 1
        for (int t = 0; t < nk; ++t) {
            asm volatile("s_waitcnt vmcnt(6)\n\ts_barrier" ::: "memory");
            CG_STAGE(t + 3);
            const LAS unsigned char* sb = c.lds + (t & (NSTG - 1)) * STG;
            bf16x8 af[4], bf[4];
#pragma unroll
            for (int ks = 0; ks < 4; ++ks) { const int pc = ((4 * ks + fq) ^ fr) * 16; af[ks] = *(const LAS bf16x8*)(sb + ra + pc); bf[ks] = *(const LAS bf16x8*)(sb + rb + pc); }
            acc0 = __builtin_amdgcn_mfma_f32_16x16x32_bf16(bf[0], af[0], acc0, 0, 0, 0);
            acc1 = __builtin_amdgcn_mfma_f32_16x16x32_bf16(bf[1], af[1], acc1, 0, 0, 0);
            acc0 = __builtin_amdgcn_mfma_f32_16x16x32_bf16(bf[2], af[2], acc0, 0, 0, 0);
            acc1 = __builtin_amdgcn_mfma_f32_16x16x32_bf16(bf[3], af[3], acc1, 0, 0, 0);
        }
#undef CG_STAGE
        asm volatile("s_waitcnt vmcnt(0)\n\ts_barrier" ::: "memory");
        E(mb + wr * 16 + fr, nb + wc * 16 + 4 * fq, acc0 + acc1);
    }
}
template <int MODE> struct CtxMerge { const bf16* SG; const bf16* M1; bf16* OUT;
    __device__ __forceinline__ void operator()(int row, int col, f32x4 acc) const { const size_t off = (size_t)row * D + col;
        f32x4 v = acc * unpack4(*(const u32x2*)(SG + off)); if (MODE == 1) v += unpack4(*(const u32x2*)(M1 + off));
        u32x2 w; w.x = cvtpk(v[0], v[1]); w.y = cvtpk(v[2], v[3]); *(u32x2*)(OUT + off) = w; } };
struct CtxResid { float* XL; const float* SRC; const float* gate;
    __device__ __forceinline__ void operator()(int row, int col, f32x4 acc) const { const size_t o = (size_t)row * D + col; *(f32x4*)(XL + o) = *(const f32x4*)(SRC + o) + *(const f32x4*)(gate + col) * acc; } };

constexpr int N_PHASES = 22;
__global__ void __launch_bounds__(NTHREADS, 2) mega(Params p) {
    extern __shared__ __attribute__((aligned(16))) unsigned char lds_raw[];
    Ctx c0; c0.lds = (LAS unsigned char*)lds_raw; c0.tid = threadIdx.x; c0.lane = c0.tid & 63; c0.wave = __builtin_amdgcn_readfirstlane(c0.tid >> 6);
    c0.G = gridDim.x; c0.bid = blockIdx.x; c0.vcu = (c0.G % 8 == 0) ? (c0.bid % 8) * (c0.G / 8) + c0.bid / 8 : c0.bid;
    { const Ctx& c = c0; unsigned char* ws = p.ws;
    for (int u = c.tid; u < (LDS_BYTES - LCTL_OFF) / 4; u += NTHREADS) ((LAS unsigned*)(c.lds + LCTL_OFF))[u] = 0u;
    __syncthreads();
    }
    XcdBarrier bar = xcd_barrier_post((unsigned*)(p.ws + WS_CTL) + 4096, (volatile LAS unsigned*)(c0.lds + LCTL_OFF));
    const int lo = p.ph_lo, hi = p.ph_hi;
#ifndef MK_EN
#define MK_EN 0xFFFFFF
#endif
#define EN(j) (((MK_EN) >> (j)) & 1)
#ifndef MK_DUP
#define MK_DUP 0
#endif
#define NREP(j) ((((MK_DUP) >> (j)) & 1) ? 2 : 1)
#define IN(k) (lo <= (k) && (k) < hi)
#define SEAM(k) do { if (IN(k) && IN((k) + 1)) xcd_barrier(bar); } while (0)
#define PH_BEGIN const Ctx c = fresh(c0); unsigned char* ws = fresh_ptr(p.ws); unsigned char* wb = ws + WS_W; unsigned char* mx = ws + WS_MIX; const float* mod = (const float*)(ws + WS_MOD); (void)wb; (void)mx; (void)mod;
    for (int rep_ = 0; rep_ < NREP(20); ++rep_) if (EN(20) && IN(0)) { if (rep_) { xcd_barrier(bar); if (c0.bid == 0 && c0.tid == 0) __hip_atomic_store((unsigned*)(p.ws + WS_CTL) + CW_QHEAD, 0u, __ATOMIC_RELAXED, __HIP_MEMORY_SCOPE_AGENT); xcd_barrier(bar); } PH_BEGIN p0_prologue(p, c); } SEAM(0);
#if defined(MK_XBAR)
    for (int xb_ = 0; xb_ < 16; ++xb_) xcd_barrier(bar);
#endif
#pragma unroll
    for (int layer = 0; layer < DEPTH; ++layer) {
        const int P = 2 + 9 * layer; const bool last = (layer == DEPTH - 1);
        const int pm0 = last ? 1 : 0, nM = last ? 32 : 33;
        for (int rep_ = 0; rep_ < NREP(0); ++rep_) if (EN(0) && IN(P + 0)) { if (rep_) xcd_barrier(bar); PH_BEGIN if (layer == 0) p1_mod(p, c); norm_pass(p, c, layer, 0, 0, false, layer == 0); } SEAM(P + 0);
        for (int rep_ = 0; rep_ < NREP(1); ++rep_) if (EN(1) && IN(P + 1)) { if (rep_) xcd_barrier(bar); PH_BEGIN
            pg8::Geo g{D / 2, D / 2, D / 2};
            pg8::TileOrder S{nM, NT_IN, pm0, c.G, c.bid, last ? 3 : 0, 0, 2, (const char*)(ws + WS_HN), (const char*)(wb + W_IN + layer * W_IN_L), (size_t)256 * D, (size_t)256 * D, (const float*)(ws + WS_HSC), (const float*)(ws + WS_WSC) + SC_IN + layer * NIN};
            pg8::EpiInproj E{(bf16*)(mx + MX_QC), (bf16*)(mx + MX_KRB), (bf16*)(mx + MX_U), (bf16*)(mx + MX_CB), (float*)(mx + MX_SSQ), (const float*)(ws + WS_ROPE)};
            pg8::gemm_phase<pg8::EpiInproj, pg8::TileOrder, true, true>(c.lds, g, S, E);
        } SEAM(P + 1);
        for (int rep_ = 0; rep_ < NREP(2); ++rep_) if (EN(2) && IN(P + 2)) { if (rep_) xcd_barrier(bar); PH_BEGIN
            pg8::Geo g{1024, 512, 512};
            pg8::QkvOrder S{33, nM, pm0, c.G, c.bid, (const char*)(mx + MX_QC), (const char*)(wb + W_QB + layer * W_QB_L), (long)(W_KVB + layer * W_KVB_L) - (long)(W_QB + layer * W_QB_L)};
            pg8::EpiQkv E{(bf16*)(mx + MX_Q), (bf16*)(mx + MX_KV), (const float*)(mx + MX_SSQ), (const float*)(ws + WS_ROPE)};
            pg8::gemm_phase<pg8::EpiQkv, pg8::QkvOrder, true>(c.lds, g, S, E);
            conv_pass(p, c, layer, pm0 * 256);
        } SEAM(P + 2);
        for (int rep_ = 0; rep_ < NREP(3); ++rep_) if (EN(3) && IN(P + 3)) { if (rep_) xcd_barrier(bar); PH_BEGIN
            const bf16* Q = (const bf16*)(mx + MX_Q); const bf16* KV = (const bf16*)(mx + MX_KV); const bf16* KR = (const bf16*)(mx + MX_KRB); bf16* O = (bf16*)(mx + MX_O);
            for (int i = 0;; ++i) { const int u = i * c.G + c.vcu; if (u >= NH * 32) break;
                const int h = u >> 5, q0 = LC + 256 * (u & 31);
                att::attn_unit(Q + (size_t)q0 * att::LDQ + h * DQK, KV, h * 512, KR, O + (size_t)q0 * D + h * DV, MT, (LAS char*)c.lds); }
            if (!last) for (int i = 0;; ++i) { const int h = i * c.G + c.vcu; if (h >= NH) break;
                att::attn_unit(Q + h * DQK, KV, h * 512, KR, O + h * DV, LC, (LAS char*)c.lds); }
            pg8::Geo g{D, D, D};
            pg8::TileOrder S{32, 8, 1, c.G, c.bid, 0, 0, 0, (const char*)(mx + MX_V2), (const char*)(wb + W_OB + layer * W_SQ_L), (size_t)256 * D * 2, (size_t)256 * D * 2, nullptr, nullptr};
            pg8::EpiMerge<0> E{(const bf16*)(mx + MX_SGB), nullptr, (bf16*)(mx + MX_M1)};
            pg8::gemm_phase<pg8::EpiMerge<0>, pg8::TileOrder, true>(c.lds, g, S, E);
            if (!last) ctx_gemm(c, (const bf16*)(mx + MX_V2), D, (const bf16*)(wb + W_OB + layer * W_SQ_L), D, D, CtxMerge<0>{(const bf16*)(mx + MX_SGB), nullptr, (bf16*)(mx + MX_M1)});
        } SEAM(P + 3);
        for (int rep_ = 0; rep_ < NREP(4); ++rep_) if (EN(4) && IN(P + 4)) { if (rep_) xcd_barrier(bar); PH_BEGIN
            pg8::Geo g{D, D, D};
            pg8::TileOrder S{32, 8, 1, c.G, c.bid, 0, 0, 0, (const char*)(mx + MX_O), (const char*)(wb + W_OA + layer * W_SQ_L), (size_t)256 * D * 2, (size_t)256 * D * 2, nullptr, nullptr};
            pg8::EpiMerge<1> E{(const bf16*)(mx + MX_SGA), (const bf16*)(mx + MX_M1), (bf16*)(mx + MX_MG)};
            pg8::gemm_phase<pg8::EpiMerge<1>, pg8::TileOrder, true>(c.lds, g, S, E);
            if (!last) ctx_gemm(c, (const bf16*)(mx + MX_O), D, (const bf16*)(wb + W_OA + layer * W_SQ_L), D, D, CtxMerge<1>{(const bf16*)(mx + MX_SGA), (const bf16*)(mx + MX_M1), (bf16*)(mx + MX_MG)});
        } SEAM(P + 4);
        for (int rep_ = 0; rep_ < 1; ++rep_) if (EN(5) && IN(P + 5)) { PH_BEGIN
            pg8::Geo g{D, D, D};
            pg8::TileOrder S{32, 8, 1, c.G, c.bid, 0, 0, 0, (const char*)(mx + MX_MG), (const char*)(wb + W_O + layer * W_SQ_L), (size_t)256 * D * 2, (size_t)256 * D * 2, nullptr, nullptr};
            pg8::EpiResid E{(float*)(ws + WS_XL), layer == 0 ? p.in[0] - (size_t)LC * D : (const float*)(ws + WS_XL), mod + (size_t)(2 * layer) * (6 * D) + 2 * D};
            pg8::gemm_phase<pg8::EpiResid, pg8::TileOrder, true>(c.lds, g, S, E);
            if (!last) ctx_gemm(c, (const bf16*)(mx + MX_MG), D, (const bf16*)(wb + W_O + layer * W_SQ_L), D, D, CtxResid{(float*)(ws + WS_XL), p.in[2], mod + (size_t)(2 * layer + 1) * (6 * D) + 2 * D});
        } SEAM(P + 5);
        for (int rep_ = 0; rep_ < NREP(6); ++rep_) if (EN(6) && IN(P + 6)) { if (rep_) xcd_barrier(bar); PH_BEGIN norm_pass(p, c, layer, 1, pm0 * 256, last, false); } SEAM(P + 6);
        if (!last) {
            for (int rep_ = 0; rep_ < NREP(7); ++rep_) if (EN(7) && IN(P + 7)) { if (rep_) xcd_barrier(bar); PH_BEGIN
                pg8::Geo g{D / 2, D / 2, D / 2};
                pg8::TileOrder S{nM, 2 * DFF / 256, pm0, c.G, c.bid, 0, 0, 0, (const char*)(ws + WS_HN), (const char*)(wb + W_GU), (size_t)256 * D, (size_t)256 * D, (const float*)(ws + WS_HSC), (const float*)(ws + WS_WSC) + SC_GU};
                pg8::EpiSwiglu E{(bf16*)(mx + FX_ACT), DFF};
                pg8::gemm_phase<pg8::EpiSwiglu, pg8::TileOrder, true, true>(c.lds, g, S, E);
            } SEAM(P + 7);
            for (int rep_ = 0; rep_ < 1; ++rep_) if (EN(8) && IN(P + 8)) { PH_BEGIN
                pg8::Geo g{DFF, DFF, DFF};
                pg8::TileOrder S{32, 8, 1, c.G, c.bid, 0, 0, 0, (const char*)(mx + FX_ACT), (const char*)(wb + W_DD), (size_t)256 * DFF * 2, (size_t)256 * DFF * 2, nullptr, nullptr};
                pg8::EpiResid E{(float*)(ws + WS_XL), (const float*)(ws + WS_XL), mod + (size_t)(2 * layer) * (6 * D) + 5 * D};
                pg8::gemm_phase<pg8::EpiResid, pg8::TileOrder, true>(c.lds, g, S, E);
                ctx_gemm(c, (const bf16*)(mx + FX_ACT), DFF, (const bf16*)(wb + W_DD), DFF, DFF, CtxResid{(float*)(ws + WS_XL), (const float*)(ws + WS_XL), mod + (size_t)(2 * layer + 1) * (6 * D) + 5 * D});
            } SEAM(P + 8);
        } else {
            const LAS int* lctl = (const LAS int*)(c0.lds + LCTL_OFF);
            for (int rep_ = 0; rep_ < NREP(7); ++rep_) if (EN(7) && IN(P + 7)) { if (rep_) xcd_barrier(bar); PH_BEGIN moe_counts(p, c); moe_route(p, c); } SEAM(P + 7);
            for (int rep_ = 0; rep_ < NREP(8); ++rep_) if (EN(8) && IN(P + 8)) { if (rep_) xcd_barrier(bar); PH_BEGIN
                if (!IN(P + 7)) moe_counts(p, c);
                const int T = __builtin_amdgcn_readfirstlane(lctl[16]);
                pg8::Geo g{D / 2, D / 2, D / 2};
                pg8::MoeOrder S{T, 2 * DFE / 256, c.G, c.bid, (const char*)(mx + FX_XS), (const char*)(wb + W_GUE), (size_t)256 * D, (size_t)256 * D, W_GUE_E, lctl + 32, (const float*)(ws + WS_XSC), (const float*)(ws + WS_WSC) + SC_GUE, 2 * DFE};
                pg8::EpiSwiglu E{(bf16*)(mx + FX_ACTE), DFE};
                pg8::gemm_phase<pg8::EpiSwiglu, pg8::MoeOrder, true, true>(c.lds, g, S, E);
            } SEAM(P + 8);
            for (int rep_ = 0; rep_ < NREP(9); ++rep_) if (EN(9) && IN(P + 9)) { if (rep_) xcd_barrier(bar); PH_BEGIN
                if (!IN(P + 7)) moe_counts(p, c);
                const int T = __builtin_amdgcn_readfirstlane(lctl[16]);
                pg8::Geo g{DFE, DFE, DFE};
                pg8::MoeOrder S{T, 8, c.G, c.bid, (const char*)(mx + FX_ACTE), (const char*)(wb + W_DE), (size_t)256 * DFE * 2, (size_t)256 * DFE * 2, W_DE_E, lctl + 32, nullptr, nullptr, 0};
                pg8::EpiStoreBf16 E{(bf16*)(mx + FX_YS), D};
                pg8::gemm_phase<pg8::EpiStoreBf16, pg8::MoeOrder, true>(c.lds, g, S, E);
            } SEAM(P + 9);
            for (int rep_ = 0; rep_ < NREP(10); ++rep_) if (EN(10) && IN(P + 10)) { if (rep_) xcd_barrier(bar); PH_BEGIN final_pass(p, c); }
        }
    }
#undef IN
#undef SEAM
}

static void forward(void* const* d_in, float* out, void* d_ws, size_t ws_size, hipStream_t st, int n_launches) {
    static int grid = 0;
    if (grid == 0) {
        if (ws_size < WS_END) { fprintf(stderr, "mk::forward: workspace too small (%zu < %zu)\n", ws_size, (size_t)WS_END); grid = -1; return; }
        int dev = 0, cus = 0;
        if (hipGetDevice(&dev) != hipSuccess || hipDeviceGetAttribute(&cus, hipDeviceAttributeMultiprocessorCount, dev) != hipSuccess) { grid = -1; return; }
        if (hipFuncSetAttribute((const void*)mega, hipFuncAttributeMaxDynamicSharedMemorySize, LDS_BYTES) != hipSuccess) { fprintf(stderr, "mk::forward: hipFuncSetAttribute failed\n"); grid = -1; return; }
        int per_cu = 0; (void)hipOccupancyMaxActiveBlocksPerMultiprocessor(&per_cu, (const void*)mega, NTHREADS, LDS_BYTES); (void)hipGetLastError();
        grid = cus;
    }
    if (grid < 0) return;
    (void)hipMemsetAsync((char*)d_ws + WS_CTL, 0, CTL_BYTES, st);
    Params p{};
    for (int i = 0; i < 25; ++i) p.in[i] = (const float*)d_in[i];
    p.out = out; p.ws = (unsigned char*)d_ws;
    if (n_launches == 1) { p.ph_lo = 0; p.ph_hi = N_PHASES; hipLaunchKernelGGL(mega, dim3(grid), dim3(NTHREADS), LDS_BYTES, st, p); }
    else for (int k = 0; k < N_PHASES; ++k) { p.ph_lo = k; p.ph_hi = k + 1; hipLaunchKernelGGL(mega, dim3(grid), dim3(NTHREADS), LDS_BYTES, st, p); }
    const hipError_t le = hipPeekAtLastError();
    if (le != hipSuccess) fprintf(stderr, "mk::forward: launch failed: %s\n", hipGetErrorName(le));
}
}

#ifndef MK_LAUNCHES
#define MK_LAUNCHES 1
#endif
#ifndef USE_SLOW
#define USE_SLOW 0
#endif
extern "C" void kernel_launch(void* const* d_in, const int* in_sizes, int n_in, void* d_out, int out_size, void* d_ws, size_t ws_size, hipStream_t stream) {
    if (n_in != 25 || out_size != SEQ * D) { fprintf(stderr, "kernel_launch: unexpected shapes (n_in %d out %d)\n", n_in, out_size); return; }
#if USE_SLOW
    slow::forward(d_in, (float*)d_out, (float*)d_ws, ws_size / 4, stream);
#else
    mk::forward(d_in, (float*)d_out, d_ws, ws_size, stream, MK_LAUNCHES);
#endif
}
```

```cpp
#include <hip/hip_runtime.h>
#include <cstdio>
#include <cstdint>

constexpr int D = 2048, LC = 256, SEQ = 8192, MT = LC + SEQ, DEPTH = 2;
constexpr int NH = 16, DN = 128, DR = 64, DV = 128, DQK = DN + DR, QL = 512, KVL = 512;
constexpr int CW = 2048, DIN = QL + KVL + DR + 3 * CW + 2 * D;
constexpr int OFF_QA = 0, OFF_CKV = 512, OFF_KR = 1024, OFF_CX = 1088, OFF_CB = OFF_CX + CW, OFF_CC = OFF_CB + CW, OFF_GA = OFF_CC + CW, OFF_GB = OFF_GA + D;
constexpr int DFF = 5632, NE = 8, DFE = 2816;
constexpr float EPS = 1e-6f;
constexpr float ATT_SCALE = 0.07216878364870322f;

namespace slow {
typedef float f32x16 __attribute__((ext_vector_type(16)));

struct GArgs { const float* A; long lda, abs_; const float* B; long sbk, sbn, bbs; const int* rowidx; const int* rioff; const int* Mptr; int M, N, K, pad; };
static_assert(sizeof(GArgs) == 96, "GArgs has no implicit padding");

template <bool BT, class Epi>
__global__ __launch_bounds__(256) void k_gemm(GArgs g, Epi epi) {
    __shared__ float As[32][65];
    __shared__ float Bs[32][65];
    const int b = blockIdx.z, m0 = blockIdx.y * 64, n0 = blockIdx.x * 64;
    const int M = g.Mptr ? g.Mptr[b] : g.M;
    if (m0 >= M) return;
    const int t = threadIdx.x, lane = t & 63, w = t >> 6, wm = w >> 1, wn = w & 1;
    const float* A = g.A + (long)b * g.abs_; const float* B = g.B + (long)b * g.bbs;
    const int ar = t >> 2, ak = (t & 3) * 8, am = m0 + ar;
    long arow = -1;
    if (am < M) { const int base = g.rioff ? g.rioff[b] : 0; arow = g.rowidx ? (long)g.rowidx[base + am] : (long)(base + am); }
    f32x16 acc;
#pragma unroll
    for (int r = 0; r < 16; ++r) acc[r] = 0.f;
    for (int k0 = 0; k0 < g.K; k0 += 32) {
        float4 a0 = make_float4(0.f, 0.f, 0.f, 0.f), a1 = a0, b0, b1;
        if (arow >= 0) { const float4* p = (const float4*)(A + arow * g.lda + k0 + ak); a0 = p[0]; a1 = p[1]; }
        if (BT) { const int bn = t >> 2, bk = (t & 3) * 8; const float4* p = (const float4*)(B + (long)(n0 + bn) * g.sbn + k0 + bk); b0 = p[0]; b1 = p[1]; }
        else    { const int bk = t >> 3, bn = (t & 7) * 8; const float4* p = (const float4*)(B + (long)(k0 + bk) * g.sbk + n0 + bn); b0 = p[0]; b1 = p[1]; }
        __syncthreads();
        As[ak + 0][ar] = a0.x; As[ak + 1][ar] = a0.y; As[ak + 2][ar] = a0.z; As[ak + 3][ar] = a0.w;
        As[ak + 4][ar] = a1.x; As[ak + 5][ar] = a1.y; As[ak + 6][ar] = a1.z; As[ak + 7][ar] = a1.w;
        if (BT) { const int bn = t >> 2, bk = (t & 3) * 8;
            Bs[bk + 0][bn] = b0.x; Bs[bk + 1][bn] = b0.y; Bs[bk + 2][bn] = b0.z; Bs[bk + 3][bn] = b0.w;
            Bs[bk + 4][bn] = b1.x; Bs[bk + 5][bn] = b1.y; Bs[bk + 6][bn] = b1.z; Bs[bk + 7][bn] = b1.w; }
        else { const int bk = t >> 3, bn = (t & 7) * 8;
            Bs[bk][bn + 0] = b0.x; Bs[bk][bn + 1] = b0.y; Bs[bk][bn + 2] = b0.z; Bs[bk][bn + 3] = b0.w;
            Bs[bk][bn + 4] = b1.x; Bs[bk][bn + 5] = b1.y; Bs[bk][bn + 6] = b1.z; Bs[bk][bn + 7] = b1.w; }
        __syncthreads();
#pragma unroll
        for (int kk = 0; kk < 32; kk += 2) {
            const float a = As[kk + (lane >> 5)][wm * 32 + (lane & 31)];
            const float bb = Bs[kk + (lane >> 5)][wn * 32 + (lane & 31)];
            acc = __builtin_amdgcn_mfma_f32_32x32x2f32(a, bb, acc, 0, 0, 0);
        }
    }
    const int base = g.rioff ? g.rioff[b] : 0;
#pragma unroll
    for (int r = 0; r < 16; ++r) {
        const int row = m0 + wm * 32 + (r & 3) + 8 * (r >> 2) + 4 * (lane >> 5), col = n0 + wn * 32 + (lane & 31);
        if (row < M) epi(b, base + row, col, acc[r]);
    }
}
struct EpiStore { float* C; long ldc, cbs; float alpha; int accum;
    __device__ void operator()(int b, int row, int col, float v) const { float* p = C + (long)b * cbs + (long)row * ldc + col; *p = accum ? *p + alpha * v : alpha * v; } };
struct EpiResid { float* X; const float* gl; const float* gc;
    __device__ void operator()(int, int row, int col, float v) const { float* p = X + (long)row * D + col; *p += (row < LC ? gc[col] : gl[col]) * v; } };

template <bool BT, class Epi> static void gemm(hipStream_t st, const GArgs& g, const Epi& e, int nbatch, int maxM) {
    dim3 grid(g.N / 64, (maxM + 63) / 64, nbatch);
    hipLaunchKernelGGL((k_gemm<BT, Epi>), grid, dim3(256), 0, st, g, e);
}

__device__ __forceinline__ float block_sum(float v, float* red) {
#pragma unroll
    for (int o = 32; o > 0; o >>= 1) v += __shfl_xor(v, o);
    __syncthreads();
    if ((threadIdx.x & 63) == 0) red[threadIdx.x >> 6] = v;
    __syncthreads();
    return red[0] + red[1] + red[2] + red[3];
}
__device__ __forceinline__ float block_max(float v, float* red) {
#pragma unroll
    for (int o = 32; o > 0; o >>= 1) v = fmaxf(v, __shfl_xor(v, o));
    __syncthreads();
    if ((threadIdx.x & 63) == 0) red[threadIdx.x >> 6] = v;
    __syncthreads();
    return fmaxf(fmaxf(red[0], red[1]), fmaxf(red[2], red[3]));
}
__device__ __forceinline__ float silu(float x) { return x / (1.f + expf(-x)); }
__device__ __forceinline__ float sigm(float x) { return 1.f / (1.f + expf(-x)); }

__global__ void k_copy_x(const float* ctx, const float* x, float* XL) {
    const long n = (long)MT * D / 4; const float4* c4 = (const float4*)ctx; const float4* x4 = (const float4*)x; float4* o = (float4*)XL; const long nc = (long)LC * D / 4;
    for (long i = blockIdx.x * 256L + threadIdx.x; i < n; i += gridDim.x * 256L) o[i] = i < nc ? c4[i] : x4[i - nc];
}
__global__ void k_ada(const float* c, const float* cctx, const float* w_ada, const float* b_ada, float* MOD) {
    const int n = blockIdx.x * 256 + threadIdx.x, lv = blockIdx.y, l = lv >> 1, v = lv & 1;
    const float* cv = v ? cctx : c; const float* W = w_ada + (long)l * D * (6 * D);
    float acc = 0.f;
    for (int k = 0; k < D; ++k) acc += silu(cv[k]) * W[(long)k * (6 * D) + n];
    MOD[(long)lv * (6 * D) + n] = acc + b_ada[l * 6 * D + n];
}
__global__ __launch_bounds__(256) void k_modnorm(const float* X, const float* g, const float* modl, const float* modc, int sh_off, int sc_off, float* H) {
    __shared__ float red[4];
    const int r = blockIdx.x; const float* x = X + (long)r * D; const float* mod = r < LC ? modc : modl;
    float v[8]; float ss = 0.f;
#pragma unroll
    for (int j = 0; j < 8; ++j) { v[j] = x[threadIdx.x + 256 * j]; ss += v[j] * v[j]; }
    ss = block_sum(ss, red);
    const float rs = rsqrtf(ss * (1.f / D) + EPS);
#pragma unroll
    for (int j = 0; j < 8; ++j) { const int c = threadIdx.x + 256 * j; H[(long)r * D + c] = (v[j] * rs * g[c]) * (1.f + mod[sc_off + c]) + mod[sh_off + c]; }
}
__global__ __launch_bounds__(256) void k_rms512(const float* P, int off, const float* g, float* out) {
    __shared__ float red[4];
    const int r = blockIdx.x; const float* x = P + (long)r * DIN + off;
    const float a = x[threadIdx.x], b = x[threadIdx.x + 256];
    const float ss = block_sum(a * a + b * b, red);
    const float rs = rsqrtf(ss * (1.f / 512.f) + EPS);
    out[(long)r * 512 + threadIdx.x] = a * rs * g[threadIdx.x]; out[(long)r * 512 + threadIdx.x + 256] = b * rs * g[threadIdx.x + 256];
}
__device__ __forceinline__ float inv_freq(int i) { return powf(10000.f, -(float)(2 * i) / 32.f); }
__global__ void k_rope_q(float* Q) {
    const long idx = blockIdx.x * 256L + threadIdx.x;
    if (idx >= (long)SEQ * NH * 32) return;
    const int i = idx & 15, part = (idx >> 4) & 1, h = (idx >> 5) & 15; const int t = (int)(idx >> 9);
    const float pos = part ? (float)(t % 64) : (float)(t / 64);
    const float ang = pos * inv_freq(i), cs = cosf(ang), sn = sinf(ang);
    float* p = Q + (long)(LC + t) * (NH * DQK) + h * DQK + DN + part * 32;
    const float x1 = p[i], x2 = p[i + 16];
    p[i] = x1 * cs - x2 * sn; p[i + 16] = x2 * cs + x1 * sn;
}
__global__ void k_rope_k(const float* P, float* KR) {
    const long idx = blockIdx.x * 256L + threadIdx.x;
    if (idx >= (long)MT * 32) return;
    const int i = idx & 15, part = (idx >> 4) & 1; const int r = (int)(idx >> 5);
    const float* p = P + (long)r * DIN + OFF_KR + part * 32; float* o = KR + (long)r * DR + part * 32;
    const float x1 = p[i], x2 = p[i + 16];
    if (r < LC) { o[i] = x1; o[i + 16] = x2; return; }
    const int t = r - LC; const float pos = part ? (float)(t % 64) : (float)(t / 64);
    const float ang = pos * inv_freq(i), cs = cosf(ang), sn = sinf(ang);
    o[i] = x1 * cs - x2 * sn; o[i + 16] = x2 * cs + x1 * sn;
}
__global__ __launch_bounds__(256) void k_softmax(float* SC, int n) {
    __shared__ float red[4];
    float* s = SC + (long)blockIdx.x * n;
    float mx = -3.0e38f;
    for (int j = threadIdx.x; j < n; j += 256) mx = fmaxf(mx, s[j]);
    mx = block_max(mx, red);
    float sum = 0.f;
    for (int j = threadIdx.x; j < n; j += 256) { const float e = expf(s[j] - mx); s[j] = e; sum += e; }
    sum = block_sum(sum, red);
    const float inv = 1.f / sum;
    for (int j = threadIdx.x; j < n; j += 256) s[j] *= inv;
}
__global__ void k_conv(const float* P, const float* wconv, float* V2) {
    const long idx = blockIdx.x * 256L + threadIdx.x; if (idx >= (long)MT * CW) return;
    const int c = idx % CW; const int r = (int)(idx / CW);
    const int lo = r < LC ? 0 : LC, hi = r < LC ? LC : MT;
    const float* p = P + (long)r * DIN;
    float acc = wconv[CW + c] * (p[OFF_CC + c] * p[OFF_CX + c]);
    if (r - 1 >= lo) acc += wconv[c] * (p[OFF_CC + c - DIN] * p[OFF_CX + c - DIN]);
    if (r + 1 < hi) acc += wconv[2 * CW + c] * (p[OFF_CC + c + DIN] * p[OFF_CX + c + DIN]);
    V2[idx] = p[OFF_CB + c] * acc;
}
__global__ void k_merge(const float* P, const float* OA, const float* OB, float* MG) {
    const long idx = blockIdx.x * 256L + threadIdx.x; if (idx >= (long)MT * D) return;
    const int c = idx % D; const long r = idx / D;
    MG[idx] = sigm(P[r * DIN + OFF_GA + c]) * OA[idx] + sigm(P[r * DIN + OFF_GB + c]) * OB[idx];
}
__global__ void k_swiglu(float* G, const float* U, long n) {
    for (long i = blockIdx.x * 256L + threadIdx.x; i < n; i += gridDim.x * 256L) G[i] = silu(G[i]) * U[i];
}
__global__ __launch_bounds__(256) void k_router(const float* H2, const float* wr, int* sel, float* gw) {
    const int t = blockIdx.x * 4 + (threadIdx.x >> 6), lane = threadIdx.x & 63;
    const float* h = H2 + (long)(LC + t) * D;
    float lg[NE];
#pragma unroll
    for (int e = 0; e < NE; ++e) lg[e] = 0.f;
    for (int k = lane; k < D; k += 64) { const float hv = h[k];
#pragma unroll
        for (int e = 0; e < NE; ++e) lg[e] += hv * wr[k * NE + e]; }
#pragma unroll
    for (int e = 0; e < NE; ++e) {
#pragma unroll
        for (int o = 32; o > 0; o >>= 1) lg[e] += __shfl_xor(lg[e], o); }
    if (lane == 0) {
        int e0 = 0; for (int e = 1; e < NE; ++e) if (lg[e] > lg[e0]) e0 = e;
        int e1 = e0 == 0 ? 1 : 0; for (int e = 0; e < NE; ++e) if (e != e0 && lg[e] > lg[e1]) e1 = e;
        const float m = lg[e0], a = 1.f, b = expf(lg[e1] - m), inv = 1.f / (a + b);
        sel[2 * t] = e0; sel[2 * t + 1] = e1; gw[2 * t] = a * inv; gw[2 * t + 1] = b * inv;
    }
}
__global__ __launch_bounds__(512) void k_sort(const int* sel, int* cnt, int* off, int* toklist, int* slot_of) {
    __shared__ int scnt[NE];
    const int e = threadIdx.x >> 6, lane = threadIdx.x & 63; const int NA = 2 * SEQ;
    int c = 0;
    for (int a0 = 0; a0 < NA; a0 += 64) c += __popcll(__ballot(sel[a0 + lane] == e));
    if (lane == 0) scnt[e] = c;
    __syncthreads();
    int base = 0; for (int j = 0; j < e; ++j) base += scnt[j];
    if (lane == 0) { cnt[e] = c; off[e] = base; }
    int pos = base;
    for (int a0 = 0; a0 < NA; a0 += 64) {
        const bool f = sel[a0 + lane] == e; const unsigned long long m = __ballot(f);
        if (f) { const int p = pos + __popcll(m & ((1ull << lane) - 1ull)); toklist[p] = LC + (a0 + lane) / 2; slot_of[a0 + lane] = p; }
        pos += __popcll(m);
    }
}
__global__ void k_moe_combine(float* XL, const float* Ys, const int* slot_of, const float* gw, const float* gt2) {
    const long idx = blockIdx.x * 256L + threadIdx.x; if (idx >= (long)SEQ * D) return;
    const int c = idx % D; const int t = (int)(idx / D);
    const float y = gw[2 * t] * Ys[(long)slot_of[2 * t] * D + c] + gw[2 * t + 1] * Ys[(long)slot_of[2 * t + 1] * D + c];
    XL[(long)(LC + t) * D + c] += gt2[c] * y;
}
__global__ __launch_bounds__(256) void k_final(const float* XL, const float* g, float* out) {
    __shared__ float red[4];
    const int r = blockIdx.x; const float* x = XL + (long)(LC + r) * D;
    float v[8]; float ss = 0.f;
#pragma unroll
    for (int j = 0; j < 8; ++j) { v[j] = x[threadIdx.x + 256 * j]; ss += v[j] * v[j]; }
    ss = block_sum(ss, red);
    const float rs = rsqrtf(ss * (1.f / D) + EPS);
#pragma unroll
    for (int j = 0; j < 8; ++j) { const int c = threadIdx.x + 256 * j; out[(long)r * D + c] = v[j] * rs * g[c]; }
}

static inline int nblk(long n) { return (int)((n + 255) / 256); }

static void forward(void* const* d_in, float* out, float* ws, size_t ws_floats, hipStream_t st) {
    const float* x = (const float*)d_in[0]; const float* c = (const float*)d_in[1]; const float* ctx = (const float*)d_in[2]; const float* cctx = (const float*)d_in[3];
    const float* w_ada = (const float*)d_in[4]; const float* b_ada = (const float*)d_in[5]; const float* g_attn = (const float*)d_in[6]; const float* w_in = (const float*)d_in[7];
    const float* g_qa = (const float*)d_in[8]; const float* w_qb = (const float*)d_in[9]; const float* g_kva = (const float*)d_in[10]; const float* w_kvb = (const float*)d_in[11];
    const float* w_conv = (const float*)d_in[12]; const float* w_oa = (const float*)d_in[13]; const float* w_ob = (const float*)d_in[14]; const float* w_o = (const float*)d_in[15];
    const float* g_ffn = (const float*)d_in[16]; const float* w_gd = (const float*)d_in[17]; const float* w_ud = (const float*)d_in[18]; const float* w_dd = (const float*)d_in[19];
    const float* w_router = (const float*)d_in[20]; const float* w_ge = (const float*)d_in[21]; const float* w_ue = (const float*)d_in[22]; const float* w_de = (const float*)d_in[23];
    const float* g_final = (const float*)d_in[24];
    size_t o = 0; auto take = [&](size_t n) { float* p = ws + o; o += (n + 63) / 64 * 64; return p; };
    float* XL = take((size_t)MT * D); float* MOD = take(4 * 6 * D); float* H = take((size_t)MT * D); float* P = take((size_t)MT * DIN);
    float* QN = take((size_t)MT * 512); float* CN = take((size_t)MT * 512); float* Q = take((size_t)MT * NH * DQK); float* KV = take((size_t)MT * NH * 256);
    float* KR = take((size_t)MT * DR); float* SC = take((size_t)NH * 256 * MT); float* ATT = take((size_t)MT * D);
    int* IB = (int*)take(4 * SEQ + 64 + 2 * SEQ + 2 * SEQ);
    if (o > ws_floats) { fprintf(stderr, "slow::forward: workspace too small (%zu > %zu floats)\n", o, ws_floats); return; }
    int* sel = IB; int* slot_of = IB + 2 * SEQ; int* toklist = IB + 4 * SEQ; int* cnt = IB + 6 * SEQ; int* off = cnt + 8; float* gw = (float*)(IB + 6 * SEQ + 64);
    float* OA = SC; float* OB = SC + (size_t)MT * D; float* V2 = SC + 2 * (size_t)MT * D; float* MG = SC + 3 * (size_t)MT * D;
    static_assert((size_t)NH * 256 * MT >= 2 * (size_t)MT * D, "SC region");
    V2 = Q; MG = KV;
    float* OUT = H; float* H2 = H; float* G = P; float* U = P + (size_t)MT * DFF; float* Y = Q; float* Ys = KV;
    static_assert((size_t)MT * DIN >= 2 * (size_t)MT * DFF, "P region holds G and U");

    hipLaunchKernelGGL(k_copy_x, dim3(2048), dim3(256), 0, st, ctx, x, XL);
    hipLaunchKernelGGL(k_ada, dim3(6 * D / 256, 4), dim3(256), 0, st, c, cctx, w_ada, b_ada, MOD);
    for (int i = 0; i < DEPTH; ++i) {
        const bool last = (i == DEPTH - 1);
        const float* modl = MOD + (size_t)(2 * i) * 6 * D; const float* modc = MOD + (size_t)(2 * i + 1) * 6 * D;
        hipLaunchKernelGGL(k_modnorm, dim3(MT), dim3(256), 0, st, XL, g_attn + i * D, modl, modc, 0, D, H);
        { GArgs g{H, D, 0, w_in + (size_t)i * D * DIN, DIN, 1, 0, nullptr, nullptr, nullptr, MT, DIN, D}; gemm<false>(st, g, EpiStore{P, DIN, 0, 1.f, 0}, 1, MT); }
        hipLaunchKernelGGL(k_rms512, dim3(MT), dim3(256), 0, st, P, OFF_QA, g_qa + i * QL, QN);
        hipLaunchKernelGGL(k_rms512, dim3(MT), dim3(256), 0, st, P, OFF_CKV, g_kva + i * KVL, CN);
        { GArgs g{QN, 512, 0, w_qb + (size_t)i * QL * NH * DQK, NH * DQK, 1, 0, nullptr, nullptr, nullptr, MT, NH * DQK, QL}; gemm<false>(st, g, EpiStore{Q, NH * DQK, 0, 1.f, 0}, 1, MT); }
        { GArgs g{CN, 512, 0, w_kvb + (size_t)i * KVL * NH * 256, NH * 256, 1, 0, nullptr, nullptr, nullptr, MT, NH * 256, KVL}; gemm<false>(st, g, EpiStore{KV, NH * 256, 0, 1.f, 0}, 1, MT); }
        hipLaunchKernelGGL(k_rope_q, dim3(nblk((long)SEQ * NH * 32)), dim3(256), 0, st, Q);
        hipLaunchKernelGGL(k_rope_k, dim3(nblk((long)MT * 32)), dim3(256), 0, st, P, KR);
        for (int ch = last ? 0 : -1; ch < SEQ / 256; ++ch) {
            const int q0 = ch < 0 ? 0 : LC + 256 * ch, nk = ch < 0 ? LC : MT;
            { GArgs g{Q + (size_t)q0 * NH * DQK, NH * DQK, DQK, KV, 1, NH * 256, 256, nullptr, nullptr, nullptr, 256, nk, DN}; gemm<true>(st, g, EpiStore{SC, nk, (long)256 * nk, ATT_SCALE, 0}, NH, 256); }
            { GArgs g{Q + (size_t)q0 * NH * DQK + DN, NH * DQK, DQK, KR, 1, DR, 0, nullptr, nullptr, nullptr, 256, nk, DR}; gemm<true>(st, g, EpiStore{SC, nk, (long)256 * nk, ATT_SCALE, 1}, NH, 256); }
            hipLaunchKernelGGL(k_softmax, dim3(NH * 256), dim3(256), 0, st, SC, nk);
            { GArgs g{SC, nk, (long)256 * nk, KV + DN, NH * 256, 1, 256, nullptr, nullptr, nullptr, 256, DV, nk}; gemm<false>(st, g, EpiStore{ATT + (size_t)q0 * D, D, DV, 1.f, 0}, NH, 256); }
        }
        { GArgs g{ATT, D, 0, w_oa + (size_t)i * D * D, D, 1, 0, nullptr, nullptr, nullptr, MT, D, D}; gemm<false>(st, g, EpiStore{OA, D, 0, 1.f, 0}, 1, MT); }
        hipLaunchKernelGGL(k_conv, dim3(nblk((long)MT * CW)), dim3(256), 0, st, P, w_conv + (size_t)i * 3 * CW, V2);
        { GArgs g{V2, CW, 0, w_ob + (size_t)i * CW * D, D, 1, 0, nullptr, nullptr, nullptr, MT, D, CW}; gemm<false>(st, g, EpiStore{OB, D, 0, 1.f, 0}, 1, MT); }
        hipLaunchKernelGGL(k_merge, dim3(nblk((long)MT * D)), dim3(256), 0, st, P, OA, OB, MG);
        { GArgs g{MG, D, 0, w_o + (size_t)i * D * D, D, 1, 0, nullptr, nullptr, nullptr, MT, D, D}; gemm<false>(st, g, EpiResid{XL, modl + 2 * D, modc + 2 * D}, 1, MT); }
        hipLaunchKernelGGL(k_modnorm, dim3(MT), dim3(256), 0, st, XL, g_ffn + i * D, modl, modc, 3 * D, 4 * D, H2);
        if (i % 2 == 0) {
            const int j = i / 2;
            { GArgs g{H2, D, 0, w_gd + (size_t)j * D * DFF, DFF, 1, 0, nullptr, nullptr, nullptr, MT, DFF, D}; gemm<false>(st, g, EpiStore{G, DFF, 0, 1.f, 0}, 1, MT); }
            { GArgs g{H2, D, 0, w_ud + (size_t)j * D * DFF, DFF, 1, 0, nullptr, nullptr, nullptr, MT, DFF, D}; gemm<false>(st, g, EpiStore{U, DFF, 0, 1.f, 0}, 1, MT); }
            hipLaunchKernelGGL(k_swiglu, dim3(4096), dim3(256), 0, st, G, U, (long)MT * DFF);
            { GArgs g{G, DFF, 0, w_dd + (size_t)j * DFF * D, D, 1, 0, nullptr, nullptr, nullptr, MT, D, DFF}; gemm<false>(st, g, EpiResid{XL, modl + 5 * D, modc + 5 * D}, 1, MT); }
        } else {
            const int j = i / 2;
            float* Ge = P; float* Ue = P + (size_t)2 * SEQ * DFE;
            hipLaunchKernelGGL(k_router, dim3(SEQ / 4), dim3(256), 0, st, H2, w_router + (size_t)j * D * NE, sel, gw);
            hipLaunchKernelGGL(k_sort, dim3(1), dim3(512), 0, st, sel, cnt, off, toklist, slot_of);
            { GArgs g{H2, D, 0, w_ge + (size_t)j * NE * D * DFE, DFE, 1, (long)D * DFE, toklist, off, cnt, 0, DFE, D}; gemm<false>(st, g, EpiStore{Ge, DFE, 0, 1.f, 0}, NE, SEQ); }
            { GArgs g{H2, D, 0, w_ue + (size_t)j * NE * D * DFE, DFE, 1, (long)D * DFE, toklist, off, cnt, 0, DFE, D}; gemm<false>(st, g, EpiStore{Ue, DFE, 0, 1.f, 0}, NE, SEQ); }
            hipLaunchKernelGGL(k_swiglu, dim3(4096), dim3(256), 0, st, Ge, Ue, (long)2 * SEQ * DFE);
            { GArgs g{Ge, DFE, 0, w_de + (size_t)j * NE * DFE * D, D, 1, (long)DFE * D, nullptr, off, cnt, 0, D, DFE}; gemm<false>(st, g, EpiStore{Ys, D, 0, 1.f, 0}, NE, SEQ); }
            hipLaunchKernelGGL(k_moe_combine, dim3(nblk((long)SEQ * D)), dim3(256), 0, st, XL, Ys, slot_of, gw, modl + 5 * D);
        }
        (void)OUT; (void)Y;
    }
    hipLaunchKernelGGL(k_final, dim3(SEQ), dim3(256), 0, st, XL, g_final, out);
}
}


namespace mk {
#define LAS __attribute__((address_space(3)))
#define GAS __attribute__((address_space(1)))
typedef unsigned short bf16;
typedef short bf16x8 __attribute__((ext_vector_type(8)));
typedef short s16x4 __attribute__((ext_vector_type(4)));
typedef float f32x2 __attribute__((ext_vector_type(2)));
typedef float f32x4 __attribute__((ext_vector_type(4)));
typedef float f32x16 __attribute__((ext_vector_type(16)));
typedef unsigned u32x2 __attribute__((ext_vector_type(2)));
typedef unsigned u32x4 __attribute__((ext_vector_type(4)));
typedef __bf16 bf16x2_t __attribute__((ext_vector_type(2)));
typedef int i32x4 __attribute__((ext_vector_type(4)));
typedef GAS unsigned gu32;

constexpr int NWAVES = 8, NTHREADS = 512;
constexpr int NT_IN = 45;
constexpr int NIN = NT_IN * 256;
constexpr int KS_ADA = 16;
constexpr int MAXT = 72;
constexpr int XS_ROWS = MAXT * 256;

constexpr size_t al256(size_t x) { return (x + 255) / 256 * 256; }
constexpr size_t WS_CTL = 0, CTL_BYTES = 1u << 20;
constexpr size_t WS_MOD = WS_CTL + CTL_BYTES;
constexpr size_t WS_PART = WS_MOD + al256((size_t)4 * 6 * D * 4);
constexpr size_t WS_ROPE = WS_PART + al256((size_t)2 * KS_ADA * 2 * 6 * D * 4);
constexpr size_t WS_SEL = WS_ROPE + al256(2 * 128 * 16 * 4);
constexpr size_t WS_GW = WS_SEL + al256((size_t)2 * SEQ * 4);
constexpr size_t WS_SLOT = WS_GW + al256((size_t)2 * SEQ * 4);
constexpr int SC_IN = 0, SC_GU = 2 * NIN, SC_GUE = SC_GU + 2 * DFF, SC_TOTAL = SC_GUE + NE * 2 * DFE;
constexpr size_t WS_HSC = WS_SLOT + al256((size_t)2 * SEQ * 4);
constexpr size_t WS_XSC = WS_HSC + al256((size_t)MT * 4);
constexpr size_t WS_WSC = WS_XSC + al256((size_t)XS_ROWS * 4);
constexpr size_t CTL_COLMAX = 65536;
static_assert(CTL_COLMAX + (size_t)SC_TOTAL * 4 <= CTL_BYTES, "column maxima inside the zeroed control region");
constexpr size_t WS_XL = WS_WSC + al256((size_t)SC_TOTAL * 4);
constexpr size_t WS_HN = WS_XL + al256((size_t)MT * D * 4);
constexpr size_t WS_MIX = WS_HN + al256((size_t)MT * D * 2);
constexpr size_t MX_QC = 0;
constexpr size_t MX_KRB = MX_QC + al256((size_t)MT * 1024 * 2);
constexpr size_t MX_SSQ = MX_KRB + al256((size_t)MT * 64 * 2);
constexpr size_t MX_U = MX_SSQ + al256((size_t)MT * 16 * 4);
constexpr size_t MX_CB = MX_U + al256((size_t)MT * D * 2);
constexpr size_t MX_SGA = MX_CB + al256((size_t)MT * D * 2);
constexpr size_t MX_SGB = MX_SGA + al256((size_t)MT * D * 2);
constexpr size_t MX_Q = MX_SGB + al256((size_t)MT * D * 2);
constexpr size_t MX_KV = MX_Q + al256((size_t)MT * 3072 * 2);
constexpr size_t MX_O = MX_KV + al256((size_t)MT * 4096 * 2);
constexpr size_t MX_V2 = MX_O + al256((size_t)MT * D * 2);
constexpr size_t MX_M1 = MX_V2 + al256((size_t)MT * D * 2);
constexpr size_t MX_MG = MX_M1 + al256((size_t)MT * D * 2);
constexpr size_t MX_END = MX_MG + al256((size_t)MT * D * 2);
constexpr size_t FX_ACT = 0;
constexpr size_t FX_XS = 0;
constexpr size_t FX_ACTE = FX_XS + al256((size_t)XS_ROWS * D * 2);
constexpr size_t FX_YS = FX_ACTE + al256((size_t)XS_ROWS * DFE * 2);
constexpr size_t FX_END = FX_YS + al256((size_t)XS_ROWS * D * 2);
static_assert(MX_SGA - MX_CB == (size_t)MT * D * 2 && MX_SGB - MX_SGA == (size_t)MT * D * 2, "CB | SGA | SGB contiguous");
static_assert(FX_END <= MX_END && (size_t)MT * DFF * 2 <= MX_END, "FFN scratch overlays the mixer scratch");
constexpr size_t WS_W = WS_MIX + MX_END;
constexpr size_t W_IN = 0, W_IN_L = (size_t)NIN * D * 2;
constexpr size_t W_QB = W_IN + 2 * W_IN_L, W_QB_L = (size_t)3072 * 512 * 2;
constexpr size_t W_KVB = W_QB + 2 * W_QB_L, W_KVB_L = (size_t)4096 * 512 * 2;
constexpr size_t W_OA = W_KVB + 2 * W_KVB_L, W_SQ_L = (size_t)D * D * 2;
constexpr size_t W_OB = W_OA + 2 * W_SQ_L, W_O = W_OB + 2 * W_SQ_L;
constexpr size_t W_GU = W_O + 2 * W_SQ_L;
constexpr size_t W_DD = W_GU + (size_t)2 * DFF * D * 2;
constexpr size_t W_GUE = W_DD + (size_t)D * DFF * 2, W_GUE_E = (size_t)2 * DFE * D * 2;
constexpr size_t W_DE = W_GUE + NE * W_GUE_E, W_DE_E = (size_t)D * DFE * 2;
constexpr size_t W_END = W_DE + NE * W_DE_E;
constexpr size_t WS_END = WS_W + W_END;

constexpr int RING_BYTES = 131072;
constexpr int LCTL_OFF = RING_BYTES;
constexpr int LDS_BYTES = 147456;

__device__ __forceinline__ unsigned cvtpk(float lo, float hi) { f32x2 v = {lo, hi}; bf16x2_t b = __builtin_convertvector(v, bf16x2_t); return __builtin_bit_cast(unsigned, b); }
__device__ __forceinline__ u32x4 pack8(f32x4 a, f32x4 b) { u32x4 w; w.x = cvtpk(a[0], a[1]); w.y = cvtpk(a[2], a[3]); w.z = cvtpk(b[0], b[1]); w.w = cvtpk(b[2], b[3]); return w; }
__device__ __forceinline__ void unpack8(u32x4 w, f32x4& a, f32x4& b) {
    a[0] = __uint_as_float(w.x << 16); a[1] = __uint_as_float(w.x & 0xffff0000u); a[2] = __uint_as_float(w.y << 16); a[3] = __uint_as_float(w.y & 0xffff0000u);
    b[0] = __uint_as_float(w.z << 16); b[1] = __uint_as_float(w.z & 0xffff0000u); b[2] = __uint_as_float(w.w << 16); b[3] = __uint_as_float(w.w & 0xffff0000u); }
__device__ __forceinline__ f32x4 unpack4(u32x2 w) { f32x4 a; a[0] = __uint_as_float(w.x << 16); a[1] = __uint_as_float(w.x & 0xffff0000u); a[2] = __uint_as_float(w.y << 16); a[3] = __uint_as_float(w.y & 0xffff0000u); return a; }
__device__ __forceinline__ float fsig(float x) { return __builtin_amdgcn_rcpf(1.f + __builtin_amdgcn_exp2f(-1.4426950408889634f * x)); }
__device__ __forceinline__ f32x4 fsig4(f32x4 x) { f32x4 r; r[0] = fsig(x[0]); r[1] = fsig(x[1]); r[2] = fsig(x[2]); r[3] = fsig(x[3]); return r; }
__device__ __forceinline__ float wave_sum(float v) {
#pragma unroll
    for (int o = 1; o < 64; o <<= 1) v += __shfl_xor(v, o);
    return v;
}
#define LDS_WAIT() asm volatile("s_waitcnt lgkmcnt(0)" ::: "memory")
#define VM_WAIT() asm volatile("s_waitcnt vmcnt(0)" ::: "memory")

namespace pg8 {
constexpr int BM = 256, BK = 64, HALF = 128, HTB = HALF * BK * 2, STAGE_BYTES = 8 * HTB, NXCD = 8, WGM = 8;
__device__ __forceinline__ int lds_byte(int r, int c) { const int st = (r >> 4) * 2 + (c >> 5), rr = r & 15, cc = c & 31, ob = rr * 64 + cc * 2; return st * 1024 + (ob ^ (((ob >> 9) & 1) << 5)); }
__device__ __forceinline__ void stage_rc(int b, int& R, int& C) { const int st = b / 1024, sb = b % 1024, swz = sb ^ (((sb >> 9) & 1) << 5); R = (st >> 1) * 16 + swz / 64; C = (st & 1) * 32 + (swz % 64) / 2; }
__device__ __forceinline__ int perm32(int rho) { const int n = rho >> 4, i = rho & 15; return 8 * (i >> 2) + 4 * n + (i & 3); }
struct Unit { int pm, pn, kind; };
struct Geo { int lda, ldb, K; };
__device__ __forceinline__ void tile_of(int L, int nM, int nN, int& pm, int& pn) {
    const int nwg = nM * nN; int wgid = L; { const int q = nwg / NXCD, r = nwg % NXCD, xcd = wgid % NXCD, off = wgid / NXCD; wgid = (xcd < r ? xcd * (q + 1) : r * (q + 1) + (xcd - r) * q) + off; }
    const int nig = WGM * nN, gid = wgid / nig, fm = gid * WGM, gsz = (nM - fm) < WGM ? (nM - fm) : WGM;
    pm = fm + ((wgid % nig) % gsz); pn = (wgid % nig) / gsz;
}
template <class Epi, class Sched, bool ALIGN_EPI, bool I8 = false>
__device__ __forceinline__ void gemm_phase(LAS unsigned char* lds, const Geo g, const Sched& S, const Epi& E) {
    int tid = threadIdx.x; asm volatile("" : "+v"(tid));
    const int wid = __builtin_amdgcn_readfirstlane(tid >> 6), lane = tid & 63, wr = wid >> 2, wc = wid & 3, fr = lane & 15, fq = lane >> 4;
    const int nt = g.K / BK;
    unsigned voffA[2], voffB[2];
#pragma unroll
    for (int i = 0; i < 2; ++i) { int R, C; stage_rc(tid * 16 + i * 8192, R, C); const int Rb = Epi::PERM ? ((R & ~31) + perm32(R & 31)) : R;
        voffA[i] = (unsigned)(R * g.lda + C) * 2u; voffB[i] = (unsigned)(Rb * g.ldb + C) * 2u; }
    const size_t kstep = (size_t)(BK * 2);
    const size_t hstepA = (size_t)HALF * g.lda * 2, hstepB = (size_t)HALF * g.ldb * 2;
    const unsigned ldsw = (unsigned)wid * 1024u;
    const int aoff = lds_byte(wr * 64 + fr, fq * 8), boff = lds_byte(wc * 32 + fr, fq * 8);
#define PG8_SA(b, h) (((b) * 2 + (h)) * HTB)
#define PG8_SB(b, h) ((4 + (b) * 2 + (h)) * HTB)
#define PG8_STAGE(bufoff, gbase, voff) do { _Pragma("unroll") for (int _i = 0; _i < 2; ++_i) \
        __builtin_amdgcn_global_load_lds((const unsigned*)((const char*)(gbase) + (voff)[_i]), (LAS unsigned*)(lds + (bufoff) + ldsw + _i * 8192), 16, 0, 0); } while (0)
#define PG8_LDA(dst, b, h) do { _Pragma("unroll") for (int m = 0; m < 4; ++m) _Pragma("unroll") for (int k = 0; k < 2; ++k) dst[m][k] = *(const LAS bf16x8*)(lds + PG8_SA(b, h) + aoff + m * 2048 + k * 1024); } while (0)
#define PG8_LDB(dst, b, h) do { _Pragma("unroll") for (int n = 0; n < 2; ++n) _Pragma("unroll") for (int k = 0; k < 2; ++k) dst[n][k] = *(const LAS bf16x8*)(lds + PG8_SB(b, h) + boff + n * 2048 + k * 1024); } while (0)
#define PG8_MMA(ai, bj, At, Bt) do { __builtin_amdgcn_s_setprio(1); _Pragma("unroll") for (int m = 0; m < 4; ++m) _Pragma("unroll") for (int n = 0; n < 2; ++n) _Pragma("unroll") for (int k = 0; k < 2; ++k) { \
        if constexpr (I8) acc[ai][bj][m][n] = __builtin_bit_cast(f32x4, __builtin_amdgcn_mfma_i32_16x16x64_i8(__builtin_bit_cast(i32x4, Bt[n][k]), __builtin_bit_cast(i32x4, At[m][k]), __builtin_bit_cast(i32x4, acc[ai][bj][m][n]), 0, 0, 0)); \
        else acc[ai][bj][m][n] = __builtin_amdgcn_mfma_f32_16x16x32_bf16(Bt[n][k], At[m][k], acc[ai][bj][m][n], 0, 0, 0); } __builtin_amdgcn_s_setprio(0); } while (0)
#define PG8_WAIT_V(n) asm volatile("s_waitcnt vmcnt(" #n ")" ::: "memory")
#define PG8_WAIT_L(n) asm volatile("s_waitcnt lgkmcnt(" #n ")" ::: "memory")
#define PG8_BAR __builtin_amdgcn_s_barrier()
#define PG8_SCHED __builtin_amdgcn_sched_barrier(0)
    Unit cur, nxt; int ui = 0;
    if (!S.next(0, cur)) return;
    float zf = 0.f; asm volatile("" : "+v"(zf));
    f32x4 acc[2][2][4][2];
#pragma unroll
    for (int a = 0; a < 2; ++a)
#pragma unroll
        for (int b = 0; b < 2; ++b)
#pragma unroll
            for (int m = 0; m < 4; ++m)
#pragma unroll
                for (int n = 0; n < 2; ++n) acc[a][b][m][n] = (f32x4){zf, zf, zf, zf};
    bf16x8 At[4][2], B0[2][2], B1[2][2];
    const char* cA = S.abase(cur); const char* cB = S.bbase(cur);
    PG8_STAGE(PG8_SB(0, 0), cB, voffB); PG8_STAGE(PG8_SB(0, 1), cB + hstepB, voffB); PG8_STAGE(PG8_SA(0, 0), cA, voffA); PG8_STAGE(PG8_SA(0, 1), cA + hstepA, voffA);
    if (wr == 1) PG8_BAR;
    PG8_WAIT_V(2); PG8_BAR;
    PG8_STAGE(PG8_SB(1, 0), cB + kstep, voffB); PG8_STAGE(PG8_SA(1, 0), cA + kstep, voffA); PG8_STAGE(PG8_SB(1, 1), cB + hstepB + kstep, voffB);
    PG8_WAIT_V(6); PG8_BAR;
    for (;;) {
        const bool has_next = S.next(ui + 1, nxt);
        const char* nA = has_next ? S.abase(nxt) : cA; const char* nB = has_next ? S.bbase(nxt) : cB;
        for (int t = 0; t < nt; t += 2) {
            const bool last = (t == nt - 2);
            const char* a1 = cA + (size_t)(t + 1) * kstep;
            const char* a2 = last ? nA : cA + (size_t)(t + 2) * kstep; const char* b2 = last ? nB : cB + (size_t)(t + 2) * kstep;
            const char* a3 = a2 + kstep; const char* b3 = b2 + kstep;
            PG8_LDB(B0, 0, 0); PG8_LDB(B1, 0, 1); PG8_SCHED; PG8_LDA(At, 0, 0); PG8_STAGE(PG8_SA(1, 1), a1 + hstepA, voffA);
            PG8_WAIT_V(8); PG8_WAIT_L(0); PG8_BAR; PG8_MMA(0, 0, At, B0); PG8_MMA(0, 1, At, B1); PG8_BAR; PG8_SCHED;
            PG8_LDA(At, 0, 1); PG8_STAGE(PG8_SB(0, 0), b2, voffB); PG8_STAGE(PG8_SB(0, 1), b2 + hstepB, voffB); PG8_STAGE(PG8_SA(0, 0), a2, voffA);
            PG8_WAIT_V(8); PG8_WAIT_L(0); PG8_BAR; PG8_MMA(1, 0, At, B0); PG8_MMA(1, 1, At, B1); PG8_BAR; PG8_SCHED;
            PG8_LDB(B0, 1, 0); PG8_LDB(B1, 1, 1); PG8_SCHED; PG8_LDA(At, 1, 0); PG8_STAGE(PG8_SA(0, 1), a2 + hstepA, voffA);
            PG8_WAIT_V(8); PG8_WAIT_L(0); PG8_BAR; PG8_MMA(0, 0, At, B0); PG8_MMA(0, 1, At, B1); PG8_BAR; PG8_SCHED;
            PG8_LDA(At, 1, 1); PG8_STAGE(PG8_SB(1, 0), b3, voffB); PG8_STAGE(PG8_SB(1, 1), b3 + hstepB, voffB); PG8_STAGE(PG8_SA(1, 0), a3, voffA);
            PG8_WAIT_V(8); PG8_WAIT_L(0); PG8_BAR; PG8_MMA(1, 0, At, B0); PG8_MMA(1, 1, At, B1); PG8_BAR; PG8_SCHED;
        }
        if constexpr (ALIGN_EPI) { if (wr == 0) PG8_BAR; }
        if constexpr (I8) {
            static_assert(Epi::PERM, "the int8 path dequantises in the PERM column layout");
            const float* sa = S.sa(cur) + wr * 64 + fr; const float* sb = S.sb(cur) + wc * 32 + 8 * fq;
            f32x4 sbv[2][2];
#pragma unroll
            for (int b = 0; b < 2; ++b)
#pragma unroll
                for (int n = 0; n < 2; ++n) sbv[b][n] = *(const f32x4*)(sb + b * HALF + 4 * n);
#pragma unroll
            for (int a = 0; a < 2; ++a)
#pragma unroll
                for (int m = 0; m < 4; ++m) { const float sr = sa[a * HALF + m * 16];
#pragma unroll
                    for (int b = 0; b < 2; ++b)
#pragma unroll
                        for (int n = 0; n < 2; ++n) { const i32x4 iv = __builtin_bit_cast(i32x4, acc[a][b][m][n]);
                            acc[a][b][m][n] = (f32x4){(float)iv[0], (float)iv[1], (float)iv[2], (float)iv[3]} * (sbv[b][n] * sr); } }
        }
        E(acc, cur, wr, wc, fr, fq);
        if (!has_next) break;
#pragma unroll
        for (int a = 0; a < 2; ++a)
#pragma unroll
            for (int b = 0; b < 2; ++b)
#pragma unroll
                for (int m = 0; m < 4; ++m)
#pragma unroll
                    for (int n = 0; n < 2; ++n) acc[a][b][m][n] = (f32x4){zf, zf, zf, zf};
        cur = nxt; cA = nA; cB = nB; ++ui;
        if constexpr (ALIGN_EPI) { if (wr == 1) PG8_BAR; }
    }
    PG8_WAIT_V(0);
    if constexpr (!ALIGN_EPI) { if (wr == 0) PG8_BAR; }
    PG8_BAR;
#undef PG8_SA
#undef PG8_SB
#undef PG8_STAGE
#undef PG8_LDA
#undef PG8_LDB
#undef PG8_MMA
#undef PG8_WAIT_V
#undef PG8_WAIT_L
#undef PG8_BAR
#undef PG8_SCHED
}

struct TileOrder {
    int nM, nN, pm0, G, c, nx, xpm, xpn0;
    const char* A; const char* B; size_t tstepA, tstepB; const float* SA; const float* SB;
    __device__ __forceinline__ const float* sa(const Unit& u) const { return SA + (size_t)u.pm * 256; }
    __device__ __forceinline__ const float* sb(const Unit& u) const { return SB + (size_t)u.pn * 256; }
    __device__ __forceinline__ bool next(int i, Unit& u) const {
        const int L = i * G + c, n1 = nM * nN;
        if (L < n1) { tile_of(L, nM, nN, u.pm, u.pn); u.pm += pm0; u.kind = 0; return true; }
        if (L < n1 + nx) { u.pm = xpm; u.pn = xpn0 + (L - n1); u.kind = 0; return true; }
        return false; }
    __device__ __forceinline__ const char* abase(const Unit& u) const { return A + (size_t)u.pm * tstepA; }
    __device__ __forceinline__ const char* bbase(const Unit& u) const { return B + (size_t)u.pn * tstepB; }
};
struct QkvOrder {
    int nMkv, nMq, pm0q, G, c; const char* QC; const char* WQB; long dkv;
    __device__ __forceinline__ bool next(int i, Unit& u) const {
        const int L = i * G + c, n1 = nMkv * 16;
        if (L < n1) { tile_of(L, nMkv, 16, u.pm, u.pn); u.kind = 0; return true; }
        if (L < n1 + nMq * 12) { tile_of(L - n1, nMq, 12, u.pm, u.pn); u.pm += pm0q; u.kind = 1; return true; }
        return false; }
    __device__ __forceinline__ const char* abase(const Unit& u) const { return QC + (size_t)u.pm * (256 * 1024 * 2) + (u.kind == 0 ? 1024 : 0); }
    __device__ __forceinline__ const char* bbase(const Unit& u) const { return WQB + (u.kind == 0 ? dkv : 0l) + (size_t)u.pn * (256 * 512 * 2); }
};
struct MoeOrder {
    int T, nN, G, c; const char* A; const char* B; size_t tstepA, tstepB, estride; const LAS int* te; const float* SA; const float* SB; int sbstride; const LAS int* remap;
    __device__ __forceinline__ const float* sa(const Unit& u) const { return SA + (size_t)u.pm * 256; }
    __device__ __forceinline__ const float* sb(const Unit& u) const { const int e = __builtin_amdgcn_readfirstlane(te[u.pm]); return SB + (size_t)e * sbstride + (size_t)u.pn * 256; }
    __device__ __forceinline__ bool next(int i, Unit& u) const {
        const int L = i * G + c; if (L >= T * nN) return false;
        tile_of(L, T, nN, u.pm, u.pn); u.kind = 0; if (remap) u.pm = __builtin_amdgcn_readfirstlane(remap[u.pm]); return true; }
    __device__ __forceinline__ const char* abase(const Unit& u) const { return A + (size_t)u.pm * tstepA; }
    __device__ __forceinline__ const char* bbase(const Unit& u) const { const int e = __builtin_amdgcn_readfirstlane(te[u.pm]); return B + (size_t)e * estride + (size_t)u.pn * tstepB; }
};

typedef const f32x4 (&AccRef)[2][2][4][2];
struct EpiInproj {
    static constexpr bool PERM = true;
    bf16* QC; bf16* KRB; bf16* U; bf16* CB; float* SSQ; const float* ROPE;
    __device__ __forceinline__ void operator()(AccRef acc, const Unit& u, int wr, int wc, int fr_, int fq_) const {
        int fr = fr_, fq = fq_; asm volatile("" : "+v"(fr), "+v"(fq));
        const int pn = u.pn, row0 = u.pm * BM + wr * 64 + fr;
        if (pn < 4) {
#pragma unroll
            for (int ai = 0; ai < 2; ++ai)
#pragma unroll
                for (int m = 0; m < 4; ++m) { const int row = row0 + ai * HALF + m * 16; float s = 0.f;
#pragma unroll
                    for (int bj = 0; bj < 2; ++bj) { const f32x4 v0 = acc[ai][bj][m][0], v1 = acc[ai][bj][m][1];
                        s += (v0[0] * v0[0] + v0[1] * v0[1]) + (v0[2] * v0[2] + v0[3] * v0[3]) + (v1[0] * v1[0] + v1[1] * v1[1]) + (v1[2] * v1[2] + v1[3] * v1[3]);
                        *(u32x4*)(QC + (size_t)row * 1024 + pn * 256 + bj * HALF + wc * 32 + 8 * fq) = pack8(v0, v1); }
                    s += __shfl_xor(s, 16); s += __shfl_xor(s, 32);
                    if (fq == 0) SSQ[(size_t)row * 16 + pn * 4 + wc] = s; }
        } else if (pn == 4) {
            if (wc < 2) {
#pragma unroll
                for (int ai = 0; ai < 2; ++ai)
#pragma unroll
                    for (int m = 0; m < 4; ++m) { const int row = row0 + ai * HALF + m * 16; f32x4 v0 = acc[ai][0][m][0], v1 = acc[ai][0][m][1];
                        if (row >= LC) { const int t = row - LC, pos = wc ? (t & 63) : (t >> 6);
                            const f32x4 cs = *(const f32x4*)(ROPE + pos * 16 + 4 * fq), sn = *(const f32x4*)(ROPE + 2048 + pos * 16 + 4 * fq);
                            const f32x4 a0 = v0, a1 = v1;
                            v0[0] = a0[0] * cs[0] - a0[1] * sn[0]; v0[1] = a0[1] * cs[0] + a0[0] * sn[0]; v0[2] = a0[2] * cs[1] - a0[3] * sn[1]; v0[3] = a0[3] * cs[1] + a0[2] * sn[1];
                            v1[0] = a1[0] * cs[2] - a1[1] * sn[2]; v1[1] = a1[1] * cs[2] + a1[0] * sn[2]; v1[2] = a1[2] * cs[3] - a1[3] * sn[3]; v1[3] = a1[3] * cs[3] + a1[2] * sn[3]; }
                        *(u32x4*)(KRB + (size_t)row * 64 + wc * 32 + 8 * fq) = pack8(v0, v1); }
            }
        } else if (pn < 21) {
            const int j = pn - 5;
#pragma unroll
            for (int ai = 0; ai < 2; ++ai)
#pragma unroll
                for (int m = 0; m < 4; ++m) { const int row = row0 + ai * HALF + m * 16;
                    *(u32x4*)(U + (size_t)row * D + j * 128 + wc * 32 + 8 * fq) = pack8(acc[ai][0][m][0] * acc[ai][1][m][0], acc[ai][0][m][1] * acc[ai][1][m][1]); }
        } else {
            bf16* dst = CB + (size_t)((pn - 21) >> 3) * ((size_t)MT * D); const int col = ((pn - 21) & 7) * 256; const bool sg = pn >= 29;
#pragma unroll
            for (int ai = 0; ai < 2; ++ai)
#pragma unroll
                for (int m = 0; m < 4; ++m) { const int row = row0 + ai * HALF + m * 16;
#pragma unroll
                    for (int bj = 0; bj < 2; ++bj) { f32x4 v0 = acc[ai][bj][m][0], v1 = acc[ai][bj][m][1];
                        if (sg) { v0 = fsig4(v0); v1 = fsig4(v1); }
                        *(u32x4*)(dst + (size_t)row * D + col + bj * HALF + wc * 32 + 8 * fq) = pack8(v0, v1); } }
        }
    }
};
struct EpiQkv {
    static constexpr bool PERM = true;
    bf16* Q; bf16* KV; const float* SSQ; const float* ROPE;
    __device__ __forceinline__ void operator()(AccRef acc, const Unit& u, int wr, int wc, int fr_, int fq_) const {
        int fr = fr_, fq = fq_; asm volatile("" : "+v"(fr), "+v"(fq));
        const int row0 = u.pm * BM + wr * 64 + fr, grp = u.kind == 0 ? 8 : 0;
#pragma unroll
        for (int ai = 0; ai < 2; ++ai)
#pragma unroll
            for (int m = 0; m < 4; ++m) { const int row = row0 + ai * HALF + m * 16;
                const f32x4 s0 = *(const f32x4*)(SSQ + (size_t)row * 16 + grp), s1 = *(const f32x4*)(SSQ + (size_t)row * 16 + grp + 4);
                const float rs = rsqrtf(((s0[0] + s0[1]) + (s0[2] + s0[3]) + (s1[0] + s1[1]) + (s1[2] + s1[3])) * (1.f / 512.f) + EPS);
                const float rq = (u.kind == 0) ? rs : rs * (ATT_SCALE * 1.4426950408889634f);
#pragma unroll
                for (int bj = 0; bj < 2; ++bj) { f32x4 v0 = acc[ai][bj][m][0] * rq, v1 = acc[ai][bj][m][1] * rq;
                    if (u.kind == 0) { *(u32x4*)(KV + (size_t)row * 4096 + u.pn * 256 + bj * HALF + wc * 32 + 8 * fq) = pack8(v0, v1); }
                    else { const int hb = (u.pn * 8 + bj * 4 + wc) % 6;
                        if (hb >= 4 && row >= LC) { const int t = row - LC, pos = (hb == 5) ? (t & 63) : (t >> 6);
                            const f32x4 cs = *(const f32x4*)(ROPE + pos * 16 + 4 * fq), sn = *(const f32x4*)(ROPE + 2048 + pos * 16 + 4 * fq);
                            const f32x4 a0 = v0, a1 = v1;
                            v0[0] = a0[0] * cs[0] - a0[1] * sn[0]; v0[1] = a0[1] * cs[0] + a0[0] * sn[0]; v0[2] = a0[2] * cs[1] - a0[3] * sn[1]; v0[3] = a0[3] * cs[1] + a0[2] * sn[1];
                            v1[0] = a1[0] * cs[2] - a1[1] * sn[2]; v1[1] = a1[1] * cs[2] + a1[0] * sn[2]; v1[2] = a1[2] * cs[3] - a1[3] * sn[3]; v1[3] = a1[3] * cs[3] + a1[2] * sn[3]; }
                        *(u32x4*)(Q + (size_t)row * 3072 + u.pn * 256 + bj * HALF + wc * 32 + 8 * fq) = pack8(v0, v1); } } }
    }
};
template <int MODE> struct EpiMerge {
    static constexpr bool PERM = true;
    const bf16* SG; const bf16* M1; bf16* OUT;
    __device__ __forceinline__ void operator()(AccRef acc, const Unit& u, int wr, int wc, int fr_, int fq_) const {
        int fr = fr_, fq = fq_; asm volatile("" : "+v"(fr), "+v"(fq));
        const int row0 = u.pm * BM + wr * 64 + fr;
#pragma unroll
        for (int ai = 0; ai < 2; ++ai)
#pragma unroll
            for (int m = 0; m < 4; ++m) { const int row = row0 + ai * HALF + m * 16;
#pragma unroll
                for (int bj = 0; bj < 2; ++bj) { const size_t off = (size_t)row * D + u.pn * 256 + bj * HALF + wc * 32 + 8 * fq;
                    f32x4 g0, g1; unpack8(*(const u32x4*)(SG + off), g0, g1);
                    f32x4 v0 = acc[ai][bj][m][0] * g0, v1 = acc[ai][bj][m][1] * g1;
                    if (MODE == 1) { f32x4 m0, m1; unpack8(*(const u32x4*)(M1 + off), m0, m1); v0 += m0; v1 += m1; }
                    *(u32x4*)(OUT + off) = pack8(v0, v1); } }
    }
};
struct EpiSwiglu {
    static constexpr bool PERM = true;
    bf16* ACT; int ld;
    __device__ __forceinline__ void operator()(AccRef acc, const Unit& u, int wr, int wc, int fr_, int fq_) const {
        int fr = fr_, fq = fq_; asm volatile("" : "+v"(fr), "+v"(fq));
        const int row0 = u.pm * BM + wr * 64 + fr;
#pragma unroll
        for (int ai = 0; ai < 2; ++ai)
#pragma unroll
            for (int m = 0; m < 4; ++m) { const int row = row0 + ai * HALF + m * 16;
                const f32x4 g0 = acc[ai][0][m][0], g1 = acc[ai][0][m][1];
                const f32x4 v0 = g0 * fsig4(g0) * acc[ai][1][m][0], v1 = g1 * fsig4(g1) * acc[ai][1][m][1];
                *(u32x4*)(ACT + (size_t)row * ld + u.pn * 128 + wc * 32 + 8 * fq) = pack8(v0, v1); }
    }
};
struct EpiResid {
    static constexpr bool PERM = false;
    float* XL; const float* SRC; const float* gl;
    __device__ __forceinline__ void operator()(AccRef acc, const Unit& u, int wr, int wc, int fr_, int fq_) const {
        int fr = fr_, fq = fq_; asm volatile("" : "+v"(fr), "+v"(fq));
        const int row0 = u.pm * BM + wr * 64 + fr; const float* gate = gl + ((u.pm == 0) ? 6 * D : 0);
#pragma unroll
        for (int bj = 0; bj < 2; ++bj)
#pragma unroll
            for (int n = 0; n < 2; ++n) { const int col = u.pn * 256 + bj * HALF + wc * 32 + 16 * n + 4 * fq; const f32x4 gv = *(const f32x4*)(gate + col);
#pragma unroll
                for (int ai = 0; ai < 2; ++ai)
#pragma unroll
                    for (int m = 0; m < 4; ++m) { const size_t o = (size_t)(row0 + ai * HALF + m * 16) * D + col; *(f32x4*)(XL + o) = *(const f32x4*)(SRC + o) + gv * acc[ai][bj][m][n]; } }
    }
};
struct EpiStoreBf16 {
    static constexpr bool PERM = true;
    bf16* C; int ld;
    __device__ __forceinline__ void operator()(AccRef acc, const Unit& u, int wr, int wc, int fr_, int fq_) const {
        int fr = fr_, fq = fq_; asm volatile("" : "+v"(fr), "+v"(fq));
        const int row0 = u.pm * BM + wr * 64 + fr;
#pragma unroll
        for (int ai = 0; ai < 2; ++ai)
#pragma unroll
            for (int m = 0; m < 4; ++m)
#pragma unroll
                for (int bj = 0; bj < 2; ++bj)
                    *(u32x4*)(C + (size_t)(row0 + ai * HALF + m * 16) * ld + u.pn * 256 + bj * HALF + wc * 32 + 8 * fq) = pack8(acc[ai][bj][m][0], acc[ai][bj][m][1]);
    }
};
}

namespace att {
constexpr int QBLK = 32, KVBLK = 64;
constexpr int LDQ = NH * DQK, LDK = NH * 256, LDR = DR, LDO = D;
constexpr int SHM_V = KVBLK * DV * 2, SHM_K = KVBLK * DQK * 2;
constexpr int OFF_K = 2 * SHM_V, OFF_WS = 2 * SHM_V + 2 * SHM_K, OFF_QR = OFF_WS + NWAVES * 64 * 4, OFF_DO = OFF_QR + NWAVES * 4096, SHM_ATTN = OFF_DO + NTHREADS * 20;
static_assert(SHM_ATTN <= RING_BYTES, "attention scratch inside the ring");
constexpr float THR = 8.f;
constexpr int KROPE_OFF = 16384;
#define KSWZ(row, colB) ((row) * 384 + ((colB) ^ (((row) & 7) << 4)))
#define SBAR() __builtin_amdgcn_sched_barrier(0)
__device__ __forceinline__ int crow(int r, int hi) { return (r & 3) + 8 * (r >> 2) + 4 * hi; }
constexpr float THR2 = THR * 1.4426950408889634f;
template <bool FIRST> __device__ __forceinline__ void partialSM(f32x16& p0, f32x16& p1, float& m_reg, f32x16& negm, float& alpha) {
    float pmax = p0[0];
#pragma unroll
    for (int r = 1; r < 16; ++r) pmax = fmaxf(pmax, p0[r]);
#pragma unroll
    for (int r = 0; r < 16; ++r) pmax = fmaxf(pmax, p1[r]);
    { auto rr = __builtin_amdgcn_permlane32_swap(__float_as_uint(pmax), __float_as_uint(pmax), false, false);
      pmax = fmaxf(__uint_as_float(rr[0]), __uint_as_float(rr[1])); }
    alpha = 1.f;
    if (FIRST || !__builtin_expect(__all(pmax <= THR2), 1)) {
        const float d = FIRST ? pmax : fmaxf(pmax, 0.f);
        m_reg += d; if (!FIRST) alpha = __builtin_amdgcn_exp2f(-d);
#pragma unroll
        for (int r = 0; r < 16; ++r) { p0[r] -= d; p1[r] -= d; }
#pragma unroll
        for (int r = 0; r < 16; ++r) negm[r] = -m_reg;
    }
#pragma unroll
    for (int r = 0; r < 16; ++r) p0[r] = __builtin_amdgcn_exp2f(p0[r]);
}
__device__ __forceinline__ void finishSM(f32x16& p0, f32x16& p1, float alpha, float& l_reg, bf16x8& pa0, bf16x8& pa1, bf16x8& pa2, bf16x8& pa3) {
#pragma unroll
    for (int r = 0; r < 16; ++r) p1[r] = __builtin_amdgcn_exp2f(p1[r]);
    float ps = 0;
#pragma unroll
    for (int r = 0; r < 16; ++r) ps += p0[r];
#pragma unroll
    for (int r = 0; r < 16; ++r) ps += p1[r];
    { auto rr = __builtin_amdgcn_permlane32_swap(__float_as_uint(ps), __float_as_uint(ps), false, false);
      ps = __uint_as_float(rr[0]) + __uint_as_float(rr[1]); }
    l_reg = l_reg * alpha + ps;
#define PK4(P, BASE, OUT) do { u32x4 w = {cvtpk(P[BASE + 0], P[BASE + 1]), cvtpk(P[BASE + 2], P[BASE + 3]), cvtpk(P[BASE + 4], P[BASE + 5]), cvtpk(P[BASE + 6], P[BASE + 7])}; \
    OUT = __builtin_bit_cast(bf16x8, w); } while (0)
    PK4(p0, 0, pa0); PK4(p0, 8, pa1); PK4(p1, 0, pa2); PK4(p1, 8, pa3);
#undef PK4
}
__device__ __forceinline__ void qkt(f32x16& p0, f32x16& p1, const LAS char* Ks, const int (&kb)[4], int krd, const bf16x8* qr, const LAS char* qrl, const f32x16& negm) {
#pragma unroll
    for (int d0 = 0; d0 < 12; ++d0) {
        const LAS char* a = d0 < 8 ? Ks + kb[d0 & 3] + (d0 >> 2) * 128 : Ks + kb[d0 - 8] + krd;
        const bf16x8 b0 = *(const LAS bf16x8*)a;
        const bf16x8 b1 = *(const LAS bf16x8*)(a + (d0 < 8 ? 32 * 256 : 32 * 128));
        if (d0 == 0) { p0 = __builtin_amdgcn_mfma_f32_32x32x16_bf16(b0, qr[0], negm, 0, 0, 0); p1 = __builtin_amdgcn_mfma_f32_32x32x16_bf16(b1, qr[0], negm, 0, 0, 0); }
        else { const bf16x8 qf = d0 < 8 ? qr[d0 & 7] : *(const LAS bf16x8*)(qrl + (d0 - 8) * 1024);
            p0 = __builtin_amdgcn_mfma_f32_32x32x16_bf16(b0, qf, p0, 0, 0, 0); p1 = __builtin_amdgcn_mfma_f32_32x32x16_bf16(b1, qf, p1, 0, 0, 0); } }
}
template <int OFF> __device__ __forceinline__ bf16x8 dsr128(int addr) { bf16x8 r; asm volatile("ds_read_b128 %0, %1 offset:%2" : "=v"(r) : "v"(addr), "i"(OFF) : "memory"); return r; }
#define QK_WAIT(n) do { asm volatile("s_waitcnt lgkmcnt(" #n ")" ::: "memory"); SBAR(); } while (0)
template <int SLOT> __device__ __forceinline__ void qkt2(f32x16& p0, f32x16& p1, const int (&nb)[4], const int (&rb)[4], int qrl, const bf16x8* qr, const f32x16& negm) {
    constexpr int S = SLOT * SHM_K;
    bf16x8 a0, a1, b0, b1, qa, qb;
#define RD_N(s, K0, K1) do { K0 = dsr128<S + ((s) >> 2) * 128>(nb[(s) & 3]); K1 = dsr128<S + ((s) >> 2) * 128 + 8192>(nb[(s) & 3]); } while (0)
#define RD_R(s, K0, K1, Q) do { K0 = dsr128<S + KROPE_OFF>(rb[(s) - 8]); K1 = dsr128<S + KROPE_OFF + 4096>(rb[(s) - 8]); Q = dsr128<((s) - 8) * 1024>(qrl); } while (0)
#define MM(K0, K1, Q) do { p0 = __builtin_amdgcn_mfma_f32_32x32x16_bf16(K0, Q, p0, 0, 0, 0); p1 = __builtin_amdgcn_mfma_f32_32x32x16_bf16(K1, Q, p1, 0, 0, 0); SBAR(); } while (0)
    RD_N(0, a0, a1); RD_N(1, b0, b1);
    QK_WAIT(2); p0 = __builtin_amdgcn_mfma_f32_32x32x16_bf16(a0, qr[0], negm, 0, 0, 0); p1 = __builtin_amdgcn_mfma_f32_32x32x16_bf16(a1, qr[0], negm, 0, 0, 0); SBAR(); RD_N(2, a0, a1);
    QK_WAIT(2); MM(b0, b1, qr[1]); RD_N(3, b0, b1);
    QK_WAIT(2); MM(a0, a1, qr[2]); RD_N(4, a0, a1);
    QK_WAIT(2); MM(b0, b1, qr[3]); RD_N(5, b0, b1);
    QK_WAIT(2); MM(a0, a1, qr[4]); RD_N(6, a0, a1);
    QK_WAIT(2); MM(b0, b1, qr[5]); RD_N(7, b0, b1);
    QK_WAIT(2); MM(a0, a1, qr[6]); RD_R(8, a0, a1, qa);
    QK_WAIT(3); MM(b0, b1, qr[7]); RD_R(9, b0, b1, qb);
    QK_WAIT(3); MM(a0, a1, qa); RD_R(10, a0, a1, qa);
    QK_WAIT(3); MM(b0, b1, qb); RD_R(11, b0, b1, qb);
    QK_WAIT(3); MM(a0, a1, qa);
    QK_WAIT(0); MM(b0, b1, qb);
#undef RD_N
#undef RD_R
#undef MM
}
__device__ __forceinline__ int v_st(int k, int c) { const int kk = (k & ~0xC) | ((k & 4) << 1) | ((k & 8) >> 1); return ((kk >> 3) * 4 + (c >> 5)) * 512 + ((kk & 7) * 32 + (c & 31)) * 2; }
__device__ __forceinline__ int v_rd_base(int lane) { return ((lane & 3) << 3) | (((lane >> 2) & 3) << 6) | (((lane >> 4) & 1) << 5) | (((lane >> 5) & 1) << 8); }
constexpr int v_rd_off(int d0, int ks, int half) { return d0 * 512 + ks * 4096 + half * 2048; }
template <int OFF> __device__ __forceinline__ s16x4 tr_read(int vb) {
    s16x4 r; asm volatile("ds_read_b64_tr_b16 %0, %1 offset:%2" : "=&v"(r) : "v"(vb), "i"(OFF) : "memory"); return r;
}
template <int D0> __device__ __forceinline__ void pv_one(f32x16& od, int vb, bf16x8 pa0, bf16x8 pa1, bf16x8 pa2, bf16x8 pa3) {
    const s16x4 l0 = tr_read<v_rd_off(D0, 0, 0)>(vb), h0 = tr_read<v_rd_off(D0, 0, 1)>(vb), l1 = tr_read<v_rd_off(D0, 1, 0)>(vb), h1 = tr_read<v_rd_off(D0, 1, 1)>(vb);
    const s16x4 l2 = tr_read<v_rd_off(D0, 2, 0)>(vb), h2 = tr_read<v_rd_off(D0, 2, 1)>(vb), l3 = tr_read<v_rd_off(D0, 3, 0)>(vb), h3 = tr_read<v_rd_off(D0, 3, 1)>(vb);
    asm volatile("s_waitcnt lgkmcnt(0)" ::: "memory"); SBAR();
#define PK(L, H) (bf16x8){L[0], L[1], L[2], L[3], H[0], H[1], H[2], H[3]}
    od = __builtin_amdgcn_mfma_f32_32x32x16_bf16(PK(l0, h0), pa0, od, 0, 0, 0);
    od = __builtin_amdgcn_mfma_f32_32x32x16_bf16(PK(l1, h1), pa1, od, 0, 0, 0);
    od = __builtin_amdgcn_mfma_f32_32x32x16_bf16(PK(l2, h2), pa2, od, 0, 0, 0);
    od = __builtin_amdgcn_mfma_f32_32x32x16_bf16(PK(l3, h3), pa3, od, 0, 0, 0);
#undef PK
}
__device__ __forceinline__ void pv_d0(f32x16* o, int vb, bf16x8 pa0, bf16x8 pa1, bf16x8 pa2, bf16x8 pa3) {
    pv_one<0>(o[0], vb, pa0, pa1, pa2, pa3); pv_one<1>(o[1], vb, pa0, pa1, pa2, pa3); pv_one<2>(o[2], vb, pa0, pa1, pa2, pa3); pv_one<3>(o[3], vb, pa0, pa1, pa2, pa3);
}
__device__ __forceinline__ void attn_unit(const bf16* Qb, const bf16* KVb, int hoff, const bf16* KRb, bf16* Ob, int seq, LAS char* lds) {
    int tid = threadIdx.x; asm volatile("" : "+v"(tid));
    const int wid = __builtin_amdgcn_readfirstlane(tid >> 6), lane = tid & 63, r32 = lane & 31, hi = lane >> 5;
    LAS char* V_lds = lds; LAS char* K_lds = lds + OFF_K;
        float m_reg = 0.f, l_reg = 0; f32x16 o[4]; bf16x8 qr[8]; f32x16 negm;
#pragma unroll
    for (int r = 0; r < 16; ++r) negm[r] = 0.f;
#pragma unroll
    for (int d = 0; d < 4; ++d)
#pragma unroll
        for (int r = 0; r < 16; ++r) o[d][r] = 0.f;
    const bf16* Qw = Qb + (long)(wid * QBLK + r32) * LDQ + hi * 8;
#pragma unroll
    for (int d0 = 0; d0 < 8; ++d0) qr[d0] = *(const bf16x8*)(Qw + d0 * 16);
    LAS char* qrl = lds + OFF_QR + wid * 4096 + lane * 16;
#pragma unroll
    for (int d0 = 8; d0 < 12; ++d0) *(LAS bf16x8*)(qrl + (d0 - 8) * 1024) = *(const bf16x8*)(Qw + d0 * 16);
    int kb[4];
#pragma unroll
    for (int i = 0; i < 4; ++i) kb[i] = r32 * 256 + (((2 * i + hi) ^ (r32 & 7)) << 4);
    const int krd = KROPE_OFF - r32 * 128; (void)krd;
    int nbase[4], rbase[4];
#pragma unroll
    for (int i = 0; i < 4; ++i) { nbase[i] = (int)(uintptr_t)K_lds + kb[i]; rbase[i] = nbase[i] - r32 * 128; }
    const int vb0 = (int)(uintptr_t)V_lds + v_rd_base(lane);
    unsigned gk[2], gv[2], gr;
#pragma unroll
    for (int i = 0; i < 2; ++i) { const int s = (wid + 8 * i) * 64 + lane;
        { const int row = s >> 4, lc = (s & 15) ^ (row & 7); gk[i] = (unsigned)(row * (LDK * 2) + lc * 16); }
        { const int st = s >> 5, k = (st >> 2) * 8 + ((s & 31) >> 2), cc = (st & 3) * 32 + (s & 3) * 8; gv[i] = (unsigned)(k * (LDK * 2) + cc * 2); } }
    { const int s = wid * 64 + lane, row = s >> 3, lc = (s & 7) ^ (row & 7); gr = (unsigned)(row * (LDR * 2) + lc * 16); }
    LAS u32x4* dofs = (LAS u32x4*)(lds + OFF_DO + tid * 16); LAS unsigned* dofr = (LAS unsigned*)(lds + OFF_DO + NTHREADS * 16 + tid * 4);
    *dofs = (u32x4){gk[0], gk[1], gv[0], gv[1]}; *dofr = gr;
    const unsigned ldsw = (unsigned)wid * 1024u;
    const __amdgpu_buffer_rsrc_t rkv = __builtin_amdgcn_make_buffer_rsrc((void*)KVb, 0, (int)((size_t)MT * LDK * 2), 0x00020000);
    const __amdgpu_buffer_rsrc_t rkr = __builtin_amdgcn_make_buffer_rsrc((void*)KRb, 0, (int)((size_t)MT * LDR * 2), 0x00020000);
#define DMA_K(t, slot) do { const int ko_ = (t) * (KVBLK * LDK * 2) + hoff, ro_ = (t) * (KVBLK * LDR * 2); const u32x4 of_ = *dofs; const unsigned gr_ = *dofr; \
    __builtin_amdgcn_raw_ptr_buffer_load_lds(rkv, (LAS void*)(K_lds + (slot) * SHM_K + ldsw), 16, (int)of_.x, ko_, 0, 0); \
    __builtin_amdgcn_raw_ptr_buffer_load_lds(rkv, (LAS void*)(K_lds + (slot) * SHM_K + 8192 + ldsw), 16, (int)of_.y, ko_, 0, 0); \
    __builtin_amdgcn_raw_ptr_buffer_load_lds(rkr, (LAS void*)(K_lds + (slot) * SHM_K + KROPE_OFF + ldsw), 16, (int)gr_, ro_, 0, 0); } while (0)
#define DMA_V(t, slot) do { const int vo_ = (t) * (KVBLK * LDK * 2) + hoff + DN * 2; const u32x4 of_ = *dofs; \
    __builtin_amdgcn_raw_ptr_buffer_load_lds(rkv, (LAS void*)(V_lds + (slot) * SHM_V + ldsw), 16, (int)of_.z, vo_, 0, 0); \
    __builtin_amdgcn_raw_ptr_buffer_load_lds(rkv, (LAS void*)(V_lds + (slot) * SHM_V + 8192 + ldsw), 16, (int)of_.w, vo_, 0, 0); } while (0)
#define WAITBAR() asm volatile("s_waitcnt vmcnt(0) lgkmcnt(0)\n\ts_barrier" ::: "memory")
#define RESC(a) do { if (__any((a) < 1.f)) { \
    _Pragma("unroll") for (int d = 0; d < 4; ++d) _Pragma("unroll") for (int r = 0; r < 16; ++r) o[d][r] *= (a); } } while (0)
    f32x16 pA0, pA1, pB0, pB1; float alA, alB; bf16x8 pa0, pa1, pa2, pa3; const int NT = seq / KVBLK;
    if (wid >= 4) __builtin_amdgcn_s_setprio(1);
    DMA_K(0, 0); DMA_V(0, 0); WAITBAR();
    DMA_K(1, 1);
    att::qkt2<0>(pA0, pA1, nbase, rbase, (int)(uintptr_t)qrl, qr, negm); partialSM<true>(pA0, pA1, m_reg, negm, alA);
    WAITBAR();
    for (int j = 1; j + 1 < NT; j += 2) {
        DMA_K(j + 1, 0); DMA_V(j, 1);
        SBAR(); att::qkt2<1>(pB0, pB1, nbase, rbase, (int)(uintptr_t)qrl, qr, negm);
        finishSM(pA0, pA1, alA, l_reg, pa0, pa1, pa2, pa3); SBAR();
        pv_d0(o, vb0, pa0, pa1, pa2, pa3); partialSM<false>(pB0, pB1, m_reg, negm, alB);
        RESC(alB); WAITBAR();
        DMA_K(j + 2, 1); DMA_V(j + 1, 0);
        SBAR(); att::qkt2<0>(pA0, pA1, nbase, rbase, (int)(uintptr_t)qrl, qr, negm);
        finishSM(pB0, pB1, alB, l_reg, pa0, pa1, pa2, pa3); SBAR();
        pv_d0(o, vb0 + SHM_V, pa0, pa1, pa2, pa3); partialSM<false>(pA0, pA1, m_reg, negm, alA);
        RESC(alA); WAITBAR();
    }
    DMA_V(NT - 1, 1);
    SBAR(); att::qkt2<1>(pB0, pB1, nbase, rbase, (int)(uintptr_t)qrl, qr, negm);
    finishSM(pA0, pA1, alA, l_reg, pa0, pa1, pa2, pa3); SBAR();
    pv_d0(o, vb0, pa0, pa1, pa2, pa3); partialSM<false>(pB0, pB1, m_reg, negm, alB);
    RESC(alB); WAITBAR();
    finishSM(pB0, pB1, alB, l_reg, pa0, pa1, pa2, pa3); SBAR();
    pv_d0(o, vb0 + SHM_V, pa0, pa1, pa2, pa3);
    const float rli = __builtin_amdgcn_rcpf(l_reg);
    WAITBAR();
    LAS char* stg = lds + wid * 8704 + r32 * 272 + hi * 8;
#pragma unroll
    for (int d0 = 0; d0 < 4; ++d0)
#pragma unroll
        for (int g = 0; g < 4; ++g) { u32x2 w; w.x = cvtpk(o[d0][4 * g] * rli, o[d0][4 * g + 1] * rli); w.y = cvtpk(o[d0][4 * g + 2] * rli, o[d0][4 * g + 3] * rli);
            *(LAS u32x2*)(stg + (32 * d0 + 8 * g) * 2) = w; }
    asm volatile("s_waitcnt lgkmcnt(0)" ::: "memory");
    bf16* Ow = Ob + (long)(wid * QBLK) * LDO;
#pragma unroll
    for (int i = 0; i < 8; ++i) { const int row = i * 4 + (lane >> 4), ch = lane & 15; const u32x4 v = *(const LAS u32x4*)(lds + wid * 8704 + row * 272 + ch * 16); *(u32x4*)(Ow + (long)row * LDO + ch * 8) = v; }
    WAITBAR();
    __builtin_amdgcn_s_setprio(0);
#undef DMA_K
#undef DMA_V
#undef WAITBAR
#undef RESC
}
#undef KSWZ
#undef SBAR
}

#define XB_TMO      128
#define XB_XCNT(j)  (256  + 64 * (j))
#define XB_XSUB(j)  (1280 + 64 * (j))
#define XB_XGEN(j)  (2304 + 64 * (j))
#define XB_TOP      3328
#define XB_TOPGEN   3392
#define XCD_BAR_WORDS 3456
#define XB_SPIN_CAP (1u << 18)
__device__ __forceinline__ unsigned xb_ld(unsigned* p)              { return __hip_atomic_load(p, __ATOMIC_RELAXED, __HIP_MEMORY_SCOPE_AGENT); }
__device__ __forceinline__ unsigned xb_add(unsigned* p, unsigned v) { return __hip_atomic_fetch_add(p, v, __ATOMIC_RELAXED, __HIP_MEMORY_SCOPE_AGENT); }
__device__ __forceinline__ unsigned xb_xcc_id() { return (unsigned)__builtin_amdgcn_s_getreg((3 << 11) | 20) & 0xFu; }
#define XB_SPIN(cond, bar) do { unsigned _sp = 0; while (cond) { __builtin_amdgcn_s_sleep(1); \
    if ((++_sp & 255u) == 0u) { if (xb_ld(&(bar)[XB_TMO])) break; if (_sp > XB_SPIN_CAP) { atomicAdd(&(bar)[XB_TMO], 1u); break; } } } } while (0)
struct XcdBarrier { unsigned* bar; unsigned x; volatile LAS unsigned* st; };
__device__ __forceinline__ XcdBarrier xcd_barrier_post(unsigned* bar, volatile LAS unsigned* st) {
    XcdBarrier b; b.bar = bar; b.x = xb_xcc_id(); b.st = st;
    if (threadIdx.x == 0) (void)xb_add(&bar[XB_XCNT(b.x)], 1u);
    return b;
}
__device__ __forceinline__ void xcd_barrier_complete(unsigned* bar, unsigned x, unsigned& nloc, unsigned& nx) {
    const unsigned G = gridDim.x * gridDim.y * gridDim.z;
    unsigned sum, cnt, mine, sp = 0u;
    for (;;) {
        sum = 0u; cnt = 0u; mine = 0u;
#pragma unroll
        for (unsigned j = 0; j < 16; ++j) { const unsigned c = xb_ld(&bar[XB_XCNT(j)]); sum += c; cnt += (c > 0u) ? 1u : 0u; mine = (j == x) ? c : mine; }
        if (sum == G) break;
        __builtin_amdgcn_s_sleep(1);
        if ((++sp & 255u) == 0u) { if (xb_ld(&bar[XB_TMO])) break; if (sp > XB_SPIN_CAP) { atomicAdd(&bar[XB_TMO], 1u); break; } }
    }
    nloc = mine > 0u ? mine : 1u; nx = cnt > 0u ? cnt : 1u;
}
__device__ __forceinline__ void xcd_barrier(const XcdBarrier& b) {
    asm volatile("s_waitcnt vmcnt(0)" ::: "memory");
    __syncthreads();
    if (threadIdx.x == 0) {
        unsigned* bar = b.bar;
        __builtin_amdgcn_s_waitcnt(0);
        unsigned nloc = b.st[0], nx = b.st[1];
        if (nloc == 0u) { xcd_barrier_complete(bar, b.x, nloc, nx); b.st[0] = nloc; b.st[1] = nx; }
        const unsigned old = xb_add(&bar[XB_XSUB(b.x)], 1u);
        const unsigned gen = old / nloc;
        if (old + 1u == (gen + 1u) * nloc) {
            __builtin_amdgcn_fence(__ATOMIC_RELEASE, "agent");
            asm volatile("s_waitcnt vmcnt(0)" ::: "memory");
            const unsigned og = xb_add(&bar[XB_TOP], 1u);
            const unsigned tg = og / nx;
            if (og + 1u == (tg + 1u) * nx) xb_add(&bar[XB_TOPGEN], 1u);
            else XB_SPIN(xb_ld(&bar[XB_TOPGEN]) == tg, bar);
            __builtin_amdgcn_fence(__ATOMIC_ACQUIRE, "agent");
            xb_add(&bar[XB_XGEN(b.x)], 1u);
            asm volatile("s_waitcnt vmcnt(0)" ::: "memory");
        } else {
            XB_SPIN(xb_ld(&bar[XB_XGEN(b.x)]) == gen, bar);
            __builtin_amdgcn_fence(__ATOMIC_ACQUIRE, "agent");
            asm volatile("s_waitcnt vmcnt(0)" ::: "memory");
        }
    }
    __syncthreads();
}

struct Params { const float* in[25]; float* out; unsigned char* ws; int ph_lo, ph_hi; };
static_assert(sizeof(Params) == 25 * 8 + 8 + 8 + 8, "Params has no padding");
struct Ctx { LAS unsigned char* lds; int tid, lane, wave, vcu, G, bid; };
__device__ __forceinline__ Ctx fresh(const Ctx& c) {
    Ctx f; f.lds = c.lds; int tid = c.tid; asm volatile("" : "+v"(tid)); f.tid = tid; f.lane = tid & 63; f.wave = __builtin_amdgcn_readfirstlane(tid >> 6);
    int vcu = c.vcu, G = c.G, bid = c.bid; asm volatile("" : "+v"(vcu), "+v"(G), "+v"(bid));
    f.vcu = __builtin_amdgcn_readfirstlane(vcu); f.G = __builtin_amdgcn_readfirstlane(G); f.bid = __builtin_amdgcn_readfirstlane(bid); return f; }
__device__ __forceinline__ unsigned char* fresh_ptr(unsigned char* p) { unsigned lo = (unsigned)(unsigned long long)p, hi = (unsigned)((unsigned long long)p >> 32); asm volatile("" : "+v"(lo), "+v"(hi));
    const unsigned long long v = ((unsigned long long)(unsigned)__builtin_amdgcn_readfirstlane((int)hi) << 32) | (unsigned)__builtin_amdgcn_readfirstlane((int)lo); return (unsigned char*)(GAS unsigned char*)v; }

__device__ __forceinline__ int win_dst(int s) {
    if (s < 1024) return s;
    if (s < 1088) { const int j = s - 1024, part = j >> 5, w = j & 31; return 1024 + part * 32 + 2 * (w & 15) + (w >> 4); }
    if (s < 3136) { const int c = s - 1088; return 1280 + 256 * (c >> 7) + (c & 127); }
    if (s < 5184) { return 5376 + (s - 3136); }
    if (s < 7232) { const int c = s - 5184; return 1280 + 256 * (c >> 7) + 128 + (c & 127); }
    if (s < 9280) { return 7424 + (s - 7232); }
    return 9472 + (s - 9280);
}
__device__ __forceinline__ int qb_dst(int n) { const int h = n / DQK, d = n - h * DQK; if (d < DN) return n; const int j = d - DN, part = j >> 5, w = j & 31; return h * DQK + DN + part * 32 + 2 * (w & 15) + (w >> 4); }
__device__ __forceinline__ int map_dst(int mode, int n) {
    switch (mode) { case 1: return win_dst(n); case 2: return qb_dst(n); case 3: return 256 * (n >> 7) + (n & 127); case 4: return 256 * (n >> 7) + 128 + (n & 127); default: return n; }
}
__device__ __forceinline__ void transpose_item(const float* W, int K, int N, bf16* WT, int mode, const float* gk, int item, int lane) {
    const int kblk = K / 64, nb = item / kblk, kb = item - nb * kblk, k0 = 64 * kb + 16 * (lane >> 4), n0 = 64 * nb + 4 * (lane & 15);
    const float* src = W + (size_t)k0 * N + n0;
    f32x4 v[16];
#pragma unroll
    for (int i = 0; i < 16; ++i) v[i] = *(const f32x4*)(src + (size_t)i * N);
    if (gk) {
#pragma unroll
        for (int i = 0; i < 16; ++i) v[i] *= gk[k0 + i]; }
#pragma unroll
    for (int x = 0; x < 4; ++x) { bf16* d = WT + (size_t)map_dst(mode, n0 + x) * K + k0;
        u32x4 lo, hi;
        lo.x = cvtpk(v[0][x], v[1][x]); lo.y = cvtpk(v[2][x], v[3][x]); lo.z = cvtpk(v[4][x], v[5][x]); lo.w = cvtpk(v[6][x], v[7][x]);
        hi.x = cvtpk(v[8][x], v[9][x]); hi.y = cvtpk(v[10][x], v[11][x]); hi.z = cvtpk(v[12][x], v[13][x]); hi.w = cvtpk(v[14][x], v[15][x]);
        *(u32x4*)d = lo; *(u32x4*)(d + 8) = hi; }
}
struct Strip { const float* W; int N, mode, nb; signed char* w8; float* wsc; };
constexpr int ST_IN = DIN / 64, ST_GD = DFF / 64, ST_GE = DFE / 64, N_STRIPS = 2 * ST_IN + 2 * ST_GD + NE * 2 * ST_GE;
__device__ __forceinline__ Strip strip_of(const Params& p, int sid) {
    unsigned char* wb = p.ws + WS_W; float* wsc = (float*)(p.ws + WS_WSC);
    Strip q;
    if (sid < 2 * ST_IN) { const int l = sid / ST_IN; q.nb = sid - l * ST_IN; q.W = p.in[7] + (size_t)l * D * DIN; q.N = DIN; q.mode = 1; q.w8 = (signed char*)(wb + W_IN + l * W_IN_L); q.wsc = wsc + SC_IN + l * NIN; return q; }
    sid -= 2 * ST_IN;
    if (sid < 2 * ST_GD) { const int which = sid / ST_GD; q.nb = sid - which * ST_GD; q.W = p.in[17 + which]; q.N = DFF; q.mode = 3 + which; q.w8 = (signed char*)(wb + W_GU); q.wsc = wsc + SC_GU; return q; }
    sid -= 2 * ST_GD;
    { const int e = sid / (2 * ST_GE); sid -= e * (2 * ST_GE); const int which = sid / ST_GE; q.nb = sid - which * ST_GE; q.W = p.in[21 + which] + (size_t)e * D * DFE; q.N = DFE; q.mode = 3 + which;
      q.w8 = (signed char*)(wb + W_GUE + e * W_GUE_E); q.wsc = wsc + SC_GUE + e * 2 * DFE; return q; }
}
__device__ __forceinline__ unsigned pack4i8(float a, float b, float c, float d) {
    const int ia = (int)__builtin_rintf(a), ib = (int)__builtin_rintf(b), ic = (int)__builtin_rintf(c), id = (int)__builtin_rintf(d);
    return ((unsigned)ia & 0xffu) | (((unsigned)ib & 0xffu) << 8) | (((unsigned)ic & 0xffu) << 16) | ((unsigned)id << 24); }
__device__ __forceinline__ void quant_strip(const Strip& q, const Ctx& c, LAS float* cmax  ) {
    const int qd = c.lane >> 4, c4 = 4 * (c.lane & 15), n0 = 64 * q.nb + c4;
    const float* src = q.W + (size_t)(256 * c.wave + 16 * qd) * q.N + n0;
    f32x4 m = {0.f, 0.f, 0.f, 0.f};
#pragma unroll 1
    for (int sb = 0; sb < 4; ++sb) { f32x4 v[16];
#pragma unroll
        for (int i = 0; i < 16; ++i) v[i] = *(const f32x4*)(src + (size_t)(64 * sb + i) * q.N);
#pragma unroll
        for (int i = 0; i < 16; ++i) m = __builtin_elementwise_max(m, __builtin_elementwise_abs(v[i])); }
#pragma unroll
    for (int x = 0; x < 4; ++x) { float t = m[x]; t = fmaxf(t, __shfl_xor(t, 16)); t = fmaxf(t, __shfl_xor(t, 32)); m[x] = t; }
    if (c.lane < 16) *(LAS f32x4*)(cmax + c.wave * 64 + c4) = m;
    __syncthreads();
    f32x4 am = *(const LAS f32x4*)(cmax + c4);
#pragma unroll
    for (int w = 1; w < 8; ++w) am = __builtin_elementwise_max(am, *(const LAS f32x4*)(cmax + w * 64 + c4));
    f32x4 inv; int dst[4];
#pragma unroll
    for (int x = 0; x < 4; ++x) { inv[x] = am[x] > 0.f ? 127.f / am[x] : 0.f; dst[x] = map_dst(q.mode, n0 + x); }
    if (c.wave == 0 && c.lane < 16) {
#pragma unroll
        for (int x = 0; x < 4; ++x) q.wsc[dst[x]] = am[x] * (1.f / 127.f); }
#pragma unroll 1
    for (int sb = 0; sb < 4; ++sb) { f32x4 v[16];
#pragma unroll
        for (int i = 0; i < 16; ++i) v[i] = *(const f32x4*)(src + (size_t)(64 * sb + i) * q.N);
        const int k0 = 256 * c.wave + 64 * sb + 16 * qd;
#pragma unroll
        for (int x = 0; x < 4; ++x) { const float iv = inv[x];
            u32x4 o; o.x = pack4i8(v[0][x] * iv, v[1][x] * iv, v[2][x] * iv, v[3][x] * iv); o.y = pack4i8(v[4][x] * iv, v[5][x] * iv, v[6][x] * iv, v[7][x] * iv);
            o.z = pack4i8(v[8][x] * iv, v[9][x] * iv, v[10][x] * iv, v[11][x] * iv); o.w = pack4i8(v[12][x] * iv, v[13][x] * iv, v[14][x] * iv, v[15][x] * iv);
            *(u32x4*)(q.w8 + (size_t)dst[x] * D + k0) = o; } }
    __syncthreads();
}
constexpr int I_QB = (QL / 64) * (NH * DQK / 64), I_KVB = (KVL / 64) * (NH * 256 / 64), I_SQ = (D / 64) * (D / 64), I_L = I_QB + I_KVB + 3 * I_SQ;
constexpr int I_DD = (DFF / 64) * (D / 64), I_DE = (DFE / 64) * (D / 64);
constexpr int N_ADA = 2 * KS_ADA * 48, N_SMALL = N_ADA + 2 * I_L + I_DD + NE * I_DE, SMALL_BATCH = 32, N_BATCH = (N_SMALL + SMALL_BATCH - 1) / SMALL_BATCH, N_QUEUE = N_STRIPS + N_BATCH;
__device__ __forceinline__ void small_item(const Params& p, const Ctx& c, int it, const LAS float* sil) {
    unsigned char* ws = p.ws; unsigned char* wb = ws + WS_W;
    if (it < N_ADA) {
        float* part = (float*)(ws + WS_PART); const int cg = it % 48, lk = it / 48, kc = lk % KS_ADA, l = lk / KS_ADA;
        const float* W = p.in[4] + (size_t)l * D * (6 * D) + (size_t)(kc * 128) * (6 * D) + cg * 256 + c.lane * 4;
        float zf = 0.f; asm volatile("" : "+v"(zf)); f32x4 al = {zf, zf, zf, zf}, ac = al;
#pragma unroll 8
        for (int k = 0; k < 128; ++k) { const f32x4 w = *(const f32x4*)(W + (size_t)k * (6 * D)); al += w * sil[kc * 128 + k]; ac += w * sil[D + kc * 128 + k]; }
        *(f32x4*)(part + ((size_t)(l * KS_ADA + kc) * 2 + 0) * (6 * D) + cg * 256 + c.lane * 4) = al;
        *(f32x4*)(part + ((size_t)(l * KS_ADA + kc) * 2 + 1) * (6 * D) + cg * 256 + c.lane * 4) = ac; return; }
    int r = it - N_ADA;
    if (r < 2 * I_L) { const int l = r / I_L; r -= l * I_L;
        if (r < I_QB) { transpose_item(p.in[9] + (size_t)l * QL * NH * DQK, QL, NH * DQK, (bf16*)(wb + W_QB + l * W_QB_L), 2, p.in[8] + l * QL, r, c.lane); return; } r -= I_QB;
        if (r < I_KVB) { transpose_item(p.in[11] + (size_t)l * KVL * NH * 256, KVL, NH * 256, (bf16*)(wb + W_KVB + l * W_KVB_L), 0, p.in[10] + l * KVL, r, c.lane); return; } r -= I_KVB;
        const int which = r / I_SQ; r -= which * I_SQ;
        transpose_item(p.in[13 + which] + (size_t)l * D * D, D, D, (bf16*)(wb + (which == 0 ? W_OA : which == 1 ? W_OB : W_O) + l * W_SQ_L), 0, nullptr, r, c.lane); return; }
    r -= 2 * I_L;
    if (r < I_DD) { transpose_item(p.in[19], DFF, D, (bf16*)(wb + W_DD), 0, nullptr, r, c.lane); return; }
    r -= I_DD;
    { const int e = r / I_DE; r -= e * I_DE; transpose_item(p.in[23] + (size_t)e * DFE * D, DFE, D, (bf16*)(wb + W_DE + e * W_DE_E), 0, nullptr, r, c.lane); }
}
constexpr int CW_QHEAD = 2048;
__device__ __forceinline__ void p0_prologue(const Params& p, const Ctx& c) {
    unsigned char* ws = p.ws; unsigned char* wb = ws + WS_W;
    const int gt = c.vcu * NTHREADS + c.tid, NGT = c.G * NTHREADS;
    LAS float* sil = (LAS float*)(c.lds + 98304);
    LAS float* cmax = (LAS float*)(c.lds + 114688);
    LAS int* qslot = (LAS int*)(c.lds + 116736);
    for (int k = c.tid; k < 2 * D; k += NTHREADS) { const float x = k < D ? p.in[1][k] : p.in[3][k - D]; sil[k] = x / (1.f + expf(-x)); }
    { float* rope = (float*)(ws + WS_ROPE);
      for (int i = gt; i < 2048; i += NGT) { const int pos = i >> 4, k = i & 15; const float ang = (float)pos * powf(10000.f, -(float)(2 * k) / 32.f); rope[i] = cosf(ang); rope[2048 + i] = sinf(ang); } }
    { const int n16 = 192 * D / 16; unsigned zu = 0u; asm volatile("" : "+v"(zu));
      for (int i = gt; i < 2 * n16; i += NGT) { const int l = i / n16, r = i - l * n16; *(u32x4*)(wb + W_IN + l * W_IN_L + (size_t)1088 * D + (size_t)r * 16) = (u32x4){zu, zu, zu, zu}; }
      for (int i = gt; i < 2 * 192; i += NGT) { const int l = i / 192, r = i - l * 192; ((float*)(ws + WS_WSC))[SC_IN + l * NIN + 1088 + r] = __uint_as_float(zu); } }
    __syncthreads();
    unsigned* head = (unsigned*)(ws + WS_CTL) + CW_QHEAD;
    for (;;) {
        if (c.tid == 0) *qslot = (int)__hip_atomic_fetch_add(head, 1u, __ATOMIC_RELAXED, __HIP_MEMORY_SCOPE_AGENT);
        __syncthreads();
        const int id = __builtin_amdgcn_readfirstlane(*qslot);
        __syncthreads();
        if (id >= N_QUEUE) break;
        if (id < N_STRIPS) { quant_strip(strip_of(p, id), c, cmax); continue; }
        const int base = (id - N_STRIPS) * SMALL_BATCH;
#pragma unroll 1
        for (int j = 0; j < SMALL_BATCH / NWAVES; ++j) { const int it = base + j * NWAVES + c.wave; if (it < N_SMALL) small_item(p, c, it, sil); }
    }
}
__device__ __forceinline__ void p1_mod(const Params& p, const Ctx& c) {
    const float* part = (const float*)(p.ws + WS_PART); float* mod = (float*)(p.ws + WS_MOD);
    for (int i = c.vcu * NTHREADS + c.tid; i < 4 * 6 * D; i += c.G * NTHREADS) { const int n = i % (6 * D), lv = i / (6 * D), l = lv >> 1, v = lv & 1;
        float s = p.in[5][l * 6 * D + n];
#pragma unroll
        for (int kc = 0; kc < KS_ADA; ++kc) s += part[((size_t)(l * KS_ADA + kc) * 2 + v) * (6 * D) + n];
        mod[i] = s; }
}
__device__ __forceinline__ void norm_pass(const Params& p, const Ctx& c, int layer, int which, int row_lo, bool moe, bool local_mod) {
    const float* XL = (const float*)(p.ws + WS_XL); unsigned char* HN = p.ws + WS_HN; float* HSC = (float*)(p.ws + WS_HSC); const float* mod = (const float*)(p.ws + WS_MOD);
    const bool from_in = (layer == 0 && which == 0);
    const float* g = (which ? p.in[16] : p.in[6]) + layer * D;
    const int gw = c.vcu * NWAVES + c.wave, NGW = c.G * NWAVES;
    LAS float* lmod = (LAS float*)(c.lds + 65536);
    if (local_mod) { const float* part = (const float*)(p.ws + WS_PART);
        for (int i = c.tid; i < 4 * D; i += NTHREADS) { const int vec = i / D, v = vec >> 1, n = ((vec & 1) ? D : 0) + (i - vec * D);
            float sacc = p.in[5][layer * 6 * D + n];
#pragma unroll
            for (int kc = 0; kc < KS_ADA; ++kc) sacc += part[((size_t)(layer * KS_ADA + kc) * 2 + v) * (6 * D) + n];
            lmod[i] = sacc; }
        __syncthreads(); }
    LAS float* wrt = (LAS float*)c.lds;
    if (moe) { const float* wr = p.in[20];
        for (int i = c.tid; i < D * NE / 4; i += NTHREADS) { const f32x4 w = *(const f32x4*)(wr + 4 * i); const int k = i >> 1, e0 = (i & 1) * 4;
            wrt[(e0 + 0) * D + k] = w[0]; wrt[(e0 + 1) * D + k] = w[1]; wrt[(e0 + 2) * D + k] = w[2]; wrt[(e0 + 3) * D + k] = w[3]; }
        __syncthreads(); }
    for (int r = row_lo + gw; r < MT; r += NGW) {
        const f32x4* xr = (const f32x4*)(from_in ? (r < LC ? p.in[2] + (size_t)r * D : p.in[0] + (size_t)(r - LC) * D) : XL + (size_t)r * D) + c.lane;
        const float* mv = mod + (size_t)(layer * 2 + (r < LC ? 1 : 0)) * (6 * D) + (which ? 3 * D : 0);
        f32x4 v[8]; float ss = 0.f;
#pragma unroll
        for (int j = 0; j < 8; ++j) { v[j] = xr[64 * j]; ss += (v[j][0] * v[j][0] + v[j][1] * v[j][1]) + (v[j][2] * v[j][2] + v[j][3] * v[j][3]); }
        const float rs = rsqrtf(wave_sum(ss) * (1.f / D) + EPS);
        float amax = 0.f;
#pragma unroll
        for (int j = 0; j < 8; ++j) { const int col = 4 * c.lane + 256 * j;
            const f32x4 gv = *(const f32x4*)(g + col);
            const f32x4 sh = local_mod ? *(const LAS f32x4*)(lmod + (r < LC ? 2 * D : 0) + col) : *(const f32x4*)(mv + col), sc = local_mod ? *(const LAS f32x4*)(lmod + (r < LC ? 3 * D : D) + col) : *(const f32x4*)(mv + D + col);
            v[j] = (v[j] * rs * gv) * (sc + 1.f) + sh;
            amax = fmaxf(fmaxf(amax, fmaxf(fabsf(v[j][0]), fabsf(v[j][1]))), fmaxf(fabsf(v[j][2]), fabsf(v[j][3]))); }
#pragma unroll
        for (int o = 1; o < 64; o <<= 1) amax = fmaxf(amax, __shfl_xor(amax, o));
        const float inv = amax > 0.f ? 127.f / amax : 0.f;
        unsigned* o4 = (unsigned*)(HN + (size_t)r * D) + c.lane;
#pragma unroll
        for (int j = 0; j < 8; ++j) o4[64 * j] = pack4i8(v[j][0] * inv, v[j][1] * inv, v[j][2] * inv, v[j][3] * inv);
        if (c.lane == 0) HSC[r] = amax * (1.f / 127.f);
        if (moe) {
            float lg[NE];
#pragma unroll
            for (int e = 0; e < NE; ++e) { float a = 0.f;
#pragma unroll
                for (int j = 0; j < 8; ++j) { const f32x4 w = *(const LAS f32x4*)(wrt + e * D + 4 * c.lane + 256 * j); a += (v[j][0] * w[0] + v[j][1] * w[1]) + (v[j][2] * w[2] + v[j][3] * w[3]); }
                lg[e] = a; }
#pragma unroll
            for (int e = 0; e < NE; ++e) lg[e] = wave_sum(lg[e]);
            int e0 = 0; float m0 = lg[0];
#pragma unroll
            for (int e = 1; e < NE; ++e) if (lg[e] > m0) { m0 = lg[e]; e0 = e; }
            int e1 = -1; float m1 = -3.0e38f;
#pragma unroll
            for (int e = 0; e < NE; ++e) if (e != e0 && lg[e] > m1) { m1 = lg[e]; e1 = e; }
            if (c.lane == 0) { const int t = r - LC; const float b = expf(m1 - m0), inv = 1.f / (1.f + b);
                int* sel = (int*)(p.ws + WS_SEL); float* gwt = (float*)(p.ws + WS_GW);
                sel[2 * t] = e0; sel[2 * t + 1] = e1; gwt[2 * t] = inv; gwt[2 * t + 1] = b * inv; }
        }
    }
}
__device__ __forceinline__ void conv_pass(const Params& p, const Ctx& c, int layer, int row_lo) {
    const bf16* U = (const bf16*)(p.ws + WS_MIX + MX_U); const bf16* CBp = (const bf16*)(p.ws + WS_MIX + MX_CB); bf16* V2 = (bf16*)(p.ws + WS_MIX + MX_V2);
    const float* wc = p.in[12] + (size_t)layer * 3 * CW;
    const int gw = c.vcu * NWAVES + c.wave, NGW = c.G * NWAVES, nitems = ((MT - row_lo) / 16) * 4;
    for (int it = gw; it < nitems; it += NGW) {
        const int q = it & 3, r0 = row_lo + (it >> 2) * 16, ch = q * 512 + c.lane * 8;
        const int lo = r0 < LC ? 0 : LC, hi = r0 < LC ? LC : MT;
        const f32x4 w0a = *(const f32x4*)(wc + ch), w0b = *(const f32x4*)(wc + ch + 4), w1a = *(const f32x4*)(wc + CW + ch), w1b = *(const f32x4*)(wc + CW + ch + 4), w2a = *(const f32x4*)(wc + 2 * CW + ch), w2b = *(const f32x4*)(wc + 2 * CW + ch + 4);
        float zf = 0.f; asm volatile("" : "+v"(zf)); const f32x4 z4 = {zf, zf, zf, zf}; f32x4 pa = z4, pb = pa, ca, cb, na, nb;
        if (r0 - 1 >= lo) unpack8(*(const u32x4*)(U + (size_t)(r0 - 1) * CW + ch), pa, pb);
        unpack8(*(const u32x4*)(U + (size_t)r0 * CW + ch), ca, cb);
#pragma unroll 4
        for (int r = r0; r < r0 + 16; ++r) {
            na = z4; nb = na;
            if (r + 1 < hi) unpack8(*(const u32x4*)(U + (size_t)(r + 1) * CW + ch), na, nb);
            f32x4 ga, gb; unpack8(*(const u32x4*)(CBp + (size_t)r * CW + ch), ga, gb);
            const f32x4 ya = ga * (w0a * pa + w1a * ca + w2a * na), yb = gb * (w0b * pb + w1b * cb + w2b * nb);
            *(u32x4*)(V2 + (size_t)r * CW + ch) = pack8(ya, yb);
            pa = ca; pb = cb; ca = na; cb = nb; }
    }
}
__device__ __forceinline__ void moe_counts(const Params& p, const Ctx& c) {
    const int* sel = (const int*)(p.ws + WS_SEL);
    LAS int* H = (LAS int*)c.lds;
    LAS int* tot = (LAS int*)(c.lds + 16384);
    LAS int* lctl = (LAS int*)(c.lds + LCTL_OFF);
    { int h[NE];
#pragma unroll
      for (int e = 0; e < NE; ++e) h[e] = 0;
#pragma unroll
      for (int i = 0; i < 8; ++i) { const int4 v = *(const int4*)(sel + c.tid * 32 + i * 4);
#pragma unroll
          for (int e = 0; e < NE; ++e) h[e] += (v.x == e) + (v.y == e) + (v.z == e) + (v.w == e); }
#pragma unroll
      for (int e = 0; e < NE; ++e) H[c.tid * 8 + e] = h[e]; }
    __syncthreads();
    { int s = 0;
#pragma unroll
      for (int i = 0; i < 8; ++i) s += H[(c.lane * 8 + i) * 8 + c.wave];
#pragma unroll
      for (int o = 1; o < 64; o <<= 1) s += __shfl_xor(s, o);
      if (c.lane == 0) tot[c.wave] = s; }
    __syncthreads();
    if (c.tid == 0) { int off = 0;
#pragma unroll
        for (int e = 0; e < NE; ++e) { lctl[128 + e] = off; off += (tot[e] + 255) >> 8; }
        lctl[128 + NE] = off; lctl[16] = off;
        int M = 0, nrt = 0, rb = 0;
        for (int e = 0; e < NE; ++e) { const int cnt = tot[e], first = lctl[128 + e], nf = cnt >> 8;
            for (int t = 0; t < nf; ++t) lctl[176 + M++] = first + t;
            lctl[288 + e] = cnt & 255; }
        for (int it = 0; it < NE && M < 64; ++it) { int be = -1, bv = 0;
            for (int e = 0; e < NE; ++e) { const int v = lctl[288 + e]; if (v > bv) { bv = v; be = e; } }
            if (be < 0) break;
            lctl[176 + M++] = lctl[128 + be] + (tot[be] >> 8); lctl[288 + be] = 0; }
        for (int e = 0; e < NE; ++e) { const int v = lctl[288 + e]; if (v > 0) { lctl[256 + nrt] = lctl[128 + e] + (tot[e] >> 8); lctl[272 + nrt] = rb; rb += (v + 31) >> 5; ++nrt; } }
        lctl[272 + nrt] = rb; lctl[17] = M; lctl[18] = rb; lctl[19] = nrt; }
    __syncthreads();
    if (c.tid < MAXT) { int e = 0;
#pragma unroll
        for (int x = 1; x < NE; ++x) e += (c.tid >= lctl[128 + x]) ? 1 : 0;
        lctl[32 + c.tid] = e; }
    __syncthreads();
}
__device__ __forceinline__ void moe_route(const Params& p, const Ctx& c) {
    const int* sel = (const int*)(p.ws + WS_SEL); int* slot = (int*)(p.ws + WS_SLOT);
    const unsigned char* HN = p.ws + WS_HN; unsigned char* XS = p.ws + WS_MIX + FX_XS; const float* HSC = (const float*)(p.ws + WS_HSC); float* XSC = (float*)(p.ws + WS_XSC);
    LAS int* H = (LAS int*)c.lds; LAS int* tot = (LAS int*)(c.lds + 16384); LAS int* lctl = (LAS int*)(c.lds + LCTL_OFF);
    for (int b = c.bid; b < 2 * SEQ / 64; b += c.G) {
        { int s = 0;
#pragma unroll
          for (int i = 0; i < 8; ++i) { const int t = c.lane * 8 + i; s += (t < 2 * b) ? H[t * 8 + c.wave] : 0; }
#pragma unroll
          for (int o = 1; o < 64; o <<= 1) s += __shfl_xor(s, o);
          if (c.lane == 0) tot[8 + c.wave] = s; }
        __syncthreads();
        if (c.wave == 0) { const int a = 64 * b + c.lane, e = sel[a]; int rank = 0;
#pragma unroll
            for (int x = 0; x < NE; ++x) { const unsigned long long m = __ballot(e == x); if (e == x) rank = tot[8 + x] + __popcll(m & ((1ull << c.lane) - 1ull)); }
            const int s = 256 * lctl[128 + e] + rank; slot[a] = s; tot[16 + c.lane] = s; }
        __syncthreads();
#pragma unroll
        for (int i = 0; i < 8; ++i) { const int j = c.wave * 8 + i, a = 64 * b + j, tok = a >> 1, s = tot[16 + j];
            const u32x4* src = (const u32x4*)(HN + (size_t)(LC + tok) * D) + c.lane; u32x4* dst = (u32x4*)(XS + (size_t)s * D) + c.lane;
            const u32x4 v0 = src[0], v1 = src[64]; dst[0] = v0; dst[64] = v1;
            if (c.lane == 0) XSC[s] = HSC[LC + tok]; }
        __syncthreads();
    }
}
__device__ __forceinline__ void final_pass(const Params& p, const Ctx& c) {
    const float* XL = (const float*)(p.ws + WS_XL); const bf16* YS = (const bf16*)(p.ws + WS_MIX + FX_YS);
    const int* slot = (const int*)(p.ws + WS_SLOT); const float* gwt = (const float*)(p.ws + WS_GW);
    const float* gt2 = (const float*)(p.ws + WS_MOD) + (size_t)2 * (6 * D) + 5 * D; const float* gf = p.in[24];
    const int gw = c.vcu * NWAVES + c.wave, NGW = c.G * NWAVES;
    for (int t = gw; t < SEQ; t += NGW) {
        const int s0 = slot[2 * t], s1 = slot[2 * t + 1]; const float g0 = gwt[2 * t], g1 = gwt[2 * t + 1];
        const f32x4* xr = (const f32x4*)(XL + (size_t)(LC + t) * D) + c.lane;
        const u32x2* y0 = (const u32x2*)(YS + (size_t)s0 * D) + c.lane; const u32x2* y1 = (const u32x2*)(YS + (size_t)s1 * D) + c.lane;
        f32x4 v[8]; float ss = 0.f;
#pragma unroll
        for (int j = 0; j < 8; ++j) { const f32x4 gv = *(const f32x4*)(gt2 + 4 * c.lane + 256 * j);
            v[j] = xr[64 * j] + gv * (unpack4(y0[64 * j]) * g0 + unpack4(y1[64 * j]) * g1);
            ss += (v[j][0] * v[j][0] + v[j][1] * v[j][1]) + (v[j][2] * v[j][2] + v[j][3] * v[j][3]); }
        const float rs = rsqrtf(wave_sum(ss) * (1.f / D) + EPS);
        f32x4* o = (f32x4*)(p.out + (size_t)t * D) + c.lane;
#pragma unroll
        for (int j = 0; j < 8; ++j) o[64 * j] = v[j] * rs * *(const f32x4*)(gf + 4 * c.lane + 256 * j);
    }
}


template <class Items, class Epi>
__device__ __forceinline__ void small_gemm(const Ctx& c, int n_items, const Items& I, int lda, int ldb, int K, const Epi& E) {
    int tid = c.tid; asm volatile("" : "+v"(tid));
    const int lane = tid & 63, wid = __builtin_amdgcn_readfirstlane(tid >> 6), fr = lane & 15, fq = lane >> 4, wr = wid >> 2, wc = wid & 3;
    constexpr int STG = 24576, NSTG = 4;
    const int nk = K / 128;
    for (int j = c.vcu; j < n_items; j += c.G) {
        const bf16* Ab; const bf16* Bb; int mb, nb; I(j, Ab, Bb, mb, nb);
        const int sA = wid * 64 + lane, rA = sA >> 4, cA = (sA & 15) ^ (rA & 15);
        const bf16* gA = Ab + (size_t)rA * lda + cA * 8;
        const bf16* gB0 = Bb + (size_t)rA * ldb + cA * 8;
        const bf16* gB1 = gB0 + (size_t)32 * ldb;
        LAS unsigned char* lw = c.lds + wid * 1024;
#define CG_STAGE(t) do { const int kk_ = ((t) < nk ? (t) : nk - 1) * 128; LAS unsigned char* d_ = lw + ((t) & (NSTG - 1)) * STG; \
        __builtin_amdgcn_global_load_lds((const unsigned*)(gA + kk_), (LAS unsigned*)(d_), 16, 0, 0); \
        __builtin_amdgcn_global_load_lds((const unsigned*)(gB0 + kk_), (LAS unsigned*)(d_ + 8192), 16, 0, 0); \
        __builtin_amdgcn_global_load_lds((const unsigned*)(gB1 + kk_), (LAS unsigned*)(d_ + 16384), 16, 0, 0); } while (0)
        CG_STAGE(0); CG_STAGE(1); CG_STAGE(2);
        const int ra = (wr * 16 + fr) * 256, rb = 8192 + (wc * 16 + fr) * 256;
        float zf = 0.f; asm volatile("" : "+v"(zf));
        f32x4 acc0 = {zf, zf, zf, zf}, acc1 = acc0;
#pragma unroll 1
        for (int t = 0; t < nk; ++t) {
            asm volatile("s_waitcnt vmcnt(6)\n\ts_barrier" ::: "memory");
            CG_STAGE(t + 3);
            const LAS unsigned char* sb = c.lds + (t & (NSTG - 1)) * STG;
            bf16x8 af[4], bf[4];
#pragma unroll
            for (int ks = 0; ks < 4; ++ks) { const int pc = ((4 * ks + fq) ^ fr) * 16; af[ks] = *(const LAS bf16x8*)(sb + ra + pc); bf[ks] = *(const LAS bf16x8*)(sb + rb + pc); }
            acc0 = __builtin_amdgcn_mfma_f32_16x16x32_bf16(bf[0], af[0], acc0, 0, 0, 0);
            acc1 = __builtin_amdgcn_mfma_f32_16x16x32_bf16(bf[1], af[1], acc1, 0, 0, 0);
            acc0 = __builtin_amdgcn_mfma_f32_16x16x32_bf16(bf[2], af[2], acc0, 0, 0, 0);
            acc1 = __builtin_amdgcn_mfma_f32_16x16x32_bf16(bf[3], af[3], acc1, 0, 0, 0);
        }
#undef CG_STAGE
        asm volatile("s_waitcnt vmcnt(0)\n\ts_barrier" ::: "memory");
        E(mb + wr * 16 + fr, nb + wc * 16 + 4 * fq, acc0 + acc1);
    }
}
struct CtxItems { const bf16* A; const bf16* Bt; int lda, ldb;
    __device__ __forceinline__ void operator()(int j, const bf16*& Ab, const bf16*& Bb, int& mb, int& nb) const { mb = (j >> 5) * 32; nb = (j & 31) * 64; Ab = A + (size_t)mb * lda; Bb = Bt + (size_t)nb * ldb; } };
template <class Epi>
__device__ __forceinline__ void ctx_gemm(const Ctx& c, const bf16* A, int lda, const bf16* Bt, int ldb, int K, const Epi& E) { small_gemm(c, 256, CtxItems{A, Bt, lda, ldb}, lda, ldb, K, E); }
struct MoeTailItems { const bf16* A; const bf16* W; size_t estride; const LAS int* lctl;
    __device__ __forceinline__ void operator()(int j, const bf16*& Ab, const bf16*& Bb, int& mb, int& nb) const {
        const int q = j >> 5, nrt = lctl[19]; int k = 0;
#pragma unroll
        for (int x = 1; x < NE; ++x) k += (x < nrt && q >= lctl[272 + x]) ? 1 : 0;
        k = __builtin_amdgcn_readfirstlane(k);
        const int tile = __builtin_amdgcn_readfirstlane(lctl[256 + k]), rb = q - __builtin_amdgcn_readfirstlane(lctl[272 + k]), e = __builtin_amdgcn_readfirstlane(lctl[32 + tile]);
        mb = tile * 256 + rb * 32; nb = (j & 31) * 64; Ab = A + (size_t)mb * DFE; Bb = W + (size_t)e * estride + (size_t)nb * DFE; } };
struct CtxStoreBf16 { bf16* OUT; int ld;
    __device__ __forceinline__ void operator()(int row, int col, f32x4 acc) const { u32x2 w; w.x = cvtpk(acc[0], acc[1]); w.y = cvtpk(acc[2], acc[3]); *(u32x2*)(OUT + (size_t)row * ld + col) = w; } };
template <int MODE> struct CtxMerge { const bf16* SG; const bf16* M1; bf16* OUT;
    __device__ __forceinline__ void operator()(int row, int col, f32x4 acc) const { const size_t off = (size_t)row * D + col;
        f32x4 v = acc * unpack4(*(const u32x2*)(SG + off)); if (MODE == 1) v += unpack4(*(const u32x2*)(M1 + off));
        u32x2 w; w.x = cvtpk(v[0], v[1]); w.y = cvtpk(v[2], v[3]); *(u32x2*)(OUT + off) = w; } };
struct CtxResid { float* XL; const float* SRC; const float* gate;
    __device__ __forceinline__ void operator()(int row, int col, f32x4 acc) const { const size_t o = (size_t)row * D + col; *(f32x4*)(XL + o) = *(const f32x4*)(SRC + o) + *(const f32x4*)(gate + col) * acc; } };

constexpr int N_PHASES = 22;
__global__ void __launch_bounds__(NTHREADS, 2) mega(Params p) {
    extern __shared__ __attribute__((aligned(16))) unsigned char lds_raw[];
    Ctx c0; c0.lds = (LAS unsigned char*)lds_raw; c0.tid = threadIdx.x; c0.lane = c0.tid & 63; c0.wave = __builtin_amdgcn_readfirstlane(c0.tid >> 6);
    c0.G = gridDim.x; c0.bid = blockIdx.x; c0.vcu = (c0.G % 8 == 0) ? (c0.bid % 8) * (c0.G / 8) + c0.bid / 8 : c0.bid;
    { const Ctx& c = c0; unsigned char* ws = p.ws;
    for (int u = c.tid; u < (LDS_BYTES - LCTL_OFF) / 4; u += NTHREADS) ((LAS unsigned*)(c.lds + LCTL_OFF))[u] = 0u;
    __syncthreads();
    }
    XcdBarrier bar = xcd_barrier_post((unsigned*)(p.ws + WS_CTL) + 4096, (volatile LAS unsigned*)(c0.lds + LCTL_OFF));
    const int lo = p.ph_lo, hi = p.ph_hi;
#ifndef MK_EN
#define MK_EN 0xFFFFFF
#endif
#define EN(j) (((MK_EN) >> (j)) & 1)
#ifndef MK_DUP
#define MK_DUP 0
#endif
#define NREP(j) ((((MK_DUP) >> (j)) & 1) ? 2 : 1)
#define IN(k) (lo <= (k) && (k) < hi)
#define SEAM(k) do { if (IN(k) && IN((k) + 1)) xcd_barrier(bar); } while (0)
#define PH_BEGIN const Ctx c = fresh(c0); unsigned char* ws = fresh_ptr(p.ws); unsigned char* wb = ws + WS_W; unsigned char* mx = ws + WS_MIX; const float* mod = (const float*)(ws + WS_MOD); (void)wb; (void)mx; (void)mod;
    for (int rep_ = 0; rep_ < NREP(20); ++rep_) if (EN(20) && IN(0)) { if (rep_) { xcd_barrier(bar); if (c0.bid == 0 && c0.tid == 0) __hip_atomic_store((unsigned*)(p.ws + WS_CTL) + CW_QHEAD, 0u, __ATOMIC_RELAXED, __HIP_MEMORY_SCOPE_AGENT); xcd_barrier(bar); } PH_BEGIN p0_prologue(p, c); } SEAM(0);
#if defined(MK_XBAR)
    for (int xb_ = 0; xb_ < 16; ++xb_) xcd_barrier(bar);
#endif
#pragma unroll
    for (int layer = 0; layer < DEPTH; ++layer) {
        const int P = 2 + 9 * layer; const bool last = (layer == DEPTH - 1);
        const int pm0 = last ? 1 : 0, nM = last ? 32 : 33;
        for (int rep_ = 0; rep_ < NREP(0); ++rep_) if (EN(0) && IN(P + 0)) { if (rep_) xcd_barrier(bar); PH_BEGIN if (layer == 0) p1_mod(p, c); norm_pass(p, c, layer, 0, 0, false, layer == 0); } SEAM(P + 0);
        for (int rep_ = 0; rep_ < NREP(1); ++rep_) if (EN(1) && IN(P + 1)) { if (rep_) xcd_barrier(bar); PH_BEGIN
            pg8::Geo g{D / 2, D / 2, D / 2};
            pg8::TileOrder S{nM, NT_IN, pm0, c.G, c.bid, last ? 3 : 0, 0, 2, (const char*)(ws + WS_HN), (const char*)(wb + W_IN + layer * W_IN_L), (size_t)256 * D, (size_t)256 * D, (const float*)(ws + WS_HSC), (const float*)(ws + WS_WSC) + SC_IN + layer * NIN};
            pg8::EpiInproj E{(bf16*)(mx + MX_QC), (bf16*)(mx + MX_KRB), (bf16*)(mx + MX_U), (bf16*)(mx + MX_CB), (float*)(mx + MX_SSQ), (const float*)(ws + WS_ROPE)};
            pg8::gemm_phase<pg8::EpiInproj, pg8::TileOrder, true, true>(c.lds, g, S, E);
        } SEAM(P + 1);
        for (int rep_ = 0; rep_ < NREP(2); ++rep_) if (EN(2) && IN(P + 2)) { if (rep_) xcd_barrier(bar); PH_BEGIN
            pg8::Geo g{1024, 512, 512};
            pg8::QkvOrder S{33, nM, pm0, c.G, c.bid, (const char*)(mx + MX_QC), (const char*)(wb + W_QB + layer * W_QB_L), (long)(W_KVB + layer * W_KVB_L) - (long)(W_QB + layer * W_QB_L)};
            pg8::EpiQkv E{(bf16*)(mx + MX_Q), (bf16*)(mx + MX_KV), (const float*)(mx + MX_SSQ), (const float*)(ws + WS_ROPE)};
            pg8::gemm_phase<pg8::EpiQkv, pg8::QkvOrder, true>(c.lds, g, S, E);
            conv_pass(p, c, layer, pm0 * 256);
        } SEAM(P + 2);
        for (int rep_ = 0; rep_ < NREP(3); ++rep_) if (EN(3) && IN(P + 3)) { if (rep_) xcd_barrier(bar); PH_BEGIN
            const bf16* Q = (const bf16*)(mx + MX_Q); const bf16* KV = (const bf16*)(mx + MX_KV); const bf16* KR = (const bf16*)(mx + MX_KRB); bf16* O = (bf16*)(mx + MX_O);
            for (int i = 0;; ++i) { const int u = i * c.G + c.vcu; if (u >= NH * 32) break;
                const int h = u >> 5, q0 = LC + 256 * (u & 31);
                att::attn_unit(Q + (size_t)q0 * att::LDQ + h * DQK, KV, h * 512, KR, O + (size_t)q0 * D + h * DV, MT, (LAS char*)c.lds); }
            if (!last) for (int i = 0;; ++i) { const int h = i * c.G + c.vcu; if (h >= NH) break;
                att::attn_unit(Q + h * DQK, KV, h * 512, KR, O + h * DV, LC, (LAS char*)c.lds); }
            pg8::Geo g{D, D, D};
            pg8::TileOrder S{32, 8, 1, c.G, c.bid, 0, 0, 0, (const char*)(mx + MX_V2), (const char*)(wb + W_OB + layer * W_SQ_L), (size_t)256 * D * 2, (size_t)256 * D * 2, nullptr, nullptr};
            pg8::EpiMerge<0> E{(const bf16*)(mx + MX_SGB), nullptr, (bf16*)(mx + MX_M1)};
            pg8::gemm_phase<pg8::EpiMerge<0>, pg8::TileOrder, true>(c.lds, g, S, E);
            if (!last) ctx_gemm(c, (const bf16*)(mx + MX_V2), D, (const bf16*)(wb + W_OB + layer * W_SQ_L), D, D, CtxMerge<0>{(const bf16*)(mx + MX_SGB), nullptr, (bf16*)(mx + MX_M1)});
        } SEAM(P + 3);
        for (int rep_ = 0; rep_ < NREP(4); ++rep_) if (EN(4) && IN(P + 4)) { if (rep_) xcd_barrier(bar); PH_BEGIN
            pg8::Geo g{D, D, D};
            pg8::TileOrder S{32, 8, 1, c.G, c.bid, 0, 0, 0, (const char*)(mx + MX_O), (const char*)(wb + W_OA + layer * W_SQ_L), (size_t)256 * D * 2, (size_t)256 * D * 2, nullptr, nullptr};
            pg8::EpiMerge<1> E{(const bf16*)(mx + MX_SGA), (const bf16*)(mx + MX_M1), (bf16*)(mx + MX_MG)};
            pg8::gemm_phase<pg8::EpiMerge<1>, pg8::TileOrder, true>(c.lds, g, S, E);
            if (!last) ctx_gemm(c, (const bf16*)(mx + MX_O), D, (const bf16*)(wb + W_OA + layer * W_SQ_L), D, D, CtxMerge<1>{(const bf16*)(mx + MX_SGA), (const bf16*)(mx + MX_M1), (bf16*)(mx + MX_MG)});
        } SEAM(P + 4);
        for (int rep_ = 0; rep_ < 1; ++rep_) if (EN(5) && IN(P + 5)) { PH_BEGIN
            pg8::Geo g{D, D, D};
            pg8::TileOrder S{32, 8, 1, c.G, c.bid, 0, 0, 0, (const char*)(mx + MX_MG), (const char*)(wb + W_O + layer * W_SQ_L), (size_t)256 * D * 2, (size_t)256 * D * 2, nullptr, nullptr};
            pg8::EpiResid E{(float*)(ws + WS_XL), layer == 0 ? p.in[0] - (size_t)LC * D : (const float*)(ws + WS_XL), mod + (size_t)(2 * layer) * (6 * D) + 2 * D};
            pg8::gemm_phase<pg8::EpiResid, pg8::TileOrder, true>(c.lds, g, S, E);
            if (!last) ctx_gemm(c, (const bf16*)(mx + MX_MG), D, (const bf16*)(wb + W_O + layer * W_SQ_L), D, D, CtxResid{(float*)(ws + WS_XL), p.in[2], mod + (size_t)(2 * layer + 1) * (6 * D) + 2 * D});
        } SEAM(P + 5);
        for (int rep_ = 0; rep_ < NREP(6); ++rep_) if (EN(6) && IN(P + 6)) { if (rep_) xcd_barrier(bar); PH_BEGIN norm_pass(p, c, layer, 1, pm0 * 256, last, false); } SEAM(P + 6);
        if (!last) {
            for (int rep_ = 0; rep_ < NREP(7); ++rep_) if (EN(7) && IN(P + 7)) { if (rep_) xcd_barrier(bar); PH_BEGIN
                pg8::Geo g{D / 2, D / 2, D / 2};
                pg8::TileOrder S{nM, 2 * DFF / 256, pm0, c.G, c.bid, 0, 0, 0, (const char*)(ws + WS_HN), (const char*)(wb + W_GU), (size_t)256 * D, (size_t)256 * D, (const float*)(ws + WS_HSC), (const float*)(ws + WS_WSC) + SC_GU};
                pg8::EpiSwiglu E{(bf16*)(mx + FX_ACT), DFF};
                pg8::gemm_phase<pg8::EpiSwiglu, pg8::TileOrder, true, true>(c.lds, g, S, E);
            } SEAM(P + 7);
            for (int rep_ = 0; rep_ < 1; ++rep_) if (EN(8) && IN(P + 8)) { PH_BEGIN
                pg8::Geo g{DFF, DFF, DFF};
                pg8::TileOrder S{32, 8, 1, c.G, c.bid, 0, 0, 0, (const char*)(mx + FX_ACT), (const char*)(wb + W_DD), (size_t)256 * DFF * 2, (size_t)256 * DFF * 2, nullptr, nullptr};
                pg8::EpiResid E{(float*)(ws + WS_XL), (const float*)(ws + WS_XL), mod + (size_t)(2 * layer) * (6 * D) + 5 * D};
                pg8::gemm_phase<pg8::EpiResid, pg8::TileOrder, true>(c.lds, g, S, E);
                ctx_gemm(c, (const bf16*)(mx + FX_ACT), DFF, (const bf16*)(wb + W_DD), DFF, DFF, CtxResid{(float*)(ws + WS_XL), (const float*)(ws + WS_XL), mod + (size_t)(2 * layer + 1) * (6 * D) + 5 * D});
            } SEAM(P + 8);
        } else {
            const LAS int* lctl = (const LAS int*)(c0.lds + LCTL_OFF);
            for (int rep_ = 0; rep_ < NREP(7); ++rep_) if (EN(7) && IN(P + 7)) { if (rep_) xcd_barrier(bar); PH_BEGIN moe_counts(p, c); moe_route(p, c); } SEAM(P + 7);
            for (int rep_ = 0; rep_ < NREP(8); ++rep_) if (EN(8) && IN(P + 8)) { if (rep_) xcd_barrier(bar); PH_BEGIN
                if (!IN(P + 7)) moe_counts(p, c);
                const int T = __builtin_amdgcn_readfirstlane(lctl[16]);
                pg8::Geo g{D / 2, D / 2, D / 2};
                pg8::MoeOrder S{T, 2 * DFE / 256, c.G, c.bid, (const char*)(mx + FX_XS), (const char*)(wb + W_GUE), (size_t)256 * D, (size_t)256 * D, W_GUE_E, lctl + 32, (const float*)(ws + WS_XSC), (const float*)(ws + WS_WSC) + SC_GUE, 2 * DFE, nullptr};
                pg8::EpiSwiglu E{(bf16*)(mx + FX_ACTE), DFE};
                pg8::gemm_phase<pg8::EpiSwiglu, pg8::MoeOrder, true, true>(c.lds, g, S, E);
            } SEAM(P + 8);
            for (int rep_ = 0; rep_ < NREP(9); ++rep_) if (EN(9) && IN(P + 9)) { if (rep_) xcd_barrier(bar); PH_BEGIN
                if (!IN(P + 7)) moe_counts(p, c);
                const int M = __builtin_amdgcn_readfirstlane(lctl[17]), NRB = __builtin_amdgcn_readfirstlane(lctl[18]);
                pg8::Geo g{DFE, DFE, DFE};
                pg8::MoeOrder S{M, 8, c.G, c.bid, (const char*)(mx + FX_ACTE), (const char*)(wb + W_DE), (size_t)256 * DFE * 2, (size_t)256 * DFE * 2, W_DE_E, lctl + 32, nullptr, nullptr, 0, lctl + 176};
                pg8::EpiStoreBf16 E{(bf16*)(mx + FX_YS), D};
                pg8::gemm_phase<pg8::EpiStoreBf16, pg8::MoeOrder, true>(c.lds, g, S, E);
                small_gemm(c, NRB * 32, MoeTailItems{(const bf16*)(mx + FX_ACTE), (const bf16*)(wb + W_DE), (size_t)(W_DE_E / 2), lctl}, DFE, DFE, DFE, CtxStoreBf16{(bf16*)(mx + FX_YS), D});
            } SEAM(P + 9);
            for (int rep_ = 0; rep_ < NREP(10); ++rep_) if (EN(10) && IN(P + 10)) { if (rep_) xcd_barrier(bar); PH_BEGIN final_pass(p, c); }
        }
    }
#undef IN
#undef SEAM
}

static void forward(void* const* d_in, float* out, void* d_ws, size_t ws_size, hipStream_t st, int n_launches) {
    static int grid = 0;
    if (grid == 0) {
        if (ws_size < WS_END) { fprintf(stderr, "mk::forward: workspace too small (%zu < %zu)\n", ws_size, (size_t)WS_END); grid = -1; return; }
        int dev = 0, cus = 0;
        if (hipGetDevice(&dev) != hipSuccess || hipDeviceGetAttribute(&cus, hipDeviceAttributeMultiprocessorCount, dev) != hipSuccess) { grid = -1; return; }
        if (hipFuncSetAttribute((const void*)mega, hipFuncAttributeMaxDynamicSharedMemorySize, LDS_BYTES) != hipSuccess) { fprintf(stderr, "mk::forward: hipFuncSetAttribute failed\n"); grid = -1; return; }
        int per_cu = 0; (void)hipOccupancyMaxActiveBlocksPerMultiprocessor(&per_cu, (const void*)mega, NTHREADS, LDS_BYTES); (void)hipGetLastError();
        grid = cus;
    }
    if (grid < 0) return;
    (void)hipMemsetAsync((char*)d_ws + WS_CTL, 0, CTL_BYTES, st);
    Params p{};
    for (int i = 0; i < 25; ++i) p.in[i] = (const float*)d_in[i];
    p.out = out; p.ws = (unsigned char*)d_ws;
    if (n_launches == 1) { p.ph_lo = 0; p.ph_hi = N_PHASES; hipLaunchKernelGGL(mega, dim3(grid), dim3(NTHREADS), LDS_BYTES, st, p); }
    else for (int k = 0; k < N_PHASES; ++k) { p.ph_lo = k; p.ph_hi = k + 1; hipLaunchKernelGGL(mega, dim3(grid), dim3(NTHREADS), LDS_BYTES, st, p); }
    const hipError_t le = hipPeekAtLastError();
    if (le != hipSuccess) fprintf(stderr, "mk::forward: launch failed: %s\n", hipGetErrorName(le));
}
}

#ifndef MK_LAUNCHES
#define MK_LAUNCHES 1
#endif
#ifndef USE_SLOW
#define USE_SLOW 0
#endif
extern "C" void kernel_launch(void* const* d_in, const int* in_sizes, int n_in, void* d_out, int out_size, void* d_ws, size_t ws_size, hipStream_t stream) {
    if (n_in != 25 || out_size != SEQ * D) { fprintf(stderr, "kernel_launch: unexpected shapes (n_in %d out %d)\n", n_in, out_size); return; }
#if USE_SLOW
    slow::forward(d_in, (float*)d_out, (float*)d_ws, ws_size / 4, stream);
#else
    mk::forward(d_in, (float*)d_out, d_ws, ws_size, stream, MK_LAUNCHES);
#endif
}
```

```cpp
#include <hip/hip_runtime.h>
#include <cstdio>
#include <cstdint>

constexpr int D = 2048, LC = 256, SEQ = 8192, MT = LC + SEQ, DEPTH = 2;
constexpr int NH = 16, DN = 128, DR = 64, DV = 128, DQK = DN + DR, QL = 512, KVL = 512;
constexpr int CW = 2048, DIN = QL + KVL + DR + 3 * CW + 2 * D;
constexpr int OFF_QA = 0, OFF_CKV = 512, OFF_KR = 1024, OFF_CX = 1088, OFF_CB = OFF_CX + CW, OFF_CC = OFF_CB + CW, OFF_GA = OFF_CC + CW, OFF_GB = OFF_GA + D;
constexpr int DFF = 5632, NE = 8, DFE = 2816;
constexpr float EPS = 1e-6f;
constexpr float ATT_SCALE = 0.07216878364870322f;

namespace slow {
typedef float f32x16 __attribute__((ext_vector_type(16)));

struct GArgs { const float* A; long lda, abs_; const float* B; long sbk, sbn, bbs; const int* rowidx; const int* rioff; const int* Mptr; int M, N, K, pad; };
static_assert(sizeof(GArgs) == 96, "GArgs has no implicit padding");

template <bool BT, class Epi>
__global__ __launch_bounds__(256) void k_gemm(GArgs g, Epi epi) {
    __shared__ float As[32][65];
    __shared__ float Bs[32][65];
    const int b = blockIdx.z, m0 = blockIdx.y * 64, n0 = blockIdx.x * 64;
    const int M = g.Mptr ? g.Mptr[b] : g.M;
    if (m0 >= M) return;
    const int t = threadIdx.x, lane = t & 63, w = t >> 6, wm = w >> 1, wn = w & 1;
    const float* A = g.A + (long)b * g.abs_; const float* B = g.B + (long)b * g.bbs;
    const int ar = t >> 2, ak = (t & 3) * 8, am = m0 + ar;
    long arow = -1;
    if (am < M) { const int base = g.rioff ? g.rioff[b] : 0; arow = g.rowidx ? (long)g.rowidx[base + am] : (long)(base + am); }
    f32x16 acc;
#pragma unroll
    for (int r = 0; r < 16; ++r) acc[r] = 0.f;
    for (int k0 = 0; k0 < g.K; k0 += 32) {
        float4 a0 = make_float4(0.f, 0.f, 0.f, 0.f), a1 = a0, b0, b1;
        if (arow >= 0) { const float4* p = (const float4*)(A + arow * g.lda + k0 + ak); a0 = p[0]; a1 = p[1]; }
        if (BT) { const int bn = t >> 2, bk = (t & 3) * 8; const float4* p = (const float4*)(B + (long)(n0 + bn) * g.sbn + k0 + bk); b0 = p[0]; b1 = p[1]; }
        else    { const int bk = t >> 3, bn = (t & 7) * 8; const float4* p = (const float4*)(B + (long)(k0 + bk) * g.sbk + n0 + bn); b0 = p[0]; b1 = p[1]; }
        __syncthreads();
        As[ak + 0][ar] = a0.x; As[ak + 1][ar] = a0.y; As[ak + 2][ar] = a0.z; As[ak + 3][ar] = a0.w;
        As[ak + 4][ar] = a1.x; As[ak + 5][ar] = a1.y; As[ak + 6][ar] = a1.z; As[ak + 7][ar] = a1.w;
        if (BT) { const int bn = t >> 2, bk = (t & 3) * 8;
            Bs[bk + 0][bn] = b0.x; Bs[bk + 1][bn] = b0.y; Bs[bk + 2][bn] = b0.z; Bs[bk + 3][bn] = b0.w;
            Bs[bk + 4][bn] = b1.x; Bs[bk + 5][bn] = b1.y; Bs[bk + 6][bn] = b1.z; Bs[bk + 7][bn] = b1.w; }
        else { const int bk = t >> 3, bn = (t & 7) * 8;
            Bs[bk][bn + 0] = b0.x; Bs[bk][bn + 1] = b0.y; Bs[bk][bn + 2] = b0.z; Bs[bk][bn + 3] = b0.w;
            Bs[bk][bn + 4] = b1.x; Bs[bk][bn + 5] = b1.y; Bs[bk][bn + 6] = b1.z; Bs[bk][bn + 7] = b1.w; }
        __syncthreads();
#pragma unroll
        for (int kk = 0; kk < 32; kk += 2) {
            const float a = As[kk + (lane >> 5)][wm * 32 + (lane & 31)];
            const float bb = Bs[kk + (lane >> 5)][wn * 32 + (lane & 31)];
            acc = __builtin_amdgcn_mfma_f32_32x32x2f32(a, bb, acc, 0, 0, 0);
        }
    }
    const int base = g.rioff ? g.rioff[b] : 0;
#pragma unroll
    for (int r = 0; r < 16; ++r) {
        const int row = m0 + wm * 32 + (r & 3) + 8 * (r >> 2) + 4 * (lane >> 5), col = n0 + wn * 32 + (lane & 31);
        if (row < M) epi(b, base + row, col, acc[r]);
    }
}
struct EpiStore { float* C; long ldc, cbs; float alpha; int accum;
    __device__ void operator()(int b, int row, int col, float v) const { float* p = C + (long)b * cbs + (long)row * ldc + col; *p = accum ? *p + alpha * v : alpha * v; } };
struct EpiResid { float* X; const float* gl; const float* gc;
    __device__ void operator()(int, int row, int col, float v) const { float* p = X + (long)row * D + col; *p += (row < LC ? gc[col] : gl[col]) * v; } };

template <bool BT, class Epi> static void gemm(hipStream_t st, const GArgs& g, const Epi& e, int nbatch, int maxM) {
    dim3 grid(g.N / 64, (maxM + 63) / 64, nbatch);
    hipLaunchKernelGGL((k_gemm<BT, Epi>), grid, dim3(256), 0, st, g, e);
}

__device__ __forceinline__ float block_sum(float v, float* red) {
#pragma unroll
    for (int o = 32; o > 0; o >>= 1) v += __shfl_xor(v, o);
    __syncthreads();
    if ((threadIdx.x & 63) == 0) red[threadIdx.x >> 6] = v;
    __syncthreads();
    return red[0] + red[1] + red[2] + red[3];
}
__device__ __forceinline__ float block_max(float v, float* red) {
#pragma unroll
    for (int o = 32; o > 0; o >>= 1) v = fmaxf(v, __shfl_xor(v, o));
    __syncthreads();
    if ((threadIdx.x & 63) == 0) red[threadIdx.x >> 6] = v;
    __syncthreads();
    return fmaxf(fmaxf(red[0], red[1]), fmaxf(red[2], red[3]));
}
__device__ __forceinline__ float silu(float x) { return x / (1.f + expf(-x)); }
__device__ __forceinline__ float sigm(float x) { return 1.f / (1.f + expf(-x)); }

__global__ void k_copy_x(const float* ctx, const float* x, float* XL) {
    const long n = (long)MT * D / 4; const float4* c4 = (const float4*)ctx; const float4* x4 = (const float4*)x; float4* o = (float4*)XL; const long nc = (long)LC * D / 4;
    for (long i = blockIdx.x * 256L + threadIdx.x; i < n; i += gridDim.x * 256L) o[i] = i < nc ? c4[i] : x4[i - nc];
}
__global__ void k_ada(const float* c, const float* cctx, const float* w_ada, const float* b_ada, float* MOD) {
    const int n = blockIdx.x * 256 + threadIdx.x, lv = blockIdx.y, l = lv >> 1, v = lv & 1;
    const float* cv = v ? cctx : c; const float* W = w_ada + (long)l * D * (6 * D);
    float acc = 0.f;
    for (int k = 0; k < D; ++k) acc += silu(cv[k]) * W[(long)k * (6 * D) + n];
    MOD[(long)lv * (6 * D) + n] = acc + b_ada[l * 6 * D + n];
}
__global__ __launch_bounds__(256) void k_modnorm(const float* X, const float* g, const float* modl, const float* modc, int sh_off, int sc_off, float* H) {
    __shared__ float red[4];
    const int r = blockIdx.x; const float* x = X + (long)r * D; const float* mod = r < LC ? modc : modl;
    float v[8]; float ss = 0.f;
#pragma unroll
    for (int j = 0; j < 8; ++j) { v[j] = x[threadIdx.x + 256 * j]; ss += v[j] * v[j]; }
    ss = block_sum(ss, red);
    const float rs = rsqrtf(ss * (1.f / D) + EPS);
#pragma unroll
    for (int j = 0; j < 8; ++j) { const int c = threadIdx.x + 256 * j; H[(long)r * D + c] = (v[j] * rs * g[c]) * (1.f + mod[sc_off + c]) + mod[sh_off + c]; }
}
__global__ __launch_bounds__(256) void k_rms512(const float* P, int off, const float* g, float* out) {
    __shared__ float red[4];
    const int r = blockIdx.x; const float* x = P + (long)r * DIN + off;
    const float a = x[threadIdx.x], b = x[threadIdx.x + 256];
    const float ss = block_sum(a * a + b * b, red);
    const float rs = rsqrtf(ss * (1.f / 512.f) + EPS);
    out[(long)r * 512 + threadIdx.x] = a * rs * g[threadIdx.x]; out[(long)r * 512 + threadIdx.x + 256] = b * rs * g[threadIdx.x + 256];
}
__device__ __forceinline__ float inv_freq(int i) { return powf(10000.f, -(float)(2 * i) / 32.f); }
__global__ void k_rope_q(float* Q) {
    const long idx = blockIdx.x * 256L + threadIdx.x;
    if (idx >= (long)SEQ * NH * 32) return;
    const int i = idx & 15, part = (idx >> 4) & 1, h = (idx >> 5) & 15; const int t = (int)(idx >> 9);
    const float pos = part ? (float)(t % 64) : (float)(t / 64);
    const float ang = pos * inv_freq(i), cs = cosf(ang), sn = sinf(ang);
    float* p = Q + (long)(LC + t) * (NH * DQK) + h * DQK + DN + part * 32;
    const float x1 = p[i], x2 = p[i + 16];
    p[i] = x1 * cs - x2 * sn; p[i + 16] = x2 * cs + x1 * sn;
}
__global__ void k_rope_k(const float* P, float* KR) {
    const long idx = blockIdx.x * 256L + threadIdx.x;
    if (idx >= (long)MT * 32) return;
    const int i = idx & 15, part = (idx >> 4) & 1; const int r = (int)(idx >> 5);
    const float* p = P + (long)r * DIN + OFF_KR + part * 32; float* o = KR + (long)r * DR + part * 32;
    const float x1 = p[i], x2 = p[i + 16];
    if (r < LC) { o[i] = x1; o[i + 16] = x2; return; }
    const int t = r - LC; const float pos = part ? (float)(t % 64) : (float)(t / 64);
    const float ang = pos * inv_freq(i), cs = cosf(ang), sn = sinf(ang);
    o[i] = x1 * cs - x2 * sn; o[i + 16] = x2 * cs + x1 * sn;
}
__global__ __launch_bounds__(256) void k_softmax(float* SC, int n) {
    __shared__ float red[4];
    float* s = SC + (long)blockIdx.x * n;
    float mx = -3.0e38f;
    for (int j = threadIdx.x; j < n; j += 256) mx = fmaxf(mx, s[j]);
    mx = block_max(mx, red);
    float sum = 0.f;
    for (int j = threadIdx.x; j < n; j += 256) { const float e = expf(s[j] - mx); s[j] = e; sum += e; }
    sum = block_sum(sum, red);
    const float inv = 1.f / sum;
    for (int j = threadIdx.x; j < n; j += 256) s[j] *= inv;
}
__global__ void k_conv(const float* P, const float* wconv, float* V2) {
    const long idx = blockIdx.x * 256L + threadIdx.x; if (idx >= (long)MT * CW) return;
    const int c = idx % CW; const int r = (int)(idx / CW);
    const int lo = r < LC ? 0 : LC, hi = r < LC ? LC : MT;
    const float* p = P + (long)r * DIN;
    float acc = wconv[CW + c] * (p[OFF_CC + c] * p[OFF_CX + c]);
    if (r - 1 >= lo) acc += wconv[c] * (p[OFF_CC + c - DIN] * p[OFF_CX + c - DIN]);
    if (r + 1 < hi) acc += wconv[2 * CW + c] * (p[OFF_CC + c + DIN] * p[OFF_CX + c + DIN]);
    V2[idx] = p[OFF_CB + c] * acc;
}
__global__ void k_merge(const float* P, const float* OA, const float* OB, float* MG) {
    const long idx = blockIdx.x * 256L + threadIdx.x; if (idx >= (long)MT * D) return;
    const int c = idx % D; const long r = idx / D;
    MG[idx] = sigm(P[r * DIN + OFF_GA + c]) * OA[idx] + sigm(P[r * DIN + OFF_GB + c]) * OB[idx];
}
__global__ void k_swiglu(float* G, const float* U, long n) {
    for (long i = blockIdx.x * 256L + threadIdx.x; i < n; i += gridDim.x * 256L) G[i] = silu(G[i]) * U[i];
}
__global__ __launch_bounds__(256) void k_router(const float* H2, const float* wr, int* sel, float* gw) {
    const int t = blockIdx.x * 4 + (threadIdx.x >> 6), lane = threadIdx.x & 63;
    const float* h = H2 + (long)(LC + t) * D;
    float lg[NE];
#pragma unroll
    for (int e = 0; e < NE; ++e) lg[e] = 0.f;
    for (int k = lane; k < D; k += 64) { const float hv = h[k];
#pragma unroll
        for (int e = 0; e < NE; ++e) lg[e] += hv * wr[k * NE + e]; }
#pragma unroll
    for (int e = 0; e < NE; ++e) {
#pragma unroll
        for (int o = 32; o > 0; o >>= 1) lg[e] += __shfl_xor(lg[e], o); }
    if (lane == 0) {
        int e0 = 0; for (int e = 1; e < NE; ++e) if (lg[e] > lg[e0]) e0 = e;
        int e1 = e0 == 0 ? 1 : 0; for (int e = 0; e < NE; ++e) if (e != e0 && lg[e] > lg[e1]) e1 = e;
        const float m = lg[e0], a = 1.f, b = expf(lg[e1] - m), inv = 1.f / (a + b);
        sel[2 * t] = e0; sel[2 * t + 1] = e1; gw[2 * t] = a * inv; gw[2 * t + 1] = b * inv;
    }
}
__global__ __launch_bounds__(512) void k_sort(const int* sel, int* cnt, int* off, int* toklist, int* slot_of) {
    __shared__ int scnt[NE];
    const int e = threadIdx.x >> 6, lane = threadIdx.x & 63; const int NA = 2 * SEQ;
    int c = 0;
    for (int a0 = 0; a0 < NA; a0 += 64) c += __popcll(__ballot(sel[a0 + lane] == e));
    if (lane == 0) scnt[e] = c;
    __syncthreads();
    int base = 0; for (int j = 0; j < e; ++j) base += scnt[j];
    if (lane == 0) { cnt[e] = c; off[e] = base; }
    int pos = base;
    for (int a0 = 0; a0 < NA; a0 += 64) {
        const bool f = sel[a0 + lane] == e; const unsigned long long m = __ballot(f);
        if (f) { const int p = pos + __popcll(m & ((1ull << lane) - 1ull)); toklist[p] = LC + (a0 + lane) / 2; slot_of[a0 + lane] = p; }
        pos += __popcll(m);
    }
}
__global__ void k_moe_combine(float* XL, const float* Ys, const int* slot_of, const float* gw, const float* gt2) {
    const long idx = blockIdx.x * 256L + threadIdx.x; if (idx >= (long)SEQ * D) return;
    const int c = idx % D; const int t = (int)(idx / D);
    const float y = gw[2 * t] * Ys[(long)slot_of[2 * t] * D + c] + gw[2 * t + 1] * Ys[(long)slot_of[2 * t + 1] * D + c];
    XL[(long)(LC + t) * D + c] += gt2[c] * y;
}
__global__ __launch_bounds__(256) void k_final(const float* XL, const float* g, float* out) {
    __shared__ float red[4];
    const int r = blockIdx.x; const float* x = XL + (long)(LC + r) * D;
    float v[8]; float ss = 0.f;
#pragma unroll
    for (int j = 0; j < 8; ++j) { v[j] = x[threadIdx.x + 256 * j]; ss += v[j] * v[j]; }
    ss = block_sum(ss, red);
    const float rs = rsqrtf(ss * (1.f / D) + EPS);
#pragma unroll
    for (int j = 0; j < 8; ++j) { const int c = threadIdx.x + 256 * j; out[(long)r * D + c] = v[j] * rs * g[c]; }
}

static inline int nblk(long n) { return (int)((n + 255) / 256); }

static void forward(void* const* d_in, float* out, float* ws, size_t ws_floats, hipStream_t st) {
    const float* x = (const float*)d_in[0]; const float* c = (const float*)d_in[1]; const float* ctx = (const float*)d_in[2]; const float* cctx = (const float*)d_in[3];
    const float* w_ada = (const float*)d_in[4]; const float* b_ada = (const float*)d_in[5]; const float* g_attn = (const float*)d_in[6]; const float* w_in = (const float*)d_in[7];
    const float* g_qa = (const float*)d_in[8]; const float* w_qb = (const float*)d_in[9]; const float* g_kva = (const float*)d_in[10]; const float* w_kvb = (const float*)d_in[11];
    const float* w_conv = (const float*)d_in[12]; const float* w_oa = (const float*)d_in[13]; const float* w_ob = (const float*)d_in[14]; const float* w_o = (const float*)d_in[15];
    const float* g_ffn = (const float*)d_in[16]; const float* w_gd = (const float*)d_in[17]; const float* w_ud = (const float*)d_in[18]; const float* w_dd = (const float*)d_in[19];
    const float* w_router = (const float*)d_in[20]; const float* w_ge = (const float*)d_in[21]; const float* w_ue = (const float*)d_in[22]; const float* w_de = (const float*)d_in[23];
    const float* g_final = (const float*)d_in[24];
    size_t o = 0; auto take = [&](size_t n) { float* p = ws + o; o += (n + 63) / 64 * 64; return p; };
    float* XL = take((size_t)MT * D); float* MOD = take(4 * 6 * D); float* H = take((size_t)MT * D); float* P = take((size_t)MT * DIN);
    float* QN = take((size_t)MT * 512); float* CN = take((size_t)MT * 512); float* Q = take((size_t)MT * NH * DQK); float* KV = take((size_t)MT * NH * 256);
    float* KR = take((size_t)MT * DR); float* SC = take((size_t)NH * 256 * MT); float* ATT = take((size_t)MT * D);
    int* IB = (int*)take(4 * SEQ + 64 + 2 * SEQ + 2 * SEQ);
    if (o > ws_floats) { fprintf(stderr, "slow::forward: workspace too small (%zu > %zu floats)\n", o, ws_floats); return; }
    int* sel = IB; int* slot_of = IB + 2 * SEQ; int* toklist = IB + 4 * SEQ; int* cnt = IB + 6 * SEQ; int* off = cnt + 8; float* gw = (float*)(IB + 6 * SEQ + 64);
    float* OA = SC; float* OB = SC + (size_t)MT * D; float* V2 = SC + 2 * (size_t)MT * D; float* MG = SC + 3 * (size_t)MT * D;
    static_assert((size_t)NH * 256 * MT >= 2 * (size_t)MT * D, "SC region");
    V2 = Q; MG = KV;
    float* OUT = H; float* H2 = H; float* G = P; float* U = P + (size_t)MT * DFF; float* Y = Q; float* Ys = KV;
    static_assert((size_t)MT * DIN >= 2 * (size_t)MT * DFF, "P region holds G and U");

    hipLaunchKernelGGL(k_copy_x, dim3(2048), dim3(256), 0, st, ctx, x, XL);
    hipLaunchKernelGGL(k_ada, dim3(6 * D / 256, 4), dim3(256), 0, st, c, cctx, w_ada, b_ada, MOD);
    for (int i = 0; i < DEPTH; ++i) {
        const bool last = (i == DEPTH - 1);
        const float* modl = MOD + (size_t)(2 * i) * 6 * D; const float* modc = MOD + (size_t)(2 * i + 1) * 6 * D;
        hipLaunchKernelGGL(k_modnorm, dim3(MT), dim3(256), 0, st, XL, g_attn + i * D, modl, modc, 0, D, H);
        { GArgs g{H, D, 0, w_in + (size_t)i * D * DIN, DIN, 1, 0, nullptr, nullptr, nullptr, MT, DIN, D}; gemm<false>(st, g, EpiStore{P, DIN, 0, 1.f, 0}, 1, MT); }
        hipLaunchKernelGGL(k_rms512, dim3(MT), dim3(256), 0, st, P, OFF_QA, g_qa + i * QL, QN);
        hipLaunchKernelGGL(k_rms512, dim3(MT), dim3(256), 0, st, P, OFF_CKV, g_kva + i * KVL, CN);
        { GArgs g{QN, 512, 0, w_qb + (size_t)i * QL * NH * DQK, NH * DQK, 1, 0, nullptr, nullptr, nullptr, MT, NH * DQK, QL}; gemm<false>(st, g, EpiStore{Q, NH * DQK, 0, 1.f, 0}, 1, MT); }
        { GArgs g{CN, 512, 0, w_kvb + (size_t)i * KVL * NH * 256, NH * 256, 1, 0, nullptr, nullptr, nullptr, MT, NH * 256, KVL}; gemm<false>(st, g, EpiStore{KV, NH * 256, 0, 1.f, 0}, 1, MT); }
        hipLaunchKernelGGL(k_rope_q, dim3(nblk((long)SEQ * NH * 32)), dim3(256), 0, st, Q);
        hipLaunchKernelGGL(k_rope_k, dim3(nblk((long)MT * 32)), dim3(256), 0, st, P, KR);
        for (int ch = last ? 0 : -1; ch < SEQ / 256; ++ch) {
            const int q0 = ch < 0 ? 0 : LC + 256 * ch, nk = ch < 0 ? LC : MT;
            { GArgs g{Q + (size_t)q0 * NH * DQK, NH * DQK, DQK, KV, 1, NH * 256, 256, nullptr, nullptr, nullptr, 256, nk, DN}; gemm<true>(st, g, EpiStore{SC, nk, (long)256 * nk, ATT_SCALE, 0}, NH, 256); }
            { GArgs g{Q + (size_t)q0 * NH * DQK + DN, NH * DQK, DQK, KR, 1, DR, 0, nullptr, nullptr, nullptr, 256, nk, DR}; gemm<true>(st, g, EpiStore{SC, nk, (long)256 * nk, ATT_SCALE, 1}, NH, 256); }
            hipLaunchKernelGGL(k_softmax, dim3(NH * 256), dim3(256), 0, st, SC, nk);
            { GArgs g{SC, nk, (long)256 * nk, KV + DN, NH * 256, 1, 256, nullptr, nullptr, nullptr, 256, DV, nk}; gemm<false>(st, g, EpiStore{ATT + (size_t)q0 * D, D, DV, 1.f, 0}, NH, 256); }
        }
        { GArgs g{ATT, D, 0, w_oa + (size_t)i * D * D, D, 1, 0, nullptr, nullptr, nullptr, MT, D, D}; gemm<false>(st, g, EpiStore{OA, D, 0, 1.f, 0}, 1, MT); }
        hipLaunchKernelGGL(k_conv, dim3(nblk((long)MT * CW)), dim3(256), 0, st, P, w_conv + (size_t)i * 3 * CW, V2);
        { GArgs g{V2, CW, 0, w_ob + (size_t)i * CW * D, D, 1, 0, nullptr, nullptr, nullptr, MT, D, CW}; gemm<false>(st, g, EpiStore{OB, D, 0, 1.f, 0}, 1, MT); }
        hipLaunchKernelGGL(k_merge, dim3(nblk((long)MT * D)), dim3(256), 0, st, P, OA, OB, MG);
        { GArgs g{MG, D, 0, w_o + (size_t)i * D * D, D, 1, 0, nullptr, nullptr, nullptr, MT, D, D}; gemm<false>(st, g, EpiResid{XL, modl + 2 * D, modc + 2 * D}, 1, MT); }
        hipLaunchKernelGGL(k_modnorm, dim3(MT), dim3(256), 0, st, XL, g_ffn + i * D, modl, modc, 3 * D, 4 * D, H2);
        if (i % 2 == 0) {
            const int j = i / 2;
            { GArgs g{H2, D, 0, w_gd + (size_t)j * D * DFF, DFF, 1, 0, nullptr, nullptr, nullptr, MT, DFF, D}; gemm<false>(st, g, EpiStore{G, DFF, 0, 1.f, 0}, 1, MT); }
            { GArgs g{H2, D, 0, w_ud + (size_t)j * D * DFF, DFF, 1, 0, nullptr, nullptr, nullptr, MT, DFF, D}; gemm<false>(st, g, EpiStore{U, DFF, 0, 1.f, 0}, 1, MT); }
            hipLaunchKernelGGL(k_swiglu, dim3(4096), dim3(256), 0, st, G, U, (long)MT * DFF);
            { GArgs g{G, DFF, 0, w_dd + (size_t)j * DFF * D, D, 1, 0, nullptr, nullptr, nullptr, MT, D, DFF}; gemm<false>(st, g, EpiResid{XL, modl + 5 * D, modc + 5 * D}, 1, MT); }
        } else {
            const int j = i / 2;
            float* Ge = P; float* Ue = P + (size_t)2 * SEQ * DFE;
            hipLaunchKernelGGL(k_router, dim3(SEQ / 4), dim3(256), 0, st, H2, w_router + (size_t)j * D * NE, sel, gw);
            hipLaunchKernelGGL(k_sort, dim3(1), dim3(512), 0, st, sel, cnt, off, toklist, slot_of);
            { GArgs g{H2, D, 0, w_ge + (size_t)j * NE * D * DFE, DFE, 1, (long)D * DFE, toklist, off, cnt, 0, DFE, D}; gemm<false>(st, g, EpiStore{Ge, DFE, 0, 1.f, 0}, NE, SEQ); }
            { GArgs g{H2, D, 0, w_ue + (size_t)j * NE * D * DFE, DFE, 1, (long)D * DFE, toklist, off, cnt, 0, DFE, D}; gemm<false>(st, g, EpiStore{Ue, DFE, 0, 1.f, 0}, NE, SEQ); }
            hipLaunchKernelGGL(k_swiglu, dim3(4096), dim3(256), 0, st, Ge, Ue, (long)2 * SEQ * DFE);
            { GArgs g{Ge, DFE, 0, w_de + (size_t)j * NE * DFE * D, D, 1, (long)DFE * D, nullptr, off, cnt, 0, D, DFE}; gemm<false>(st, g, EpiStore{Ys, D, 0, 1.f, 0}, NE, SEQ); }
            hipLaunchKernelGGL(k_moe_combine, dim3(nblk((long)SEQ * D)), dim3(256), 0, st, XL, Ys, slot_of, gw, modl + 5 * D);
        }
        (void)OUT; (void)Y;
    }
    hipLaunchKernelGGL(k_final, dim3(SEQ), dim3(256), 0, st, XL, g_final, out);
}
}


namespace mk {
#define LAS __attribute__((address_space(3)))
#define GAS __attribute__((address_space(1)))
typedef unsigned short bf16;
typedef short bf16x8 __attribute__((ext_vector_type(8)));
typedef short s16x4 __attribute__((ext_vector_type(4)));
typedef float f32x2 __attribute__((ext_vector_type(2)));
typedef float f32x4 __attribute__((ext_vector_type(4)));
typedef float f32x16 __attribute__((ext_vector_type(16)));
typedef unsigned u32x2 __attribute__((ext_vector_type(2)));
typedef unsigned u32x4 __attribute__((ext_vector_type(4)));
typedef __bf16 bf16x2_t __attribute__((ext_vector_type(2)));
typedef int i32x4 __attribute__((ext_vector_type(4)));
typedef GAS unsigned gu32;

constexpr int NWAVES = 8, NTHREADS = 512;
constexpr int NT_IN = 45;
constexpr int NIN = NT_IN * 256;
constexpr int KS_ADA = 16;
constexpr int MAXT = 72;
constexpr int XS_ROWS = MAXT * 256;

constexpr size_t al256(size_t x) { return (x + 255) / 256 * 256; }
constexpr size_t WS_CTL = 0, CTL_BYTES = 1u << 20;
constexpr size_t WS_MOD = WS_CTL + CTL_BYTES;
constexpr size_t WS_PART = WS_MOD + al256((size_t)4 * 6 * D * 4);
constexpr size_t WS_ROPE = WS_PART + al256((size_t)2 * KS_ADA * 2 * 6 * D * 4);
constexpr size_t WS_SEL = WS_ROPE + al256(2 * 128 * 16 * 4);
constexpr size_t WS_GW = WS_SEL + al256((size_t)2 * SEQ * 4);
constexpr size_t WS_SLOT = WS_GW + al256((size_t)2 * SEQ * 4);
constexpr int SC_IN = 0, SC_GU = 2 * NIN, SC_GUE = SC_GU + 2 * DFF, SC_TOTAL = SC_GUE + NE * 2 * DFE;
constexpr size_t WS_HSC = WS_SLOT + al256((size_t)2 * SEQ * 4);
constexpr size_t WS_XSC = WS_HSC + al256((size_t)MT * 4);
constexpr size_t WS_WSC = WS_XSC + al256((size_t)XS_ROWS * 4);
constexpr size_t CTL_COLMAX = 65536;
static_assert(CTL_COLMAX + (size_t)SC_TOTAL * 4 <= CTL_BYTES, "column maxima inside the zeroed control region");
constexpr size_t WS_XL = WS_WSC + al256((size_t)SC_TOTAL * 4);
constexpr size_t WS_HN = WS_XL + al256((size_t)MT * D * 4);
constexpr size_t WS_MIX = WS_HN + al256((size_t)MT * D * 2);
constexpr size_t MX_QC = 0;
constexpr size_t MX_KRB = MX_QC + al256((size_t)MT * 1024 * 2);
constexpr size_t MX_SSQ = MX_KRB + al256((size_t)MT * 64 * 2);
constexpr size_t MX_U = MX_SSQ + al256((size_t)MT * 16 * 4);
constexpr size_t MX_CB = MX_U + al256((size_t)MT * D * 2);
constexpr size_t MX_SGA = MX_CB + al256((size_t)MT * D * 2);
constexpr size_t MX_SGB = MX_SGA + al256((size_t)MT * D * 2);
constexpr size_t MX_Q = MX_SGB + al256((size_t)MT * D * 2);
constexpr size_t MX_KV = MX_Q + al256((size_t)MT * 3072 * 2);
constexpr size_t MX_O = MX_KV + al256((size_t)MT * 4096 * 2);
constexpr size_t MX_V2 = MX_O + al256((size_t)MT * D * 2);
constexpr size_t MX_M1 = MX_V2 + al256((size_t)MT * D * 2);
constexpr size_t MX_MG = MX_M1 + al256((size_t)MT * D * 2);
constexpr size_t MX_END = MX_MG + al256((size_t)MT * D * 2);
constexpr size_t FX_ACT = 0;
constexpr size_t FX_XS = 0;
constexpr size_t FX_ACTE = FX_XS + al256((size_t)XS_ROWS * D * 2);
constexpr size_t FX_YS = FX_ACTE + al256((size_t)XS_ROWS * DFE * 2);
constexpr size_t FX_END = FX_YS + al256((size_t)XS_ROWS * D * 2);
static_assert(MX_SGA - MX_CB == (size_t)MT * D * 2 && MX_SGB - MX_SGA == (size_t)MT * D * 2, "CB | SGA | SGB contiguous");
static_assert(FX_END <= MX_END && (size_t)MT * DFF * 2 <= MX_END, "FFN scratch overlays the mixer scratch");
constexpr size_t WS_W = WS_MIX + MX_END;
constexpr size_t W_IN = 0, W_IN_L = (size_t)NIN * D * 2;
constexpr size_t W_QB = W_IN + 2 * W_IN_L, W_QB_L = (size_t)3072 * 512 * 2;
constexpr size_t W_KVB = W_QB + 2 * W_QB_L, W_KVB_L = (size_t)4096 * 512 * 2;
constexpr size_t W_OA = W_KVB + 2 * W_KVB_L, W_SQ_L = (size_t)D * D * 2;
constexpr size_t W_OB = W_OA + 2 * W_SQ_L, W_O = W_OB + 2 * W_SQ_L;
constexpr size_t W_GU = W_O + 2 * W_SQ_L;
constexpr size_t W_DD = W_GU + (size_t)2 * DFF * D * 2;
constexpr size_t W_GUE = W_DD + (size_t)D * DFF * 2, W_GUE_E = (size_t)2 * DFE * D * 2;
constexpr size_t W_DE = W_GUE + NE * W_GUE_E, W_DE_E = (size_t)D * DFE * 2;
constexpr size_t W_END = W_DE + NE * W_DE_E;
constexpr size_t WS_END = WS_W + W_END;

constexpr int RING_BYTES = 131072;
constexpr int LCTL_OFF = RING_BYTES;
constexpr int LDS_BYTES = 147456;

__device__ __forceinline__ unsigned cvtpk(float lo, float hi) { f32x2 v = {lo, hi}; bf16x2_t b = __builtin_convertvector(v, bf16x2_t); return __builtin_bit_cast(unsigned, b); }
__device__ __forceinline__ u32x4 pack8(f32x4 a, f32x4 b) { u32x4 w; w.x = cvtpk(a[0], a[1]); w.y = cvtpk(a[2], a[3]); w.z = cvtpk(b[0], b[1]); w.w = cvtpk(b[2], b[3]); return w; }
__device__ __forceinline__ void unpack8(u32x4 w, f32x4& a, f32x4& b) {
    a[0] = __uint_as_float(w.x << 16); a[1] = __uint_as_float(w.x & 0xffff0000u); a[2] = __uint_as_float(w.y << 16); a[3] = __uint_as_float(w.y & 0xffff0000u);
    b[0] = __uint_as_float(w.z << 16); b[1] = __uint_as_float(w.z & 0xffff0000u); b[2] = __uint_as_float(w.w << 16); b[3] = __uint_as_float(w.w & 0xffff0000u); }
__device__ __forceinline__ f32x4 unpack4(u32x2 w) { f32x4 a; a[0] = __uint_as_float(w.x << 16); a[1] = __uint_as_float(w.x & 0xffff0000u); a[2] = __uint_as_float(w.y << 16); a[3] = __uint_as_float(w.y & 0xffff0000u); return a; }
__device__ __forceinline__ float fsig(float x) { return __builtin_amdgcn_rcpf(1.f + __builtin_amdgcn_exp2f(-1.4426950408889634f * x)); }
__device__ __forceinline__ f32x4 fsig4(f32x4 x) { f32x4 r; r[0] = fsig(x[0]); r[1] = fsig(x[1]); r[2] = fsig(x[2]); r[3] = fsig(x[3]); return r; }
__device__ __forceinline__ float wave_sum(float v) {
#pragma unroll
    for (int o = 1; o < 64; o <<= 1) v += __shfl_xor(v, o);
    return v;
}
#define LDS_WAIT() asm volatile("s_waitcnt lgkmcnt(0)" ::: "memory")
#define VM_WAIT() asm volatile("s_waitcnt vmcnt(0)" ::: "memory")

namespace pg8 {
constexpr int BM = 256, BK = 64, HALF = 128, HTB = HALF * BK * 2, STAGE_BYTES = 8 * HTB, NXCD = 8, WGM = 8;
__device__ __forceinline__ int lds_byte(int r, int c) { const int st = (r >> 4) * 2 + (c >> 5), rr = r & 15, cc = c & 31, ob = rr * 64 + cc * 2; return st * 1024 + (ob ^ (((ob >> 9) & 1) << 5)); }
__device__ __forceinline__ void stage_rc(int b, int& R, int& C) { const int st = b / 1024, sb = b % 1024, swz = sb ^ (((sb >> 9) & 1) << 5); R = (st >> 1) * 16 + swz / 64; C = (st & 1) * 32 + (swz % 64) / 2; }
__device__ __forceinline__ int perm32(int rho) { const int n = rho >> 4, i = rho & 15; return 8 * (i >> 2) + 4 * n + (i & 3); }
struct Unit { int pm, pn, kind; };
struct Geo { int lda, ldb, K; };
__device__ __forceinline__ void tile_of(int L, int nM, int nN, int& pm, int& pn) {
    const int nwg = nM * nN; int wgid = L; { const int q = nwg / NXCD, r = nwg % NXCD, xcd = wgid % NXCD, off = wgid / NXCD; wgid = (xcd < r ? xcd * (q + 1) : r * (q + 1) + (xcd - r) * q) + off; }
    const int nig = WGM * nN, gid = wgid / nig, fm = gid * WGM, gsz = (nM - fm) < WGM ? (nM - fm) : WGM;
    pm = fm + ((wgid % nig) % gsz); pn = (wgid % nig) / gsz;
}
template <class Epi, class Sched, bool ALIGN_EPI, bool I8 = false>
__device__ __forceinline__ void gemm_phase(LAS unsigned char* lds, const Geo g, const Sched& S, const Epi& E) {
    int tid = threadIdx.x; asm volatile("" : "+v"(tid));
    const int wid = __builtin_amdgcn_readfirstlane(tid >> 6), lane = tid & 63, wr = wid >> 2, wc = wid & 3, fr = lane & 15, fq = lane >> 4;
    const int nt = g.K / BK;
    unsigned voffA[2], voffB[2];
#pragma unroll
    for (int i = 0; i < 2; ++i) { int R, C; stage_rc(tid * 16 + i * 8192, R, C); const int Rb = Epi::PERM ? ((R & ~31) + perm32(R & 31)) : R;
        voffA[i] = (unsigned)(R * g.lda + C) * 2u; voffB[i] = (unsigned)(Rb * g.ldb + C) * 2u; }
    const size_t kstep = (size_t)(BK * 2);
    const size_t hstepA = (size_t)HALF * g.lda * 2, hstepB = (size_t)HALF * g.ldb * 2;
    const unsigned ldsw = (unsigned)wid * 1024u;
    const int aoff = lds_byte(wr * 64 + fr, fq * 8), boff = lds_byte(wc * 32 + fr, fq * 8);
#define PG8_SA(b, h) (((b) * 2 + (h)) * HTB)
#define PG8_SB(b, h) ((4 + (b) * 2 + (h)) * HTB)
#define PG8_STAGE(bufoff, gbase, voff) do { _Pragma("unroll") for (int _i = 0; _i < 2; ++_i) \
        __builtin_amdgcn_global_load_lds((const unsigned*)((const char*)(gbase) + (voff)[_i]), (LAS unsigned*)(lds + (bufoff) + ldsw + _i * 8192), 16, 0, 0); } while (0)
#define PG8_LDA(dst, b, h) do { _Pragma("unroll") for (int m = 0; m < 4; ++m) _Pragma("unroll") for (int k = 0; k < 2; ++k) dst[m][k] = *(const LAS bf16x8*)(lds + PG8_SA(b, h) + aoff + m * 2048 + k * 1024); } while (0)
#define PG8_LDB(dst, b, h) do { _Pragma("unroll") for (int n = 0; n < 2; ++n) _Pragma("unroll") for (int k = 0; k < 2; ++k) dst[n][k] = *(const LAS bf16x8*)(lds + PG8_SB(b, h) + boff + n * 2048 + k * 1024); } while (0)
#define PG8_MMA(ai, bj, At, Bt) do { __builtin_amdgcn_s_setprio(1); _Pragma("unroll") for (int m = 0; m < 4; ++m) _Pragma("unroll") for (int n = 0; n < 2; ++n) _Pragma("unroll") for (int k = 0; k < 2; ++k) { \
        if constexpr (I8) acc[ai][bj][m][n] = __builtin_bit_cast(f32x4, __builtin_amdgcn_mfma_i32_16x16x64_i8(__builtin_bit_cast(i32x4, Bt[n][k]), __builtin_bit_cast(i32x4, At[m][k]), __builtin_bit_cast(i32x4, acc[ai][bj][m][n]), 0, 0, 0)); \
        else acc[ai][bj][m][n] = __builtin_amdgcn_mfma_f32_16x16x32_bf16(Bt[n][k], At[m][k], acc[ai][bj][m][n], 0, 0, 0); } __builtin_amdgcn_s_setprio(0); } while (0)
#define PG8_WAIT_V(n) asm volatile("s_waitcnt vmcnt(" #n ")" ::: "memory")
#define PG8_WAIT_L(n) asm volatile("s_waitcnt lgkmcnt(" #n ")" ::: "memory")
#define PG8_BAR __builtin_amdgcn_s_barrier()
#define PG8_SCHED __builtin_amdgcn_sched_barrier(0)
    Unit cur, nxt; int ui = 0;
    if (!S.next(0, cur)) return;
    float zf = 0.f; asm volatile("" : "+v"(zf));
    f32x4 acc[2][2][4][2];
#pragma unroll
    for (int a = 0; a < 2; ++a)
#pragma unroll
        for (int b = 0; b < 2; ++b)
#pragma unroll
            for (int m = 0; m < 4; ++m)
#pragma unroll
                for (int n = 0; n < 2; ++n) acc[a][b][m][n] = (f32x4){zf, zf, zf, zf};
    bf16x8 At[4][2], B0[2][2], B1[2][2];
    const char* cA = S.abase(cur); const char* cB = S.bbase(cur);
    PG8_STAGE(PG8_SB(0, 0), cB, voffB); PG8_STAGE(PG8_SB(0, 1), cB + hstepB, voffB); PG8_STAGE(PG8_SA(0, 0), cA, voffA); PG8_STAGE(PG8_SA(0, 1), cA + hstepA, voffA);
    if (wr == 1) PG8_BAR;
    PG8_WAIT_V(2); PG8_BAR;
    PG8_STAGE(PG8_SB(1, 0), cB + kstep, voffB); PG8_STAGE(PG8_SA(1, 0), cA + kstep, voffA); PG8_STAGE(PG8_SB(1, 1), cB + hstepB + kstep, voffB);
    PG8_WAIT_V(6); PG8_BAR;
    for (;;) {
        const bool has_next = S.next(ui + 1, nxt);
        const char* nA = has_next ? S.abase(nxt) : cA; const char* nB = has_next ? S.bbase(nxt) : cB;
        for (int t = 0; t < nt; t += 2) {
            const bool last = (t == nt - 2);
            const char* a1 = cA + (size_t)(t + 1) * kstep;
            const char* a2 = last ? nA : cA + (size_t)(t + 2) * kstep; const char* b2 = last ? nB : cB + (size_t)(t + 2) * kstep;
            const char* a3 = a2 + kstep; const char* b3 = b2 + kstep;
            PG8_LDB(B0, 0, 0); PG8_LDB(B1, 0, 1); PG8_SCHED; PG8_LDA(At, 0, 0); PG8_STAGE(PG8_SA(1, 1), a1 + hstepA, voffA);
            PG8_WAIT_V(8); PG8_WAIT_L(0); PG8_BAR; PG8_MMA(0, 0, At, B0); PG8_MMA(0, 1, At, B1); PG8_BAR; PG8_SCHED;
            PG8_LDA(At, 0, 1); PG8_STAGE(PG8_SB(0, 0), b2, voffB); PG8_STAGE(PG8_SB(0, 1), b2 + hstepB, voffB); PG8_STAGE(PG8_SA(0, 0), a2, voffA);
            PG8_WAIT_V(8); PG8_WAIT_L(0); PG8_BAR; PG8_MMA(1, 0, At, B0); PG8_MMA(1, 1, At, B1); PG8_BAR; PG8_SCHED;
            PG8_LDB(B0, 1, 0); PG8_LDB(B1, 1, 1); PG8_SCHED; PG8_LDA(At, 1, 0); PG8_STAGE(PG8_SA(0, 1), a2 + hstepA, voffA);
            PG8_WAIT_V(8); PG8_WAIT_L(0); PG8_BAR; PG8_MMA(0, 0, At, B0); PG8_MMA(0, 1, At, B1); PG8_BAR; PG8_SCHED;
            PG8_LDA(At, 1, 1); PG8_STAGE(PG8_SB(1, 0), b3, voffB); PG8_STAGE(PG8_SB(1, 1), b3 + hstepB, voffB); PG8_STAGE(PG8_SA(1, 0), a3, voffA);
            PG8_WAIT_V(8); PG8_WAIT_L(0); PG8_BAR; PG8_MMA(1, 0, At, B0); PG8_MMA(1, 1, At, B1); PG8_BAR; PG8_SCHED;
        }
        if constexpr (ALIGN_EPI) { if (wr == 0) PG8_BAR; }
        if constexpr (I8) {
            static_assert(Epi::PERM, "the int8 path dequantises in the PERM column layout");
            const float* sa = S.sa(cur) + wr * 64 + fr; const float* sb = S.sb(cur) + wc * 32 + 8 * fq;
            f32x4 sbv[2][2];
#pragma unroll
            for (int b = 0; b < 2; ++b)
#pragma unroll
                for (int n = 0; n < 2; ++n) sbv[b][n] = *(const f32x4*)(sb + b * HALF + 4 * n);
#pragma unroll
            for (int a = 0; a < 2; ++a)
#pragma unroll
                for (int m = 0; m < 4; ++m) { const float sr = sa[a * HALF + m * 16];
#pragma unroll
                    for (int b = 0; b < 2; ++b)
#pragma unroll
                        for (int n = 0; n < 2; ++n) { const i32x4 iv = __builtin_bit_cast(i32x4, acc[a][b][m][n]);
                            acc[a][b][m][n] = (f32x4){(float)iv[0], (float)iv[1], (float)iv[2], (float)iv[3]} * (sbv[b][n] * sr); } }
        }
        E(acc, cur, wr, wc, fr, fq);
        if (!has_next) break;
#pragma unroll
        for (int a = 0; a < 2; ++a)
#pragma unroll
            for (int b = 0; b < 2; ++b)
#pragma unroll
                for (int m = 0; m < 4; ++m)
#pragma unroll
                    for (int n = 0; n < 2; ++n) acc[a][b][m][n] = (f32x4){zf, zf, zf, zf};
        cur = nxt; cA = nA; cB = nB; ++ui;
        if constexpr (ALIGN_EPI) { if (wr == 1) PG8_BAR; }
    }
    PG8_WAIT_V(0);
    if constexpr (!ALIGN_EPI) { if (wr == 0) PG8_BAR; }
    PG8_BAR;
#undef PG8_SA
#undef PG8_SB
#undef PG8_STAGE
#undef PG8_LDA
#undef PG8_LDB
#undef PG8_MMA
#undef PG8_WAIT_V
#undef PG8_WAIT_L
#undef PG8_BAR
#undef PG8_SCHED
}

struct TileOrder {
    int nM, nN, pm0, G, c, nx, xpm, xpn0;
    const char* A; const char* B; size_t tstepA, tstepB; const float* SA; const float* SB;
    __device__ __forceinline__ const float* sa(const Unit& u) const { return SA + (size_t)u.pm * 256; }
    __device__ __forceinline__ const float* sb(const Unit& u) const { return SB + (size_t)u.pn * 256; }
    __device__ __forceinline__ bool next(int i, Unit& u) const {
        const int L = i * G + c, n1 = nM * nN;
        if (L < n1) { tile_of(L, nM, nN, u.pm, u.pn); u.pm += pm0; u.kind = 0; return true; }
        if (L < n1 + nx) { u.pm = xpm; u.pn = xpn0 + (L - n1); u.kind = 0; return true; }
        return false; }
    __device__ __forceinline__ const char* abase(const Unit& u) const { return A + (size_t)u.pm * tstepA; }
    __device__ __forceinline__ const char* bbase(const Unit& u) const { return B + (size_t)u.pn * tstepB; }
};
struct QkvOrder {
    int nMkv, nMq, pm0q, G, c; const char* QC; const char* WQB; long dkv;
    __device__ __forceinline__ bool next(int i, Unit& u) const {
        const int L = i * G + c, n1 = nMkv * 16;
        if (L < n1) { tile_of(L, nMkv, 16, u.pm, u.pn); u.kind = 0; return true; }
        if (L < n1 + nMq * 12) { tile_of(L - n1, nMq, 12, u.pm, u.pn); u.pm += pm0q; u.kind = 1; return true; }
        return false; }
    __device__ __forceinline__ const char* abase(const Unit& u) const { return QC + (size_t)u.pm * (256 * 1024 * 2) + (u.kind == 0 ? 1024 : 0); }
    __device__ __forceinline__ const char* bbase(const Unit& u) const { return WQB + (u.kind == 0 ? dkv : 0l) + (size_t)u.pn * (256 * 512 * 2); }
};
struct MoeOrder {
    int T, nN, G, c; const char* A; const char* B; size_t tstepA, tstepB, estride; const LAS int* te; const float* SA; const float* SB; int sbstride; const LAS int* remap;
    __device__ __forceinline__ const float* sa(const Unit& u) const { return SA + (size_t)u.pm * 256; }
    __device__ __forceinline__ const float* sb(const Unit& u) const { const int e = __builtin_amdgcn_readfirstlane(te[u.pm]); return SB + (size_t)e * sbstride + (size_t)u.pn * 256; }
    __device__ __forceinline__ bool next(int i, Unit& u) const {
        const int L = i * G + c; if (L >= T * nN) return false;
        tile_of(L, T, nN, u.pm, u.pn); u.kind = 0; if (remap) u.pm = __builtin_amdgcn_readfirstlane(remap[u.pm]); return true; }
    __device__ __forceinline__ const char* abase(const Unit& u) const { return A + (size_t)u.pm * tstepA; }
    __device__ __forceinline__ const char* bbase(const Unit& u) const { const int e = __builtin_amdgcn_readfirstlane(te[u.pm]); return B + (size_t)e * estride + (size_t)u.pn * tstepB; }
};

typedef const f32x4 (&AccRef)[2][2][4][2];
struct EpiInproj {
    static constexpr bool PERM = true;
    bf16* QC; bf16* KRB; bf16* U; bf16* CB; float* SSQ; const float* ROPE;
    __device__ __forceinline__ void operator()(AccRef acc, const Unit& u, int wr, int wc, int fr_, int fq_) const {
        int fr = fr_, fq = fq_; asm volatile("" : "+v"(fr), "+v"(fq));
        const int pn = u.pn, row0 = u.pm * BM + wr * 64 + fr;
        if (pn < 4) {
#pragma unroll
            for (int ai = 0; ai < 2; ++ai)
#pragma unroll
                for (int m = 0; m < 4; ++m) { const int row = row0 + ai * HALF + m * 16; float s = 0.f;
#pragma unroll
                    for (int bj = 0; bj < 2; ++bj) { const f32x4 v0 = acc[ai][bj][m][0], v1 = acc[ai][bj][m][1];
                        s += (v0[0] * v0[0] + v0[1] * v0[1]) + (v0[2] * v0[2] + v0[3] * v0[3]) + (v1[0] * v1[0] + v1[1] * v1[1]) + (v1[2] * v1[2] + v1[3] * v1[3]);
                        *(u32x4*)(QC + (size_t)row * 1024 + pn * 256 + bj * HALF + wc * 32 + 8 * fq) = pack8(v0, v1); }
                    s += __shfl_xor(s, 16); s += __shfl_xor(s, 32);
                    if (fq == 0) SSQ[(size_t)row * 16 + pn * 4 + wc] = s; }
        } else if (pn == 4) {
            if (wc < 2) {
#pragma unroll
                for (int ai = 0; ai < 2; ++ai)
#pragma unroll
                    for (int m = 0; m < 4; ++m) { const int row = row0 + ai * HALF + m * 16; f32x4 v0 = acc[ai][0][m][0], v1 = acc[ai][0][m][1];
                        if (row >= LC) { const int t = row - LC, pos = wc ? (t & 63) : (t >> 6);
                            const f32x4 cs = *(const f32x4*)(ROPE + pos * 16 + 4 * fq), sn = *(const f32x4*)(ROPE + 2048 + pos * 16 + 4 * fq);
                            const f32x4 a0 = v0, a1 = v1;
                            v0[0] = a0[0] * cs[0] - a0[1] * sn[0]; v0[1] = a0[1] * cs[0] + a0[0] * sn[0]; v0[2] = a0[2] * cs[1] - a0[3] * sn[1]; v0[3] = a0[3] * cs[1] + a0[2] * sn[1];
                            v1[0] = a1[0] * cs[2] - a1[1] * sn[2]; v1[1] = a1[1] * cs[2] + a1[0] * sn[2]; v1[2] = a1[2] * cs[3] - a1[3] * sn[3]; v1[3] = a1[3] * cs[3] + a1[2] * sn[3]; }
                        *(u32x4*)(KRB + (size_t)row * 64 + wc * 32 + 8 * fq) = pack8(v0, v1); }
            }
        } else if (pn < 21) {
            const int j = pn - 5;
#pragma unroll
            for (int ai = 0; ai < 2; ++ai)
#pragma unroll
                for (int m = 0; m < 4; ++m) { const int row = row0 + ai * HALF + m * 16;
                    *(u32x4*)(U + (size_t)row * D + j * 128 + wc * 32 + 8 * fq) = pack8(acc[ai][0][m][0] * acc[ai][1][m][0], acc[ai][0][m][1] * acc[ai][1][m][1]); }
        } else {
            bf16* dst = CB + (size_t)((pn - 21) >> 3) * ((size_t)MT * D); const int col = ((pn - 21) & 7) * 256; const bool sg = pn >= 29;
#pragma unroll
            for (int ai = 0; ai < 2; ++ai)
#pragma unroll
                for (int m = 0; m < 4; ++m) { const int row = row0 + ai * HALF + m * 16;
#pragma unroll
                    for (int bj = 0; bj < 2; ++bj) { f32x4 v0 = acc[ai][bj][m][0], v1 = acc[ai][bj][m][1];
                        if (sg) { v0 = fsig4(v0); v1 = fsig4(v1); }
                        *(u32x4*)(dst + (size_t)row * D + col + bj * HALF + wc * 32 + 8 * fq) = pack8(v0, v1); } }
        }
    }
};
struct EpiQkv {
    static constexpr bool PERM = true;
    bf16* Q; bf16* KV; const float* SSQ; const float* ROPE;
    __device__ __forceinline__ void operator()(AccRef acc, const Unit& u, int wr, int wc, int fr_, int fq_) const {
        int fr = fr_, fq = fq_; asm volatile("" : "+v"(fr), "+v"(fq));
        const int row0 = u.pm * BM + wr * 64 + fr, grp = u.kind == 0 ? 8 : 0;
#pragma unroll
        for (int ai = 0; ai < 2; ++ai) {
            float rqv[4];
#pragma unroll
            for (int m = 0; m < 4; ++m) { const int row = row0 + ai * HALF + m * 16;
                const f32x4 s0 = *(const f32x4*)(SSQ + (size_t)row * 16 + grp), s1 = *(const f32x4*)(SSQ + (size_t)row * 16 + grp + 4);
                const float rs = rsqrtf(((s0[0] + s0[1]) + (s0[2] + s0[3]) + (s1[0] + s1[1]) + (s1[2] + s1[3])) * (1.f / 512.f) + EPS);
                rqv[m] = (u.kind == 0) ? rs : rs * (ATT_SCALE * 1.4426950408889634f); }
#pragma unroll
            for (int bj = 0; bj < 2; ++bj) {
                const int hb = (u.pn * 8 + bj * 4 + wc) % 6; const bool rope = (u.kind != 0) && hb >= 4;
                f32x4 cs[4], sn[4];
                if (rope) {
#pragma unroll
                    for (int m = 0; m < 4; ++m) { const int row = row0 + ai * HALF + m * 16, t = row - LC, pos = (hb == 5) ? (t & 63) : (t >> 6);
                        if (row >= LC) { cs[m] = *(const f32x4*)(ROPE + pos * 16 + 4 * fq); sn[m] = *(const f32x4*)(ROPE + 2048 + pos * 16 + 4 * fq); }
                        else { cs[m] = (f32x4){1.f, 1.f, 1.f, 1.f}; sn[m] = (f32x4){0.f, 0.f, 0.f, 0.f}; } } }
#pragma unroll
                for (int m = 0; m < 4; ++m) { const int row = row0 + ai * HALF + m * 16; const float rq = rqv[m];
                    f32x4 v0 = acc[ai][bj][m][0] * rq, v1 = acc[ai][bj][m][1] * rq;
                    if (u.kind == 0) { *(u32x4*)(KV + (size_t)row * 4096 + u.pn * 256 + bj * HALF + wc * 32 + 8 * fq) = pack8(v0, v1); }
                    else {
                        if (rope) { const f32x4 a0 = v0, a1 = v1, c4 = cs[m], s4 = sn[m];
                            v0[0] = a0[0] * c4[0] - a0[1] * s4[0]; v0[1] = a0[1] * c4[0] + a0[0] * s4[0]; v0[2] = a0[2] * c4[1] - a0[3] * s4[1]; v0[3] = a0[3] * c4[1] + a0[2] * s4[1];
                            v1[0] = a1[0] * c4[2] - a1[1] * s4[2]; v1[1] = a1[1] * c4[2] + a1[0] * s4[2]; v1[2] = a1[2] * c4[3] - a1[3] * s4[3]; v1[3] = a1[3] * c4[3] + a1[2] * s4[3]; }
                        *(u32x4*)(Q + (size_t)row * 3072 + u.pn * 256 + bj * HALF + wc * 32 + 8 * fq) = pack8(v0, v1); } } } }
    }
};
template <int MODE> struct EpiMerge {
    static constexpr bool PERM = true;
    const bf16* SG; const bf16* M1; bf16* OUT;
    __device__ __forceinline__ void operator()(AccRef acc, const Unit& u, int wr, int wc, int fr_, int fq_) const {
        int fr = fr_, fq = fq_; asm volatile("" : "+v"(fr), "+v"(fq));
        const int row0 = u.pm * BM + wr * 64 + fr;
#pragma unroll
        for (int ai = 0; ai < 2; ++ai) { u32x4 sg[8], ad[8];
#pragma unroll
            for (int m = 0; m < 4; ++m)
#pragma unroll
                for (int bj = 0; bj < 2; ++bj) { const size_t off = (size_t)(row0 + ai * HALF + m * 16) * D + u.pn * 256 + bj * HALF + wc * 32 + 8 * fq;
                    sg[m * 2 + bj] = *(const u32x4*)(SG + off); if (MODE == 1) ad[m * 2 + bj] = *(const u32x4*)(M1 + off); }
#pragma unroll
            for (int m = 0; m < 4; ++m)
#pragma unroll
                for (int bj = 0; bj < 2; ++bj) { const size_t off = (size_t)(row0 + ai * HALF + m * 16) * D + u.pn * 256 + bj * HALF + wc * 32 + 8 * fq;
                    f32x4 g0, g1; unpack8(sg[m * 2 + bj], g0, g1);
                    f32x4 v0 = acc[ai][bj][m][0] * g0, v1 = acc[ai][bj][m][1] * g1;
                    if (MODE == 1) { f32x4 m0, m1; unpack8(ad[m * 2 + bj], m0, m1); v0 += m0; v1 += m1; }
                    *(u32x4*)(OUT + off) = pack8(v0, v1); } }
    }
};
struct EpiSwiglu {
    static constexpr bool PERM = true;
    bf16* ACT; int ld;
    __device__ __forceinline__ void operator()(AccRef acc, const Unit& u, int wr, int wc, int fr_, int fq_) const {
        int fr = fr_, fq = fq_; asm volatile("" : "+v"(fr), "+v"(fq));
        const int row0 = u.pm * BM + wr * 64 + fr;
#pragma unroll
        for (int ai = 0; ai < 2; ++ai)
#pragma unroll
            for (int m = 0; m < 4; ++m) { const int row = row0 + ai * HALF + m * 16;
                const f32x4 g0 = acc[ai][0][m][0], g1 = acc[ai][0][m][1];
                const f32x4 v0 = g0 * fsig4(g0) * acc[ai][1][m][0], v1 = g1 * fsig4(g1) * acc[ai][1][m][1];
                *(u32x4*)(ACT + (size_t)row * ld + u.pn * 128 + wc * 32 + 8 * fq) = pack8(v0, v1); }
    }
};
struct EpiResid {
    static constexpr bool PERM = false;
    float* XL; const float* SRC; const float* gl;
    __device__ __forceinline__ void operator()(AccRef acc, const Unit& u, int wr, int wc, int fr_, int fq_) const {
        int fr = fr_, fq = fq_; asm volatile("" : "+v"(fr), "+v"(fq));
        const int row0 = u.pm * BM + wr * 64 + fr; const float* gate = gl + ((u.pm == 0) ? 6 * D : 0);
#pragma unroll
        for (int bj = 0; bj < 2; ++bj) { f32x4 t[16], gv[2];
#pragma unroll
            for (int n = 0; n < 2; ++n) { const int col = u.pn * 256 + bj * HALF + wc * 32 + 16 * n + 4 * fq; gv[n] = *(const f32x4*)(gate + col);
#pragma unroll
                for (int ai = 0; ai < 2; ++ai)
#pragma unroll
                    for (int m = 0; m < 4; ++m) t[n * 8 + ai * 4 + m] = *(const f32x4*)(SRC + (size_t)(row0 + ai * HALF + m * 16) * D + col); }
#pragma unroll
            for (int n = 0; n < 2; ++n) { const int col = u.pn * 256 + bj * HALF + wc * 32 + 16 * n + 4 * fq;
#pragma unroll
                for (int ai = 0; ai < 2; ++ai)
#pragma unroll
                    for (int m = 0; m < 4; ++m) *(f32x4*)(XL + (size_t)(row0 + ai * HALF + m * 16) * D + col) = t[n * 8 + ai * 4 + m] + gv[n] * acc[ai][bj][m][n]; } }
    }
};
struct EpiStoreBf16 {
    static constexpr bool PERM = true;
    bf16* C; int ld;
    __device__ __forceinline__ void operator()(AccRef acc, const Unit& u, int wr, int wc, int fr_, int fq_) const {
        int fr = fr_, fq = fq_; asm volatile("" : "+v"(fr), "+v"(fq));
        const int row0 = u.pm * BM + wr * 64 + fr;
#pragma unroll
        for (int ai = 0; ai < 2; ++ai)
#pragma unroll
            for (int m = 0; m < 4; ++m)
#pragma unroll
                for (int bj = 0; bj < 2; ++bj)
                    *(u32x4*)(C + (size_t)(row0 + ai * HALF + m * 16) * ld + u.pn * 256 + bj * HALF + wc * 32 + 8 * fq) = pack8(acc[ai][bj][m][0], acc[ai][bj][m][1]);
    }
};
}

namespace att {
constexpr int QBLK = 32, KVBLK = 64;
constexpr int LDQ = NH * DQK, LDK = NH * 256, LDR = DR, LDO = D;
constexpr int SHM_V = KVBLK * DV * 2, SHM_K = KVBLK * DQK * 2;
constexpr int OFF_K = 2 * SHM_V, OFF_WS = 2 * SHM_V + 2 * SHM_K, OFF_QR = OFF_WS + NWAVES * 64 * 4, OFF_DO = OFF_QR + NWAVES * 4096, SHM_ATTN = OFF_DO + NTHREADS * 20;
static_assert(SHM_ATTN <= RING_BYTES, "attention scratch inside the ring");
constexpr float THR = 8.f;
constexpr int KROPE_OFF = 16384;
#define KSWZ(row, colB) ((row) * 384 + ((colB) ^ (((row) & 7) << 4)))
#define SBAR() __builtin_amdgcn_sched_barrier(0)
__device__ __forceinline__ int crow(int r, int hi) { return (r & 3) + 8 * (r >> 2) + 4 * hi; }
constexpr float THR2 = THR * 1.4426950408889634f;
template <bool FIRST> __device__ __forceinline__ void partialSM(f32x16& p0, f32x16& p1, float& m_reg, f32x16& negm, float& alpha) {
    float pmax = p0[0];
#pragma unroll
    for (int r = 1; r < 16; ++r) pmax = fmaxf(pmax, p0[r]);
#pragma unroll
    for (int r = 0; r < 16; ++r) pmax = fmaxf(pmax, p1[r]);
    { auto rr = __builtin_amdgcn_permlane32_swap(__float_as_uint(pmax), __float_as_uint(pmax), false, false);
      pmax = fmaxf(__uint_as_float(rr[0]), __uint_as_float(rr[1])); }
    alpha = 1.f;
    if (FIRST || !__builtin_expect(__all(pmax <= THR2), 1)) {
        const float d = FIRST ? pmax : fmaxf(pmax, 0.f);
        m_reg += d; if (!FIRST) alpha = __builtin_amdgcn_exp2f(-d);
#pragma unroll
        for (int r = 0; r < 16; ++r) { p0[r] -= d; p1[r] -= d; }
#pragma unroll
        for (int r = 0; r < 16; ++r) negm[r] = -m_reg;
    }
#pragma unroll
    for (int r = 0; r < 16; ++r) p0[r] = __builtin_amdgcn_exp2f(p0[r]);
}
__device__ __forceinline__ void finishSM(f32x16& p0, f32x16& p1, float alpha, float& l_reg, bf16x8& pa0, bf16x8& pa1, bf16x8& pa2, bf16x8& pa3) {
#pragma unroll
    for (int r = 0; r < 16; ++r) p1[r] = __builtin_amdgcn_exp2f(p1[r]);
    float ps = 0;
#pragma unroll
    for (int r = 0; r < 16; ++r) ps += p0[r];
#pragma unroll
    for (int r = 0; r < 16; ++r) ps += p1[r];
    { auto rr = __builtin_amdgcn_permlane32_swap(__float_as_uint(ps), __float_as_uint(ps), false, false);
      ps = __uint_as_float(rr[0]) + __uint_as_float(rr[1]); }
    l_reg = l_reg * alpha + ps;
#define PK4(P, BASE, OUT) do { u32x4 w = {cvtpk(P[BASE + 0], P[BASE + 1]), cvtpk(P[BASE + 2], P[BASE + 3]), cvtpk(P[BASE + 4], P[BASE + 5]), cvtpk(P[BASE + 6], P[BASE + 7])}; \
    OUT = __builtin_bit_cast(bf16x8, w); } while (0)
    PK4(p0, 0, pa0); PK4(p0, 8, pa1); PK4(p1, 0, pa2); PK4(p1, 8, pa3);
#undef PK4
}
__device__ __forceinline__ void qkt(f32x16& p0, f32x16& p1, const LAS char* Ks, const int (&kb)[4], int krd, const bf16x8* qr, const LAS char* qrl, const f32x16& negm) {
#pragma unroll
    for (int d0 = 0; d0 < 12; ++d0) {
        const LAS char* a = d0 < 8 ? Ks + kb[d0 & 3] + (d0 >> 2) * 128 : Ks + kb[d0 - 8] + krd;
        const bf16x8 b0 = *(const LAS bf16x8*)a;
        const bf16x8 b1 = *(const LAS bf16x8*)(a + (d0 < 8 ? 32 * 256 : 32 * 128));
        if (d0 == 0) { p0 = __builtin_amdgcn_mfma_f32_32x32x16_bf16(b0, qr[0], negm, 0, 0, 0); p1 = __builtin_amdgcn_mfma_f32_32x32x16_bf16(b1, qr[0], negm, 0, 0, 0); }
        else { const bf16x8 qf = d0 < 8 ? qr[d0 & 7] : *(const LAS bf16x8*)(qrl + (d0 - 8) * 1024);
            p0 = __builtin_amdgcn_mfma_f32_32x32x16_bf16(b0, qf, p0, 0, 0, 0); p1 = __builtin_amdgcn_mfma_f32_32x32x16_bf16(b1, qf, p1, 0, 0, 0); } }
}
template <int OFF> __device__ __forceinline__ bf16x8 dsr128(int addr) { bf16x8 r; asm volatile("ds_read_b128 %0, %1 offset:%2" : "=v"(r) : "v"(addr), "i"(OFF) : "memory"); return r; }
#define QK_WAIT(n) do { asm volatile("s_waitcnt lgkmcnt(" #n ")" ::: "memory"); SBAR(); } while (0)
template <int SLOT> __device__ __forceinline__ void qkt2(f32x16& p0, f32x16& p1, const int (&nb)[4], const int (&rb)[4], int qrl, const bf16x8* qr, const f32x16& negm) {
    constexpr int S = SLOT * SHM_K;
    bf16x8 a0, a1, b0, b1, qa, qb;
#define RD_N(s, K0, K1) do { K0 = dsr128<S + ((s) >> 2) * 128>(nb[(s) & 3]); K1 = dsr128<S + ((s) >> 2) * 128 + 8192>(nb[(s) & 3]); } while (0)
#define RD_R(s, K0, K1, Q) do { K0 = dsr128<S + KROPE_OFF>(rb[(s) - 8]); K1 = dsr128<S + KROPE_OFF + 4096>(rb[(s) - 8]); Q = dsr128<((s) - 8) * 1024>(qrl); } while (0)
#define MM(K0, K1, Q) do { p0 = __builtin_amdgcn_mfma_f32_32x32x16_bf16(K0, Q, p0, 0, 0, 0); p1 = __builtin_amdgcn_mfma_f32_32x32x16_bf16(K1, Q, p1, 0, 0, 0); SBAR(); } while (0)
    RD_N(0, a0, a1); RD_N(1, b0, b1);
    QK_WAIT(2); p0 = __builtin_amdgcn_mfma_f32_32x32x16_bf16(a0, qr[0], negm, 0, 0, 0); p1 = __builtin_amdgcn_mfma_f32_32x32x16_bf16(a1, qr[0], negm, 0, 0, 0); SBAR(); RD_N(2, a0, a1);
    QK_WAIT(2); MM(b0, b1, qr[1]); RD_N(3, b0, b1);
    QK_WAIT(2); MM(a0, a1, qr[2]); RD_N(4, a0, a1);
    QK_WAIT(2); MM(b0, b1, qr[3]); RD_N(5, b0, b1);
    QK_WAIT(2); MM(a0, a1, qr[4]); RD_N(6, a0, a1);
    QK_WAIT(2); MM(b0, b1, qr[5]); RD_N(7, b0, b1);
    QK_WAIT(2); MM(a0, a1, qr[6]); RD_R(8, a0, a1, qa);
    QK_WAIT(3); MM(b0, b1, qr[7]); RD_R(9, b0, b1, qb);
    QK_WAIT(3); MM(a0, a1, qa); RD_R(10, a0, a1, qa);
    QK_WAIT(3); MM(b0, b1, qb); RD_R(11, b0, b1, qb);
    QK_WAIT(3); MM(a0, a1, qa);
    QK_WAIT(0); MM(b0, b1, qb);
#undef RD_N
#undef RD_R
#undef MM
}
__device__ __forceinline__ int v_st(int k, int c) { const int kk = (k & ~0xC) | ((k & 4) << 1) | ((k & 8) >> 1); return ((kk >> 3) * 4 + (c >> 5)) * 512 + ((kk & 7) * 32 + (c & 31)) * 2; }
__device__ __forceinline__ int v_rd_base(int lane) { return ((lane & 3) << 3) | (((lane >> 2) & 3) << 6) | (((lane >> 4) & 1) << 5) | (((lane >> 5) & 1) << 8); }
constexpr int v_rd_off(int d0, int ks, int half) { return d0 * 512 + ks * 4096 + half * 2048; }
template <int OFF> __device__ __forceinline__ s16x4 tr_read(int vb) {
    s16x4 r; asm volatile("ds_read_b64_tr_b16 %0, %1 offset:%2" : "=&v"(r) : "v"(vb), "i"(OFF) : "memory"); return r;
}
template <int D0> __device__ __forceinline__ void pv_one(f32x16& od, int vb, bf16x8 pa0, bf16x8 pa1, bf16x8 pa2, bf16x8 pa3) {
    const s16x4 l0 = tr_read<v_rd_off(D0, 0, 0)>(vb), h0 = tr_read<v_rd_off(D0, 0, 1)>(vb), l1 = tr_read<v_rd_off(D0, 1, 0)>(vb), h1 = tr_read<v_rd_off(D0, 1, 1)>(vb);
    const s16x4 l2 = tr_read<v_rd_off(D0, 2, 0)>(vb), h2 = tr_read<v_rd_off(D0, 2, 1)>(vb), l3 = tr_read<v_rd_off(D0, 3, 0)>(vb), h3 = tr_read<v_rd_off(D0, 3, 1)>(vb);
    asm volatile("s_waitcnt lgkmcnt(0)" ::: "memory"); SBAR();
#define PK(L, H) (bf16x8){L[0], L[1], L[2], L[3], H[0], H[1], H[2], H[3]}
    od = __builtin_amdgcn_mfma_f32_32x32x16_bf16(PK(l0, h0), pa0, od, 0, 0, 0);
    od = __builtin_amdgcn_mfma_f32_32x32x16_bf16(PK(l1, h1), pa1, od, 0, 0, 0);
    od = __builtin_amdgcn_mfma_f32_32x32x16_bf16(PK(l2, h2), pa2, od, 0, 0, 0);
    od = __builtin_amdgcn_mfma_f32_32x32x16_bf16(PK(l3, h3), pa3, od, 0, 0, 0);
#undef PK
}
__device__ __forceinline__ void pv_d0(f32x16* o, int vb, bf16x8 pa0, bf16x8 pa1, bf16x8 pa2, bf16x8 pa3) {
    pv_one<0>(o[0], vb, pa0, pa1, pa2, pa3); pv_one<1>(o[1], vb, pa0, pa1, pa2, pa3); pv_one<2>(o[2], vb, pa0, pa1, pa2, pa3); pv_one<3>(o[3], vb, pa0, pa1, pa2, pa3);
}
__device__ __forceinline__ void attn_unit(const bf16* Qb, const bf16* KVb, int hoff, const bf16* KRb, bf16* Ob, int seq, LAS char* lds) {
    int tid = threadIdx.x; asm volatile("" : "+v"(tid));
    const int wid = __builtin_amdgcn_readfirstlane(tid >> 6), lane = tid & 63, r32 = lane & 31, hi = lane >> 5;
    LAS char* V_lds = lds; LAS char* K_lds = lds + OFF_K;
        float m_reg = 0.f, l_reg = 0; f32x16 o[4]; bf16x8 qr[8]; f32x16 negm;
#pragma unroll
    for (int r = 0; r < 16; ++r) negm[r] = 0.f;
#pragma unroll
    for (int d = 0; d < 4; ++d)
#pragma unroll
        for (int r = 0; r < 16; ++r) o[d][r] = 0.f;
    const bf16* Qw = Qb + (long)(wid * QBLK + r32) * LDQ + hi * 8;
#pragma unroll
    for (int d0 = 0; d0 < 8; ++d0) qr[d0] = *(const bf16x8*)(Qw + d0 * 16);
    LAS char* qrl = lds + OFF_QR + wid * 4096 + lane * 16;
#pragma unroll
    for (int d0 = 8; d0 < 12; ++d0) *(LAS bf16x8*)(qrl + (d0 - 8) * 1024) = *(const bf16x8*)(Qw + d0 * 16);
    int kb[4];
#pragma unroll
    for (int i = 0; i < 4; ++i) kb[i] = r32 * 256 + (((2 * i + hi) ^ (r32 & 7)) << 4);
    const int krd = KROPE_OFF - r32 * 128; (void)krd;
    int nbase[4], rbase[4];
#pragma unroll
    for (int i = 0; i < 4; ++i) { nbase[i] = (int)(uintptr_t)K_lds + kb[i]; rbase[i] = nbase[i] - r32 * 128; }
    const int vb0 = (int)(uintptr_t)V_lds + v_rd_base(lane);
    unsigned gk[2], gv[2], gr;
#pragma unroll
    for (int i = 0; i < 2; ++i) { const int s = (wid + 8 * i) * 64 + lane;
        { const int row = s >> 4, lc = (s & 15) ^ (row & 7); gk[i] = (unsigned)(row * (LDK * 2) + lc * 16); }
        { const int st = s >> 5, k = (st >> 2) * 8 + ((s & 31) >> 2), cc = (st & 3) * 32 + (s & 3) * 8; gv[i] = (unsigned)(k * (LDK * 2) + cc * 2); } }
    { const int s = wid * 64 + lane, row = s >> 3, lc = (s & 7) ^ (row & 7); gr = (unsigned)(row * (LDR * 2) + lc * 16); }
    LAS u32x4* dofs = (LAS u32x4*)(lds + OFF_DO + tid * 16); LAS unsigned* dofr = (LAS unsigned*)(lds + OFF_DO + NTHREADS * 16 + tid * 4);
    *dofs = (u32x4){gk[0], gk[1], gv[0], gv[1]}; *dofr = gr;
    const unsigned ldsw = (unsigned)wid * 1024u;
    const __amdgpu_buffer_rsrc_t rkv = __builtin_amdgcn_make_buffer_rsrc((void*)KVb, 0, (int)((size_t)MT * LDK * 2), 0x00020000);
    const __amdgpu_buffer_rsrc_t rkr = __builtin_amdgcn_make_buffer_rsrc((void*)KRb, 0, (int)((size_t)MT * LDR * 2), 0x00020000);
#define DMA_K(t, slot) do { const int ko_ = (t) * (KVBLK * LDK * 2) + hoff, ro_ = (t) * (KVBLK * LDR * 2); const u32x4 of_ = *dofs; const unsigned gr_ = *dofr; \
    __builtin_amdgcn_raw_ptr_buffer_load_lds(rkv, (LAS void*)(K_lds + (slot) * SHM_K + ldsw), 16, (int)of_.x, ko_, 0, 0); \
    __builtin_amdgcn_raw_ptr_buffer_load_lds(rkv, (LAS void*)(K_lds + (slot) * SHM_K + 8192 + ldsw), 16, (int)of_.y, ko_, 0, 0); \
    __builtin_amdgcn_raw_ptr_buffer_load_lds(rkr, (LAS void*)(K_lds + (slot) * SHM_K + KROPE_OFF + ldsw), 16, (int)gr_, ro_, 0, 0); } while (0)
#define DMA_V(t, slot) do { const int vo_ = (t) * (KVBLK * LDK * 2) + hoff + DN * 2; const u32x4 of_ = *dofs; \
    __builtin_amdgcn_raw_ptr_buffer_load_lds(rkv, (LAS void*)(V_lds + (slot) * SHM_V + ldsw), 16, (int)of_.z, vo_, 0, 0); \
    __builtin_amdgcn_raw_ptr_buffer_load_lds(rkv, (LAS void*)(V_lds + (slot) * SHM_V + 8192 + ldsw), 16, (int)of_.w, vo_, 0, 0); } while (0)
#define WAITBAR() asm volatile("s_waitcnt vmcnt(0) lgkmcnt(0)\n\ts_barrier" ::: "memory")
#define RESC(a) do { if (__any((a) < 1.f)) { \
    _Pragma("unroll") for (int d = 0; d < 4; ++d) _Pragma("unroll") for (int r = 0; r < 16; ++r) o[d][r] *= (a); } } while (0)
    f32x16 pA0, pA1, pB0, pB1; float alA, alB; bf16x8 pa0, pa1, pa2, pa3; const int NT = seq / KVBLK;
    if (wid >= 4) __builtin_amdgcn_s_setprio(1);
    DMA_K(0, 0); DMA_V(0, 0); WAITBAR();
    DMA_K(1, 1);
    att::qkt2<0>(pA0, pA1, nbase, rbase, (int)(uintptr_t)qrl, qr, negm); partialSM<true>(pA0, pA1, m_reg, negm, alA);
    WAITBAR();
#ifndef ATT_ALIGN
#define ATT_ALIGN 6
#endif
#ifndef ATT_PAD
#define ATT_PAD 4
#endif
    asm volatile(".p2align %0\n\t.rept %1\n\ts_nop 0\n\t.endr" :: "n"(ATT_ALIGN), "n"(ATT_PAD));
    for (int j = 1; j + 1 < NT; j += 2) {
        DMA_K(j + 1, 0); DMA_V(j, 1);
        SBAR(); att::qkt2<1>(pB0, pB1, nbase, rbase, (int)(uintptr_t)qrl, qr, negm);
        finishSM(pA0, pA1, alA, l_reg, pa0, pa1, pa2, pa3); SBAR();
        pv_d0(o, vb0, pa0, pa1, pa2, pa3); partialSM<false>(pB0, pB1, m_reg, negm, alB);
        RESC(alB); WAITBAR();
        DMA_K(j + 2, 1); DMA_V(j + 1, 0);
        SBAR(); att::qkt2<0>(pA0, pA1, nbase, rbase, (int)(uintptr_t)qrl, qr, negm);
        finishSM(pB0, pB1, alB, l_reg, pa0, pa1, pa2, pa3); SBAR();
        pv_d0(o, vb0 + SHM_V, pa0, pa1, pa2, pa3); partialSM<false>(pA0, pA1, m_reg, negm, alA);
        RESC(alA); WAITBAR();
    }
    DMA_V(NT - 1, 1);
    SBAR(); att::qkt2<1>(pB0, pB1, nbase, rbase, (int)(uintptr_t)qrl, qr, negm);
    finishSM(pA0, pA1, alA, l_reg, pa0, pa1, pa2, pa3); SBAR();
    pv_d0(o, vb0, pa0, pa1, pa2, pa3); partialSM<false>(pB0, pB1, m_reg, negm, alB);
    RESC(alB); WAITBAR();
    finishSM(pB0, pB1, alB, l_reg, pa0, pa1, pa2, pa3); SBAR();
    pv_d0(o, vb0 + SHM_V, pa0, pa1, pa2, pa3);
    const float rli = __builtin_amdgcn_rcpf(l_reg);
    WAITBAR();
    LAS char* stg = lds + wid * 8704 + r32 * 272 + hi * 8;
#pragma unroll
    for (int d0 = 0; d0 < 4; ++d0)
#pragma unroll
        for (int g = 0; g < 4; ++g) { u32x2 w; w.x = cvtpk(o[d0][4 * g] * rli, o[d0][4 * g + 1] * rli); w.y = cvtpk(o[d0][4 * g + 2] * rli, o[d0][4 * g + 3] * rli);
            *(LAS u32x2*)(stg + (32 * d0 + 8 * g) * 2) = w; }
    asm volatile("s_waitcnt lgkmcnt(0)" ::: "memory");
    bf16* Ow = Ob + (long)(wid * QBLK) * LDO;
#pragma unroll
    for (int i = 0; i < 8; ++i) { const int row = i * 4 + (lane >> 4), ch = lane & 15; const u32x4 v = *(const LAS u32x4*)(lds + wid * 8704 + row * 272 + ch * 16); *(u32x4*)(Ow + (long)row * LDO + ch * 8) = v; }
    WAITBAR();
    __builtin_amdgcn_s_setprio(0);
#undef DMA_K
#undef DMA_V
#undef WAITBAR
#undef RESC
}
#undef KSWZ
#undef SBAR
}

#define XB_TMO      128
#define XB_XCNT(j)  (256  + 64 * (j))
#define XB_XSUB(j)  (1280 + 64 * (j))
#define XB_XGEN(j)  (2304 + 64 * (j))
#define XB_TOP      3328
#define XB_TOPGEN   3392
#define XCD_BAR_WORDS 3456
#define XB_SPIN_CAP (1u << 18)
__device__ __forceinline__ unsigned xb_ld(unsigned* p)              { return __hip_atomic_load(p, __ATOMIC_RELAXED, __HIP_MEMORY_SCOPE_AGENT); }
__device__ __forceinline__ unsigned xb_add(unsigned* p, unsigned v) { return __hip_atomic_fetch_add(p, v, __ATOMIC_RELAXED, __HIP_MEMORY_SCOPE_AGENT); }
__device__ __forceinline__ unsigned xb_xcc_id() { return (unsigned)__builtin_amdgcn_s_getreg((3 << 11) | 20) & 0xFu; }
#define XB_SPIN(cond, bar) do { unsigned _sp = 0; while (cond) { __builtin_amdgcn_s_sleep(1); \
    if ((++_sp & 255u) == 0u) { if (xb_ld(&(bar)[XB_TMO])) break; if (_sp > XB_SPIN_CAP) { atomicAdd(&(bar)[XB_TMO], 1u); break; } } } } while (0)
struct XcdBarrier { unsigned* bar; unsigned x; volatile LAS unsigned* st; };
__device__ __forceinline__ XcdBarrier xcd_barrier_post(unsigned* bar, volatile LAS unsigned* st) {
    XcdBarrier b; b.bar = bar; b.x = xb_xcc_id(); b.st = st;
    if (threadIdx.x == 0) (void)xb_add(&bar[XB_XCNT(b.x)], 1u);
    return b;
}
__device__ __forceinline__ void xcd_barrier_complete(unsigned* bar, unsigned x, unsigned& nloc, unsigned& nx) {
    const unsigned G = gridDim.x * gridDim.y * gridDim.z;
    unsigned sum, cnt, mine, sp = 0u;
    for (;;) {
        sum = 0u; cnt = 0u; mine = 0u;
#pragma unroll
        for (unsigned j = 0; j < 16; ++j) { const unsigned c = xb_ld(&bar[XB_XCNT(j)]); sum += c; cnt += (c > 0u) ? 1u : 0u; mine = (j == x) ? c : mine; }
        if (sum == G) break;
        __builtin_amdgcn_s_sleep(1);
        if ((++sp & 255u) == 0u) { if (xb_ld(&bar[XB_TMO])) break; if (sp > XB_SPIN_CAP) { atomicAdd(&bar[XB_TMO], 1u); break; } }
    }
    nloc = mine > 0u ? mine : 1u; nx = cnt > 0u ? cnt : 1u;
}
__device__ __forceinline__ void xcd_barrier(const XcdBarrier& b) {
    asm volatile("s_waitcnt vmcnt(0)" ::: "memory");
    __syncthreads();
    if (threadIdx.x == 0) {
        unsigned* bar = b.bar;
        __builtin_amdgcn_s_waitcnt(0);
        unsigned nloc = b.st[0], nx = b.st[1];
        if (nloc == 0u) { xcd_barrier_complete(bar, b.x, nloc, nx); b.st[0] = nloc; b.st[1] = nx; }
        const unsigned old = xb_add(&bar[XB_XSUB(b.x)], 1u);
        const unsigned gen = old / nloc;
        if (old + 1u == (gen + 1u) * nloc) {
            __builtin_amdgcn_fence(__ATOMIC_RELEASE, "agent");
            asm volatile("s_waitcnt vmcnt(0)" ::: "memory");
            const unsigned og = xb_add(&bar[XB_TOP], 1u);
            const unsigned tg = og / nx;
            if (og + 1u == (tg + 1u) * nx) xb_add(&bar[XB_TOPGEN], 1u);
            else XB_SPIN(xb_ld(&bar[XB_TOPGEN]) == tg, bar);
            __builtin_amdgcn_fence(__ATOMIC_ACQUIRE, "agent");
            xb_add(&bar[XB_XGEN(b.x)], 1u);
            asm volatile("s_waitcnt vmcnt(0)" ::: "memory");
        } else {
            XB_SPIN(xb_ld(&bar[XB_XGEN(b.x)]) == gen, bar);
            __builtin_amdgcn_fence(__ATOMIC_ACQUIRE, "agent");
            asm volatile("s_waitcnt vmcnt(0)" ::: "memory");
        }
    }
    __syncthreads();
}

struct Params { const float* in[25]; float* out; unsigned char* ws; int ph_lo, ph_hi; };
static_assert(sizeof(Params) == 25 * 8 + 8 + 8 + 8, "Params has no padding");
struct Ctx { LAS unsigned char* lds; int tid, lane, wave, vcu, G, bid; };
__device__ __forceinline__ Ctx fresh(const Ctx& c) {
    Ctx f; f.lds = c.lds; int tid = c.tid; asm volatile("" : "+v"(tid)); f.tid = tid; f.lane = tid & 63; f.wave = __builtin_amdgcn_readfirstlane(tid >> 6);
    int vcu = c.vcu, G = c.G, bid = c.bid; asm volatile("" : "+v"(vcu), "+v"(G), "+v"(bid));
    f.vcu = __builtin_amdgcn_readfirstlane(vcu); f.G = __builtin_amdgcn_readfirstlane(G); f.bid = __builtin_amdgcn_readfirstlane(bid); return f; }
__device__ __forceinline__ unsigned char* fresh_ptr(unsigned char* p) { unsigned lo = (unsigned)(unsigned long long)p, hi = (unsigned)((unsigned long long)p >> 32); asm volatile("" : "+v"(lo), "+v"(hi));
    const unsigned long long v = ((unsigned long long)(unsigned)__builtin_amdgcn_readfirstlane((int)hi) << 32) | (unsigned)__builtin_amdgcn_readfirstlane((int)lo); return (unsigned char*)(GAS unsigned char*)v; }

__device__ __forceinline__ int win_dst(int s) {
    if (s < 1024) return s;
    if (s < 1088) { const int j = s - 1024, part = j >> 5, w = j & 31; return 1024 + part * 32 + 2 * (w & 15) + (w >> 4); }
    if (s < 3136) { const int c = s - 1088; return 1280 + 256 * (c >> 7) + (c & 127); }
    if (s < 5184) { return 5376 + (s - 3136); }
    if (s < 7232) { const int c = s - 5184; return 1280 + 256 * (c >> 7) + 128 + (c & 127); }
    if (s < 9280) { return 7424 + (s - 7232); }
    return 9472 + (s - 9280);
}
__device__ __forceinline__ int qb_dst(int n) { const int h = n / DQK, d = n - h * DQK; if (d < DN) return n; const int j = d - DN, part = j >> 5, w = j & 31; return h * DQK + DN + part * 32 + 2 * (w & 15) + (w >> 4); }
__device__ __forceinline__ int map_dst(int mode, int n) {
    switch (mode) { case 1: return win_dst(n); case 2: return qb_dst(n); case 3: return 256 * (n >> 7) + (n & 127); case 4: return 256 * (n >> 7) + 128 + (n & 127); default: return n; }
}
__device__ __forceinline__ void transpose_item(const float* W, int K, int N, bf16* WT, int mode, const float* gk, int item, int lane) {
    const int kblk = K / 64, nb = item / kblk, kb = item - nb * kblk, k0 = 64 * kb + 16 * (lane >> 4), n0 = 64 * nb + 4 * (lane & 15);
    const float* src = W + (size_t)k0 * N + n0;
    f32x4 v[16];
#pragma unroll
    for (int i = 0; i < 16; ++i) v[i] = *(const f32x4*)(src + (size_t)i * N);
    if (gk) {
#pragma unroll
        for (int i = 0; i < 16; ++i) v[i] *= gk[k0 + i]; }
#pragma unroll
    for (int x = 0; x < 4; ++x) { bf16* d = WT + (size_t)map_dst(mode, n0 + x) * K + k0;
        u32x4 lo, hi;
        lo.x = cvtpk(v[0][x], v[1][x]); lo.y = cvtpk(v[2][x], v[3][x]); lo.z = cvtpk(v[4][x], v[5][x]); lo.w = cvtpk(v[6][x], v[7][x]);
        hi.x = cvtpk(v[8][x], v[9][x]); hi.y = cvtpk(v[10][x], v[11][x]); hi.z = cvtpk(v[12][x], v[13][x]); hi.w = cvtpk(v[14][x], v[15][x]);
        *(u32x4*)d = lo; *(u32x4*)(d + 8) = hi; }
}
struct Strip { const float* W; int N, mode, nb; signed char* w8; float* wsc; };
constexpr int ST_IN = DIN / 64, ST_GD = DFF / 64, ST_GE = DFE / 64, N_STRIPS = 2 * ST_IN + 2 * ST_GD + NE * 2 * ST_GE;
__device__ __forceinline__ Strip strip_of(const Params& p, int sid) {
    unsigned char* wb = p.ws + WS_W; float* wsc = (float*)(p.ws + WS_WSC);
    Strip q;
    if (sid < 2 * ST_IN) { const int l = sid / ST_IN; q.nb = sid - l * ST_IN; q.W = p.in[7] + (size_t)l * D * DIN; q.N = DIN; q.mode = 1; q.w8 = (signed char*)(wb + W_IN + l * W_IN_L); q.wsc = wsc + SC_IN + l * NIN; return q; }
    sid -= 2 * ST_IN;
    if (sid < 2 * ST_GD) { const int which = sid / ST_GD; q.nb = sid - which * ST_GD; q.W = p.in[17 + which]; q.N = DFF; q.mode = 3 + which; q.w8 = (signed char*)(wb + W_GU); q.wsc = wsc + SC_GU; return q; }
    sid -= 2 * ST_GD;
    { const int e = sid / (2 * ST_GE); sid -= e * (2 * ST_GE); const int which = sid / ST_GE; q.nb = sid - which * ST_GE; q.W = p.in[21 + which] + (size_t)e * D * DFE; q.N = DFE; q.mode = 3 + which;
      q.w8 = (signed char*)(wb + W_GUE + e * W_GUE_E); q.wsc = wsc + SC_GUE + e * 2 * DFE; return q; }
}
__device__ __forceinline__ unsigned pack4i8(float a, float b, float c, float d) {
    const int ia = (int)__builtin_rintf(a), ib = (int)__builtin_rintf(b), ic = (int)__builtin_rintf(c), id = (int)__builtin_rintf(d);
    return ((unsigned)ia & 0xffu) | (((unsigned)ib & 0xffu) << 8) | (((unsigned)ic & 0xffu) << 16) | ((unsigned)id << 24); }
__device__ __forceinline__ void quant_strip(const Strip& q, const Ctx& c, LAS float* cmax  ) {
    const int qd = c.lane >> 4, c4 = 4 * (c.lane & 15), n0 = 64 * q.nb + c4;
    const float* src = q.W + (size_t)(256 * c.wave + 16 * qd) * q.N + n0;
    f32x4 m = {0.f, 0.f, 0.f, 0.f};
#pragma unroll 1
    for (int sb = 0; sb < 4; ++sb) { f32x4 v[16];
#pragma unroll
        for (int i = 0; i < 16; ++i) v[i] = *(const f32x4*)(src + (size_t)(64 * sb + i) * q.N);
#pragma unroll
        for (int i = 0; i < 16; ++i) m = __builtin_elementwise_max(m, __builtin_elementwise_abs(v[i])); }
#pragma unroll
    for (int x = 0; x < 4; ++x) { float t = m[x]; t = fmaxf(t, __shfl_xor(t, 16)); t = fmaxf(t, __shfl_xor(t, 32)); m[x] = t; }
    if (c.lane < 16) *(LAS f32x4*)(cmax + c.wave * 64 + c4) = m;
    __syncthreads();
    f32x4 am = *(const LAS f32x4*)(cmax + c4);
#pragma unroll
    for (int w = 1; w < 8; ++w) am = __builtin_elementwise_max(am, *(const LAS f32x4*)(cmax + w * 64 + c4));
    f32x4 inv; int dst[4];
#pragma unroll
    for (int x = 0; x < 4; ++x) { inv[x] = am[x] > 0.f ? 127.f / am[x] : 0.f; dst[x] = map_dst(q.mode, n0 + x); }
    if (c.wave == 0 && c.lane < 16) {
#pragma unroll
        for (int x = 0; x < 4; ++x) q.wsc[dst[x]] = am[x] * (1.f / 127.f); }
#pragma unroll 1
    for (int sb = 0; sb < 4; ++sb) { f32x4 v[16];
#pragma unroll
        for (int i = 0; i < 16; ++i) v[i] = *(const f32x4*)(src + (size_t)(64 * sb + i) * q.N);
        const int k0 = 256 * c.wave + 64 * sb + 16 * qd;
#pragma unroll
        for (int x = 0; x < 4; ++x) { const float iv = inv[x];
            u32x4 o; o.x = pack4i8(v[0][x] * iv, v[1][x] * iv, v[2][x] * iv, v[3][x] * iv); o.y = pack4i8(v[4][x] * iv, v[5][x] * iv, v[6][x] * iv, v[7][x] * iv);
            o.z = pack4i8(v[8][x] * iv, v[9][x] * iv, v[10][x] * iv, v[11][x] * iv); o.w = pack4i8(v[12][x] * iv, v[13][x] * iv, v[14][x] * iv, v[15][x] * iv);
            *(u32x4*)(q.w8 + (size_t)dst[x] * D + k0) = o; } }
    __syncthreads();
}
constexpr int I_QB = (QL / 64) * (NH * DQK / 64), I_KVB = (KVL / 64) * (NH * 256 / 64), I_SQ = (D / 64) * (D / 64), I_L = I_QB + I_KVB + 3 * I_SQ;
constexpr int I_DD = (DFF / 64) * (D / 64), I_DE = (DFE / 64) * (D / 64);
constexpr int N_ADA = 2 * KS_ADA * 48, N_SMALL = N_ADA + 2 * I_L + I_DD + NE * I_DE, SMALL_BATCH = 32, N_BATCH = (N_SMALL + SMALL_BATCH - 1) / SMALL_BATCH, N_QUEUE = N_STRIPS + N_BATCH;
__device__ __forceinline__ void small_item(const Params& p, const Ctx& c, int it, const LAS float* sil) {
    unsigned char* ws = p.ws; unsigned char* wb = ws + WS_W;
    if (it < N_ADA) {
        float* part = (float*)(ws + WS_PART); const int cg = it % 48, lk = it / 48, kc = lk % KS_ADA, l = lk / KS_ADA;
        const float* W = p.in[4] + (size_t)l * D * (6 * D) + (size_t)(kc * 128) * (6 * D) + cg * 256 + c.lane * 4;
        float zf = 0.f; asm volatile("" : "+v"(zf)); f32x4 al = {zf, zf, zf, zf}, ac = al;
#pragma unroll 8
        for (int k = 0; k < 128; ++k) { const f32x4 w = *(const f32x4*)(W + (size_t)k * (6 * D)); al += w * sil[kc * 128 + k]; ac += w * sil[D + kc * 128 + k]; }
        *(f32x4*)(part + ((size_t)(l * KS_ADA + kc) * 2 + 0) * (6 * D) + cg * 256 + c.lane * 4) = al;
        *(f32x4*)(part + ((size_t)(l * KS_ADA + kc) * 2 + 1) * (6 * D) + cg * 256 + c.lane * 4) = ac; return; }
    int r = it - N_ADA;
    if (r < 2 * I_L) { const int l = r / I_L; r -= l * I_L;
        if (r < I_QB) { transpose_item(p.in[9] + (size_t)l * QL * NH * DQK, QL, NH * DQK, (bf16*)(wb + W_QB + l * W_QB_L), 2, p.in[8] + l * QL, r, c.lane); return; } r -= I_QB;
        if (r < I_KVB) { transpose_item(p.in[11] + (size_t)l * KVL * NH * 256, KVL, NH * 256, (bf16*)(wb + W_KVB + l * W_KVB_L), 0, p.in[10] + l * KVL, r, c.lane); return; } r -= I_KVB;
        const int which = r / I_SQ; r -= which * I_SQ;
        transpose_item(p.in[13 + which] + (size_t)l * D * D, D, D, (bf16*)(wb + (which == 0 ? W_OA : which == 1 ? W_OB : W_O) + l * W_SQ_L), 0, nullptr, r, c.lane); return; }
    r -= 2 * I_L;
    if (r < I_DD) { transpose_item(p.in[19], DFF, D, (bf16*)(wb + W_DD), 0, nullptr, r, c.lane); return; }
    r -= I_DD;
    { const int e = r / I_DE; r -= e * I_DE; transpose_item(p.in[23] + (size_t)e * DFE * D, DFE, D, (bf16*)(wb + W_DE + e * W_DE_E), 0, nullptr, r, c.lane); }
}
constexpr int CW_QHEAD = 2048;
__device__ __forceinline__ void p0_prologue(const Params& p, const Ctx& c) {
    unsigned char* ws = p.ws; unsigned char* wb = ws + WS_W;
    const int gt = c.vcu * NTHREADS + c.tid, NGT = c.G * NTHREADS;
    LAS float* sil = (LAS float*)(c.lds + 98304);
    LAS float* cmax = (LAS float*)(c.lds + 114688);
    LAS int* qslot = (LAS int*)(c.lds + 116736);
    for (int k = c.tid; k < 2 * D; k += NTHREADS) { const float x = k < D ? p.in[1][k] : p.in[3][k - D]; sil[k] = x / (1.f + expf(-x)); }
    { float* rope = (float*)(ws + WS_ROPE);
      for (int i = gt; i < 2048; i += NGT) { const int pos = i >> 4, k = i & 15; const float ang = (float)pos * powf(10000.f, -(float)(2 * k) / 32.f); rope[i] = cosf(ang); rope[2048 + i] = sinf(ang); } }
    { const int n16 = 192 * D / 16; unsigned zu = 0u; asm volatile("" : "+v"(zu));
      for (int i = gt; i < 2 * n16; i += NGT) { const int l = i / n16, r = i - l * n16; *(u32x4*)(wb + W_IN + l * W_IN_L + (size_t)1088 * D + (size_t)r * 16) = (u32x4){zu, zu, zu, zu}; }
      for (int i = gt; i < 2 * 192; i += NGT) { const int l = i / 192, r = i - l * 192; ((float*)(ws + WS_WSC))[SC_IN + l * NIN + 1088 + r] = __uint_as_float(zu); } }
    __syncthreads();
    unsigned* head = (unsigned*)(ws + WS_CTL) + CW_QHEAD;
    for (;;) {
        if (c.tid == 0) *qslot = (int)__hip_atomic_fetch_add(head, 1u, __ATOMIC_RELAXED, __HIP_MEMORY_SCOPE_AGENT);
        __syncthreads();
        const int id = __builtin_amdgcn_readfirstlane(*qslot);
        __syncthreads();
        if (id >= N_QUEUE) break;
        if (id < N_STRIPS) { quant_strip(strip_of(p, id), c, cmax); continue; }
        const int base = (id - N_STRIPS) * SMALL_BATCH;
#pragma unroll 1
        for (int j = 0; j < SMALL_BATCH / NWAVES; ++j) { const int it = base + j * NWAVES + c.wave; if (it < N_SMALL) small_item(p, c, it, sil); }
    }
}
__device__ __forceinline__ void p1_mod(const Params& p, const Ctx& c) {
    const float* part = (const float*)(p.ws + WS_PART); float* mod = (float*)(p.ws + WS_MOD);
    for (int i = c.vcu * NTHREADS + c.tid; i < 4 * 6 * D; i += c.G * NTHREADS) { const int n = i % (6 * D), lv = i / (6 * D), l = lv >> 1, v = lv & 1;
        float s = p.in[5][l * 6 * D + n];
#pragma unroll
        for (int kc = 0; kc < KS_ADA; ++kc) s += part[((size_t)(l * KS_ADA + kc) * 2 + v) * (6 * D) + n];
        mod[i] = s; }
}
__device__ __forceinline__ void norm_pass(const Params& p, const Ctx& c, int layer, int which, int row_lo, bool moe, bool local_mod) {
    const float* XL = (const float*)(p.ws + WS_XL); unsigned char* HN = p.ws + WS_HN; float* HSC = (float*)(p.ws + WS_HSC); const float* mod = (const float*)(p.ws + WS_MOD);
    const bool from_in = (layer == 0 && which == 0);
    const float* g = (which ? p.in[16] : p.in[6]) + layer * D;
    const int gw = c.vcu * NWAVES + c.wave, NGW = c.G * NWAVES;
    LAS float* lmod = (LAS float*)(c.lds + 65536);
    if (local_mod) { const float* part = (const float*)(p.ws + WS_PART);
#pragma unroll 4
        for (int i = c.tid; i < 4 * D; i += NTHREADS) { const int vec = i / D, v = vec >> 1, n = ((vec & 1) ? D : 0) + (i - vec * D);
            float sacc = p.in[5][layer * 6 * D + n];
#pragma unroll
            for (int kc = 0; kc < KS_ADA; ++kc) sacc += part[((size_t)(layer * KS_ADA + kc) * 2 + v) * (6 * D) + n];
            lmod[i] = sacc; }
        __syncthreads(); }
    LAS float* wrt = (LAS float*)c.lds;
    if (moe) { const float* wr = p.in[20];
#pragma unroll 8
        for (int i = c.tid; i < D * NE / 4; i += NTHREADS) { const f32x4 w = *(const f32x4*)(wr + 4 * i); const int k = i >> 1, e0 = (i & 1) * 4;
            wrt[(e0 + 0) * D + k] = w[0]; wrt[(e0 + 1) * D + k] = w[1]; wrt[(e0 + 2) * D + k] = w[2]; wrt[(e0 + 3) * D + k] = w[3]; }
        __syncthreads(); }
#define CJ(j) ((((j) + c.wave) & 7) * 256)
    f32x4 A[8], S[8]; int cur_type = -1;
    for (int r = row_lo + gw; r < MT; r += NGW) {
        const f32x4* xr = (const f32x4*)(from_in ? (r < LC ? p.in[2] + (size_t)r * D : p.in[0] + (size_t)(r - LC) * D) : XL + (size_t)r * D) + c.lane;
        const int type = r < LC ? 1 : 0;
        if (type != cur_type) { cur_type = type;
            const float* mv = mod + (size_t)(layer * 2 + type) * (6 * D) + (which ? 3 * D : 0);
#pragma unroll
            for (int j = 0; j < 8; ++j) { const int col = 4 * c.lane + CJ(j);
                const f32x4 gv = *(const f32x4*)(g + col);
                const f32x4 sh = local_mod ? *(const LAS f32x4*)(lmod + (type ? 2 * D : 0) + col) : *(const f32x4*)(mv + col), sc = local_mod ? *(const LAS f32x4*)(lmod + (type ? 3 * D : D) + col) : *(const f32x4*)(mv + D + col);
                A[j] = gv * (sc + 1.f); S[j] = sh; } }
        f32x4 v[8]; float ss = 0.f;
#pragma unroll
        for (int j = 0; j < 8; ++j) { v[j] = xr[CJ(j) / 4]; ss += (v[j][0] * v[j][0] + v[j][1] * v[j][1]) + (v[j][2] * v[j][2] + v[j][3] * v[j][3]); }
        const float rs = rsqrtf(wave_sum(ss) * (1.f / D) + EPS);
        float amax = 0.f;
#pragma unroll
        for (int j = 0; j < 8; ++j) {
            v[j] = (v[j] * rs) * A[j] + S[j];
            amax = fmaxf(fmaxf(amax, fmaxf(fabsf(v[j][0]), fabsf(v[j][1]))), fmaxf(fabsf(v[j][2]), fabsf(v[j][3]))); }
#pragma unroll
        for (int o = 1; o < 64; o <<= 1) amax = fmaxf(amax, __shfl_xor(amax, o));
        const float inv = amax > 0.f ? 127.f / amax : 0.f;
        unsigned* o4 = (unsigned*)(HN + (size_t)r * D) + c.lane;
#pragma unroll
        for (int j = 0; j < 8; ++j) o4[CJ(j) / 4] = pack4i8(v[j][0] * inv, v[j][1] * inv, v[j][2] * inv, v[j][3] * inv);
        if (c.lane == 0) HSC[r] = amax * (1.f / 127.f);
        if (moe) {
            float lg[NE];
#pragma unroll
            for (int e = 0; e < NE; ++e) { float a = 0.f;
#pragma unroll
                for (int j = 0; j < 8; ++j) { const f32x4 w = *(const LAS f32x4*)(wrt + e * D + 4 * c.lane + CJ(j)); a += (v[j][0] * w[0] + v[j][1] * w[1]) + (v[j][2] * w[2] + v[j][3] * w[3]); }
                lg[e] = a; }
#pragma unroll
            for (int e = 0; e < NE; ++e) lg[e] = wave_sum(lg[e]);
            int e0 = 0; float m0 = lg[0];
#pragma unroll
            for (int e = 1; e < NE; ++e) if (lg[e] > m0) { m0 = lg[e]; e0 = e; }
            int e1 = -1; float m1 = -3.0e38f;
#pragma unroll
            for (int e = 0; e < NE; ++e) if (e != e0 && lg[e] > m1) { m1 = lg[e]; e1 = e; }
            if (c.lane == 0) { const int t = r - LC; const float b = expf(m1 - m0), inv = 1.f / (1.f + b);
                int* sel = (int*)(p.ws + WS_SEL); float* gwt = (float*)(p.ws + WS_GW);
                sel[2 * t] = e0; sel[2 * t + 1] = e1; gwt[2 * t] = inv; gwt[2 * t + 1] = b * inv; }
        }
    }
#undef CJ
}
__device__ __forceinline__ void conv_pass(const Params& p, const Ctx& c, int layer, int row_lo) {
    const bf16* U = (const bf16*)(p.ws + WS_MIX + MX_U); const bf16* CBp = (const bf16*)(p.ws + WS_MIX + MX_CB); bf16* V2 = (bf16*)(p.ws + WS_MIX + MX_V2);
    const float* wc = p.in[12] + (size_t)layer * 3 * CW;
    const int gw = c.vcu * NWAVES + c.wave, NGW = c.G * NWAVES, nitems = ((MT - row_lo) / 16) * 4;
    for (int it = gw; it < nitems; it += NGW) {
        const int q = it & 3, r0 = row_lo + (it >> 2) * 16, ch = q * 512 + c.lane * 8;
        const int lo = r0 < LC ? 0 : LC, hi = r0 < LC ? LC : MT;
        const f32x4 w0a = *(const f32x4*)(wc + ch), w0b = *(const f32x4*)(wc + ch + 4), w1a = *(const f32x4*)(wc + CW + ch), w1b = *(const f32x4*)(wc + CW + ch + 4), w2a = *(const f32x4*)(wc + 2 * CW + ch), w2b = *(const f32x4*)(wc + 2 * CW + ch + 4);
        unsigned zu = 0u; asm volatile("" : "+v"(zu)); const u32x4 zq = {zu, zu, zu, zu};
        u32x4 ur[18], gr[16];
#pragma unroll
        for (int i = 0; i < 18; ++i) { const int r = r0 - 1 + i; ur[i] = (r >= lo && r < hi) ? *(const u32x4*)(U + (size_t)r * CW + ch) : zq; }
#pragma unroll
        for (int i = 0; i < 16; ++i) gr[i] = *(const u32x4*)(CBp + (size_t)(r0 + i) * CW + ch);
#pragma unroll
        for (int i = 0; i < 16; ++i) { f32x4 pa, pb, ca, cb, na, nb, ga, gb;
            unpack8(ur[i], pa, pb); unpack8(ur[i + 1], ca, cb); unpack8(ur[i + 2], na, nb); unpack8(gr[i], ga, gb);
            const f32x4 ya = ga * (w0a * pa + w1a * ca + w2a * na), yb = gb * (w0b * pb + w1b * cb + w2b * nb);
            *(u32x4*)(V2 + (size_t)(r0 + i) * CW + ch) = pack8(ya, yb); }
    }
}
__device__ __forceinline__ void moe_counts(const Params& p, const Ctx& c) {
    const int* sel = (const int*)(p.ws + WS_SEL);
    LAS int* H = (LAS int*)c.lds;
    LAS int* tot = (LAS int*)(c.lds + 16384);
    LAS int* lctl = (LAS int*)(c.lds + LCTL_OFF);
    { int h[NE];
#pragma unroll
      for (int e = 0; e < NE; ++e) h[e] = 0;
#pragma unroll
      for (int i = 0; i < 8; ++i) { const int4 v = *(const int4*)(sel + c.tid * 32 + i * 4);
#pragma unroll
          for (int e = 0; e < NE; ++e) h[e] += (v.x == e) + (v.y == e) + (v.z == e) + (v.w == e); }
#pragma unroll
      for (int e = 0; e < NE; ++e) H[c.tid * 8 + e] = h[e]; }
    __syncthreads();
    { int s = 0;
#pragma unroll
      for (int i = 0; i < 8; ++i) s += H[(c.lane * 8 + i) * 8 + c.wave];
#pragma unroll
      for (int o = 1; o < 64; o <<= 1) s += __shfl_xor(s, o);
      if (c.lane == 0) tot[c.wave] = s; }
    __syncthreads();
    if (c.tid == 0) { int off = 0;
#pragma unroll
        for (int e = 0; e < NE; ++e) { lctl[128 + e] = off; off += (tot[e] + 255) >> 8; }
        lctl[128 + NE] = off; lctl[16] = off;
        int M = 0, nrt = 0, rb = 0;
        for (int e = 0; e < NE; ++e) { const int cnt = tot[e], first = lctl[128 + e], nf = cnt >> 8;
            for (int t = 0; t < nf; ++t) lctl[176 + M++] = first + t;
            lctl[288 + e] = cnt & 255; }
        for (int it = 0; it < NE && M < 64; ++it) { int be = -1, bv = 0;
            for (int e = 0; e < NE; ++e) { const int v = lctl[288 + e]; if (v > bv) { bv = v; be = e; } }
            if (be < 0) break;
            lctl[176 + M++] = lctl[128 + be] + (tot[be] >> 8); lctl[288 + be] = 0; }
        for (int e = 0; e < NE; ++e) { const int v = lctl[288 + e]; if (v > 0) { lctl[256 + nrt] = lctl[128 + e] + (tot[e] >> 8); lctl[272 + nrt] = rb; rb += (v + 31) >> 5; ++nrt; } }
        lctl[272 + nrt] = rb; lctl[17] = M; lctl[18] = rb; lctl[19] = nrt; }
    __syncthreads();
    if (c.tid < MAXT) { int e = 0;
#pragma unroll
        for (int x = 1; x < NE; ++x) e += (c.tid >= lctl[128 + x]) ? 1 : 0;
        lctl[32 + c.tid] = e; }
    __syncthreads();
}
__device__ __forceinline__ void moe_route(const Params& p, const Ctx& c) {
    const int* sel = (const int*)(p.ws + WS_SEL); int* slot = (int*)(p.ws + WS_SLOT);
    const unsigned char* HN = p.ws + WS_HN; unsigned char* XS = p.ws + WS_MIX + FX_XS; const float* HSC = (const float*)(p.ws + WS_HSC); float* XSC = (float*)(p.ws + WS_XSC);
    LAS int* H = (LAS int*)c.lds; LAS int* tot = (LAS int*)(c.lds + 16384); LAS int* lctl = (LAS int*)(c.lds + LCTL_OFF);
    for (int b = c.bid; b < 2 * SEQ / 64; b += c.G) {
        { int s = 0;
#pragma unroll
          for (int i = 0; i < 8; ++i) { const int t = c.lane * 8 + i; s += (t < 2 * b) ? H[t * 8 + c.wave] : 0; }
#pragma unroll
          for (int o = 1; o < 64; o <<= 1) s += __shfl_xor(s, o);
          if (c.lane == 0) tot[8 + c.wave] = s; }
        __syncthreads();
        if (c.wave == 0) { const int a = 64 * b + c.lane, e = sel[a]; int rank = 0;
#pragma unroll
            for (int x = 0; x < NE; ++x) { const unsigned long long m = __ballot(e == x); if (e == x) rank = tot[8 + x] + __popcll(m & ((1ull << c.lane) - 1ull)); }
            const int s = 256 * lctl[128 + e] + rank; slot[a] = s; tot[16 + c.lane] = s; }
        __syncthreads();
        { u32x4 v0[8], v1[8]; float sc[8]; int ss[8];
#pragma unroll
          for (int i = 0; i < 8; ++i) { const int j = c.wave * 8 + i, a = 64 * b + j, tok = a >> 1; ss[i] = tot[16 + j];
              const u32x4* src = (const u32x4*)(HN + (size_t)(LC + tok) * D) + c.lane; v0[i] = src[0]; v1[i] = src[64]; sc[i] = HSC[LC + tok]; }
#pragma unroll
          for (int i = 0; i < 8; ++i) { u32x4* dst = (u32x4*)(XS + (size_t)ss[i] * D) + c.lane; dst[0] = v0[i]; dst[64] = v1[i]; if (c.lane == 0) XSC[ss[i]] = sc[i]; } }
        __syncthreads();
    }
}
__device__ __forceinline__ void final_pass(const Params& p, const Ctx& c) {
    const float* XL = (const float*)(p.ws + WS_XL); const bf16* YS = (const bf16*)(p.ws + WS_MIX + FX_YS);
    const int* slot = (const int*)(p.ws + WS_SLOT); const float* gwt = (const float*)(p.ws + WS_GW);
    const float* gt2 = (const float*)(p.ws + WS_MOD) + (size_t)2 * (6 * D) + 5 * D; const float* gf = p.in[24];
    const int gw = c.vcu * NWAVES + c.wave, NGW = c.G * NWAVES;
#define CJ(j) ((((j) + c.wave) & 7) * 64)
    f32x4 G2[8], GF[8];
#pragma unroll
    for (int j = 0; j < 8; ++j) { G2[j] = *(const f32x4*)(gt2 + 4 * c.lane + 4 * CJ(j)); GF[j] = *(const f32x4*)(gf + 4 * c.lane + 4 * CJ(j)); }
    int s0n = 0, s1n = 0; float g0n = 0.f, g1n = 0.f;
    if (gw < SEQ) { s0n = slot[2 * gw]; s1n = slot[2 * gw + 1]; g0n = gwt[2 * gw]; g1n = gwt[2 * gw + 1]; }
    for (int t = gw; t < SEQ; t += NGW) {
        const int s0 = s0n, s1 = s1n; const float g0 = g0n, g1 = g1n;
        if (t + NGW < SEQ) { const int tn = t + NGW; s0n = slot[2 * tn]; s1n = slot[2 * tn + 1]; g0n = gwt[2 * tn]; g1n = gwt[2 * tn + 1]; }
        const f32x4* xr = (const f32x4*)(XL + (size_t)(LC + t) * D) + c.lane;
        const u32x2* y0 = (const u32x2*)(YS + (size_t)s0 * D) + c.lane; const u32x2* y1 = (const u32x2*)(YS + (size_t)s1 * D) + c.lane;
        f32x4 xv[8]; u32x2 ya[8], yb[8];
#pragma unroll
        for (int j = 0; j < 8; ++j) { xv[j] = xr[CJ(j)]; ya[j] = y0[CJ(j)]; yb[j] = y1[CJ(j)]; }
        __builtin_amdgcn_sched_barrier(0);
        f32x4 v[8]; float ss = 0.f;
#pragma unroll
        for (int j = 0; j < 8; ++j) {
            v[j] = xv[j] + G2[j] * (unpack4(ya[j]) * g0 + unpack4(yb[j]) * g1);
            ss += (v[j][0] * v[j][0] + v[j][1] * v[j][1]) + (v[j][2] * v[j][2] + v[j][3] * v[j][3]); }
        const float rs = rsqrtf(wave_sum(ss) * (1.f / D) + EPS);
        f32x4* o = (f32x4*)(p.out + (size_t)t * D) + c.lane;
#pragma unroll
        for (int j = 0; j < 8; ++j) o[CJ(j)] = v[j] * rs * GF[j];
    }
#undef CJ
}


template <class Items, class Epi>
__device__ __forceinline__ void small_gemm(const Ctx& c, int n_items, const Items& I, int lda, int ldb, int K, const Epi& E) {
    int tid = c.tid; asm volatile("" : "+v"(tid));
    const int lane = tid & 63, wid = __builtin_amdgcn_readfirstlane(tid >> 6), fr = lane & 15, fq = lane >> 4, wr = wid >> 2, wc = wid & 3;
    constexpr int STG = 24576, NSTG = 4;
    const int nk = K / 128;
    for (int j = c.vcu; j < n_items; j += c.G) {
        const bf16* Ab; const bf16* Bb; int mb, nb; I(j, Ab, Bb, mb, nb);
        const int sA = wid * 64 + lane, rA = sA >> 4, cA = (sA & 15) ^ (rA & 15);
        const bf16* gA = Ab + (size_t)rA * lda + cA * 8;
        const bf16* gB0 = Bb + (size_t)rA * ldb + cA * 8;
        const bf16* gB1 = gB0 + (size_t)32 * ldb;
        LAS unsigned char* lw = c.lds + wid * 1024;
#define CG_STAGE(t) do { const int kk_ = ((t) < nk ? (t) : nk - 1) * 128; LAS unsigned char* d_ = lw + ((t) & (NSTG - 1)) * STG; \
        __builtin_amdgcn_global_load_lds((const unsigned*)(gA + kk_), (LAS unsigned*)(d_), 16, 0, 0); \
        __builtin_amdgcn_global_load_lds((const unsigned*)(gB0 + kk_), (LAS unsigned*)(d_ + 8192), 16, 0, 0); \
        __builtin_amdgcn_global_load_lds((const unsigned*)(gB1 + kk_), (LAS unsigned*)(d_ + 16384), 16, 0, 0); } while (0)
        CG_STAGE(0); CG_STAGE(1); CG_STAGE(2);
        const int ra = (wr * 16 + fr) * 256, rb = 8192 + (wc * 16 + fr) * 256;
        float zf = 0.f; asm volatile("" : "+v"(zf));
        f32x4 acc0 = {zf, zf, zf, zf}, acc1 = acc0;
#pragma unroll 1
        for (int t = 0; t < nk; ++t) {
            asm volatile("s_waitcnt vmcnt(6)\n\ts_barrier" ::: "memory");
            CG_STAGE(t + 3);
            const LAS unsigned char* sb = c.lds + (t & (NSTG - 1)) * STG;
            bf16x8 af[4], bf[4];
#pragma unroll
            for (int ks = 0; ks < 4; ++ks) { const int pc = ((4 * ks + fq) ^ fr) * 16; af[ks] = *(const LAS bf16x8*)(sb + ra + pc); bf[ks] = *(const LAS bf16x8*)(sb + rb + pc); }
            acc0 = __builtin_amdgcn_mfma_f32_16x16x32_bf16(bf[0], af[0], acc0, 0, 0, 0);
            acc1 = __builtin_amdgcn_mfma_f32_16x16x32_bf16(bf[1], af[1], acc1, 0, 0, 0);
            acc0 = __builtin_amdgcn_mfma_f32_16x16x32_bf16(bf[2], af[2], acc0, 0, 0, 0);
            acc1 = __builtin_amdgcn_mfma_f32_16x16x32_bf16(bf[3], af[3], acc1, 0, 0, 0);
        }
#undef CG_STAGE
        asm volatile("s_waitcnt vmcnt(0)\n\ts_barrier" ::: "memory");
        E(mb + wr * 16 + fr, nb + wc * 16 + 4 * fq, acc0 + acc1);
    }
}
struct CtxItems { const bf16* A; const bf16* Bt; int lda, ldb;
    __device__ __forceinline__ void operator()(int j, const bf16*& Ab, const bf16*& Bb, int& mb, int& nb) const { mb = (j >> 5) * 32; nb = (j & 31) * 64; Ab = A + (size_t)mb * lda; Bb = Bt + (size_t)nb * ldb; } };
template <class Epi>
__device__ __forceinline__ void ctx_gemm(const Ctx& c, const bf16* A, int lda, const bf16* Bt, int ldb, int K, const Epi& E) { small_gemm(c, 256, CtxItems{A, Bt, lda, ldb}, lda, ldb, K, E); }
struct MoeTailItems { const bf16* A; const bf16* W; size_t estride; const LAS int* lctl;
    __device__ __forceinline__ void operator()(int j, const bf16*& Ab, const bf16*& Bb, int& mb, int& nb) const {
        const int q = j >> 5, nrt = lctl[19]; int k = 0;
#pragma unroll
        for (int x = 1; x < NE; ++x) k += (x < nrt && q >= lctl[272 + x]) ? 1 : 0;
        k = __builtin_amdgcn_readfirstlane(k);
        const int tile = __builtin_amdgcn_readfirstlane(lctl[256 + k]), rb = q - __builtin_amdgcn_readfirstlane(lctl[272 + k]), e = __builtin_amdgcn_readfirstlane(lctl[32 + tile]);
        mb = tile * 256 + rb * 32; nb = (j & 31) * 64; Ab = A + (size_t)mb * DFE; Bb = W + (size_t)e * estride + (size_t)nb * DFE; } };
struct CtxStoreBf16 { bf16* OUT; int ld;
    __device__ __forceinline__ void operator()(int row, int col, f32x4 acc) const { u32x2 w; w.x = cvtpk(acc[0], acc[1]); w.y = cvtpk(acc[2], acc[3]); *(u32x2*)(OUT + (size_t)row * ld + col) = w; } };
template <int MODE> struct CtxMerge { const bf16* SG; const bf16* M1; bf16* OUT;
    __device__ __forceinline__ void operator()(int row, int col, f32x4 acc) const { const size_t off = (size_t)row * D + col;
        f32x4 v = acc * unpack4(*(const u32x2*)(SG + off)); if (MODE == 1) v += unpack4(*(const u32x2*)(M1 + off));
        u32x2 w; w.x = cvtpk(v[0], v[1]); w.y = cvtpk(v[2], v[3]); *(u32x2*)(OUT + off) = w; } };
struct CtxResid { float* XL; const float* SRC; const float* gate;
    __device__ __forceinline__ void operator()(int row, int col, f32x4 acc) const { const size_t o = (size_t)row * D + col; *(f32x4*)(XL + o) = *(const f32x4*)(SRC + o) + *(const f32x4*)(gate + col) * acc; } };

constexpr int N_PHASES = 22;
__global__ void __launch_bounds__(NTHREADS, 2) mega(Params p) {
    extern __shared__ __attribute__((aligned(16))) unsigned char lds_raw[];
    Ctx c0; c0.lds = (LAS unsigned char*)lds_raw; c0.tid = threadIdx.x; c0.lane = c0.tid & 63; c0.wave = __builtin_amdgcn_readfirstlane(c0.tid >> 6);
    c0.G = gridDim.x; c0.bid = blockIdx.x; c0.vcu = (c0.G % 8 == 0) ? (c0.bid % 8) * (c0.G / 8) + c0.bid / 8 : c0.bid;
    { const Ctx& c = c0; unsigned char* ws = p.ws;
    for (int u = c.tid; u < (LDS_BYTES - LCTL_OFF) / 4; u += NTHREADS) ((LAS unsigned*)(c.lds + LCTL_OFF))[u] = 0u;
    __syncthreads();
    }
    XcdBarrier bar = xcd_barrier_post((unsigned*)(p.ws + WS_CTL) + 4096, (volatile LAS unsigned*)(c0.lds + LCTL_OFF));
    const int lo = p.ph_lo, hi = p.ph_hi;
#ifndef MK_EN
#define MK_EN 0xFFFFFF
#endif
#define EN(j) (((MK_EN) >> (j)) & 1)
#ifndef MK_DUP
#define MK_DUP 0
#endif
#define NREP(j) ((((MK_DUP) >> (j)) & 1) ? 2 : 1)
#define IN(k) (lo <= (k) && (k) < hi)
#define SEAM(k) do { if (IN(k) && IN((k) + 1)) xcd_barrier(bar); } while (0)
#define PH_BEGIN const Ctx c = fresh(c0); unsigned char* ws = fresh_ptr(p.ws); unsigned char* wb = ws + WS_W; unsigned char* mx = ws + WS_MIX; const float* mod = (const float*)(ws + WS_MOD); (void)wb; (void)mx; (void)mod;
    for (int rep_ = 0; rep_ < NREP(20); ++rep_) if (EN(20) && IN(0)) { if (rep_) { xcd_barrier(bar); if (c0.bid == 0 && c0.tid == 0) __hip_atomic_store((unsigned*)(p.ws + WS_CTL) + CW_QHEAD, 0u, __ATOMIC_RELAXED, __HIP_MEMORY_SCOPE_AGENT); xcd_barrier(bar); } PH_BEGIN p0_prologue(p, c); } SEAM(0);
#if defined(MK_XBAR)
    for (int xb_ = 0; xb_ < 16; ++xb_) xcd_barrier(bar);
#endif
#pragma unroll
    for (int layer = 0; layer < DEPTH; ++layer) {
        const int P = 2 + 9 * layer; const bool last = (layer == DEPTH - 1);
        const int pm0 = last ? 1 : 0, nM = last ? 32 : 33;
        for (int rep_ = 0; rep_ < NREP(0); ++rep_) if (EN(0) && IN(P + 0)) { if (rep_) xcd_barrier(bar); PH_BEGIN if (layer == 0) p1_mod(p, c); norm_pass(p, c, layer, 0, 0, false, layer == 0); } SEAM(P + 0);
        for (int rep_ = 0; rep_ < NREP(1); ++rep_) if (EN(1) && IN(P + 1)) { if (rep_) xcd_barrier(bar); PH_BEGIN
            pg8::Geo g{D / 2, D / 2, D / 2};
            pg8::TileOrder S{nM, NT_IN, pm0, c.G, c.bid, last ? 3 : 0, 0, 2, (const char*)(ws + WS_HN), (const char*)(wb + W_IN + layer * W_IN_L), (size_t)256 * D, (size_t)256 * D, (const float*)(ws + WS_HSC), (const float*)(ws + WS_WSC) + SC_IN + layer * NIN};
            pg8::EpiInproj E{(bf16*)(mx + MX_QC), (bf16*)(mx + MX_KRB), (bf16*)(mx + MX_U), (bf16*)(mx + MX_CB), (float*)(mx + MX_SSQ), (const float*)(ws + WS_ROPE)};
            pg8::gemm_phase<pg8::EpiInproj, pg8::TileOrder, true, true>(c.lds, g, S, E);
        } SEAM(P + 1);
        for (int rep_ = 0; rep_ < NREP(2); ++rep_) if (EN(2) && IN(P + 2)) { if (rep_) xcd_barrier(bar); PH_BEGIN
            pg8::Geo g{1024, 512, 512};
            pg8::QkvOrder S{33, nM, pm0, c.G, c.bid, (const char*)(mx + MX_QC), (const char*)(wb + W_QB + layer * W_QB_L), (long)(W_KVB + layer * W_KVB_L) - (long)(W_QB + layer * W_QB_L)};
            pg8::EpiQkv E{(bf16*)(mx + MX_Q), (bf16*)(mx + MX_KV), (const float*)(mx + MX_SSQ), (const float*)(ws + WS_ROPE)};
            pg8::gemm_phase<pg8::EpiQkv, pg8::QkvOrder, true>(c.lds, g, S, E);
            conv_pass(p, c, layer, pm0 * 256);
        } SEAM(P + 2);
        for (int rep_ = 0; rep_ < NREP(3); ++rep_) if (EN(3) && IN(P + 3)) { if (rep_) xcd_barrier(bar); PH_BEGIN
            const bf16* Q = (const bf16*)(mx + MX_Q); const bf16* KV = (const bf16*)(mx + MX_KV); const bf16* KR = (const bf16*)(mx + MX_KRB); bf16* O = (bf16*)(mx + MX_O);
            for (int i = 0;; ++i) { const int u = i * c.G + c.vcu; if (u >= NH * 32) break;
                const int h = u >> 5, q0 = LC + 256 * (u & 31);
                att::attn_unit(Q + (size_t)q0 * att::LDQ + h * DQK, KV, h * 512, KR, O + (size_t)q0 * D + h * DV, MT, (LAS char*)c.lds); }
            if (!last) for (int i = 0;; ++i) { const int h = i * c.G + c.vcu; if (h >= NH) break;
                att::attn_unit(Q + h * DQK, KV, h * 512, KR, O + h * DV, LC, (LAS char*)c.lds); }
            pg8::Geo g{D, D, D};
            pg8::TileOrder S{32, 8, 1, c.G, c.bid, 0, 0, 0, (const char*)(mx + MX_V2), (const char*)(wb + W_OB + layer * W_SQ_L), (size_t)256 * D * 2, (size_t)256 * D * 2, nullptr, nullptr};
            pg8::EpiMerge<0> E{(const bf16*)(mx + MX_SGB), nullptr, (bf16*)(mx + MX_M1)};
            pg8::gemm_phase<pg8::EpiMerge<0>, pg8::TileOrder, true>(c.lds, g, S, E);
            if (!last) ctx_gemm(c, (const bf16*)(mx + MX_V2), D, (const bf16*)(wb + W_OB + layer * W_SQ_L), D, D, CtxMerge<0>{(const bf16*)(mx + MX_SGB), nullptr, (bf16*)(mx + MX_M1)});
        } SEAM(P + 3);
        for (int rep_ = 0; rep_ < NREP(4); ++rep_) if (EN(4) && IN(P + 4)) { if (rep_) xcd_barrier(bar); PH_BEGIN
            pg8::Geo g{D, D, D};
            pg8::TileOrder S{32, 8, 1, c.G, c.bid, 0, 0, 0, (const char*)(mx + MX_O), (const char*)(wb + W_OA + layer * W_SQ_L), (size_t)256 * D * 2, (size_t)256 * D * 2, nullptr, nullptr};
            pg8::EpiMerge<1> E{(const bf16*)(mx + MX_SGA), (const bf16*)(mx + MX_M1), (bf16*)(mx + MX_MG)};
            pg8::gemm_phase<pg8::EpiMerge<1>, pg8::TileOrder, true>(c.lds, g, S, E);
            if (!last) ctx_gemm(c, (const bf16*)(mx + MX_O), D, (const bf16*)(wb + W_OA + layer * W_SQ_L), D, D, CtxMerge<1>{(const bf16*)(mx + MX_SGA), (const bf16*)(mx + MX_M1), (bf16*)(mx + MX_MG)});
        } SEAM(P + 4);
        for (int rep_ = 0; rep_ < 1; ++rep_) if (EN(5) && IN(P + 5)) { PH_BEGIN
            pg8::Geo g{D, D, D};
            pg8::TileOrder S{32, 8, 1, c.G, c.bid, 0, 0, 0, (const char*)(mx + MX_MG), (const char*)(wb + W_O + layer * W_SQ_L), (size_t)256 * D * 2, (size_t)256 * D * 2, nullptr, nullptr};
            pg8::EpiResid E{(float*)(ws + WS_XL), layer == 0 ? p.in[0] - (size_t)LC * D : (const float*)(ws + WS_XL), mod + (size_t)(2 * layer) * (6 * D) + 2 * D};
            pg8::gemm_phase<pg8::EpiResid, pg8::TileOrder, true>(c.lds, g, S, E);
            if (!last) ctx_gemm(c, (const bf16*)(mx + MX_MG), D, (const bf16*)(wb + W_O + layer * W_SQ_L), D, D, CtxResid{(float*)(ws + WS_XL), p.in[2], mod + (size_t)(2 * layer + 1) * (6 * D) + 2 * D});
        } SEAM(P + 5);
        for (int rep_ = 0; rep_ < NREP(6); ++rep_) if (EN(6) && IN(P + 6)) { if (rep_) xcd_barrier(bar); PH_BEGIN norm_pass(p, c, layer, 1, pm0 * 256, last, false); } SEAM(P + 6);
        if (!last) {
            for (int rep_ = 0; rep_ < NREP(7); ++rep_) if (EN(7) && IN(P + 7)) { if (rep_) xcd_barrier(bar); PH_BEGIN
                pg8::Geo g{D / 2, D / 2, D / 2};
                pg8::TileOrder S{nM, 2 * DFF / 256, pm0, c.G, c.bid, 0, 0, 0, (const char*)(ws + WS_HN), (const char*)(wb + W_GU), (size_t)256 * D, (size_t)256 * D, (const float*)(ws + WS_HSC), (const float*)(ws + WS_WSC) + SC_GU};
                pg8::EpiSwiglu E{(bf16*)(mx + FX_ACT), DFF};
                pg8::gemm_phase<pg8::EpiSwiglu, pg8::TileOrder, true, true>(c.lds, g, S, E);
            } SEAM(P + 7);
            for (int rep_ = 0; rep_ < 1; ++rep_) if (EN(8) && IN(P + 8)) { PH_BEGIN
                pg8::Geo g{DFF, DFF, DFF};
                pg8::TileOrder S{32, 8, 1, c.G, c.bid, 0, 0, 0, (const char*)(mx + FX_ACT), (const char*)(wb + W_DD), (size_t)256 * DFF * 2, (size_t)256 * DFF * 2, nullptr, nullptr};
                pg8::EpiResid E{(float*)(ws + WS_XL), (const float*)(ws + WS_XL), mod + (size_t)(2 * layer) * (6 * D) + 5 * D};
                pg8::gemm_phase<pg8::EpiResid, pg8::TileOrder, true>(c.lds, g, S, E);
                ctx_gemm(c, (const bf16*)(mx + FX_ACT), DFF, (const bf16*)(wb + W_DD), DFF, DFF, CtxResid{(float*)(ws + WS_XL), (const float*)(ws + WS_XL), mod + (size_t)(2 * layer + 1) * (6 * D) + 5 * D});
            } SEAM(P + 8);
        } else {
            const LAS int* lctl = (const LAS int*)(c0.lds + LCTL_OFF);
            for (int rep_ = 0; rep_ < NREP(7); ++rep_) if (EN(7) && IN(P + 7)) { if (rep_) xcd_barrier(bar); PH_BEGIN moe_counts(p, c); moe_route(p, c); } SEAM(P + 7);
            for (int rep_ = 0; rep_ < NREP(8); ++rep_) if (EN(8) && IN(P + 8)) { if (rep_) xcd_barrier(bar); PH_BEGIN
                if (!IN(P + 7)) moe_counts(p, c);
                const int T = __builtin_amdgcn_readfirstlane(lctl[16]);
                pg8::Geo g{D / 2, D / 2, D / 2};
                pg8::MoeOrder S{T, 2 * DFE / 256, c.G, c.bid, (const char*)(mx + FX_XS), (const char*)(wb + W_GUE), (size_t)256 * D, (size_t)256 * D, W_GUE_E, lctl + 32, (const float*)(ws + WS_XSC), (const float*)(ws + WS_WSC) + SC_GUE, 2 * DFE, nullptr};
                pg8::EpiSwiglu E{(bf16*)(mx + FX_ACTE), DFE};
                pg8::gemm_phase<pg8::EpiSwiglu, pg8::MoeOrder, true, true>(c.lds, g, S, E);
            } SEAM(P + 8);
            for (int rep_ = 0; rep_ < NREP(9); ++rep_) if (EN(9) && IN(P + 9)) { if (rep_) xcd_barrier(bar); PH_BEGIN
                if (!IN(P + 7)) moe_counts(p, c);
                const int M = __builtin_amdgcn_readfirstlane(lctl[17]), NRB = __builtin_amdgcn_readfirstlane(lctl[18]);
                pg8::Geo g{DFE, DFE, DFE};
                pg8::MoeOrder S{M, 8, c.G, c.bid, (const char*)(mx + FX_ACTE), (const char*)(wb + W_DE), (size_t)256 * DFE * 2, (size_t)256 * DFE * 2, W_DE_E, lctl + 32, nullptr, nullptr, 0, lctl + 176};
                pg8::EpiStoreBf16 E{(bf16*)(mx + FX_YS), D};
                pg8::gemm_phase<pg8::EpiStoreBf16, pg8::MoeOrder, true>(c.lds, g, S, E);
                small_gemm(c, NRB * 32, MoeTailItems{(const bf16*)(mx + FX_ACTE), (const bf16*)(wb + W_DE), (size_t)(W_DE_E / 2), lctl}, DFE, DFE, DFE, CtxStoreBf16{(bf16*)(mx + FX_YS), D});
            } SEAM(P + 9);
            for (int rep_ = 0; rep_ < NREP(10); ++rep_) if (EN(10) && IN(P + 10)) { if (rep_) xcd_barrier(bar); PH_BEGIN final_pass(p, c); }
        }
    }
#undef IN
#undef SEAM
}

static void forward(void* const* d_in, float* out, void* d_ws, size_t ws_size, hipStream_t st, int n_launches) {
    static int grid = 0;
    if (grid == 0) {
        if (ws_size < WS_END) { fprintf(stderr, "mk::forward: workspace too small (%zu < %zu)\n", ws_size, (size_t)WS_END); grid = -1; return; }
        int dev = 0, cus = 0;
        if (hipGetDevice(&dev) != hipSuccess || hipDeviceGetAttribute(&cus, hipDeviceAttributeMultiprocessorCount, dev) != hipSuccess) { grid = -1; return; }
        if (hipFuncSetAttribute((const void*)mega, hipFuncAttributeMaxDynamicSharedMemorySize, LDS_BYTES) != hipSuccess) { fprintf(stderr, "mk::forward: hipFuncSetAttribute failed\n"); grid = -1; return; }
        int per_cu = 0; (void)hipOccupancyMaxActiveBlocksPerMultiprocessor(&per_cu, (const void*)mega, NTHREADS, LDS_BYTES); (void)hipGetLastError();
        grid = cus;
    }
    if (grid < 0) return;
    (void)hipMemsetAsync((char*)d_ws + WS_CTL, 0, CTL_BYTES, st);
    Params p{};
    for (int i = 0; i < 25; ++i) p.in[i] = (const float*)d_in[i];
    p.out = out; p.ws = (unsigned char*)d_ws;
    if (n_launches == 1) { p.ph_lo = 0; p.ph_hi = N_PHASES; hipLaunchKernelGGL(mega, dim3(grid), dim3(NTHREADS), LDS_BYTES, st, p); }
    else for (int k = 0; k < N_PHASES; ++k) { p.ph_lo = k; p.ph_hi = k + 1; hipLaunchKernelGGL(mega, dim3(grid), dim3(NTHREADS), LDS_BYTES, st, p); }
    const hipError_t le = hipPeekAtLastError();
    if (le != hipSuccess) fprintf(stderr, "mk::forward: launch failed: %s\n", hipGetErrorName(le));
}
}

#ifndef MK_LAUNCHES
#define MK_LAUNCHES 1
#endif
#ifndef USE_SLOW
#define USE_SLOW 0
#endif
extern "C" void kernel_launch(void* const* d_in, const int* in_sizes, int n_in, void* d_out, int out_size, void* d_ws, size_t ws_size, hipStream_t stream) {
    if (n_in != 25 || out_size != SEQ * D) { fprintf(stderr, "kernel_launch: unexpected shapes (n_in %d out %d)\n", n_in, out_size); return; }
#if USE_SLOW
    slow::forward(d_in, (float*)d_out, (float*)d_ws, ws_size / 4, stream);
#else
    mk::forward(d_in, (float*)d_out, d_ws, ws_size, stream, MK_LAUNCHES);
#endif
}
```

```cpp
#include <hip/hip_runtime.h>
#include <cstdio>
#include <cstdint>

constexpr int D = 2048, LC = 256, SEQ = 8192, MT = LC + SEQ, DEPTH = 2;
constexpr int NH = 16, DN = 128, DR = 64, DV = 128, DQK = DN + DR, QL = 512, KVL = 512;
constexpr int CW = 2048, DIN = QL + KVL + DR + 3 * CW + 2 * D;
constexpr int OFF_QA = 0, OFF_CKV = 512, OFF_KR = 1024, OFF_CX = 1088, OFF_CB = OFF_CX + CW, OFF_CC = OFF_CB + CW, OFF_GA = OFF_CC + CW, OFF_GB = OFF_GA + D;
constexpr int DFF = 5632, NE = 8, DFE = 2816;
constexpr float EPS = 1e-6f;
constexpr float ATT_SCALE = 0.07216878364870322f;

namespace slow {
typedef float f32x16 __attribute__((ext_vector_type(16)));

struct GArgs { const float* A; long lda, abs_; const float* B; long sbk, sbn, bbs; const int* rowidx; const int* rioff; const int* Mptr; int M, N, K, pad; };
static_assert(sizeof(GArgs) == 96, "GArgs has no implicit padding");

template <bool BT, class Epi>
__global__ __launch_bounds__(256) void k_gemm(GArgs g, Epi epi) {
    __shared__ float As[32][65];
    __shared__ float Bs[32][65];
    const int b = blockIdx.z, m0 = blockIdx.y * 64, n0 = blockIdx.x * 64;
    const int M = g.Mptr ? g.Mptr[b] : g.M;
    if (m0 >= M) return;
    const int t = threadIdx.x, lane = t & 63, w = t >> 6, wm = w >> 1, wn = w & 1;
    const float* A = g.A + (long)b * g.abs_; const float* B = g.B + (long)b * g.bbs;
    const int ar = t >> 2, ak = (t & 3) * 8, am = m0 + ar;
    long arow = -1;
    if (am < M) { const int base = g.rioff ? g.rioff[b] : 0; arow = g.rowidx ? (long)g.rowidx[base + am] : (long)(base + am); }
    f32x16 acc;
#pragma unroll
    for (int r = 0; r < 16; ++r) acc[r] = 0.f;
    for (int k0 = 0; k0 < g.K; k0 += 32) {
        float4 a0 = make_float4(0.f, 0.f, 0.f, 0.f), a1 = a0, b0, b1;
        if (arow >= 0) { const float4* p = (const float4*)(A + arow * g.lda + k0 + ak); a0 = p[0]; a1 = p[1]; }
        if (BT) { const int bn = t >> 2, bk = (t & 3) * 8; const float4* p = (const float4*)(B + (long)(n0 + bn) * g.sbn + k0 + bk); b0 = p[0]; b1 = p[1]; }
        else    { const int bk = t >> 3, bn = (t & 7) * 8; const float4* p = (const float4*)(B + (long)(k0 + bk) * g.sbk + n0 + bn); b0 = p[0]; b1 = p[1]; }
        __syncthreads();
        As[ak + 0][ar] = a0.x; As[ak + 1][ar] = a0.y; As[ak + 2][ar] = a0.z; As[ak + 3][ar] = a0.w;
        As[ak + 4][ar] = a1.x; As[ak + 5][ar] = a1.y; As[ak + 6][ar] = a1.z; As[ak + 7][ar] = a1.w;
        if (BT) { const int bn = t >> 2, bk = (t & 3) * 8;
            Bs[bk + 0][bn] = b0.x; Bs[bk + 1][bn] = b0.y; Bs[bk + 2][bn] = b0.z; Bs[bk + 3][bn] = b0.w;
            Bs[bk + 4][bn] = b1.x; Bs[bk + 5][bn] = b1.y; Bs[bk + 6][bn] = b1.z; Bs[bk + 7][bn] = b1.w; }
        else { const int bk = t >> 3, bn = (t & 7) * 8;
            Bs[bk][bn + 0] = b0.x; Bs[bk][bn + 1] = b0.y; Bs[bk][bn + 2] = b0.z; Bs[bk][bn + 3] = b0.w;
            Bs[bk][bn + 4] = b1.x; Bs[bk][bn + 5] = b1.y; Bs[bk][bn + 6] = b1.z; Bs[bk][bn + 7] = b1.w; }
        __syncthreads();
#pragma unroll
        for (int kk = 0; kk < 32; kk += 2) {
            const float a = As[kk + (lane >> 5)][wm * 32 + (lane & 31)];
            const float bb = Bs[kk + (lane >> 5)][wn * 32 + (lane & 31)];
            acc = __builtin_amdgcn_mfma_f32_32x32x2f32(a, bb, acc, 0, 0, 0);
        }
    }
    const int base = g.rioff ? g.rioff[b] : 0;
#pragma unroll
    for (int r = 0; r < 16; ++r) {
        const int row = m0 + wm * 32 + (r & 3) + 8 * (r >> 2) + 4 * (lane >> 5), col = n0 + wn * 32 + (lane & 31);
        if (row < M) epi(b, base + row, col, acc[r]);
    }
}
struct EpiStore { float* C; long ldc, cbs; float alpha; int accum;
    __device__ void operator()(int b, int row, int col, float v) const { float* p = C + (long)b * cbs + (long)row * ldc + col; *p = accum ? *p + alpha * v : alpha * v; } };
struct EpiResid { float* X; const float* gl; const float* gc;
    __device__ void operator()(int, int row, int col, float v) const { float* p = X + (long)row * D + col; *p += (row < LC ? gc[col] : gl[col]) * v; } };

template <bool BT, class Epi> static void gemm(hipStream_t st, const GArgs& g, const Epi& e, int nbatch, int maxM) {
    dim3 grid(g.N / 64, (maxM + 63) / 64, nbatch);
    hipLaunchKernelGGL((k_gemm<BT, Epi>), grid, dim3(256), 0, st, g, e);
}

__device__ __forceinline__ float block_sum(float v, float* red) {
#pragma unroll
    for (int o = 32; o > 0; o >>= 1) v += __shfl_xor(v, o);
    __syncthreads();
    if ((threadIdx.x & 63) == 0) red[threadIdx.x >> 6] = v;
    __syncthreads();
    return red[0] + red[1] + red[2] + red[3];
}
__device__ __forceinline__ float block_max(float v, float* red) {
#pragma unroll
    for (int o = 32; o > 0; o >>= 1) v = fmaxf(v, __shfl_xor(v, o));
    __syncthreads();
    if ((threadIdx.x & 63) == 0) red[threadIdx.x >> 6] = v;
    __syncthreads();
    return fmaxf(fmaxf(red[0], red[1]), fmaxf(red[2], red[3]));
}
__device__ __forceinline__ float silu(float x) { return x / (1.f + expf(-x)); }
__device__ __forceinline__ float sigm(float x) { return 1.f / (1.f + expf(-x)); }

__global__ void k_copy_x(const float* ctx, const float* x, float* XL) {
    const long n = (long)MT * D / 4; const float4* c4 = (const float4*)ctx; const float4* x4 = (const float4*)x; float4* o = (float4*)XL; const long nc = (long)LC * D / 4;
    for (long i = blockIdx.x * 256L + threadIdx.x; i < n; i += gridDim.x * 256L) o[i] = i < nc ? c4[i] : x4[i - nc];
}
__global__ void k_ada(const float* c, const float* cctx, const float* w_ada, const float* b_ada, float* MOD) {
    const int n = blockIdx.x * 256 + threadIdx.x, lv = blockIdx.y, l = lv >> 1, v = lv & 1;
    const float* cv = v ? cctx : c; const float* W = w_ada + (long)l * D * (6 * D);
    float acc = 0.f;
    for (int k = 0; k < D; ++k) acc += silu(cv[k]) * W[(long)k * (6 * D) + n];
    MOD[(long)lv * (6 * D) + n] = acc + b_ada[l * 6 * D + n];
}
__global__ __launch_bounds__(256) void k_modnorm(const float* X, const float* g, const float* modl, const float* modc, int sh_off, int sc_off, float* H) {
    __shared__ float red[4];
    const int r = blockIdx.x; const float* x = X + (long)r * D; const float* mod = r < LC ? modc : modl;
    float v[8]; float ss = 0.f;
#pragma unroll
    for (int j = 0; j < 8; ++j) { v[j] = x[threadIdx.x + 256 * j]; ss += v[j] * v[j]; }
    ss = block_sum(ss, red);
    const float rs = rsqrtf(ss * (1.f / D) + EPS);
#pragma unroll
    for (int j = 0; j < 8; ++j) { const int c = threadIdx.x + 256 * j; H[(long)r * D + c] = (v[j] * rs * g[c]) * (1.f + mod[sc_off + c]) + mod[sh_off + c]; }
}
__global__ __launch_bounds__(256) void k_rms512(const float* P, int off, const float* g, float* out) {
    __shared__ float red[4];
    const int r = blockIdx.x; const float* x = P + (long)r * DIN + off;
    const float a = x[threadIdx.x], b = x[threadIdx.x + 256];
    const float ss = block_sum(a * a + b * b, red);
    const float rs = rsqrtf(ss * (1.f / 512.f) + EPS);
    out[(long)r * 512 + threadIdx.x] = a * rs * g[threadIdx.x]; out[(long)r * 512 + threadIdx.x + 256] = b * rs * g[threadIdx.x + 256];
}
__device__ __forceinline__ float inv_freq(int i) { return powf(10000.f, -(float)(2 * i) / 32.f); }
__global__ void k_rope_q(float* Q) {
    const long idx = blockIdx.x * 256L + threadIdx.x;
    if (idx >= (long)SEQ * NH * 32) return;
    const int i = idx & 15, part = (idx >> 4) & 1, h = (idx >> 5) & 15; const int t = (int)(idx >> 9);
    const float pos = part ? (float)(t % 64) : (float)(t / 64);
    const float ang = pos * inv_freq(i), cs = cosf(ang), sn = sinf(ang);
    float* p = Q + (long)(LC + t) * (NH * DQK) + h * DQK + DN + part * 32;
    const float x1 = p[i], x2 = p[i + 16];
    p[i] = x1 * cs - x2 * sn; p[i + 16] = x2 * cs + x1 * sn;
}
__global__ void k_rope_k(const float* P, float* KR) {
    const long idx = blockIdx.x * 256L + threadIdx.x;
    if (idx >= (long)MT * 32) return;
    const int i = idx & 15, part = (idx >> 4) & 1; const int r = (int)(idx >> 5);
    const float* p = P + (long)r * DIN + OFF_KR + part * 32; float* o = KR + (long)r * DR + part * 32;
    const float x1 = p[i], x2 = p[i + 16];
    if (r < LC) { o[i] = x1; o[i + 16] = x2; return; }
    const int t = r - LC; const float pos = part ? (float)(t % 64) : (float)(t / 64);
    const float ang = pos * inv_freq(i), cs = cosf(ang), sn = sinf(ang);
    o[i] = x1 * cs - x2 * sn; o[i + 16] = x2 * cs + x1 * sn;
}
__global__ __launch_bounds__(256) void k_softmax(float* SC, int n) {
    __shared__ float red[4];
    float* s = SC + (long)blockIdx.x * n;
    float mx = -3.0e38f;
    for (int j = threadIdx.x; j < n; j += 256) mx = fmaxf(mx, s[j]);
    mx = block_max(mx, red);
    float sum = 0.f;
    for (int j = threadIdx.x; j < n; j += 256) { const float e = expf(s[j] - mx); s[j] = e; sum += e; }
    sum = block_sum(sum, red);
    const float inv = 1.f / sum;
    for (int j = threadIdx.x; j < n; j += 256) s[j] *= inv;
}
__global__ void k_conv(const float* P, const float* wconv, float* V2) {
    const long idx = blockIdx.x * 256L + threadIdx.x; if (idx >= (long)MT * CW) return;
    const int c = idx % CW; const int r = (int)(idx / CW);
    const int lo = r < LC ? 0 : LC, hi = r < LC ? LC : MT;
    const float* p = P + (long)r * DIN;
    float acc = wconv[CW + c] * (p[OFF_CC + c] * p[OFF_CX + c]);
    if (r - 1 >= lo) acc += wconv[c] * (p[OFF_CC + c - DIN] * p[OFF_CX + c - DIN]);
    if (r + 1 < hi) acc += wconv[2 * CW + c] * (p[OFF_CC + c + DIN] * p[OFF_CX + c + DIN]);
    V2[idx] = p[OFF_CB + c] * acc;
}
__global__ void k_merge(const float* P, const float* OA, const float* OB, float* MG) {
    const long idx = blockIdx.x * 256L + threadIdx.x; if (idx >= (long)MT * D) return;
    const int c = idx % D; const long r = idx / D;
    MG[idx] = sigm(P[r * DIN + OFF_GA + c]) * OA[idx] + sigm(P[r * DIN + OFF_GB + c]) * OB[idx];
}
__global__ void k_swiglu(float* G, const float* U, long n) {
    for (long i = blockIdx.x * 256L + threadIdx.x; i < n; i += gridDim.x * 256L) G[i] = silu(G[i]) * U[i];
}
__global__ __launch_bounds__(256) void k_router(const float* H2, const float* wr, int* sel, float* gw) {
    const int t = blockIdx.x * 4 + (threadIdx.x >> 6), lane = threadIdx.x & 63;
    const float* h = H2 + (long)(LC + t) * D;
    float lg[NE];
#pragma unroll
    for (int e = 0; e < NE; ++e) lg[e] = 0.f;
    for (int k = lane; k < D; k += 64) { const float hv = h[k];
#pragma unroll
        for (int e = 0; e < NE; ++e) lg[e] += hv * wr[k * NE + e]; }
#pragma unroll
    for (int e = 0; e < NE; ++e) {
#pragma unroll
        for (int o = 32; o > 0; o >>= 1) lg[e] += __shfl_xor(lg[e], o); }
    if (lane == 0) {
        int e0 = 0; for (int e = 1; e < NE; ++e) if (lg[e] > lg[e0]) e0 = e;
        int e1 = e0 == 0 ? 1 : 0; for (int e = 0; e < NE; ++e) if (e != e0 && lg[e] > lg[e1]) e1 = e;
        const float m = lg[e0], a = 1.f, b = expf(lg[e1] - m), inv = 1.f / (a + b);
        sel[2 * t] = e0; sel[2 * t + 1] = e1; gw[2 * t] = a * inv; gw[2 * t + 1] = b * inv;
    }
}
__global__ __launch_bounds__(512) void k_sort(const int* sel, int* cnt, int* off, int* toklist, int* slot_of) {
    __shared__ int scnt[NE];
    const int e = threadIdx.x >> 6, lane = threadIdx.x & 63; const int NA = 2 * SEQ;
    int c = 0;
    for (int a0 = 0; a0 < NA; a0 += 64) c += __popcll(__ballot(sel[a0 + lane] == e));
    if (lane == 0) scnt[e] = c;
    __syncthreads();
    int base = 0; for (int j = 0; j < e; ++j) base += scnt[j];
    if (lane == 0) { cnt[e] = c; off[e] = base; }
    int pos = base;
    for (int a0 = 0; a0 < NA; a0 += 64) {
        const bool f = sel[a0 + lane] == e; const unsigned long long m = __ballot(f);
        if (f) { const int p = pos + __popcll(m & ((1ull << lane) - 1ull)); toklist[p] = LC + (a0 + lane) / 2; slot_of[a0 + lane] = p; }
        pos += __popcll(m);
    }
}
__global__ void k_moe_combine(float* XL, const float* Ys, const int* slot_of, const float* gw, const float* gt2) {
    const long idx = blockIdx.x * 256L + threadIdx.x; if (idx >= (long)SEQ * D) return;
    const int c = idx % D; const int t = (int)(idx / D);
    const float y = gw[2 * t] * Ys[(long)slot_of[2 * t] * D + c] + gw[2 * t + 1] * Ys[(long)slot_of[2 * t + 1] * D + c];
    XL[(long)(LC + t) * D + c] += gt2[c] * y;
}
__global__ __launch_bounds__(256) void k_final(const float* XL, const float* g, float* out) {
    __shared__ float red[4];
    const int r = blockIdx.x; const float* x = XL + (long)(LC + r) * D;
    float v[8]; float ss = 0.f;
#pragma unroll
    for (int j = 0; j < 8; ++j) { v[j] = x[threadIdx.x + 256 * j]; ss += v[j] * v[j]; }
    ss = block_sum(ss, red);
    const float rs = rsqrtf(ss * (1.f / D) + EPS);
#pragma unroll
    for (int j = 0; j < 8; ++j) { const int c = threadIdx.x + 256 * j; out[(long)r * D + c] = v[j] * rs * g[c]; }
}

static inline int nblk(long n) { return (int)((n + 255) / 256); }

static void forward(void* const* d_in, float* out, float* ws, size_t ws_floats, hipStream_t st) {
    const float* x = (const float*)d_in[0]; const float* c = (const float*)d_in[1]; const float* ctx = (const float*)d_in[2]; const float* cctx = (const float*)d_in[3];
    const float* w_ada = (const float*)d_in[4]; const float* b_ada = (const float*)d_in[5]; const float* g_attn = (const float*)d_in[6]; const float* w_in = (const float*)d_in[7];
    const float* g_qa = (const float*)d_in[8]; const float* w_qb = (const float*)d_in[9]; const float* g_kva = (const float*)d_in[10]; const float* w_kvb = (const float*)d_in[11];
    const float* w_conv = (const float*)d_in[12]; const float* w_oa = (const float*)d_in[13]; const float* w_ob = (const float*)d_in[14]; const float* w_o = (const float*)d_in[15];
    const float* g_ffn = (const float*)d_in[16]; const float* w_gd = (const float*)d_in[17]; const float* w_ud = (const float*)d_in[18]; const float* w_dd = (const float*)d_in[19];
    const float* w_router = (const float*)d_in[20]; const float* w_ge = (const float*)d_in[21]; const float* w_ue = (const float*)d_in[22]; const float* w_de = (const float*)d_in[23];
    const float* g_final = (const float*)d_in[24];
    size_t o = 0; auto take = [&](size_t n) { float* p = ws + o; o += (n + 63) / 64 * 64; return p; };
    float* XL = take((size_t)MT * D); float* MOD = take(4 * 6 * D); float* H = take((size_t)MT * D); float* P = take((size_t)MT * DIN);
    float* QN = take((size_t)MT * 512); float* CN = take((size_t)MT * 512); float* Q = take((size_t)MT * NH * DQK); float* KV = take((size_t)MT * NH * 256);
    float* KR = take((size_t)MT * DR); float* SC = take((size_t)NH * 256 * MT); float* ATT = take((size_t)MT * D);
    int* IB = (int*)take(4 * SEQ + 64 + 2 * SEQ + 2 * SEQ);
    if (o > ws_floats) { fprintf(stderr, "slow::forward: workspace too small (%zu > %zu floats)\n", o, ws_floats); return; }
    int* sel = IB; int* slot_of = IB + 2 * SEQ; int* toklist = IB + 4 * SEQ; int* cnt = IB + 6 * SEQ; int* off = cnt + 8; float* gw = (float*)(IB + 6 * SEQ + 64);
    float* OA = SC; float* OB = SC + (size_t)MT * D; float* V2 = SC + 2 * (size_t)MT * D; float* MG = SC + 3 * (size_t)MT * D;
    static_assert((size_t)NH * 256 * MT >= 2 * (size_t)MT * D, "SC region");
    V2 = Q; MG = KV;
    float* OUT = H; float* H2 = H; float* G = P; float* U = P + (size_t)MT * DFF; float* Y = Q; float* Ys = KV;
    static_assert((size_t)MT * DIN >= 2 * (size_t)MT * DFF, "P region holds G and U");

    hipLaunchKernelGGL(k_copy_x, dim3(2048), dim3(256), 0, st, ctx, x, XL);
    hipLaunchKernelGGL(k_ada, dim3(6 * D / 256, 4), dim3(256), 0, st, c, cctx, w_ada, b_ada, MOD);
    for (int i = 0; i < DEPTH; ++i) {
        const bool last = (i == DEPTH - 1);
        const float* modl = MOD + (size_t)(2 * i) * 6 * D; const float* modc = MOD + (size_t)(2 * i + 1) * 6 * D;
        hipLaunchKernelGGL(k_modnorm, dim3(MT), dim3(256), 0, st, XL, g_attn + i * D, modl, modc, 0, D, H);
        { GArgs g{H, D, 0, w_in + (size_t)i * D * DIN, DIN, 1, 0, nullptr, nullptr, nullptr, MT, DIN, D}; gemm<false>(st, g, EpiStore{P, DIN, 0, 1.f, 0}, 1, MT); }
        hipLaunchKernelGGL(k_rms512, dim3(MT), dim3(256), 0, st, P, OFF_QA, g_qa + i * QL, QN);
        hipLaunchKernelGGL(k_rms512, dim3(MT), dim3(256), 0, st, P, OFF_CKV, g_kva + i * KVL, CN);
        { GArgs g{QN, 512, 0, w_qb + (size_t)i * QL * NH * DQK, NH * DQK, 1, 0, nullptr, nullptr, nullptr, MT, NH * DQK, QL}; gemm<false>(st, g, EpiStore{Q, NH * DQK, 0, 1.f, 0}, 1, MT); }
        { GArgs g{CN, 512, 0, w_kvb + (size_t)i * KVL * NH * 256, NH * 256, 1, 0, nullptr, nullptr, nullptr, MT, NH * 256, KVL}; gemm<false>(st, g, EpiStore{KV, NH * 256, 0, 1.f, 0}, 1, MT); }
        hipLaunchKernelGGL(k_rope_q, dim3(nblk((long)SEQ * NH * 32)), dim3(256), 0, st, Q);
        hipLaunchKernelGGL(k_rope_k, dim3(nblk((long)MT * 32)), dim3(256), 0, st, P, KR);
        for (int ch = last ? 0 : -1; ch < SEQ / 256; ++ch) {
            const int q0 = ch < 0 ? 0 : LC + 256 * ch, nk = ch < 0 ? LC : MT;
            { GArgs g{Q + (size_t)q0 * NH * DQK, NH * DQK, DQK, KV, 1, NH * 256, 256, nullptr, nullptr, nullptr, 256, nk, DN}; gemm<true>(st, g, EpiStore{SC, nk, (long)256 * nk, ATT_SCALE, 0}, NH, 256); }
            { GArgs g{Q + (size_t)q0 * NH * DQK + DN, NH * DQK, DQK, KR, 1, DR, 0, nullptr, nullptr, nullptr, 256, nk, DR}; gemm<true>(st, g, EpiStore{SC, nk, (long)256 * nk, ATT_SCALE, 1}, NH, 256); }
            hipLaunchKernelGGL(k_softmax, dim3(NH * 256), dim3(256), 0, st, SC, nk);
            { GArgs g{SC, nk, (long)256 * nk, KV + DN, NH * 256, 1, 256, nullptr, nullptr, nullptr, 256, DV, nk}; gemm<false>(st, g, EpiStore{ATT + (size_t)q0 * D, D, DV, 1.f, 0}, NH, 256); }
        }
        { GArgs g{ATT, D, 0, w_oa + (size_t)i * D * D, D, 1, 0, nullptr, nullptr, nullptr, MT, D, D}; gemm<false>(st, g, EpiStore{OA, D, 0, 1.f, 0}, 1, MT); }
        hipLaunchKernelGGL(k_conv, dim3(nblk((long)MT * CW)), dim3(256), 0, st, P, w_conv + (size_t)i * 3 * CW, V2);
        { GArgs g{V2, CW, 0, w_ob + (size_t)i * CW * D, D, 1, 0, nullptr, nullptr, nullptr, MT, D, CW}; gemm<false>(st, g, EpiStore{OB, D, 0, 1.f, 0}, 1, MT); }
        hipLaunchKernelGGL(k_merge, dim3(nblk((long)MT * D)), dim3(256), 0, st, P, OA, OB, MG);
        { GArgs g{MG, D, 0, w_o + (size_t)i * D * D, D, 1, 0, nullptr, nullptr, nullptr, MT, D, D}; gemm<false>(st, g, EpiResid{XL, modl + 2 * D, modc + 2 * D}, 1, MT); }
        hipLaunchKernelGGL(k_modnorm, dim3(MT), dim3(256), 0, st, XL, g_ffn + i * D, modl, modc, 3 * D, 4 * D, H2);
        if (i % 2 == 0) {
            const int j = i / 2;
            { GArgs g{H2, D, 0, w_gd + (size_t)j * D * DFF, DFF, 1, 0, nullptr, nullptr, nullptr, MT, DFF, D}; gemm<false>(st, g, EpiStore{G, DFF, 0, 1.f, 0}, 1, MT); }
            { GArgs g{H2, D, 0, w_ud + (size_t)j * D * DFF, DFF, 1, 0, nullptr, nullptr, nullptr, MT, DFF, D}; gemm<false>(st, g, EpiStore{U, DFF, 0, 1.f, 0}, 1, MT); }
            hipLaunchKernelGGL(k_swiglu, dim3(4096), dim3(256), 0, st, G, U, (long)MT * DFF);
            { GArgs g{G, DFF, 0, w_dd + (size_t)j * DFF * D, D, 1, 0, nullptr, nullptr, nullptr, MT, D, DFF}; gemm<false>(st, g, EpiResid{XL, modl + 5 * D, modc + 5 * D}, 1, MT); }
        } else {
            const int j = i / 2;
            float* Ge = P; float* Ue = P + (size_t)2 * SEQ * DFE;
            hipLaunchKernelGGL(k_router, dim3(SEQ / 4), dim3(256), 0, st, H2, w_router + (size_t)j * D * NE, sel, gw);
            hipLaunchKernelGGL(k_sort, dim3(1), dim3(512), 0, st, sel, cnt, off, toklist, slot_of);
            { GArgs g{H2, D, 0, w_ge + (size_t)j * NE * D * DFE, DFE, 1, (long)D * DFE, toklist, off, cnt, 0, DFE, D}; gemm<false>(st, g, EpiStore{Ge, DFE, 0, 1.f, 0}, NE, SEQ); }
            { GArgs g{H2, D, 0, w_ue + (size_t)j * NE * D * DFE, DFE, 1, (long)D * DFE, toklist, off, cnt, 0, DFE, D}; gemm<false>(st, g, EpiStore{Ue, DFE, 0, 1.f, 0}, NE, SEQ); }
            hipLaunchKernelGGL(k_swiglu, dim3(4096), dim3(256), 0, st, Ge, Ue, (long)2 * SEQ * DFE);
            { GArgs g{Ge, DFE, 0, w_de + (size_t)j * NE * DFE * D, D, 1, (long)DFE * D, nullptr, off, cnt, 0, D, DFE}; gemm<false>(st, g, EpiStore{Ys, D, 0, 1.f, 0}, NE, SEQ); }
            hipLaunchKernelGGL(k_moe_combine, dim3(nblk((long)SEQ * D)), dim3(256), 0, st, XL, Ys, slot_of, gw, modl + 5 * D);
        }
        (void)OUT; (void)Y;
    }
    hipLaunchKernelGGL(k_final, dim3(SEQ), dim3(256), 0, st, XL, g_final, out);
}
}


namespace mk {
#define LAS __attribute__((address_space(3)))
#define GAS __attribute__((address_space(1)))
typedef unsigned short bf16;
typedef short bf16x8 __attribute__((ext_vector_type(8)));
typedef short s16x4 __attribute__((ext_vector_type(4)));
typedef float f32x2 __attribute__((ext_vector_type(2)));
typedef float f32x4 __attribute__((ext_vector_type(4)));
typedef float f32x16 __attribute__((ext_vector_type(16)));
typedef unsigned u32x2 __attribute__((ext_vector_type(2)));
typedef unsigned u32x4 __attribute__((ext_vector_type(4)));
typedef __bf16 bf16x2_t __attribute__((ext_vector_type(2)));
typedef int i32x4 __attribute__((ext_vector_type(4)));
typedef GAS unsigned gu32;

constexpr int NWAVES = 8, NTHREADS = 512;
constexpr int NT_IN = 45;
constexpr int NIN = NT_IN * 256;
constexpr int KS_ADA = 16;
constexpr int MAXT = 72;
constexpr int XS_ROWS = MAXT * 256;

constexpr size_t al256(size_t x) { return (x + 255) / 256 * 256; }
constexpr size_t WS_CTL = 0, CTL_BYTES = 1u << 20;
constexpr size_t WS_MOD = WS_CTL + CTL_BYTES;
constexpr size_t WS_PART = WS_MOD + al256((size_t)4 * 6 * D * 4);
constexpr size_t WS_ROPE = WS_PART + al256((size_t)2 * KS_ADA * 2 * 6 * D * 4);
constexpr size_t WS_SEL = WS_ROPE + al256(2 * 128 * 16 * 4);
constexpr size_t WS_GW = WS_SEL + al256((size_t)2 * SEQ * 4);
constexpr size_t WS_SLOT = WS_GW + al256((size_t)2 * SEQ * 4);
constexpr int SC_IN = 0, SC_GU = 2 * NIN, SC_GUE = SC_GU + 2 * DFF, SC_TOTAL = SC_GUE + NE * 2 * DFE;
constexpr size_t WS_HSC = WS_SLOT + al256((size_t)2 * SEQ * 4);
constexpr size_t WS_XSC = WS_HSC + al256((size_t)MT * 4);
constexpr size_t WS_WSC = WS_XSC + al256((size_t)XS_ROWS * 4);
constexpr size_t CTL_COLMAX = 65536;
static_assert(CTL_COLMAX + (size_t)SC_TOTAL * 4 <= CTL_BYTES, "column maxima inside the zeroed control region");
constexpr size_t WS_XL = WS_WSC + al256((size_t)SC_TOTAL * 4);
constexpr size_t WS_HN = WS_XL + al256((size_t)MT * D * 4);
constexpr size_t WS_MIX = WS_HN + al256((size_t)MT * D * 2);
constexpr size_t MX_QC = 0;
constexpr size_t MX_KRB = MX_QC + al256((size_t)MT * 1024 * 2);
constexpr size_t MX_SSQ = MX_KRB + al256((size_t)MT * 64 * 2);
constexpr size_t MX_U = MX_SSQ + al256((size_t)MT * 16 * 4);
constexpr size_t MX_CB = MX_U + al256((size_t)MT * D * 2);
constexpr size_t MX_SGA = MX_CB + al256((size_t)MT * D * 2);
constexpr size_t MX_SGB = MX_SGA + al256((size_t)MT * D * 2);
constexpr size_t MX_Q = MX_SGB + al256((size_t)MT * D * 2);
constexpr size_t MX_KV = MX_Q + al256((size_t)MT * 3072 * 2);
constexpr size_t MX_O = MX_KV + al256((size_t)MT * 4096 * 2);
constexpr size_t MX_V2 = MX_O + al256((size_t)MT * D * 2);
constexpr size_t MX_M1 = MX_V2 + al256((size_t)MT * D * 2);
constexpr size_t MX_MG = MX_M1 + al256((size_t)MT * D * 2);
constexpr size_t MX_END = MX_MG + al256((size_t)MT * D * 2);
constexpr size_t FX_ACT = 0;
constexpr size_t FX_XS = 0;
constexpr size_t FX_ACTE = FX_XS + al256((size_t)XS_ROWS * D * 2);
constexpr size_t FX_YS = FX_ACTE + al256((size_t)XS_ROWS * DFE * 2);
constexpr size_t FX_END = FX_YS + al256((size_t)XS_ROWS * D * 2);
static_assert(MX_SGA - MX_CB == (size_t)MT * D * 2 && MX_SGB - MX_SGA == (size_t)MT * D * 2, "CB | SGA | SGB contiguous");
static_assert(FX_END <= MX_END && (size_t)MT * DFF * 2 <= MX_END, "FFN scratch overlays the mixer scratch");
constexpr size_t WS_W = WS_MIX + MX_END;
constexpr size_t W_IN = 0, W_IN_L = (size_t)NIN * D * 2;
constexpr size_t W_QB = W_IN + 2 * W_IN_L, W_QB_L = (size_t)3072 * 512 * 2;
constexpr size_t W_KVB = W_QB + 2 * W_QB_L, W_KVB_L = (size_t)4096 * 512 * 2;
constexpr size_t W_OA = W_KVB + 2 * W_KVB_L, W_SQ_L = (size_t)D * D * 2;
constexpr size_t W_OB = W_OA + 2 * W_SQ_L, W_O = W_OB + 2 * W_SQ_L;
constexpr size_t W_GU = W_O + 2 * W_SQ_L;
constexpr size_t W_DD = W_GU + (size_t)2 * DFF * D * 2;
constexpr size_t W_GUE = W_DD + (size_t)D * DFF * 2, W_GUE_E = (size_t)2 * DFE * D * 2;
constexpr size_t W_DE = W_GUE + NE * W_GUE_E, W_DE_E = (size_t)D * DFE * 2;
constexpr size_t W_END = W_DE + NE * W_DE_E;
constexpr size_t WS_END = WS_W + W_END;

constexpr int RING_BYTES = 131072;
constexpr int LCTL_OFF = RING_BYTES;
constexpr int LDS_BYTES = 147456;

__device__ __forceinline__ unsigned cvtpk(float lo, float hi) { f32x2 v = {lo, hi}; bf16x2_t b = __builtin_convertvector(v, bf16x2_t); return __builtin_bit_cast(unsigned, b); }
__device__ __forceinline__ u32x4 pack8(f32x4 a, f32x4 b) { u32x4 w; w.x = cvtpk(a[0], a[1]); w.y = cvtpk(a[2], a[3]); w.z = cvtpk(b[0], b[1]); w.w = cvtpk(b[2], b[3]); return w; }
__device__ __forceinline__ void unpack8(u32x4 w, f32x4& a, f32x4& b) {
    a[0] = __uint_as_float(w.x << 16); a[1] = __uint_as_float(w.x & 0xffff0000u); a[2] = __uint_as_float(w.y << 16); a[3] = __uint_as_float(w.y & 0xffff0000u);
    b[0] = __uint_as_float(w.z << 16); b[1] = __uint_as_float(w.z & 0xffff0000u); b[2] = __uint_as_float(w.w << 16); b[3] = __uint_as_float(w.w & 0xffff0000u); }
__device__ __forceinline__ f32x4 unpack4(u32x2 w) { f32x4 a; a[0] = __uint_as_float(w.x << 16); a[1] = __uint_as_float(w.x & 0xffff0000u); a[2] = __uint_as_float(w.y << 16); a[3] = __uint_as_float(w.y & 0xffff0000u); return a; }
__device__ __forceinline__ float fsig(float x) { return __builtin_amdgcn_rcpf(1.f + __builtin_amdgcn_exp2f(-1.4426950408889634f * x)); }
__device__ __forceinline__ f32x4 fsig4(f32x4 x) { f32x4 r; r[0] = fsig(x[0]); r[1] = fsig(x[1]); r[2] = fsig(x[2]); r[3] = fsig(x[3]); return r; }
__device__ __forceinline__ float wave_sum(float v) {
#pragma unroll
    for (int o = 1; o < 64; o <<= 1) v += __shfl_xor(v, o);
    return v;
}
#define LDS_WAIT() asm volatile("s_waitcnt lgkmcnt(0)" ::: "memory")
#define VM_WAIT() asm volatile("s_waitcnt vmcnt(0)" ::: "memory")

namespace pg8 {
constexpr int BM = 256, BK = 64, HALF = 128, HTB = HALF * BK * 2, STAGE_BYTES = 8 * HTB, NXCD = 8, WGM = 8;
__device__ __forceinline__ int lds_byte(int r, int c) { const int st = (r >> 4) * 2 + (c >> 5), rr = r & 15, cc = c & 31, ob = rr * 64 + cc * 2; return st * 1024 + (ob ^ (((ob >> 9) & 1) << 5)); }
__device__ __forceinline__ void stage_rc(int b, int& R, int& C) { const int st = b / 1024, sb = b % 1024, swz = sb ^ (((sb >> 9) & 1) << 5); R = (st >> 1) * 16 + swz / 64; C = (st & 1) * 32 + (swz % 64) / 2; }
__device__ __forceinline__ int perm32(int rho) { const int n = rho >> 4, i = rho & 15; return 8 * (i >> 2) + 4 * n + (i & 3); }
struct Unit { int pm, pn, kind; };
struct Geo { int lda, ldb, K; };
__device__ __forceinline__ void tile_of(int L, int nM, int nN, int& pm, int& pn) {
    const int nwg = nM * nN; int wgid = L; { const int q = nwg / NXCD, r = nwg % NXCD, xcd = wgid % NXCD, off = wgid / NXCD; wgid = (xcd < r ? xcd * (q + 1) : r * (q + 1) + (xcd - r) * q) + off; }
    const int nig = WGM * nN, gid = wgid / nig, fm = gid * WGM, gsz = (nM - fm) < WGM ? (nM - fm) : WGM;
    pm = fm + ((wgid % nig) % gsz); pn = (wgid % nig) / gsz;
}
template <class Epi, class Sched, bool ALIGN_EPI, bool I8 = false>
__device__ __forceinline__ void gemm_phase(LAS unsigned char* lds, const Geo g, const Sched& S, const Epi& E) {
    int tid = threadIdx.x; asm volatile("" : "+v"(tid));
    const int wid = __builtin_amdgcn_readfirstlane(tid >> 6), lane = tid & 63, wr = wid >> 2, wc = wid & 3, fr = lane & 15, fq = lane >> 4;
    const int nt = g.K / BK;
    unsigned voffA[2], voffB[2];
#pragma unroll
    for (int i = 0; i < 2; ++i) { int R, C; stage_rc(tid * 16 + i * 8192, R, C); const int Rb = Epi::PERM ? ((R & ~31) + perm32(R & 31)) : R;
        voffA[i] = (unsigned)(R * g.lda + C) * 2u; voffB[i] = (unsigned)(Rb * g.ldb + C) * 2u; }
    const size_t kstep = (size_t)(BK * 2);
    const size_t hstepA = (size_t)HALF * g.lda * 2, hstepB = (size_t)HALF * g.ldb * 2;
    const unsigned ldsw = (unsigned)wid * 1024u;
    const int aoff = lds_byte(wr * 64 + fr, fq * 8), boff = lds_byte(wc * 32 + fr, fq * 8);
#define PG8_SA(b, h) (((b) * 2 + (h)) * HTB)
#define PG8_SB(b, h) ((4 + (b) * 2 + (h)) * HTB)
#define PG8_STAGE(bufoff, gbase, voff) do { _Pragma("unroll") for (int _i = 0; _i < 2; ++_i) \
        __builtin_amdgcn_global_load_lds((const unsigned*)((const char*)(gbase) + (voff)[_i]), (LAS unsigned*)(lds + (bufoff) + ldsw + _i * 8192), 16, 0, 0); } while (0)
#define PG8_LDA(dst, b, h) do { _Pragma("unroll") for (int m = 0; m < 4; ++m) _Pragma("unroll") for (int k = 0; k < 2; ++k) dst[m][k] = *(const LAS bf16x8*)(lds + PG8_SA(b, h) + aoff + m * 2048 + k * 1024); } while (0)
#define PG8_LDB(dst, b, h) do { _Pragma("unroll") for (int n = 0; n < 2; ++n) _Pragma("unroll") for (int k = 0; k < 2; ++k) dst[n][k] = *(const LAS bf16x8*)(lds + PG8_SB(b, h) + boff + n * 2048 + k * 1024); } while (0)
#define PG8_MMA(ai, bj, At, Bt) do { __builtin_amdgcn_s_setprio(1); _Pragma("unroll") for (int m = 0; m < 4; ++m) _Pragma("unroll") for (int n = 0; n < 2; ++n) _Pragma("unroll") for (int k = 0; k < 2; ++k) { \
        if constexpr (I8) acc[ai][bj][m][n] = __builtin_bit_cast(f32x4, __builtin_amdgcn_mfma_i32_16x16x64_i8(__builtin_bit_cast(i32x4, Bt[n][k]), __builtin_bit_cast(i32x4, At[m][k]), __builtin_bit_cast(i32x4, acc[ai][bj][m][n]), 0, 0, 0)); \
        else acc[ai][bj][m][n] = __builtin_amdgcn_mfma_f32_16x16x32_bf16(Bt[n][k], At[m][k], acc[ai][bj][m][n], 0, 0, 0); } __builtin_amdgcn_s_setprio(0); } while (0)
#define PG8_WAIT_V(n) asm volatile("s_waitcnt vmcnt(" #n ")" ::: "memory")
#define PG8_WAIT_L(n) asm volatile("s_waitcnt lgkmcnt(" #n ")" ::: "memory")
#define PG8_BAR __builtin_amdgcn_s_barrier()
#define PG8_SCHED __builtin_amdgcn_sched_barrier(0)
    Unit cur, nxt; int ui = 0;
    if (!S.next(0, cur)) return;
    float zf = 0.f; asm volatile("" : "+v"(zf));
    f32x4 acc[2][2][4][2];
#pragma unroll
    for (int a = 0; a < 2; ++a)
#pragma unroll
        for (int b = 0; b < 2; ++b)
#pragma unroll
            for (int m = 0; m < 4; ++m)
#pragma unroll
                for (int n = 0; n < 2; ++n) acc[a][b][m][n] = (f32x4){zf, zf, zf, zf};
    bf16x8 At[4][2], B0[2][2], B1[2][2];
    const char* cA = S.abase(cur); const char* cB = S.bbase(cur);
    PG8_STAGE(PG8_SB(0, 0), cB, voffB); PG8_STAGE(PG8_SB(0, 1), cB + hstepB, voffB); PG8_STAGE(PG8_SA(0, 0), cA, voffA); PG8_STAGE(PG8_SA(0, 1), cA + hstepA, voffA);
    if (wr == 1) PG8_BAR;
    PG8_WAIT_V(2); PG8_BAR;
    PG8_STAGE(PG8_SB(1, 0), cB + kstep, voffB); PG8_STAGE(PG8_SA(1, 0), cA + kstep, voffA); PG8_STAGE(PG8_SB(1, 1), cB + hstepB + kstep, voffB);
    PG8_WAIT_V(6); PG8_BAR;
    for (;;) {
        const bool has_next = S.next(ui + 1, nxt);
        const char* nA = has_next ? S.abase(nxt) : cA; const char* nB = has_next ? S.bbase(nxt) : cB;
        for (int t = 0; t < nt; t += 2) {
            const bool last = (t == nt - 2);
            const char* a1 = cA + (size_t)(t + 1) * kstep;
            const char* a2 = last ? nA : cA + (size_t)(t + 2) * kstep; const char* b2 = last ? nB : cB + (size_t)(t + 2) * kstep;
            const char* a3 = a2 + kstep; const char* b3 = b2 + kstep;
            PG8_LDB(B0, 0, 0); PG8_LDB(B1, 0, 1); PG8_SCHED; PG8_LDA(At, 0, 0); PG8_STAGE(PG8_SA(1, 1), a1 + hstepA, voffA);
            PG8_WAIT_V(8); PG8_WAIT_L(0); PG8_BAR; PG8_MMA(0, 0, At, B0); PG8_MMA(0, 1, At, B1); PG8_BAR; PG8_SCHED;
            PG8_LDA(At, 0, 1); PG8_STAGE(PG8_SB(0, 0), b2, voffB); PG8_STAGE(PG8_SB(0, 1), b2 + hstepB, voffB); PG8_STAGE(PG8_SA(0, 0), a2, voffA);
            PG8_WAIT_V(8); PG8_WAIT_L(0); PG8_BAR; PG8_MMA(1, 0, At, B0); PG8_MMA(1, 1, At, B1); PG8_BAR; PG8_SCHED;
            PG8_LDB(B0, 1, 0); PG8_LDB(B1, 1, 1); PG8_SCHED; PG8_LDA(At, 1, 0); PG8_STAGE(PG8_SA(0, 1), a2 + hstepA, voffA);
            PG8_WAIT_V(8); PG8_WAIT_L(0); PG8_BAR; PG8_MMA(0, 0, At, B0); PG8_MMA(0, 1, At, B1); PG8_BAR; PG8_SCHED;
            PG8_LDA(At, 1, 1); PG8_STAGE(PG8_SB(1, 0), b3, voffB); PG8_STAGE(PG8_SB(1, 1), b3 + hstepB, voffB); PG8_STAGE(PG8_SA(1, 0), a3, voffA);
            PG8_WAIT_V(8); PG8_WAIT_L(0); PG8_BAR; PG8_MMA(1, 0, At, B0); PG8_MMA(1, 1, At, B1); PG8_BAR; PG8_SCHED;
        }
        if constexpr (ALIGN_EPI) { if (wr == 0) PG8_BAR; }
        if constexpr (I8) {
            static_assert(Epi::PERM, "the int8 path dequantises in the PERM column layout");
            const float* sa = S.sa(cur) + wr * 64 + fr; const float* sb = S.sb(cur) + wc * 32 + 8 * fq;
            f32x4 sbv[2][2]; float srv[2][4];
#pragma unroll
            for (int b = 0; b < 2; ++b)
#pragma unroll
                for (int n = 0; n < 2; ++n) sbv[b][n] = *(const f32x4*)(sb + b * HALF + 4 * n);
#pragma unroll
            for (int a = 0; a < 2; ++a)
#pragma unroll
                for (int m = 0; m < 4; ++m) srv[a][m] = sa[a * HALF + m * 16];
            __builtin_amdgcn_sched_barrier(0);
#pragma unroll
            for (int a = 0; a < 2; ++a)
#pragma unroll
                for (int m = 0; m < 4; ++m) { const float sr = srv[a][m];
#pragma unroll
                    for (int b = 0; b < 2; ++b)
#pragma unroll
                        for (int n = 0; n < 2; ++n) { const i32x4 iv = __builtin_bit_cast(i32x4, acc[a][b][m][n]);
                            acc[a][b][m][n] = (f32x4){(float)iv[0], (float)iv[1], (float)iv[2], (float)iv[3]} * (sbv[b][n] * sr); } }
        }
        E(acc, cur, wr, wc, fr, fq);
        if (!has_next) break;
#pragma unroll
        for (int a = 0; a < 2; ++a)
#pragma unroll
            for (int b = 0; b < 2; ++b)
#pragma unroll
                for (int m = 0; m < 4; ++m)
#pragma unroll
                    for (int n = 0; n < 2; ++n) acc[a][b][m][n] = (f32x4){zf, zf, zf, zf};
        cur = nxt; cA = nA; cB = nB; ++ui;
        if constexpr (ALIGN_EPI) { if (wr == 1) PG8_BAR; }
    }
    PG8_WAIT_V(0);
    if constexpr (!ALIGN_EPI) { if (wr == 0) PG8_BAR; }
    PG8_BAR;
#undef PG8_SA
#undef PG8_SB
#undef PG8_STAGE
#undef PG8_LDA
#undef PG8_LDB
#undef PG8_MMA
#undef PG8_WAIT_V
#undef PG8_WAIT_L
#undef PG8_BAR
#undef PG8_SCHED
}

struct TileOrder {
    int nM, nN, pm0, G, c, nx, xpm, xpn0;
    const char* A; const char* B; size_t tstepA, tstepB; const float* SA; const float* SB;
    __device__ __forceinline__ const float* sa(const Unit& u) const { return SA + (size_t)u.pm * 256; }
    __device__ __forceinline__ const float* sb(const Unit& u) const { return SB + (size_t)u.pn * 256; }
    __device__ __forceinline__ bool next(int i, Unit& u) const {
        const int L = i * G + c, n1 = nM * nN;
        if (L < n1) { tile_of(L, nM, nN, u.pm, u.pn); u.pm += pm0; u.kind = 0; return true; }
        if (L < n1 + nx) { u.pm = xpm; u.pn = xpn0 + (L - n1); u.kind = 0; return true; }
        return false; }
    __device__ __forceinline__ const char* abase(const Unit& u) const { return A + (size_t)u.pm * tstepA; }
    __device__ __forceinline__ const char* bbase(const Unit& u) const { return B + (size_t)u.pn * tstepB; }
};
struct QkvOrder {
    int nMkv, nMq, pm0q, G, c; const char* QC; const char* WQB; long dkv;
    __device__ __forceinline__ bool next(int i, Unit& u) const {
        const int L = i * G + c, n1 = nMkv * 16;
        if (L < n1) { tile_of(L, nMkv, 16, u.pm, u.pn); u.kind = 0; return true; }
        if (L < n1 + nMq * 12) { tile_of(L - n1, nMq, 12, u.pm, u.pn); u.pm += pm0q; u.kind = 1; return true; }
        return false; }
    __device__ __forceinline__ const char* abase(const Unit& u) const { return QC + (size_t)u.pm * (256 * 1024 * 2) + (u.kind == 0 ? 1024 : 0); }
    __device__ __forceinline__ const char* bbase(const Unit& u) const { return WQB + (u.kind == 0 ? dkv : 0l) + (size_t)u.pn * (256 * 512 * 2); }
};
struct MoeOrder {
    int T, nN, G, c; const char* A; const char* B; size_t tstepA, tstepB, estride; const LAS int* te; const float* SA; const float* SB; int sbstride; const LAS int* remap;
    __device__ __forceinline__ const float* sa(const Unit& u) const { return SA + (size_t)u.pm * 256; }
    __device__ __forceinline__ const float* sb(const Unit& u) const { const int e = __builtin_amdgcn_readfirstlane(te[u.pm]); return SB + (size_t)e * sbstride + (size_t)u.pn * 256; }
    __device__ __forceinline__ bool next(int i, Unit& u) const {
        const int L = i * G + c; if (L >= T * nN) return false;
        tile_of(L, T, nN, u.pm, u.pn); u.kind = 0; if (remap) u.pm = __builtin_amdgcn_readfirstlane(remap[u.pm]); return true; }
    __device__ __forceinline__ const char* abase(const Unit& u) const { return A + (size_t)u.pm * tstepA; }
    __device__ __forceinline__ const char* bbase(const Unit& u) const { const int e = __builtin_amdgcn_readfirstlane(te[u.pm]); return B + (size_t)e * estride + (size_t)u.pn * tstepB; }
};

typedef const f32x4 (&AccRef)[2][2][4][2];
struct EpiInproj {
    static constexpr bool PERM = true;
    bf16* QC; bf16* KRB; bf16* U; bf16* CB; float* SSQ; const float* ROPE;
    __device__ __forceinline__ void operator()(AccRef acc, const Unit& u, int wr, int wc, int fr_, int fq_) const {
        int fr = fr_, fq = fq_; asm volatile("" : "+v"(fr), "+v"(fq));
        const int pn = u.pn, row0 = u.pm * BM + wr * 64 + fr;
        if (pn < 4) {
#pragma unroll
            for (int ai = 0; ai < 2; ++ai)
#pragma unroll
                for (int m = 0; m < 4; ++m) { const int row = row0 + ai * HALF + m * 16; float s = 0.f;
#pragma unroll
                    for (int bj = 0; bj < 2; ++bj) { const f32x4 v0 = acc[ai][bj][m][0], v1 = acc[ai][bj][m][1];
                        s += (v0[0] * v0[0] + v0[1] * v0[1]) + (v0[2] * v0[2] + v0[3] * v0[3]) + (v1[0] * v1[0] + v1[1] * v1[1]) + (v1[2] * v1[2] + v1[3] * v1[3]);
                        *(u32x4*)(QC + (size_t)row * 1024 + pn * 256 + bj * HALF + wc * 32 + 8 * fq) = pack8(v0, v1); }
                    s += __shfl_xor(s, 16); s += __shfl_xor(s, 32);
                    if (fq == 0) SSQ[(size_t)row * 16 + pn * 4 + wc] = s; }
        } else if (pn == 4) {
            if (wc < 2) {
#pragma unroll
                for (int ai = 0; ai < 2; ++ai)
#pragma unroll
                    for (int m = 0; m < 4; ++m) { const int row = row0 + ai * HALF + m * 16; f32x4 v0 = acc[ai][0][m][0], v1 = acc[ai][0][m][1];
                        if (row >= LC) { const int t = row - LC, pos = wc ? (t & 63) : (t >> 6);
                            const f32x4 cs = *(const f32x4*)(ROPE + pos * 16 + 4 * fq), sn = *(const f32x4*)(ROPE + 2048 + pos * 16 + 4 * fq);
                            const f32x4 a0 = v0, a1 = v1;
                            v0[0] = a0[0] * cs[0] - a0[1] * sn[0]; v0[1] = a0[1] * cs[0] + a0[0] * sn[0]; v0[2] = a0[2] * cs[1] - a0[3] * sn[1]; v0[3] = a0[3] * cs[1] + a0[2] * sn[1];
                            v1[0] = a1[0] * cs[2] - a1[1] * sn[2]; v1[1] = a1[1] * cs[2] + a1[0] * sn[2]; v1[2] = a1[2] * cs[3] - a1[3] * sn[3]; v1[3] = a1[3] * cs[3] + a1[2] * sn[3]; }
                        *(u32x4*)(KRB + (size_t)row * 64 + wc * 32 + 8 * fq) = pack8(v0, v1); }
            }
        } else if (pn < 21) {
            const int j = pn - 5;
#pragma unroll
            for (int ai = 0; ai < 2; ++ai)
#pragma unroll
                for (int m = 0; m < 4; ++m) { const int row = row0 + ai * HALF + m * 16;
                    *(u32x4*)(U + (size_t)row * D + j * 128 + wc * 32 + 8 * fq) = pack8(acc[ai][0][m][0] * acc[ai][1][m][0], acc[ai][0][m][1] * acc[ai][1][m][1]); }
        } else {
            bf16* dst = CB + (size_t)((pn - 21) >> 3) * ((size_t)MT * D); const int col = ((pn - 21) & 7) * 256; const bool sg = pn >= 29;
#pragma unroll
            for (int ai = 0; ai < 2; ++ai)
#pragma unroll
                for (int m = 0; m < 4; ++m) { const int row = row0 + ai * HALF + m * 16;
#pragma unroll
                    for (int bj = 0; bj < 2; ++bj) { f32x4 v0 = acc[ai][bj][m][0], v1 = acc[ai][bj][m][1];
                        if (sg) { v0 = fsig4(v0); v1 = fsig4(v1); }
                        *(u32x4*)(dst + (size_t)row * D + col + bj * HALF + wc * 32 + 8 * fq) = pack8(v0, v1); } }
        }
    }
};
struct EpiQkv {
    static constexpr bool PERM = true;
    bf16* Q; bf16* KV; const float* SSQ; const float* ROPE;
    __device__ __forceinline__ void operator()(AccRef acc, const Unit& u, int wr, int wc, int fr_, int fq_) const {
        int fr = fr_, fq = fq_; asm volatile("" : "+v"(fr), "+v"(fq));
        const int row0 = u.pm * BM + wr * 64 + fr, grp = u.kind == 0 ? 8 : 0;
#pragma unroll
        for (int ai = 0; ai < 2; ++ai) {
            float rqv[4];
#pragma unroll
            for (int m = 0; m < 4; ++m) { const int row = row0 + ai * HALF + m * 16;
                const f32x4 s0 = *(const f32x4*)(SSQ + (size_t)row * 16 + grp), s1 = *(const f32x4*)(SSQ + (size_t)row * 16 + grp + 4);
                const float rs = rsqrtf(((s0[0] + s0[1]) + (s0[2] + s0[3]) + (s1[0] + s1[1]) + (s1[2] + s1[3])) * (1.f / 512.f) + EPS);
                rqv[m] = (u.kind == 0) ? rs : rs * (ATT_SCALE * 1.4426950408889634f); }
#pragma unroll
            for (int bj = 0; bj < 2; ++bj) {
                const int hb = (u.pn * 8 + bj * 4 + wc) % 6; const bool rope = (u.kind != 0) && hb >= 4;
                f32x4 cs[4], sn[4];
                if (rope) {
#pragma unroll
                    for (int m = 0; m < 4; ++m) { const int row = row0 + ai * HALF + m * 16, t = row - LC, pos = (hb == 5) ? (t & 63) : (t >> 6);
                        if (row >= LC) { cs[m] = *(const f32x4*)(ROPE + pos * 16 + 4 * fq); sn[m] = *(const f32x4*)(ROPE + 2048 + pos * 16 + 4 * fq); }
                        else { cs[m] = (f32x4){1.f, 1.f, 1.f, 1.f}; sn[m] = (f32x4){0.f, 0.f, 0.f, 0.f}; } } }
#pragma unroll
                for (int m = 0; m < 4; ++m) { const int row = row0 + ai * HALF + m * 16; const float rq = rqv[m];
                    f32x4 v0 = acc[ai][bj][m][0] * rq, v1 = acc[ai][bj][m][1] * rq;
                    if (u.kind == 0) { *(u32x4*)(KV + (size_t)row * 4096 + u.pn * 256 + bj * HALF + wc * 32 + 8 * fq) = pack8(v0, v1); }
                    else {
                        if (rope) { const f32x4 a0 = v0, a1 = v1, c4 = cs[m], s4 = sn[m];
                            v0[0] = a0[0] * c4[0] - a0[1] * s4[0]; v0[1] = a0[1] * c4[0] + a0[0] * s4[0]; v0[2] = a0[2] * c4[1] - a0[3] * s4[1]; v0[3] = a0[3] * c4[1] + a0[2] * s4[1];
                            v1[0] = a1[0] * c4[2] - a1[1] * s4[2]; v1[1] = a1[1] * c4[2] + a1[0] * s4[2]; v1[2] = a1[2] * c4[3] - a1[3] * s4[3]; v1[3] = a1[3] * c4[3] + a1[2] * s4[3]; }
                        *(u32x4*)(Q + (size_t)row * 3072 + u.pn * 256 + bj * HALF + wc * 32 + 8 * fq) = pack8(v0, v1); } } } }
    }
};
template <int MODE> struct EpiMerge {
    static constexpr bool PERM = true;
    const bf16* SG; const bf16* M1; bf16* OUT;
    __device__ __forceinline__ void operator()(AccRef acc, const Unit& u, int wr, int wc, int fr_, int fq_) const {
        int fr = fr_, fq = fq_; asm volatile("" : "+v"(fr), "+v"(fq));
        const int row0 = u.pm * BM + wr * 64 + fr;
#pragma unroll
        for (int ai = 0; ai < 2; ++ai) { u32x4 sg[8], ad[8];
#pragma unroll
            for (int m = 0; m < 4; ++m)
#pragma unroll
                for (int bj = 0; bj < 2; ++bj) { const size_t off = (size_t)(row0 + ai * HALF + m * 16) * D + u.pn * 256 + bj * HALF + wc * 32 + 8 * fq;
                    sg[m * 2 + bj] = *(const u32x4*)(SG + off); if (MODE == 1) ad[m * 2 + bj] = *(const u32x4*)(M1 + off); }
#pragma unroll
            for (int m = 0; m < 4; ++m)
#pragma unroll
                for (int bj = 0; bj < 2; ++bj) { const size_t off = (size_t)(row0 + ai * HALF + m * 16) * D + u.pn * 256 + bj * HALF + wc * 32 + 8 * fq;
                    f32x4 g0, g1; unpack8(sg[m * 2 + bj], g0, g1);
                    f32x4 v0 = acc[ai][bj][m][0] * g0, v1 = acc[ai][bj][m][1] * g1;
                    if (MODE == 1) { f32x4 m0, m1; unpack8(ad[m * 2 + bj], m0, m1); v0 += m0; v1 += m1; }
                    *(u32x4*)(OUT + off) = pack8(v0, v1); } }
    }
};
struct EpiSwiglu {
    static constexpr bool PERM = true;
    bf16* ACT; int ld;
    __device__ __forceinline__ void operator()(AccRef acc, const Unit& u, int wr, int wc, int fr_, int fq_) const {
        int fr = fr_, fq = fq_; asm volatile("" : "+v"(fr), "+v"(fq));
        const int row0 = u.pm * BM + wr * 64 + fr;
#pragma unroll
        for (int ai = 0; ai < 2; ++ai)
#pragma unroll
            for (int m = 0; m < 4; ++m) { const int row = row0 + ai * HALF + m * 16;
                const f32x4 g0 = acc[ai][0][m][0], g1 = acc[ai][0][m][1];
                const f32x4 v0 = g0 * fsig4(g0) * acc[ai][1][m][0], v1 = g1 * fsig4(g1) * acc[ai][1][m][1];
                *(u32x4*)(ACT + (size_t)row * ld + u.pn * 128 + wc * 32 + 8 * fq) = pack8(v0, v1); }
    }
};
struct EpiResid {
    static constexpr bool PERM = false;
    float* XL; const float* SRC; const float* gl;
    __device__ __forceinline__ void operator()(AccRef acc, const Unit& u, int wr, int wc, int fr_, int fq_) const {
        int fr = fr_, fq = fq_; asm volatile("" : "+v"(fr), "+v"(fq));
        const int row0 = u.pm * BM + wr * 64 + fr; const float* gate = gl + ((u.pm == 0) ? 6 * D : 0);
#pragma unroll
        for (int bj = 0; bj < 2; ++bj) { f32x4 t[16], gv[2];
#pragma unroll
            for (int n = 0; n < 2; ++n) { const int col = u.pn * 256 + bj * HALF + wc * 32 + 16 * n + 4 * fq; gv[n] = *(const f32x4*)(gate + col);
#pragma unroll
                for (int ai = 0; ai < 2; ++ai)
#pragma unroll
                    for (int m = 0; m < 4; ++m) t[n * 8 + ai * 4 + m] = *(const f32x4*)(SRC + (size_t)(row0 + ai * HALF + m * 16) * D + col); }
#pragma unroll
            for (int n = 0; n < 2; ++n) { const int col = u.pn * 256 + bj * HALF + wc * 32 + 16 * n + 4 * fq;
#pragma unroll
                for (int ai = 0; ai < 2; ++ai)
#pragma unroll
                    for (int m = 0; m < 4; ++m) *(f32x4*)(XL + (size_t)(row0 + ai * HALF + m * 16) * D + col) = t[n * 8 + ai * 4 + m] + gv[n] * acc[ai][bj][m][n]; } }
    }
};
struct EpiStoreBf16 {
    static constexpr bool PERM = true;
    bf16* C; int ld;
    __device__ __forceinline__ void operator()(AccRef acc, const Unit& u, int wr, int wc, int fr_, int fq_) const {
        int fr = fr_, fq = fq_; asm volatile("" : "+v"(fr), "+v"(fq));
        const int row0 = u.pm * BM + wr * 64 + fr;
#pragma unroll
        for (int ai = 0; ai < 2; ++ai)
#pragma unroll
            for (int m = 0; m < 4; ++m)
#pragma unroll
                for (int bj = 0; bj < 2; ++bj)
                    *(u32x4*)(C + (size_t)(row0 + ai * HALF + m * 16) * ld + u.pn * 256 + bj * HALF + wc * 32 + 8 * fq) = pack8(acc[ai][bj][m][0], acc[ai][bj][m][1]);
    }
};
}

namespace att {
constexpr int QBLK = 32, KVBLK = 64;
constexpr int LDQ = NH * DQK, LDK = NH * 256, LDR = DR, LDO = D;
constexpr int SHM_V = KVBLK * DV * 2, SHM_K = KVBLK * DQK * 2;
constexpr int OFF_K = 2 * SHM_V, OFF_WS = 2 * SHM_V + 2 * SHM_K, OFF_QR = OFF_WS + NWAVES * 64 * 4, OFF_DO = OFF_QR + NWAVES * 4096, SHM_ATTN = OFF_DO + NTHREADS * 20;
static_assert(SHM_ATTN <= RING_BYTES, "attention scratch inside the ring");
constexpr float THR = 8.f;
constexpr int KROPE_OFF = 16384;
#define KSWZ(row, colB) ((row) * 384 + ((colB) ^ (((row) & 7) << 4)))
#define SBAR() __builtin_amdgcn_sched_barrier(0)
__device__ __forceinline__ int crow(int r, int hi) { return (r & 3) + 8 * (r >> 2) + 4 * hi; }
constexpr float THR2 = THR * 1.4426950408889634f;
template <bool FIRST> __device__ __forceinline__ void partialSM(f32x16& p0, f32x16& p1, float& m_reg, f32x16& negm, float& alpha) {
    float pmax = p0[0];
#pragma unroll
    for (int r = 1; r < 16; ++r) pmax = fmaxf(pmax, p0[r]);
#pragma unroll
    for (int r = 0; r < 16; ++r) pmax = fmaxf(pmax, p1[r]);
    { auto rr = __builtin_amdgcn_permlane32_swap(__float_as_uint(pmax), __float_as_uint(pmax), false, false);
      pmax = fmaxf(__uint_as_float(rr[0]), __uint_as_float(rr[1])); }
    alpha = 1.f;
    if (FIRST || !__builtin_expect(__all(pmax <= THR2), 1)) {
        const float d = FIRST ? pmax : fmaxf(pmax, 0.f);
        m_reg += d; if (!FIRST) alpha = __builtin_amdgcn_exp2f(-d);
#pragma unroll
        for (int r = 0; r < 16; ++r) { p0[r] -= d; p1[r] -= d; }
#pragma unroll
        for (int r = 0; r < 16; ++r) negm[r] = -m_reg;
    }
#pragma unroll
    for (int r = 0; r < 16; ++r) p0[r] = __builtin_amdgcn_exp2f(p0[r]);
}
__device__ __forceinline__ void finishSM(f32x16& p0, f32x16& p1, float alpha, float& l_reg, bf16x8& pa0, bf16x8& pa1, bf16x8& pa2, bf16x8& pa3) {
#pragma unroll
    for (int r = 0; r < 16; ++r) p1[r] = __builtin_amdgcn_exp2f(p1[r]);
    float ps = 0;
#pragma unroll
    for (int r = 0; r < 16; ++r) ps += p0[r];
#pragma unroll
    for (int r = 0; r < 16; ++r) ps += p1[r];
    { auto rr = __builtin_amdgcn_permlane32_swap(__float_as_uint(ps), __float_as_uint(ps), false, false);
      ps = __uint_as_float(rr[0]) + __uint_as_float(rr[1]); }
    l_reg = l_reg * alpha + ps;
#define PK4(P, BASE, OUT) do { u32x4 w = {cvtpk(P[BASE + 0], P[BASE + 1]), cvtpk(P[BASE + 2], P[BASE + 3]), cvtpk(P[BASE + 4], P[BASE + 5]), cvtpk(P[BASE + 6], P[BASE + 7])}; \
    OUT = __builtin_bit_cast(bf16x8, w); } while (0)
    PK4(p0, 0, pa0); PK4(p0, 8, pa1); PK4(p1, 0, pa2); PK4(p1, 8, pa3);
#undef PK4
}
__device__ __forceinline__ void qkt(f32x16& p0, f32x16& p1, const LAS char* Ks, const int (&kb)[4], int krd, const bf16x8* qr, const LAS char* qrl, const f32x16& negm) {
#pragma unroll
    for (int d0 = 0; d0 < 12; ++d0) {
        const LAS char* a = d0 < 8 ? Ks + kb[d0 & 3] + (d0 >> 2) * 128 : Ks + kb[d0 - 8] + krd;
        const bf16x8 b0 = *(const LAS bf16x8*)a;
        const bf16x8 b1 = *(const LAS bf16x8*)(a + (d0 < 8 ? 32 * 256 : 32 * 128));
        if (d0 == 0) { p0 = __builtin_amdgcn_mfma_f32_32x32x16_bf16(b0, qr[0], negm, 0, 0, 0); p1 = __builtin_amdgcn_mfma_f32_32x32x16_bf16(b1, qr[0], negm, 0, 0, 0); }
        else { const bf16x8 qf = d0 < 8 ? qr[d0 & 7] : *(const LAS bf16x8*)(qrl + (d0 - 8) * 1024);
            p0 = __builtin_amdgcn_mfma_f32_32x32x16_bf16(b0, qf, p0, 0, 0, 0); p1 = __builtin_amdgcn_mfma_f32_32x32x16_bf16(b1, qf, p1, 0, 0, 0); } }
}
template <int OFF> __device__ __forceinline__ bf16x8 dsr128(int addr) { bf16x8 r; asm volatile("ds_read_b128 %0, %1 offset:%2" : "=v"(r) : "v"(addr), "i"(OFF) : "memory"); return r; }
#define QK_WAIT(n) do { asm volatile("s_waitcnt lgkmcnt(" #n ")" ::: "memory"); SBAR(); } while (0)
template <int SLOT> __device__ __forceinline__ void qkt2(f32x16& p0, f32x16& p1, const int (&nb)[4], const int (&rb)[4], int qrl, const bf16x8* qr, const f32x16& negm) {
    constexpr int S = SLOT * SHM_K;
    bf16x8 a0, a1, b0, b1, qa, qb;
#define RD_N(s, K0, K1) do { K0 = dsr128<S + ((s) >> 2) * 128>(nb[(s) & 3]); K1 = dsr128<S + ((s) >> 2) * 128 + 8192>(nb[(s) & 3]); } while (0)
#define RD_R(s, K0, K1, Q) do { K0 = dsr128<S + KROPE_OFF>(rb[(s) - 8]); K1 = dsr128<S + KROPE_OFF + 4096>(rb[(s) - 8]); Q = dsr128<((s) - 8) * 1024>(qrl); } while (0)
#define MM(K0, K1, Q) do { p0 = __builtin_amdgcn_mfma_f32_32x32x16_bf16(K0, Q, p0, 0, 0, 0); p1 = __builtin_amdgcn_mfma_f32_32x32x16_bf16(K1, Q, p1, 0, 0, 0); SBAR(); } while (0)
    RD_N(0, a0, a1); RD_N(1, b0, b1);
    QK_WAIT(2); p0 = __builtin_amdgcn_mfma_f32_32x32x16_bf16(a0, qr[0], negm, 0, 0, 0); p1 = __builtin_amdgcn_mfma_f32_32x32x16_bf16(a1, qr[0], negm, 0, 0, 0); SBAR(); RD_N(2, a0, a1);
    QK_WAIT(2); MM(b0, b1, qr[1]); RD_N(3, b0, b1);
    QK_WAIT(2); MM(a0, a1, qr[2]); RD_N(4, a0, a1);
    QK_WAIT(2); MM(b0, b1, qr[3]); RD_N(5, b0, b1);
    QK_WAIT(2); MM(a0, a1, qr[4]); RD_N(6, a0, a1);
    QK_WAIT(2); MM(b0, b1, qr[5]); RD_N(7, b0, b1);
    QK_WAIT(2); MM(a0, a1, qr[6]); RD_R(8, a0, a1, qa);
    QK_WAIT(3); MM(b0, b1, qr[7]); RD_R(9, b0, b1, qb);
    QK_WAIT(3); MM(a0, a1, qa); RD_R(10, a0, a1, qa);
    QK_WAIT(3); MM(b0, b1, qb); RD_R(11, b0, b1, qb);
    QK_WAIT(3); MM(a0, a1, qa);
    QK_WAIT(0); MM(b0, b1, qb);
#undef RD_N
#undef RD_R
#undef MM
}
__device__ __forceinline__ int v_st(int k, int c) { const int kk = (k & ~0xC) | ((k & 4) << 1) | ((k & 8) >> 1); return ((kk >> 3) * 4 + (c >> 5)) * 512 + ((kk & 7) * 32 + (c & 31)) * 2; }
__device__ __forceinline__ int v_rd_base(int lane) { return ((lane & 3) << 3) | (((lane >> 2) & 3) << 6) | (((lane >> 4) & 1) << 5) | (((lane >> 5) & 1) << 8); }
constexpr int v_rd_off(int d0, int ks, int half) { return d0 * 512 + ks * 4096 + half * 2048; }
template <int OFF> __device__ __forceinline__ s16x4 tr_read(int vb) {
    s16x4 r; asm volatile("ds_read_b64_tr_b16 %0, %1 offset:%2" : "=&v"(r) : "v"(vb), "i"(OFF) : "memory"); return r;
}
template <int D0> __device__ __forceinline__ void pv_one(f32x16& od, int vb, bf16x8 pa0, bf16x8 pa1, bf16x8 pa2, bf16x8 pa3) {
    const s16x4 l0 = tr_read<v_rd_off(D0, 0, 0)>(vb), h0 = tr_read<v_rd_off(D0, 0, 1)>(vb), l1 = tr_read<v_rd_off(D0, 1, 0)>(vb), h1 = tr_read<v_rd_off(D0, 1, 1)>(vb);
    const s16x4 l2 = tr_read<v_rd_off(D0, 2, 0)>(vb), h2 = tr_read<v_rd_off(D0, 2, 1)>(vb), l3 = tr_read<v_rd_off(D0, 3, 0)>(vb), h3 = tr_read<v_rd_off(D0, 3, 1)>(vb);
    asm volatile("s_waitcnt lgkmcnt(0)" ::: "memory"); SBAR();
#define PK(L, H) (bf16x8){L[0], L[1], L[2], L[3], H[0], H[1], H[2], H[3]}
    od = __builtin_amdgcn_mfma_f32_32x32x16_bf16(PK(l0, h0), pa0, od, 0, 0, 0);
    od = __builtin_amdgcn_mfma_f32_32x32x16_bf16(PK(l1, h1), pa1, od, 0, 0, 0);
    od = __builtin_amdgcn_mfma_f32_32x32x16_bf16(PK(l2, h2), pa2, od, 0, 0, 0);
    od = __builtin_amdgcn_mfma_f32_32x32x16_bf16(PK(l3, h3), pa3, od, 0, 0, 0);
#undef PK
}
__device__ __forceinline__ void pv_d0(f32x16* o, int vb, bf16x8 pa0, bf16x8 pa1, bf16x8 pa2, bf16x8 pa3) {
    pv_one<0>(o[0], vb, pa0, pa1, pa2, pa3); pv_one<1>(o[1], vb, pa0, pa1, pa2, pa3); pv_one<2>(o[2], vb, pa0, pa1, pa2, pa3); pv_one<3>(o[3], vb, pa0, pa1, pa2, pa3);
}
__device__ __forceinline__ void attn_unit(const bf16* Qb, const bf16* KVb, int hoff, const bf16* KRb, bf16* Ob, int seq, LAS char* lds) {
    int tid = threadIdx.x; asm volatile("" : "+v"(tid));
    const int wid = __builtin_amdgcn_readfirstlane(tid >> 6), lane = tid & 63, r32 = lane & 31, hi = lane >> 5;
    LAS char* V_lds = lds; LAS char* K_lds = lds + OFF_K;
        float m_reg = 0.f, l_reg = 0; f32x16 o[4]; bf16x8 qr[8]; f32x16 negm;
#pragma unroll
    for (int r = 0; r < 16; ++r) negm[r] = 0.f;
#pragma unroll
    for (int d = 0; d < 4; ++d)
#pragma unroll
        for (int r = 0; r < 16; ++r) o[d][r] = 0.f;
    const bf16* Qw = Qb + (long)(wid * QBLK + r32) * LDQ + hi * 8;
#pragma unroll
    for (int d0 = 0; d0 < 8; ++d0) qr[d0] = *(const bf16x8*)(Qw + d0 * 16);
    LAS char* qrl = lds + OFF_QR + wid * 4096 + lane * 16;
    { bf16x8 tq[4];
#pragma unroll
      for (int d0 = 8; d0 < 12; ++d0) tq[d0 - 8] = *(const bf16x8*)(Qw + d0 * 16);
      __builtin_amdgcn_sched_barrier(0);
#pragma unroll
      for (int d0 = 8; d0 < 12; ++d0) *(LAS bf16x8*)(qrl + (d0 - 8) * 1024) = tq[d0 - 8]; }
    int kb[4];
#pragma unroll
    for (int i = 0; i < 4; ++i) kb[i] = r32 * 256 + (((2 * i + hi) ^ (r32 & 7)) << 4);
    const int krd = KROPE_OFF - r32 * 128; (void)krd;
    int nbase[4], rbase[4];
#pragma unroll
    for (int i = 0; i < 4; ++i) { nbase[i] = (int)(uintptr_t)K_lds + kb[i]; rbase[i] = nbase[i] - r32 * 128; }
    const int vb0 = (int)(uintptr_t)V_lds + v_rd_base(lane);
    unsigned gk[2], gv[2], gr;
#pragma unroll
    for (int i = 0; i < 2; ++i) { const int s = (wid + 8 * i) * 64 + lane;
        { const int row = s >> 4, lc = (s & 15) ^ (row & 7); gk[i] = (unsigned)(row * (LDK * 2) + lc * 16); }
        { const int st = s >> 5, k = (st >> 2) * 8 + ((s & 31) >> 2), cc = (st & 3) * 32 + (s & 3) * 8; gv[i] = (unsigned)(k * (LDK * 2) + cc * 2); } }
    { const int s = wid * 64 + lane, row = s >> 3, lc = (s & 7) ^ (row & 7); gr = (unsigned)(row * (LDR * 2) + lc * 16); }
    LAS u32x4* dofs = (LAS u32x4*)(lds + OFF_DO + tid * 16); LAS unsigned* dofr = (LAS unsigned*)(lds + OFF_DO + NTHREADS * 16 + tid * 4);
    *dofs = (u32x4){gk[0], gk[1], gv[0], gv[1]}; *dofr = gr;
    const unsigned ldsw = (unsigned)wid * 1024u;
    const __amdgpu_buffer_rsrc_t rkv = __builtin_amdgcn_make_buffer_rsrc((void*)KVb, 0, (int)((size_t)MT * LDK * 2), 0x00020000);
    const __amdgpu_buffer_rsrc_t rkr = __builtin_amdgcn_make_buffer_rsrc((void*)KRb, 0, (int)((size_t)MT * LDR * 2), 0x00020000);
#define DMA_K(t, slot) do { const int ko_ = (t) * (KVBLK * LDK * 2) + hoff, ro_ = (t) * (KVBLK * LDR * 2); const u32x4 of_ = dq; const unsigned gr_ = dr; \
    __builtin_amdgcn_raw_ptr_buffer_load_lds(rkv, (LAS void*)(K_lds + (slot) * SHM_K + ldsw), 16, (int)of_.x, ko_, 0, 0); \
    __builtin_amdgcn_raw_ptr_buffer_load_lds(rkv, (LAS void*)(K_lds + (slot) * SHM_K + 8192 + ldsw), 16, (int)of_.y, ko_, 0, 0); \
    __builtin_amdgcn_raw_ptr_buffer_load_lds(rkr, (LAS void*)(K_lds + (slot) * SHM_K + KROPE_OFF + ldsw), 16, (int)gr_, ro_, 0, 0); } while (0)
#define DMA_V(t, slot) do { const int vo_ = (t) * (KVBLK * LDK * 2) + hoff + DN * 2; const u32x4 of_ = dq; \
    __builtin_amdgcn_raw_ptr_buffer_load_lds(rkv, (LAS void*)(V_lds + (slot) * SHM_V + ldsw), 16, (int)of_.z, vo_, 0, 0); \
    __builtin_amdgcn_raw_ptr_buffer_load_lds(rkv, (LAS void*)(V_lds + (slot) * SHM_V + 8192 + ldsw), 16, (int)of_.w, vo_, 0, 0); } while (0)
#define WAITBAR() asm volatile("s_waitcnt vmcnt(0) lgkmcnt(0)\n\ts_barrier" ::: "memory")
    u32x4 dq; unsigned dr; const int dofs_a = (int)(uintptr_t)dofs, dofr_a = (int)(uintptr_t)dofr;
#define DOFS_LOAD() do { dq = __builtin_bit_cast(u32x4, dsr128<0>(dofs_a)); asm volatile("ds_read_b32 %0, %1" : "=v"(dr) : "v"(dofr_a) : "memory"); } while (0)
#define RESC(a) do { if (__any((a) < 1.f)) { \
    _Pragma("unroll") for (int d = 0; d < 4; ++d) _Pragma("unroll") for (int r = 0; r < 16; ++r) o[d][r] *= (a); } } while (0)
    f32x16 pA0, pA1, pB0, pB1; float alA, alB; bf16x8 pa0, pa1, pa2, pa3; const int NT = seq / KVBLK;
    if (wid >= 4) __builtin_amdgcn_s_setprio(1);
    DOFS_LOAD(); asm volatile("s_waitcnt lgkmcnt(0)" ::: "memory");
    DMA_K(0, 0); DMA_V(0, 0); WAITBAR();
    DMA_K(1, 1);
    att::qkt2<0>(pA0, pA1, nbase, rbase, (int)(uintptr_t)qrl, qr, negm); partialSM<true>(pA0, pA1, m_reg, negm, alA);
    DOFS_LOAD(); WAITBAR();
#ifndef ATT_ALIGN
#define ATT_ALIGN 6
#endif
#ifndef ATT_PAD
#define ATT_PAD 4
#endif
    asm volatile(".p2align %0\n\t.rept %1\n\ts_nop 0\n\t.endr" :: "n"(ATT_ALIGN), "n"(ATT_PAD));
    for (int j = 1; j + 1 < NT; j += 2) {
        DMA_K(j + 1, 0); DMA_V(j, 1);
        SBAR(); att::qkt2<1>(pB0, pB1, nbase, rbase, (int)(uintptr_t)qrl, qr, negm);
        finishSM(pA0, pA1, alA, l_reg, pa0, pa1, pa2, pa3); SBAR();
        pv_d0(o, vb0, pa0, pa1, pa2, pa3); partialSM<false>(pB0, pB1, m_reg, negm, alB);
        RESC(alB); DOFS_LOAD(); WAITBAR();
        DMA_K(j + 2, 1); DMA_V(j + 1, 0);
        SBAR(); att::qkt2<0>(pA0, pA1, nbase, rbase, (int)(uintptr_t)qrl, qr, negm);
        finishSM(pB0, pB1, alB, l_reg, pa0, pa1, pa2, pa3); SBAR();
        pv_d0(o, vb0 + SHM_V, pa0, pa1, pa2, pa3); partialSM<false>(pA0, pA1, m_reg, negm, alA);
        RESC(alA); DOFS_LOAD(); WAITBAR();
    }
    DMA_V(NT - 1, 1);
    SBAR(); att::qkt2<1>(pB0, pB1, nbase, rbase, (int)(uintptr_t)qrl, qr, negm);
    finishSM(pA0, pA1, alA, l_reg, pa0, pa1, pa2, pa3); SBAR();
    pv_d0(o, vb0, pa0, pa1, pa2, pa3); partialSM<false>(pB0, pB1, m_reg, negm, alB);
    RESC(alB); WAITBAR();
    finishSM(pB0, pB1, alB, l_reg, pa0, pa1, pa2, pa3); SBAR();
    pv_d0(o, vb0 + SHM_V, pa0, pa1, pa2, pa3);
    const float rli = __builtin_amdgcn_rcpf(l_reg);
    WAITBAR();
    LAS char* stg = lds + wid * 8704 + r32 * 272 + hi * 8;
#pragma unroll
    for (int d0 = 0; d0 < 4; ++d0)
#pragma unroll
        for (int g = 0; g < 4; ++g) { u32x2 w; w.x = cvtpk(o[d0][4 * g] * rli, o[d0][4 * g + 1] * rli); w.y = cvtpk(o[d0][4 * g + 2] * rli, o[d0][4 * g + 3] * rli);
            *(LAS u32x2*)(stg + (32 * d0 + 8 * g) * 2) = w; }
    asm volatile("s_waitcnt lgkmcnt(0)" ::: "memory");
    bf16* Ow = Ob + (long)(wid * QBLK) * LDO;
#pragma unroll
    for (int i = 0; i < 8; ++i) { const int row = i * 4 + (lane >> 4), ch = lane & 15; const u32x4 v = *(const LAS u32x4*)(lds + wid * 8704 + row * 272 + ch * 16); *(u32x4*)(Ow + (long)row * LDO + ch * 8) = v; }
    WAITBAR();
    __builtin_amdgcn_s_setprio(0);
#undef DMA_K
#undef DMA_V
#undef WAITBAR
#undef DOFS_LOAD
#undef RESC
}
#undef KSWZ
#undef SBAR
}

#define XB_TMO      128
#define XB_XCNT(j)  (256  + 64 * (j))
#define XB_XSUB(j)  (1280 + 64 * (j))
#define XB_XGEN(j)  (2304 + 64 * (j))
#define XB_TOP      3328
#define XB_TOPGEN   3392
#define XCD_BAR_WORDS 3456
#define XB_SPIN_CAP (1u << 18)
__device__ __forceinline__ unsigned xb_ld(unsigned* p)              { return __hip_atomic_load(p, __ATOMIC_RELAXED, __HIP_MEMORY_SCOPE_AGENT); }
__device__ __forceinline__ unsigned xb_add(unsigned* p, unsigned v) { return __hip_atomic_fetch_add(p, v, __ATOMIC_RELAXED, __HIP_MEMORY_SCOPE_AGENT); }
__device__ __forceinline__ unsigned xb_xcc_id() { return (unsigned)__builtin_amdgcn_s_getreg((3 << 11) | 20) & 0xFu; }
#define XB_SPIN(cond, bar) do { unsigned _sp = 0; while (cond) { __builtin_amdgcn_s_sleep(1); \
    if ((++_sp & 255u) == 0u) { if (xb_ld(&(bar)[XB_TMO])) break; if (_sp > XB_SPIN_CAP) { atomicAdd(&(bar)[XB_TMO], 1u); break; } } } } while (0)
struct XcdBarrier { unsigned* bar; unsigned x; volatile LAS unsigned* st; };
__device__ __forceinline__ XcdBarrier xcd_barrier_post(unsigned* bar, volatile LAS unsigned* st) {
    XcdBarrier b; b.bar = bar; b.x = xb_xcc_id(); b.st = st;
    if (threadIdx.x == 0) (void)xb_add(&bar[XB_XCNT(b.x)], 1u);
    return b;
}
__device__ __forceinline__ void xcd_barrier_complete(unsigned* bar, unsigned x, unsigned& nloc, unsigned& nx) {
    const unsigned G = gridDim.x * gridDim.y * gridDim.z;
    unsigned sum, cnt, mine, sp = 0u;
    for (;;) {
        sum = 0u; cnt = 0u; mine = 0u;
        unsigned cv[16];
#pragma unroll
        for (unsigned j = 0; j < 16; ++j) cv[j] = xb_ld(&bar[XB_XCNT(j)]);
        __builtin_amdgcn_sched_barrier(0);
#pragma unroll
        for (unsigned j = 0; j < 16; ++j) { const unsigned c = cv[j]; sum += c; cnt += (c > 0u) ? 1u : 0u; mine = (j == x) ? c : mine; }
        if (sum == G) break;
        __builtin_amdgcn_s_sleep(1);
        if ((++sp & 255u) == 0u) { if (xb_ld(&bar[XB_TMO])) break; if (sp > XB_SPIN_CAP) { atomicAdd(&bar[XB_TMO], 1u); break; } }
    }
    nloc = mine > 0u ? mine : 1u; nx = cnt > 0u ? cnt : 1u;
}
__device__ __forceinline__ void xcd_barrier(const XcdBarrier& b) {
    asm volatile("s_waitcnt vmcnt(0)" ::: "memory");
    __syncthreads();
    if (threadIdx.x == 0) {
        unsigned* bar = b.bar;
        __builtin_amdgcn_s_waitcnt(0);
        unsigned nloc = b.st[0], nx = b.st[1];
        if (nloc == 0u) { xcd_barrier_complete(bar, b.x, nloc, nx); b.st[0] = nloc; b.st[1] = nx; }
        const unsigned old = xb_add(&bar[XB_XSUB(b.x)], 1u);
        const unsigned gen = old / nloc;
        if (old + 1u == (gen + 1u) * nloc) {
            __builtin_amdgcn_fence(__ATOMIC_RELEASE, "agent");
            asm volatile("s_waitcnt vmcnt(0)" ::: "memory");
            const unsigned og = xb_add(&bar[XB_TOP], 1u);
            const unsigned tg = og / nx;
            if (og + 1u == (tg + 1u) * nx) xb_add(&bar[XB_TOPGEN], 1u);
            else XB_SPIN(xb_ld(&bar[XB_TOPGEN]) == tg, bar);
            __builtin_amdgcn_fence(__ATOMIC_ACQUIRE, "agent");
            xb_add(&bar[XB_XGEN(b.x)], 1u);
            asm volatile("s_waitcnt vmcnt(0)" ::: "memory");
        } else {
            XB_SPIN(xb_ld(&bar[XB_XGEN(b.x)]) == gen, bar);
            __builtin_amdgcn_fence(__ATOMIC_ACQUIRE, "agent");
            asm volatile("s_waitcnt vmcnt(0)" ::: "memory");
        }
    }
    __syncthreads();
}

struct Params { const float* in[25]; float* out; unsigned char* ws; int ph_lo, ph_hi; };
static_assert(sizeof(Params) == 25 * 8 + 8 + 8 + 8, "Params has no padding");
struct Ctx { LAS unsigned char* lds; int tid, lane, wave, vcu, G, bid; };
__device__ __forceinline__ Ctx fresh(const Ctx& c) {
    Ctx f; f.lds = c.lds; int tid = c.tid; asm volatile("" : "+v"(tid)); f.tid = tid; f.lane = tid & 63; f.wave = __builtin_amdgcn_readfirstlane(tid >> 6);
    int vcu = c.vcu, G = c.G, bid = c.bid; asm volatile("" : "+v"(vcu), "+v"(G), "+v"(bid));
    f.vcu = __builtin_amdgcn_readfirstlane(vcu); f.G = __builtin_amdgcn_readfirstlane(G); f.bid = __builtin_amdgcn_readfirstlane(bid); return f; }
__device__ __forceinline__ unsigned char* fresh_ptr(unsigned char* p) { unsigned lo = (unsigned)(unsigned long long)p, hi = (unsigned)((unsigned long long)p >> 32); asm volatile("" : "+v"(lo), "+v"(hi));
    const unsigned long long v = ((unsigned long long)(unsigned)__builtin_amdgcn_readfirstlane((int)hi) << 32) | (unsigned)__builtin_amdgcn_readfirstlane((int)lo); return (unsigned char*)(GAS unsigned char*)v; }

__device__ __forceinline__ int win_dst(int s) {
    if (s < 1024) return s;
    if (s < 1088) { const int j = s - 1024, part = j >> 5, w = j & 31; return 1024 + part * 32 + 2 * (w & 15) + (w >> 4); }
    if (s < 3136) { const int c = s - 1088; return 1280 + 256 * (c >> 7) + (c & 127); }
    if (s < 5184) { return 5376 + (s - 3136); }
    if (s < 7232) { const int c = s - 5184; return 1280 + 256 * (c >> 7) + 128 + (c & 127); }
    if (s < 9280) { return 7424 + (s - 7232); }
    return 9472 + (s - 9280);
}
__device__ __forceinline__ int qb_dst(int n) { const int h = n / DQK, d = n - h * DQK; if (d < DN) return n; const int j = d - DN, part = j >> 5, w = j & 31; return h * DQK + DN + part * 32 + 2 * (w & 15) + (w >> 4); }
__device__ __forceinline__ int map_dst(int mode, int n) {
    switch (mode) { case 1: return win_dst(n); case 2: return qb_dst(n); case 3: return 256 * (n >> 7) + (n & 127); case 4: return 256 * (n >> 7) + 128 + (n & 127); default: return n; }
}
__device__ __forceinline__ void transpose_item(const float* W, int K, int N, bf16* WT, int mode, const float* gk, int item, int lane) {
    const int kblk = K / 64, nb = item / kblk, kb = item - nb * kblk, k0 = 64 * kb + 16 * (lane >> 4), n0 = 64 * nb + 4 * (lane & 15);
    const float* src = W + (size_t)k0 * N + n0;
    f32x4 v[16];
#pragma unroll
    for (int i = 0; i < 16; ++i) v[i] = *(const f32x4*)(src + (size_t)i * N);
    if (gk) {
#pragma unroll
        for (int i = 0; i < 16; ++i) v[i] *= gk[k0 + i]; }
#pragma unroll
    for (int x = 0; x < 4; ++x) { bf16* d = WT + (size_t)map_dst(mode, n0 + x) * K + k0;
        u32x4 lo, hi;
        lo.x = cvtpk(v[0][x], v[1][x]); lo.y = cvtpk(v[2][x], v[3][x]); lo.z = cvtpk(v[4][x], v[5][x]); lo.w = cvtpk(v[6][x], v[7][x]);
        hi.x = cvtpk(v[8][x], v[9][x]); hi.y = cvtpk(v[10][x], v[11][x]); hi.z = cvtpk(v[12][x], v[13][x]); hi.w = cvtpk(v[14][x], v[15][x]);
        *(u32x4*)d = lo; *(u32x4*)(d + 8) = hi; }
}
struct Strip { const float* W; int N, mode, nb; signed char* w8; float* wsc; };
constexpr int ST_IN = DIN / 32, ST_GD = DFF / 32, ST_GE = DFE / 32, N_STRIPS = 2 * ST_IN + 2 * ST_GD + NE * 2 * ST_GE;
__device__ __forceinline__ Strip strip_of(const Params& p, int sid) {
    unsigned char* wb = p.ws + WS_W; float* wsc = (float*)(p.ws + WS_WSC);
    Strip q;
    if (sid < 2 * ST_IN) { const int l = sid / ST_IN; q.nb = sid - l * ST_IN; q.W = p.in[7] + (size_t)l * D * DIN; q.N = DIN; q.mode = 1; q.w8 = (signed char*)(wb + W_IN + l * W_IN_L); q.wsc = wsc + SC_IN + l * NIN; return q; }
    sid -= 2 * ST_IN;
    if (sid < 2 * ST_GD) { const int which = sid / ST_GD; q.nb = sid - which * ST_GD; q.W = p.in[17 + which]; q.N = DFF; q.mode = 3 + which; q.w8 = (signed char*)(wb + W_GU); q.wsc = wsc + SC_GU; return q; }
    sid -= 2 * ST_GD;
    { const int e = sid / (2 * ST_GE); sid -= e * (2 * ST_GE); const int which = sid / ST_GE; q.nb = sid - which * ST_GE; q.W = p.in[21 + which] + (size_t)e * D * DFE; q.N = DFE; q.mode = 3 + which;
      q.w8 = (signed char*)(wb + W_GUE + e * W_GUE_E); q.wsc = wsc + SC_GUE + e * 2 * DFE; return q; }
}
__device__ __forceinline__ unsigned pack4i8(float a, float b, float c, float d) {
    const int ia = (int)__builtin_rintf(a), ib = (int)__builtin_rintf(b), ic = (int)__builtin_rintf(c), id = (int)__builtin_rintf(d);
    return ((unsigned)ia & 0xffu) | (((unsigned)ib & 0xffu) << 8) | (((unsigned)ic & 0xffu) << 16) | ((unsigned)id << 24); }
__device__ __forceinline__ void quant_strip(const Strip& q, const Ctx& c, LAS float* cmax  ) {
    const int qd = c.lane >> 3, c4 = 4 * (c.lane & 7), n0 = 32 * q.nb + c4;
    const float* src = q.W + (size_t)(128 * c.wave + 16 * qd) * q.N + n0;
    f32x4 v[32];
#pragma unroll
    for (int b = 0; b < 2; ++b)
#pragma unroll
        for (int i = 0; i < 16; ++i) v[16 * b + i] = *(const f32x4*)(src + (size_t)(1024 * b + i) * q.N);
    f32x4 m = __builtin_elementwise_abs(v[0]);
#pragma unroll
    for (int i = 1; i < 32; ++i) m = __builtin_elementwise_max(m, __builtin_elementwise_abs(v[i]));
#pragma unroll
    for (int x = 0; x < 4; ++x) { float t = m[x]; t = fmaxf(t, __shfl_xor(t, 8)); t = fmaxf(t, __shfl_xor(t, 16)); t = fmaxf(t, __shfl_xor(t, 32)); m[x] = t; }
    if (c.lane < 8) *(LAS f32x4*)(cmax + c.wave * 32 + c4) = m;
    __syncthreads();
    f32x4 am = *(const LAS f32x4*)(cmax + c4);
#pragma unroll
    for (int w = 1; w < 8; ++w) am = __builtin_elementwise_max(am, *(const LAS f32x4*)(cmax + w * 32 + c4));
    f32x4 inv; int dst[4];
#pragma unroll
    for (int x = 0; x < 4; ++x) { inv[x] = am[x] > 0.f ? 127.f / am[x] : 0.f; dst[x] = map_dst(q.mode, n0 + x); }
    if (c.wave == 0 && c.lane < 8) {
#pragma unroll
        for (int x = 0; x < 4; ++x) q.wsc[dst[x]] = am[x] * (1.f / 127.f); }
#pragma unroll
    for (int b = 0; b < 2; ++b) { const int k0 = 1024 * b + 128 * c.wave + 16 * qd;
#pragma unroll
        for (int x = 0; x < 4; ++x) { const float iv = inv[x]; const f32x4* u = v + 16 * b;
            u32x4 o; o.x = pack4i8(u[0][x] * iv, u[1][x] * iv, u[2][x] * iv, u[3][x] * iv); o.y = pack4i8(u[4][x] * iv, u[5][x] * iv, u[6][x] * iv, u[7][x] * iv);
            o.z = pack4i8(u[8][x] * iv, u[9][x] * iv, u[10][x] * iv, u[11][x] * iv); o.w = pack4i8(u[12][x] * iv, u[13][x] * iv, u[14][x] * iv, u[15][x] * iv);
            *(u32x4*)(q.w8 + (size_t)dst[x] * D + k0) = o; } }
    __syncthreads();
}
constexpr int I_QB = (QL / 64) * (NH * DQK / 64), I_KVB = (KVL / 64) * (NH * 256 / 64), I_SQ = (D / 64) * (D / 64), I_L = I_QB + I_KVB + 3 * I_SQ;
constexpr int I_DD = (DFF / 64) * (D / 64), I_DE = (DFE / 64) * (D / 64);
constexpr int N_ADA = 2 * KS_ADA * 48, N_SMALL = N_ADA + 2 * I_L + I_DD + NE * I_DE, SMALL_BATCH = 8, N_BATCH = (N_SMALL + SMALL_BATCH - 1) / SMALL_BATCH, N_QUEUE = N_STRIPS + N_BATCH;
__device__ __forceinline__ void small_item(const Params& p, const Ctx& c, int it, const LAS float* sil) {
    unsigned char* ws = p.ws; unsigned char* wb = ws + WS_W;
    if (it < N_ADA) {
        float* part = (float*)(ws + WS_PART); const int cg = it % 48, lk = it / 48, kc = lk % KS_ADA, l = lk / KS_ADA;
        const float* W = p.in[4] + (size_t)l * D * (6 * D) + (size_t)(kc * 128) * (6 * D) + cg * 256 + c.lane * 4;
        float zf = 0.f; asm volatile("" : "+v"(zf)); f32x4 al = {zf, zf, zf, zf}, ac = al;
#pragma unroll 1
        for (int k0 = 0; k0 < 128; k0 += 16) { f32x4 w[16];
#pragma unroll
            for (int u = 0; u < 16; ++u) w[u] = *(const f32x4*)(W + (size_t)(k0 + u) * (6 * D));
            __builtin_amdgcn_sched_barrier(0);
#pragma unroll
            for (int u = 0; u < 16; ++u) { al += w[u] * sil[kc * 128 + k0 + u]; ac += w[u] * sil[D + kc * 128 + k0 + u]; } }
        *(f32x4*)(part + ((size_t)(l * KS_ADA + kc) * 2 + 0) * (6 * D) + cg * 256 + c.lane * 4) = al;
        *(f32x4*)(part + ((size_t)(l * KS_ADA + kc) * 2 + 1) * (6 * D) + cg * 256 + c.lane * 4) = ac; return; }
    int r = it - N_ADA;
    if (r < 2 * I_L) { const int l = r / I_L; r -= l * I_L;
        if (r < I_QB) { transpose_item(p.in[9] + (size_t)l * QL * NH * DQK, QL, NH * DQK, (bf16*)(wb + W_QB + l * W_QB_L), 2, p.in[8] + l * QL, r, c.lane); return; } r -= I_QB;
        if (r < I_KVB) { transpose_item(p.in[11] + (size_t)l * KVL * NH * 256, KVL, NH * 256, (bf16*)(wb + W_KVB + l * W_KVB_L), 0, p.in[10] + l * KVL, r, c.lane); return; } r -= I_KVB;
        const int which = r / I_SQ; r -= which * I_SQ;
        transpose_item(p.in[13 + which] + (size_t)l * D * D, D, D, (bf16*)(wb + (which == 0 ? W_OA : which == 1 ? W_OB : W_O) + l * W_SQ_L), 0, nullptr, r, c.lane); return; }
    r -= 2 * I_L;
    if (r < I_DD) { transpose_item(p.in[19], DFF, D, (bf16*)(wb + W_DD), 0, nullptr, r, c.lane); return; }
    r -= I_DD;
    { const int e = r / I_DE; r -= e * I_DE; transpose_item(p.in[23] + (size_t)e * DFE * D, DFE, D, (bf16*)(wb + W_DE + e * W_DE_E), 0, nullptr, r, c.lane); }
}
constexpr int CW_QHEAD = 2048;
__device__ __forceinline__ void p0_prologue(const Params& p, const Ctx& c) {
    unsigned char* ws = p.ws; unsigned char* wb = ws + WS_W;
    const int gt = c.vcu * NTHREADS + c.tid, NGT = c.G * NTHREADS;
    LAS float* sil = (LAS float*)(c.lds + 98304);
    LAS float* cmax = (LAS float*)(c.lds + 114688);
    LAS int* qslot = (LAS int*)(c.lds + 116736);
    for (int k = c.tid; k < 2 * D; k += NTHREADS) { const float x = k < D ? p.in[1][k] : p.in[3][k - D]; sil[k] = x / (1.f + expf(-x)); }
    { float* rope = (float*)(ws + WS_ROPE);
      for (int i = gt; i < 2048; i += NGT) { const int pos = i >> 4, k = i & 15; const float ang = (float)pos * powf(10000.f, -(float)(2 * k) / 32.f); rope[i] = cosf(ang); rope[2048 + i] = sinf(ang); } }
    { const int n16 = 192 * D / 16; unsigned zu = 0u; asm volatile("" : "+v"(zu));
      for (int i = gt; i < 2 * n16; i += NGT) { const int l = i / n16, r = i - l * n16; *(u32x4*)(wb + W_IN + l * W_IN_L + (size_t)1088 * D + (size_t)r * 16) = (u32x4){zu, zu, zu, zu}; }
      for (int i = gt; i < 2 * 192; i += NGT) { const int l = i / 192, r = i - l * 192; ((float*)(ws + WS_WSC))[SC_IN + l * NIN + 1088 + r] = __uint_as_float(zu); } }
    __syncthreads();
    unsigned* head = (unsigned*)(ws + WS_CTL) + CW_QHEAD;
    for (;;) {
        if (c.tid == 0) *qslot = (int)__hip_atomic_fetch_add(head, 1u, __ATOMIC_RELAXED, __HIP_MEMORY_SCOPE_AGENT);
        __syncthreads();
        const int id = __builtin_amdgcn_readfirstlane(*qslot);
        __syncthreads();
        if (id >= N_QUEUE) break;
        if (id < N_STRIPS) { quant_strip(strip_of(p, id), c, cmax); continue; }
        const int base = (id - N_STRIPS) * SMALL_BATCH;
#pragma unroll 1
        for (int j = 0; j < SMALL_BATCH / NWAVES; ++j) { const int it = base + j * NWAVES + c.wave; if (it < N_SMALL) small_item(p, c, it, sil); }
    }
}
__device__ __forceinline__ void p1_mod(const Params& p, const Ctx& c) {
    const float* part = (const float*)(p.ws + WS_PART); float* mod = (float*)(p.ws + WS_MOD);
    for (int i = c.vcu * NTHREADS + c.tid; i < 4 * 6 * D; i += c.G * NTHREADS) { const int n = i % (6 * D), lv = i / (6 * D), l = lv >> 1, v = lv & 1;
        float s = p.in[5][l * 6 * D + n];
#pragma unroll
        for (int kc = 0; kc < KS_ADA; ++kc) s += part[((size_t)(l * KS_ADA + kc) * 2 + v) * (6 * D) + n];
        mod[i] = s; }
}
__device__ __forceinline__ void norm_pass(const Params& p, const Ctx& c, int layer, int which, int row_lo, bool moe, bool local_mod) {
    const float* XL = (const float*)(p.ws + WS_XL); unsigned char* HN = p.ws + WS_HN; float* HSC = (float*)(p.ws + WS_HSC); const float* mod = (const float*)(p.ws + WS_MOD);
    const bool from_in = (layer == 0 && which == 0);
    const float* g = (which ? p.in[16] : p.in[6]) + layer * D;
    const int gw = c.vcu * NWAVES + c.wave, NGW = c.G * NWAVES;
    LAS float* lmod = (LAS float*)(c.lds + 65536);
    if (local_mod) { const float* part = (const float*)(p.ws + WS_PART);
#pragma unroll 4
        for (int i = c.tid; i < 4 * D; i += NTHREADS) { const int vec = i / D, v = vec >> 1, n = ((vec & 1) ? D : 0) + (i - vec * D);
            float sacc = p.in[5][layer * 6 * D + n]; float pv[KS_ADA];
#pragma unroll
            for (int kc = 0; kc < KS_ADA; ++kc) pv[kc] = part[((size_t)(layer * KS_ADA + kc) * 2 + v) * (6 * D) + n];
            __builtin_amdgcn_sched_barrier(0);
#pragma unroll
            for (int kc = 0; kc < KS_ADA; ++kc) sacc += pv[kc];
            lmod[i] = sacc; }
        __syncthreads(); }
    LAS float* wrt = (LAS float*)c.lds;
    if (moe) { const float* wr = p.in[20];
        { f32x4 w[8];
#pragma unroll
          for (int u = 0; u < 8; ++u) w[u] = *(const f32x4*)(wr + 4 * (c.tid + u * NTHREADS));
          __builtin_amdgcn_sched_barrier(0);
#pragma unroll
          for (int u = 0; u < 8; ++u) { const int i = c.tid + u * NTHREADS, k = i >> 1, e0 = (i & 1) * 4;
              wrt[(e0 + 0) * D + k] = w[u][0]; wrt[(e0 + 1) * D + k] = w[u][1]; wrt[(e0 + 2) * D + k] = w[u][2]; wrt[(e0 + 3) * D + k] = w[u][3]; } }
        static_assert(D * NE / 4 == 8 * NTHREADS, "router transposition: eight pieces per thread");
        __syncthreads(); }
#define CJ(j) ((((j) + c.wave) & 7) * 256)
    f32x4 A[8], S[8]; int cur_type = -1;
    for (int r = row_lo + gw; r < MT; r += NGW) {
        const f32x4* xr = (const f32x4*)(from_in ? (r < LC ? p.in[2] + (size_t)r * D : p.in[0] + (size_t)(r - LC) * D) : XL + (size_t)r * D) + c.lane;
        const int type = r < LC ? 1 : 0;
        if (type != cur_type) { cur_type = type;
            const float* mv = mod + (size_t)(layer * 2 + type) * (6 * D) + (which ? 3 * D : 0);
#pragma unroll
            for (int j = 0; j < 8; ++j) { const int col = 4 * c.lane + CJ(j);
                const f32x4 gv = *(const f32x4*)(g + col);
                const f32x4 sh = local_mod ? *(const LAS f32x4*)(lmod + (type ? 2 * D : 0) + col) : *(const f32x4*)(mv + col), sc = local_mod ? *(const LAS f32x4*)(lmod + (type ? 3 * D : D) + col) : *(const f32x4*)(mv + D + col);
                A[j] = gv * (sc + 1.f); S[j] = sh; } }
        f32x4 v[8]; float ss = 0.f;
#pragma unroll
        for (int j = 0; j < 8; ++j) v[j] = xr[CJ(j) / 4];
        __builtin_amdgcn_sched_barrier(0);
#pragma unroll
        for (int j = 0; j < 8; ++j) ss += (v[j][0] * v[j][0] + v[j][1] * v[j][1]) + (v[j][2] * v[j][2] + v[j][3] * v[j][3]);
        const float rs = rsqrtf(wave_sum(ss) * (1.f / D) + EPS);
        float amax = 0.f;
#pragma unroll
        for (int j = 0; j < 8; ++j) {
            v[j] = (v[j] * rs) * A[j] + S[j];
            amax = fmaxf(fmaxf(amax, fmaxf(fabsf(v[j][0]), fabsf(v[j][1]))), fmaxf(fabsf(v[j][2]), fabsf(v[j][3]))); }
#pragma unroll
        for (int o = 1; o < 64; o <<= 1) amax = fmaxf(amax, __shfl_xor(amax, o));
        const float inv = amax > 0.f ? 127.f / amax : 0.f;
        unsigned* o4 = (unsigned*)(HN + (size_t)r * D) + c.lane;
#pragma unroll
        for (int j = 0; j < 8; ++j) o4[CJ(j) / 4] = pack4i8(v[j][0] * inv, v[j][1] * inv, v[j][2] * inv, v[j][3] * inv);
        if (c.lane == 0) HSC[r] = amax * (1.f / 127.f);
        if (moe) {
            float lg[NE];
#pragma unroll
            for (int e = 0; e < NE; ++e) { float a = 0.f;
#pragma unroll
                for (int j = 0; j < 8; ++j) { const f32x4 w = *(const LAS f32x4*)(wrt + e * D + 4 * c.lane + CJ(j)); a += (v[j][0] * w[0] + v[j][1] * w[1]) + (v[j][2] * w[2] + v[j][3] * w[3]); }
                lg[e] = a; }
#pragma unroll
            for (int e = 0; e < NE; ++e) lg[e] = wave_sum(lg[e]);
            int e0 = 0; float m0 = lg[0];
#pragma unroll
            for (int e = 1; e < NE; ++e) if (lg[e] > m0) { m0 = lg[e]; e0 = e; }
            int e1 = -1; float m1 = -3.0e38f;
#pragma unroll
            for (int e = 0; e < NE; ++e) if (e != e0 && lg[e] > m1) { m1 = lg[e]; e1 = e; }
            if (c.lane == 0) { const int t = r - LC; const float b = expf(m1 - m0), inv = 1.f / (1.f + b);
                int* sel = (int*)(p.ws + WS_SEL); float* gwt = (float*)(p.ws + WS_GW);
                sel[2 * t] = e0; sel[2 * t + 1] = e1; gwt[2 * t] = inv; gwt[2 * t + 1] = b * inv; }
        }
    }
#undef CJ
}
__device__ __forceinline__ void conv_pass(const Params& p, const Ctx& c, int layer, int row_lo) {
    const bf16* U = (const bf16*)(p.ws + WS_MIX + MX_U); const bf16* CBp = (const bf16*)(p.ws + WS_MIX + MX_CB); bf16* V2 = (bf16*)(p.ws + WS_MIX + MX_V2);
    const float* wc = p.in[12] + (size_t)layer * 3 * CW;
    const int gw = c.vcu * NWAVES + c.wave, NGW = c.G * NWAVES, nitems = ((MT - row_lo) / 16) * 4;
    for (int it = gw; it < nitems; it += NGW) {
        const int q = it & 3, r0 = row_lo + (it >> 2) * 16, ch = q * 512 + c.lane * 8;
        const int lo = r0 < LC ? 0 : LC, hi = r0 < LC ? LC : MT;
        const f32x4 w0a = *(const f32x4*)(wc + ch), w0b = *(const f32x4*)(wc + ch + 4), w1a = *(const f32x4*)(wc + CW + ch), w1b = *(const f32x4*)(wc + CW + ch + 4), w2a = *(const f32x4*)(wc + 2 * CW + ch), w2b = *(const f32x4*)(wc + 2 * CW + ch + 4);
        unsigned zu = 0u; asm volatile("" : "+v"(zu)); const u32x4 zq = {zu, zu, zu, zu};
        u32x4 ur[18], gr[16];
#pragma unroll
        for (int i = 0; i < 18; ++i) { const int r = r0 - 1 + i; ur[i] = (r >= lo && r < hi) ? *(const u32x4*)(U + (size_t)r * CW + ch) : zq; }
#pragma unroll
        for (int i = 0; i < 16; ++i) gr[i] = *(const u32x4*)(CBp + (size_t)(r0 + i) * CW + ch);
#pragma unroll
        for (int i = 0; i < 16; ++i) { f32x4 pa, pb, ca, cb, na, nb, ga, gb;
            unpack8(ur[i], pa, pb); unpack8(ur[i + 1], ca, cb); unpack8(ur[i + 2], na, nb); unpack8(gr[i], ga, gb);
            const f32x4 ya = ga * (w0a * pa + w1a * ca + w2a * na), yb = gb * (w0b * pb + w1b * cb + w2b * nb);
            *(u32x4*)(V2 + (size_t)(r0 + i) * CW + ch) = pack8(ya, yb); }
    }
}
__device__ __forceinline__ void moe_counts(const Params& p, const Ctx& c) {
    const int* sel = (const int*)(p.ws + WS_SEL);
    LAS int* H = (LAS int*)c.lds;
    LAS int* tot = (LAS int*)(c.lds + 16384);
    LAS int* lctl = (LAS int*)(c.lds + LCTL_OFF);
    { int h[NE];
#pragma unroll
      for (int e = 0; e < NE; ++e) h[e] = 0;
#pragma unroll
      for (int i = 0; i < 8; ++i) { const int4 v = *(const int4*)(sel + c.tid * 32 + i * 4);
#pragma unroll
          for (int e = 0; e < NE; ++e) h[e] += (v.x == e) + (v.y == e) + (v.z == e) + (v.w == e); }
#pragma unroll
      for (int e = 0; e < NE; ++e) H[c.tid * 8 + e] = h[e]; }
    __syncthreads();
    { int s = 0;
#pragma unroll
      for (int i = 0; i < 8; ++i) s += H[(c.lane * 8 + i) * 8 + c.wave];
#pragma unroll
      for (int o = 1; o < 64; o <<= 1) s += __shfl_xor(s, o);
      if (c.lane == 0) tot[c.wave] = s; }
    __syncthreads();
    if (c.tid == 0) { int off = 0;
#pragma unroll
        for (int e = 0; e < NE; ++e) { lctl[128 + e] = off; off += (tot[e] + 255) >> 8; }
        lctl[128 + NE] = off; lctl[16] = off;
        int M = 0, nrt = 0, rb = 0;
        for (int e = 0; e < NE; ++e) { const int cnt = tot[e], first = lctl[128 + e], nf = cnt >> 8;
            for (int t = 0; t < nf; ++t) lctl[176 + M++] = first + t;
            lctl[288 + e] = cnt & 255; }
        for (int it = 0; it < NE && M < 64; ++it) { int be = -1, bv = 0;
            for (int e = 0; e < NE; ++e) { const int v = lctl[288 + e]; if (v > bv) { bv = v; be = e; } }
            if (be < 0) break;
            lctl[176 + M++] = lctl[128 + be] + (tot[be] >> 8); lctl[288 + be] = 0; }
        for (int e = 0; e < NE; ++e) { const int v = lctl[288 + e]; if (v > 0) { lctl[256 + nrt] = lctl[128 + e] + (tot[e] >> 8); lctl[272 + nrt] = rb; rb += (v + 31) >> 5; ++nrt; } }
        lctl[272 + nrt] = rb; lctl[17] = M; lctl[18] = rb; lctl[19] = nrt; }
    __syncthreads();
    if (c.tid < MAXT) { int e = 0;
#pragma unroll
        for (int x = 1; x < NE; ++x) e += (c.tid >= lctl[128 + x]) ? 1 : 0;
        lctl[32 + c.tid] = e; }
    __syncthreads();
}
__device__ __forceinline__ void moe_route(const Params& p, const Ctx& c) {
    const int* sel = (const int*)(p.ws + WS_SEL); int* slot = (int*)(p.ws + WS_SLOT);
    const unsigned char* HN = p.ws + WS_HN; unsigned char* XS = p.ws + WS_MIX + FX_XS; const float* HSC = (const float*)(p.ws + WS_HSC); float* XSC = (float*)(p.ws + WS_XSC);
    LAS int* H = (LAS int*)c.lds; LAS int* tot = (LAS int*)(c.lds + 16384); LAS int* lctl = (LAS int*)(c.lds + LCTL_OFF);
    for (int b = c.bid; b < 2 * SEQ / 64; b += c.G) {
        { int s = 0;
#pragma unroll
          for (int i = 0; i < 8; ++i) { const int t = c.lane * 8 + i; s += (t < 2 * b) ? H[t * 8 + c.wave] : 0; }
#pragma unroll
          for (int o = 1; o < 64; o <<= 1) s += __shfl_xor(s, o);
          if (c.lane == 0) tot[8 + c.wave] = s; }
        __syncthreads();
        if (c.wave == 0) { const int a = 64 * b + c.lane, e = sel[a]; int rank = 0;
#pragma unroll
            for (int x = 0; x < NE; ++x) { const unsigned long long m = __ballot(e == x); if (e == x) rank = tot[8 + x] + __popcll(m & ((1ull << c.lane) - 1ull)); }
            const int s = 256 * lctl[128 + e] + rank; slot[a] = s; tot[16 + c.lane] = s; }
        __syncthreads();
        { u32x4 v0[8], v1[8]; float sc[8]; int ss[8];
#pragma unroll
          for (int i = 0; i < 8; ++i) { const int j = c.wave * 8 + i, a = 64 * b + j, tok = a >> 1; ss[i] = tot[16 + j];
              const u32x4* src = (const u32x4*)(HN + (size_t)(LC + tok) * D) + c.lane; v0[i] = src[0]; v1[i] = src[64]; sc[i] = HSC[LC + tok]; }
#pragma unroll
          for (int i = 0; i < 8; ++i) { u32x4* dst = (u32x4*)(XS + (size_t)ss[i] * D) + c.lane; dst[0] = v0[i]; dst[64] = v1[i]; if (c.lane == 0) XSC[ss[i]] = sc[i]; } }
        __syncthreads();
    }
}
__device__ __forceinline__ void final_pass(const Params& p, const Ctx& c) {
    const float* XL = (const float*)(p.ws + WS_XL); const bf16* YS = (const bf16*)(p.ws + WS_MIX + FX_YS);
    const int* slot = (const int*)(p.ws + WS_SLOT); const float* gwt = (const float*)(p.ws + WS_GW);
    const float* gt2 = (const float*)(p.ws + WS_MOD) + (size_t)2 * (6 * D) + 5 * D; const float* gf = p.in[24];
    const int gw = c.vcu * NWAVES + c.wave, NGW = c.G * NWAVES;
#define CJ(j) ((((j) + c.wave) & 7) * 64)
    f32x4 G2[8], GF[8];
#pragma unroll
    for (int j = 0; j < 8; ++j) { G2[j] = *(const f32x4*)(gt2 + 4 * c.lane + 4 * CJ(j)); GF[j] = *(const f32x4*)(gf + 4 * c.lane + 4 * CJ(j)); }
    int s0n = 0, s1n = 0; float g0n = 0.f, g1n = 0.f;
    if (gw < SEQ) { s0n = slot[2 * gw]; s1n = slot[2 * gw + 1]; g0n = gwt[2 * gw]; g1n = gwt[2 * gw + 1]; }
    for (int t = gw; t < SEQ; t += NGW) {
        const int s0 = s0n, s1 = s1n; const float g0 = g0n, g1 = g1n;
        if (t + NGW < SEQ) { const int tn = t + NGW; s0n = slot[2 * tn]; s1n = slot[2 * tn + 1]; g0n = gwt[2 * tn]; g1n = gwt[2 * tn + 1]; }
        const f32x4* xr = (const f32x4*)(XL + (size_t)(LC + t) * D) + c.lane;
        const u32x2* y0 = (const u32x2*)(YS + (size_t)s0 * D) + c.lane; const u32x2* y1 = (const u32x2*)(YS + (size_t)s1 * D) + c.lane;
        f32x4 xv[8]; u32x2 ya[8], yb[8];
#pragma unroll
        for (int j = 0; j < 8; ++j) { xv[j] = xr[CJ(j)]; ya[j] = y0[CJ(j)]; yb[j] = y1[CJ(j)]; }
        __builtin_amdgcn_sched_barrier(0);
        f32x4 v[8]; float ss = 0.f;
#pragma unroll
        for (int j = 0; j < 8; ++j) {
            v[j] = xv[j] + G2[j] * (unpack4(ya[j]) * g0 + unpack4(yb[j]) * g1);
            ss += (v[j][0] * v[j][0] + v[j][1] * v[j][1]) + (v[j][2] * v[j][2] + v[j][3] * v[j][3]); }
        const float rs = rsqrtf(wave_sum(ss) * (1.f / D) + EPS);
        f32x4* o = (f32x4*)(p.out + (size_t)t * D) + c.lane;
#pragma unroll
        for (int j = 0; j < 8; ++j) o[CJ(j)] = v[j] * rs * GF[j];
    }
#undef CJ
}


template <class Items, class Epi>
__device__ __forceinline__ void small_gemm(const Ctx& c, int n_items, const Items& I, int lda, int ldb, int K, const Epi& E) {
    int tid = c.tid; asm volatile("" : "+v"(tid));
    const int lane = tid & 63, wid = __builtin_amdgcn_readfirstlane(tid >> 6), fr = lane & 15, fq = lane >> 4, wr = wid >> 2, wc = wid & 3;
    constexpr int STG = 24576, NSTG = 4;
    const int nk = K / 128;
    for (int j = c.vcu; j < n_items; j += c.G) {
        const bf16* Ab; const bf16* Bb; int mb, nb; I(j, Ab, Bb, mb, nb);
        const int sA = wid * 64 + lane, rA = sA >> 4, cA = (sA & 15) ^ (rA & 15);
        const bf16* gA = Ab + (size_t)rA * lda + cA * 8;
        const bf16* gB0 = Bb + (size_t)rA * ldb + cA * 8;
        const bf16* gB1 = gB0 + (size_t)32 * ldb;
        LAS unsigned char* lw = c.lds + wid * 1024;
#define CG_STAGE(t) do { const int kk_ = ((t) < nk ? (t) : nk - 1) * 128; LAS unsigned char* d_ = lw + ((t) & (NSTG - 1)) * STG; \
        __builtin_amdgcn_global_load_lds((const unsigned*)(gA + kk_), (LAS unsigned*)(d_), 16, 0, 0); \
        __builtin_amdgcn_global_load_lds((const unsigned*)(gB0 + kk_), (LAS unsigned*)(d_ + 8192), 16, 0, 0); \
        __builtin_amdgcn_global_load_lds((const unsigned*)(gB1 + kk_), (LAS unsigned*)(d_ + 16384), 16, 0, 0); } while (0)
        CG_STAGE(0); CG_STAGE(1); CG_STAGE(2);
        const int ra = (wr * 16 + fr) * 256, rb = 8192 + (wc * 16 + fr) * 256;
        float zf = 0.f; asm volatile("" : "+v"(zf));
        f32x4 acc0 = {zf, zf, zf, zf}, acc1 = acc0;
#pragma unroll 1
        for (int t = 0; t < nk; ++t) {
            asm volatile("s_waitcnt vmcnt(6)\n\ts_barrier" ::: "memory");
            CG_STAGE(t + 3);
            const LAS unsigned char* sb = c.lds + (t & (NSTG - 1)) * STG;
            bf16x8 af[4], bf[4];
#pragma unroll
            for (int ks = 0; ks < 4; ++ks) { const int pc = ((4 * ks + fq) ^ fr) * 16; af[ks] = *(const LAS bf16x8*)(sb + ra + pc); bf[ks] = *(const LAS bf16x8*)(sb + rb + pc); }
            acc0 = __builtin_amdgcn_mfma_f32_16x16x32_bf16(bf[0], af[0], acc0, 0, 0, 0);
            acc1 = __builtin_amdgcn_mfma_f32_16x16x32_bf16(bf[1], af[1], acc1, 0, 0, 0);
            acc0 = __builtin_amdgcn_mfma_f32_16x16x32_bf16(bf[2], af[2], acc0, 0, 0, 0);
            acc1 = __builtin_amdgcn_mfma_f32_16x16x32_bf16(bf[3], af[3], acc1, 0, 0, 0);
        }
#undef CG_STAGE
        asm volatile("s_waitcnt vmcnt(0)\n\ts_barrier" ::: "memory");
        E(mb + wr * 16 + fr, nb + wc * 16 + 4 * fq, acc0 + acc1);
    }
}
struct CtxItems { const bf16* A; const bf16* Bt; int lda, ldb;
    __device__ __forceinline__ void operator()(int j, const bf16*& Ab, const bf16*& Bb, int& mb, int& nb) const { mb = (j >> 5) * 32; nb = (j & 31) * 64; Ab = A + (size_t)mb * lda; Bb = Bt + (size_t)nb * ldb; } };
template <class Epi>
__device__ __forceinline__ void ctx_gemm(const Ctx& c, const bf16* A, int lda, const bf16* Bt, int ldb, int K, const Epi& E) { small_gemm(c, 256, CtxItems{A, Bt, lda, ldb}, lda, ldb, K, E); }
struct MoeTailItems { const bf16* A; const bf16* W; size_t estride; const LAS int* lctl;
    __device__ __forceinline__ void operator()(int j, const bf16*& Ab, const bf16*& Bb, int& mb, int& nb) const {
        const int q = j >> 5, nrt = lctl[19]; int k = 0;
#pragma unroll
        for (int x = 1; x < NE; ++x) k += (x < nrt && q >= lctl[272 + x]) ? 1 : 0;
        k = __builtin_amdgcn_readfirstlane(k);
        const int tile = __builtin_amdgcn_readfirstlane(lctl[256 + k]), rb = q - __builtin_amdgcn_readfirstlane(lctl[272 + k]), e = __builtin_amdgcn_readfirstlane(lctl[32 + tile]);
        mb = tile * 256 + rb * 32; nb = (j & 31) * 64; Ab = A + (size_t)mb * DFE; Bb = W + (size_t)e * estride + (size_t)nb * DFE; } };
struct CtxStoreBf16 { bf16* OUT; int ld;
    __device__ __forceinline__ void operator()(int row, int col, f32x4 acc) const { u32x2 w; w.x = cvtpk(acc[0], acc[1]); w.y = cvtpk(acc[2], acc[3]); *(u32x2*)(OUT + (size_t)row * ld + col) = w; } };
template <int MODE> struct CtxMerge { const bf16* SG; const bf16* M1; bf16* OUT;
    __device__ __forceinline__ void operator()(int row, int col, f32x4 acc) const { const size_t off = (size_t)row * D + col;
        f32x4 v = acc * unpack4(*(const u32x2*)(SG + off)); if (MODE == 1) v += unpack4(*(const u32x2*)(M1 + off));
        u32x2 w; w.x = cvtpk(v[0], v[1]); w.y = cvtpk(v[2], v[3]); *(u32x2*)(OUT + off) = w; } };
struct CtxResid { float* XL; const float* SRC; const float* gate;
    __device__ __forceinline__ void operator()(int row, int col, f32x4 acc) const { const size_t o = (size_t)row * D + col; *(f32x4*)(XL + o) = *(const f32x4*)(SRC + o) + *(const f32x4*)(gate + col) * acc; } };

constexpr int N_PHASES = 22;
__global__ void __launch_bounds__(NTHREADS, 2) mega(Params p) {
    extern __shared__ __attribute__((aligned(16))) unsigned char lds_raw[];
    Ctx c0; c0.lds = (LAS unsigned char*)lds_raw; c0.tid = threadIdx.x; c0.lane = c0.tid & 63; c0.wave = __builtin_amdgcn_readfirstlane(c0.tid >> 6);
    c0.G = gridDim.x; c0.bid = blockIdx.x; c0.vcu = (c0.G % 8 == 0) ? (c0.bid % 8) * (c0.G / 8) + c0.bid / 8 : c0.bid;
    { const Ctx& c = c0; unsigned char* ws = p.ws;
    for (int u = c.tid; u < (LDS_BYTES - LCTL_OFF) / 4; u += NTHREADS) ((LAS unsigned*)(c.lds + LCTL_OFF))[u] = 0u;
    __syncthreads();
    }
    XcdBarrier bar = xcd_barrier_post((unsigned*)(p.ws + WS_CTL) + 4096, (volatile LAS unsigned*)(c0.lds + LCTL_OFF));
    const int lo = p.ph_lo, hi = p.ph_hi;
#ifndef MK_EN
#define MK_EN 0xFFFFFF
#endif
#define EN(j) (((MK_EN) >> (j)) & 1)
#ifndef MK_DUP
#define MK_DUP 0
#endif
#define NREP(j) ((((MK_DUP) >> (j)) & 1) ? 2 : 1)
#define IN(k) (lo <= (k) && (k) < hi)
#define SEAM(k) do { if (IN(k) && IN((k) + 1)) xcd_barrier(bar); } while (0)
#define PH_BEGIN const Ctx c = fresh(c0); unsigned char* ws = fresh_ptr(p.ws); unsigned char* wb = ws + WS_W; unsigned char* mx = ws + WS_MIX; const float* mod = (const float*)(ws + WS_MOD); (void)wb; (void)mx; (void)mod;
    for (int rep_ = 0; rep_ < NREP(20); ++rep_) if (EN(20) && IN(0)) { if (rep_) { xcd_barrier(bar); if (c0.bid == 0 && c0.tid == 0) __hip_atomic_store((unsigned*)(p.ws + WS_CTL) + CW_QHEAD, 0u, __ATOMIC_RELAXED, __HIP_MEMORY_SCOPE_AGENT); xcd_barrier(bar); } PH_BEGIN p0_prologue(p, c); } SEAM(0);
#if defined(MK_XBAR)
    for (int xb_ = 0; xb_ < 16; ++xb_) xcd_barrier(bar);
#endif
#pragma unroll
    for (int layer = 0; layer < DEPTH; ++layer) {
        const int P = 2 + 9 * layer; const bool last = (layer == DEPTH - 1);
        const int pm0 = last ? 1 : 0, nM = last ? 32 : 33;
        for (int rep_ = 0; rep_ < NREP(0); ++rep_) if (EN(0) && IN(P + 0)) { if (rep_) xcd_barrier(bar); PH_BEGIN if (layer == 0) p1_mod(p, c); norm_pass(p, c, layer, 0, 0, false, layer == 0); } SEAM(P + 0);
        for (int rep_ = 0; rep_ < NREP(1); ++rep_) if (EN(1) && IN(P + 1)) { if (rep_) xcd_barrier(bar); PH_BEGIN
            pg8::Geo g{D / 2, D / 2, D / 2};
            pg8::TileOrder S{nM, NT_IN, pm0, c.G, c.bid, last ? 3 : 0, 0, 2, (const char*)(ws + WS_HN), (const char*)(wb + W_IN + layer * W_IN_L), (size_t)256 * D, (size_t)256 * D, (const float*)(ws + WS_HSC), (const float*)(ws + WS_WSC) + SC_IN + layer * NIN};
            pg8::EpiInproj E{(bf16*)(mx + MX_QC), (bf16*)(mx + MX_KRB), (bf16*)(mx + MX_U), (bf16*)(mx + MX_CB), (float*)(mx + MX_SSQ), (const float*)(ws + WS_ROPE)};
            pg8::gemm_phase<pg8::EpiInproj, pg8::TileOrder, true, true>(c.lds, g, S, E);
        } SEAM(P + 1);
        for (int rep_ = 0; rep_ < NREP(2); ++rep_) if (EN(2) && IN(P + 2)) { if (rep_) xcd_barrier(bar); PH_BEGIN
            pg8::Geo g{1024, 512, 512};
            pg8::QkvOrder S{33, nM, pm0, c.G, c.bid, (const char*)(mx + MX_QC), (const char*)(wb + W_QB + layer * W_QB_L), (long)(W_KVB + layer * W_KVB_L) - (long)(W_QB + layer * W_QB_L)};
            pg8::EpiQkv E{(bf16*)(mx + MX_Q), (bf16*)(mx + MX_KV), (const float*)(mx + MX_SSQ), (const float*)(ws + WS_ROPE)};
            pg8::gemm_phase<pg8::EpiQkv, pg8::QkvOrder, true>(c.lds, g, S, E);
            conv_pass(p, c, layer, pm0 * 256);
        } SEAM(P + 2);
        for (int rep_ = 0; rep_ < NREP(3); ++rep_) if (EN(3) && IN(P + 3)) { if (rep_) xcd_barrier(bar); PH_BEGIN
            const bf16* Q = (const bf16*)(mx + MX_Q); const bf16* KV = (const bf16*)(mx + MX_KV); const bf16* KR = (const bf16*)(mx + MX_KRB); bf16* O = (bf16*)(mx + MX_O);
            for (int i = 0;; ++i) { const int u = i * c.G + c.vcu; if (u >= NH * 32) break;
                const int h = u >> 5, q0 = LC + 256 * (u & 31);
                att::attn_unit(Q + (size_t)q0 * att::LDQ + h * DQK, KV, h * 512, KR, O + (size_t)q0 * D + h * DV, MT, (LAS char*)c.lds); }
            if (!last) for (int i = 0;; ++i) { const int h = i * c.G + c.vcu; if (h >= NH) break;
                att::attn_unit(Q + h * DQK, KV, h * 512, KR, O + h * DV, LC, (LAS char*)c.lds); }
            pg8::Geo g{D, D, D};
            pg8::TileOrder S{32, 8, 1, c.G, c.bid, 0, 0, 0, (const char*)(mx + MX_V2), (const char*)(wb + W_OB + layer * W_SQ_L), (size_t)256 * D * 2, (size_t)256 * D * 2, nullptr, nullptr};
            pg8::EpiMerge<0> E{(const bf16*)(mx + MX_SGB), nullptr, (bf16*)(mx + MX_M1)};
            pg8::gemm_phase<pg8::EpiMerge<0>, pg8::TileOrder, true>(c.lds, g, S, E);
            if (!last) ctx_gemm(c, (const bf16*)(mx + MX_V2), D, (const bf16*)(wb + W_OB + layer * W_SQ_L), D, D, CtxMerge<0>{(const bf16*)(mx + MX_SGB), nullptr, (bf16*)(mx + MX_M1)});
        } SEAM(P + 3);
        for (int rep_ = 0; rep_ < NREP(4); ++rep_) if (EN(4) && IN(P + 4)) { if (rep_) xcd_barrier(bar); PH_BEGIN
            pg8::Geo g{D, D, D};
            pg8::TileOrder S{32, 8, 1, c.G, c.bid, 0, 0, 0, (const char*)(mx + MX_O), (const char*)(wb + W_OA + layer * W_SQ_L), (size_t)256 * D * 2, (size_t)256 * D * 2, nullptr, nullptr};
            pg8::EpiMerge<1> E{(const bf16*)(mx + MX_SGA), (const bf16*)(mx + MX_M1), (bf16*)(mx + MX_MG)};
            pg8::gemm_phase<pg8::EpiMerge<1>, pg8::TileOrder, true>(c.lds, g, S, E);
            if (!last) ctx_gemm(c, (const bf16*)(mx + MX_O), D, (const bf16*)(wb + W_OA + layer * W_SQ_L), D, D, CtxMerge<1>{(const bf16*)(mx + MX_SGA), (const bf16*)(mx + MX_M1), (bf16*)(mx + MX_MG)});
        } SEAM(P + 4);
        for (int rep_ = 0; rep_ < 1; ++rep_) if (EN(5) && IN(P + 5)) { PH_BEGIN
            pg8::Geo g{D, D, D};
            pg8::TileOrder S{32, 8, 1, c.G, c.bid, 0, 0, 0, (const char*)(mx + MX_MG), (const char*)(wb + W_O + layer * W_SQ_L), (size_t)256 * D * 2, (size_t)256 * D * 2, nullptr, nullptr};
            pg8::EpiResid E{(float*)(ws + WS_XL), layer == 0 ? p.in[0] - (size_t)LC * D : (const float*)(ws + WS_XL), mod + (size_t)(2 * layer) * (6 * D) + 2 * D};
            pg8::gemm_phase<pg8::EpiResid, pg8::TileOrder, true>(c.lds, g, S, E);
            if (!last) ctx_gemm(c, (const bf16*)(mx + MX_MG), D, (const bf16*)(wb + W_O + layer * W_SQ_L), D, D, CtxResid{(float*)(ws + WS_XL), p.in[2], mod + (size_t)(2 * layer + 1) * (6 * D) + 2 * D});
        } SEAM(P + 5);
        for (int rep_ = 0; rep_ < NREP(6); ++rep_) if (EN(6) && IN(P + 6)) { if (rep_) xcd_barrier(bar); PH_BEGIN norm_pass(p, c, layer, 1, pm0 * 256, last, false); } SEAM(P + 6);
        if (!last) {
            for (int rep_ = 0; rep_ < NREP(7); ++rep_) if (EN(7) && IN(P + 7)) { if (rep_) xcd_barrier(bar); PH_BEGIN
                pg8::Geo g{D / 2, D / 2, D / 2};
                pg8::TileOrder S{nM, 2 * DFF / 256, pm0, c.G, c.bid, 0, 0, 0, (const char*)(ws + WS_HN), (const char*)(wb + W_GU), (size_t)256 * D, (size_t)256 * D, (const float*)(ws + WS_HSC), (const float*)(ws + WS_WSC) + SC_GU};
                pg8::EpiSwiglu E{(bf16*)(mx + FX_ACT), DFF};
                pg8::gemm_phase<pg8::EpiSwiglu, pg8::TileOrder, true, true>(c.lds, g, S, E);
            } SEAM(P + 7);
            for (int rep_ = 0; rep_ < 1; ++rep_) if (EN(8) && IN(P + 8)) { PH_BEGIN
                pg8::Geo g{DFF, DFF, DFF};
                pg8::TileOrder S{32, 8, 1, c.G, c.bid, 0, 0, 0, (const char*)(mx + FX_ACT), (const char*)(wb + W_DD), (size_t)256 * DFF * 2, (size_t)256 * DFF * 2, nullptr, nullptr};
                pg8::EpiResid E{(float*)(ws + WS_XL), (const float*)(ws + WS_XL), mod + (size_t)(2 * layer) * (6 * D) + 5 * D};
                pg8::gemm_phase<pg8::EpiResid, pg8::TileOrder, true>(c.lds, g, S, E);
                ctx_gemm(c, (const bf16*)(mx + FX_ACT), DFF, (const bf16*)(wb + W_DD), DFF, DFF, CtxResid{(float*)(ws + WS_XL), (const float*)(ws + WS_XL), mod + (size_t)(2 * layer + 1) * (6 * D) + 5 * D});
            } SEAM(P + 8);
        } else {
            const LAS int* lctl = (const LAS int*)(c0.lds + LCTL_OFF);
            for (int rep_ = 0; rep_ < NREP(7); ++rep_) if (EN(7) && IN(P + 7)) { if (rep_) xcd_barrier(bar); PH_BEGIN moe_counts(p, c); moe_route(p, c); } SEAM(P + 7);
            for (int rep_ = 0; rep_ < NREP(8); ++rep_) if (EN(8) && IN(P + 8)) { if (rep_) xcd_barrier(bar); PH_BEGIN
                if (!IN(P + 7)) moe_counts(p, c);
                const int T = __builtin_amdgcn_readfirstlane(lctl[16]);
                pg8::Geo g{D / 2, D / 2, D / 2};
                pg8::MoeOrder S{T, 2 * DFE / 256, c.G, c.bid, (const char*)(mx + FX_XS), (const char*)(wb + W_GUE), (size_t)256 * D, (size_t)256 * D, W_GUE_E, lctl + 32, (const float*)(ws + WS_XSC), (const float*)(ws + WS_WSC) + SC_GUE, 2 * DFE, nullptr};
                pg8::EpiSwiglu E{(bf16*)(mx + FX_ACTE), DFE};
                pg8::gemm_phase<pg8::EpiSwiglu, pg8::MoeOrder, true, true>(c.lds, g, S, E);
            } SEAM(P + 8);
            for (int rep_ = 0; rep_ < NREP(9); ++rep_) if (EN(9) && IN(P + 9)) { if (rep_) xcd_barrier(bar); PH_BEGIN
                if (!IN(P + 7)) moe_counts(p, c);
                const int M = __builtin_amdgcn_readfirstlane(lctl[17]), NRB = __builtin_amdgcn_readfirstlane(lctl[18]);
                pg8::Geo g{DFE, DFE, DFE};
                pg8::MoeOrder S{M, 8, c.G, c.bid, (const char*)(mx + FX_ACTE), (const char*)(wb + W_DE), (size_t)256 * DFE * 2, (size_t)256 * DFE * 2, W_DE_E, lctl + 32, nullptr, nullptr, 0, lctl + 176};
                pg8::EpiStoreBf16 E{(bf16*)(mx + FX_YS), D};
                pg8::gemm_phase<pg8::EpiStoreBf16, pg8::MoeOrder, true>(c.lds, g, S, E);
                small_gemm(c, NRB * 32, MoeTailItems{(const bf16*)(mx + FX_ACTE), (const bf16*)(wb + W_DE), (size_t)(W_DE_E / 2), lctl}, DFE, DFE, DFE, CtxStoreBf16{(bf16*)(mx + FX_YS), D});
            } SEAM(P + 9);
            for (int rep_ = 0; rep_ < NREP(10); ++rep_) if (EN(10) && IN(P + 10)) { if (rep_) xcd_barrier(bar); PH_BEGIN final_pass(p, c); }
        }
    }
#undef IN
#undef SEAM
}

static void forward(void* const* d_in, float* out, void* d_ws, size_t ws_size, hipStream_t st, int n_launches) {
    static int grid = 0;
    if (grid == 0) {
        if (ws_size < WS_END) { fprintf(stderr, "mk::forward: workspace too small (%zu < %zu)\n", ws_size, (size_t)WS_END); grid = -1; return; }
        int dev = 0, cus = 0;
        if (hipGetDevice(&dev) != hipSuccess || hipDeviceGetAttribute(&cus, hipDeviceAttributeMultiprocessorCount, dev) != hipSuccess) { grid = -1; return; }
        if (hipFuncSetAttribute((const void*)mega, hipFuncAttributeMaxDynamicSharedMemorySize, LDS_BYTES) != hipSuccess) { fprintf(stderr, "mk::forward: hipFuncSetAttribute failed\n"); grid = -1; return; }
        int per_cu = 0; (void)hipOccupancyMaxActiveBlocksPerMultiprocessor(&per_cu, (const void*)mega, NTHREADS, LDS_BYTES); (void)hipGetLastError();
        grid = cus;
    }
    if (grid < 0) return;
    (void)hipMemsetAsync((char*)d_ws + WS_CTL, 0, CTL_BYTES, st);
    Params p{};
    for (int i = 0; i < 25; ++i) p.in[i] = (const float*)d_in[i];
    p.out = out; p.ws = (unsigned char*)d_ws;
    if (n_launches == 1) { p.ph_lo = 0; p.ph_hi = N_PHASES; hipLaunchKernelGGL(mega, dim3(grid), dim3(NTHREADS), LDS_BYTES, st, p); }
    else for (int k = 0; k < N_PHASES; ++k) { p.ph_lo = k; p.ph_hi = k + 1; hipLaunchKernelGGL(mega, dim3(grid), dim3(NTHREADS), LDS_BYTES, st, p); }
    const hipError_t le = hipPeekAtLastError();
    if (le != hipSuccess) fprintf(stderr, "mk::forward: launch failed: %s\n", hipGetErrorName(le));
}
}

#ifndef MK_LAUNCHES
#define MK_LAUNCHES 1
#endif
#ifndef USE_SLOW
#define USE_SLOW 0
#endif
extern "C" void kernel_launch(void* const* d_in, const int* in_sizes, int n_in, void* d_out, int out_size, void* d_ws, size_t ws_size, hipStream_t stream) {
    if (n_in != 25 || out_size != SEQ * D) { fprintf(stderr, "kernel_launch: unexpected shapes (n_in %d out %d)\n", n_in, out_size); return; }
#if USE_SLOW
    slow::forward(d_in, (float*)d_out, (float*)d_ws, ws_size / 4, stream);
#else
    mk::forward(d_in, (float*)d_out, d_ws, ws_size, stream, MK_LAUNCHES);
#endif
}
```
